# Optimizing an MI355X kernel written in HIP

```python
import math
import jax, jax.numpy as jnp
from jax import lax
import numpy as np

D_MODEL = 2048
BATCH = 8
SEQ = 2048
DEPTH = 4
DEC_BATCH = 32
DEC_SEQ = 64
PAST_LEN = 1024

CHUNK = 64
D_MIX = D_MODEL
A_HEADS = 4
A_HEAD_DIM = 128
A_WIDTH = A_HEADS * A_HEAD_DIM
IDX_HEADS = 16
IDX_DIM = 64
DSA_TOPK = 256
B_HEADS = 4
B_HEAD_DIM = 128
B_WIDTH = B_HEADS * B_HEAD_DIM
B_PREV_CHUNKS = 8
B_WIN = B_PREV_CHUNKS * CHUNK
REL_CLIP = 128
C_WIDTH = D_MIX - A_WIDTH - B_WIDTH
C_HEAD_DIM = 64
C_HEADS = C_WIDTH // C_HEAD_DIM
C_GROUPS = 4
C_STATE = 128
CONV_W = 4
CONV_DIM = C_WIDTH + 2 * C_GROUPS * C_STATE
D_FF = 4 * D_MODEL
ROPE_THETA = 500000.0
EPS = 1e-5

_COLS = (A_WIDTH, A_WIDTH, A_WIDTH, IDX_HEADS * IDX_DIM, IDX_DIM, IDX_HEADS,
         B_WIDTH, B_WIDTH, B_WIDTH,
         C_WIDTH, CONV_DIM, C_HEADS)
SPLIT_OFFSETS = tuple(int(v) for v in np.cumsum(_COLS)[:-1])
IN_COLS = int(sum(_COLS))

kernel_name = "hybrid_stream_dsa_band_ssd_step"


def rms_norm(x, w):
    x32 = x.astype(jnp.float32)
    y = x32 * lax.rsqrt(jnp.mean(x32 * x32, axis=-1, keepdims=True) + EPS)
    return y.astype(x.dtype) * w


def partial_rope(x, pos):
    d = x.shape[-1]
    rot = d // 4
    half = rot // 2
    inv = ROPE_THETA ** (-jnp.arange(half, dtype=jnp.float32) * 2.0 / rot)
    ang = pos.astype(jnp.float32)[:, None] * inv[None, :]
    cos = jnp.cos(ang)[None, :, None, :]
    sin = jnp.sin(ang)[None, :, None, :]
    x32 = x.astype(jnp.float32)
    x1, x2 = x32[..., :half], x32[..., half:rot]
    out = jnp.concatenate([x1 * cos - x2 * sin, x2 * cos + x1 * sin, x32[..., rot:]], axis=-1)
    return out.astype(x.dtype)


def dsa_select_attend(q, qi, wi, k, v, ki, limit, topk):
    S = k.shape[1]
    d = q.shape[-1]
    idx_logits = jnp.einsum('bqhd,bsd->bqhs', qi, ki).astype(jnp.float32) * IDX_DIM ** -0.5
    score = jnp.einsum('bqhs,bqh->bqs', jax.nn.relu(idx_logits), wi.astype(jnp.float32))
    admissible = jnp.arange(S) < limit
    score = jnp.where(admissible[None, None, :], score, -jnp.inf)
    _, sel = lax.top_k(score, topk)
    valid = sel < limit
    kg = jax.vmap(lambda kk, ii: kk[ii])(k, sel)
    vg = jax.vmap(lambda vv, ii: vv[ii])(v, sel)
    logits = jnp.einsum('bqhd,bqkhd->bhqk', q, kg).astype(jnp.float32) * d ** -0.5
    logits = jnp.where(valid[:, None, :, :], logits, -jnp.inf)
    p = jax.nn.softmax(logits, axis=-1).astype(v.dtype)
    return jnp.einsum('bhqk,bqkhd->bqhd', p, vg)


def dsa_prompt(q, qi, wi, k, v, ki):
    b, t = q.shape[:2]
    nc = t // CHUNK
    topk = min(DSA_TOPK, t // 4)

    def one_chunk(c):
        s0 = c * CHUNK
        sl = lambda a: lax.dynamic_slice_in_dim(a, s0, CHUNK, axis=1)
        return dsa_select_attend(sl(q), sl(qi), sl(wi), k, v, ki, s0 + CHUNK, topk)

    o = lax.map(one_chunk, jnp.arange(nc))
    return jnp.moveaxis(o, 0, 1).reshape(b, t, A_HEADS, A_HEAD_DIM)


def dsa_sample(q, qi, wi, k, v, ki):
    L = k.shape[1]
    topk = min(DSA_TOPK, L // 4)

    def one_seq(a):
        return dsa_select_attend(*[z[None] for z in a], L, topk)[0]

    return lax.map(one_seq, (q, qi, wi, k, v, ki))


def rel_bias(table, rel):
    return table[:, jnp.clip(rel, -REL_CLIP, REL_CLIP) + REL_CLIP]


def band_attn_prompt(q, k, v, table):
    b, t, h, d = q.shape
    nc = t // CHUNK
    nb = B_PREV_CHUNKS + 1
    qc = q.reshape(b, nc, CHUNK, h, d)
    pad = ((0, 0), (B_WIN, 0), (0, 0), (0, 0))
    kc = jnp.pad(k, pad).reshape(b, nc + B_PREV_CHUNKS, CHUNK, h, d)
    vc = jnp.pad(v, pad).reshape(b, nc + B_PREV_CHUNKS, CHUNK, h, d)
    band_idx = jnp.arange(nc)[:, None] + jnp.arange(nb)[None, :]
    kb = kc[:, band_idx].reshape(b, nc, nb * CHUNK, h, d)
    vb = vc[:, band_idx].reshape(b, nc, nb * CHUNK, h, d)
    j = jnp.arange(nb * CHUNK)
    rel = (B_WIN + jnp.arange(CHUNK))[:, None] - j[None, :]
    valid = (jnp.arange(nc)[:, None] * CHUNK - B_WIN + j[None, :]) >= 0
    logits = jnp.einsum('bcqhd,bckhd->bchqk', qc, kb).astype(jnp.float32) * d ** -0.5
    logits = logits + rel_bias(table, rel).astype(jnp.float32)[None, None]
    logits = jnp.where(valid[None, :, None, None, :], logits, -jnp.inf)
    p = jax.nn.softmax(logits, axis=-1).astype(v.dtype)
    o = jnp.einsum('bchqk,bckhd->bcqhd', p, vb)
    return o.reshape(b, t, h, d)


def band_attn_sample(q, k_new, v_new, k_buf, v_buf, table):
    t = q.shape[1]
    d = q.shape[-1]
    nbuf = k_buf.shape[1]
    k = jnp.concatenate([k_buf, k_new], axis=1)
    v = jnp.concatenate([v_buf, v_new], axis=1)
    rel = (nbuf + jnp.arange(t))[:, None] - jnp.arange(nbuf + t)[None, :]
    logits = jnp.einsum('bqhd,bkhd->bhqk', q, k).astype(jnp.float32) * d ** -0.5
    logits = logits + rel_bias(table, rel).astype(jnp.float32)[None]
    p = jax.nn.softmax(logits, axis=-1).astype(v.dtype)
    return jnp.einsum('bhqk,bkhd->bqhd', p, v)


def causal_dwconv(x, buf, w, bias):
    t = x.shape[1]
    xp = jnp.concatenate([buf, x], axis=1)
    y = bias + xp[:, 0:t] * w[0]
    for j in range(1, CONV_W):
        y = y + xp[:, j:j + t] * w[j]
    return y, xp[:, -(CONV_W - 1):]


def segsum(a):
    T = a.shape[-1]
    cs = jnp.cumsum(a, axis=-1)
    seg = cs[..., :, None] - cs[..., None, :]
    mask = jnp.tril(jnp.ones((T, T), dtype=bool))
    return jnp.where(mask, seg, -jnp.inf)


def ssd_scan(x, dt, a, bm, cm, h0, block):
    b, L, H, P = x.shape
    nc = L // block
    xd = (x * dt[..., None]).reshape(b, nc, block, H, P)
    ad = (dt * a).reshape(b, nc, block, H).transpose(0, 3, 1, 2)
    bm = bm.reshape(b, nc, block, H, -1)
    cm = cm.reshape(b, nc, block, H, -1)
    a_cs = jnp.cumsum(ad, axis=-1)
    decay_in = jnp.exp(segsum(ad))
    cb = jnp.einsum('bclhn,bcshn->bhcls', cm, bm)
    y_diag = jnp.einsum('bhcls,bcshp->bclhp', cb * decay_in, xd)
    decay_to_end = jnp.exp(a_cs[..., -1:] - a_cs)
    chunk_states = jnp.einsum('bclhn,bhcl,bclhp->bchpn', bm, decay_to_end, xd)
    states = jnp.concatenate([h0[:, None], chunk_states], axis=1)
    chunk_decay = jnp.exp(segsum(jnp.pad(a_cs[..., -1], ((0, 0), (0, 0), (1, 0)))))
    states = jnp.einsum('bhzc,bchpn->bzhpn', chunk_decay, states)
    h_in, h_last = states[:, :-1], states[:, -1]
    y_off = jnp.einsum('bclhn,bchpn,bhcl->bclhp', cm, h_in, jnp.exp(a_cs))
    return (y_diag + y_off).reshape(b, L, H, P), h_last


def ssd_mixer(z, xbc, dt_raw, conv_buf, h0, conv_w, conv_b, dt_bias, a_log, d_skip, gate_norm, block):
    f32 = jnp.float32
    b, t = z.shape[:2]
    xbc_c, new_buf = causal_dwconv(xbc, conv_buf, conv_w, conv_b)
    xbc_c = jax.nn.silu(xbc_c)
    xs, bs, cs = jnp.split(xbc_c, [C_WIDTH, C_WIDTH + C_GROUPS * C_STATE], axis=-1)
    rep = C_HEADS // C_GROUPS
    xs = xs.reshape(b, t, C_HEADS, C_HEAD_DIM).astype(f32)
    bs = jnp.repeat(bs.reshape(b, t, C_GROUPS, C_STATE).astype(f32), rep, axis=2)
    cs = jnp.repeat(cs.reshape(b, t, C_GROUPS, C_STATE).astype(f32), rep, axis=2)
    dt = jax.nn.softplus(dt_raw.astype(f32) + dt_bias.astype(f32))
    a = -jnp.exp(a_log.astype(f32))
    y, h_last = ssd_scan(xs, dt, a, bs, cs, h0.astype(f32), block)
    y = (y + d_skip.astype(f32)[:, None] * xs).reshape(b, t, C_WIDTH)
    g = (y * jax.nn.silu(z.astype(f32))).reshape(b, t, C_GROUPS, C_WIDTH // C_GROUPS)
    g = g * lax.rsqrt(jnp.mean(g * g, axis=-1, keepdims=True) + EPS)
    out = g.reshape(b, t, C_WIDTH).astype(z.dtype) * gate_norm
    return out, h_last.astype(z.dtype), new_buf


def trunk_layer(x, pos, lw, past):
    (norm1, w_in, w_out, b_rel, conv_w, conv_b, dt_bias, a_log, d_skip, gate_norm,
     norm2, w_up, w_down) = lw
    b, t, _ = x.shape
    h = rms_norm(x, norm1)
    proj = jnp.einsum('btd,de->bte', h, w_in)
    aq, ak, av, iq, ik, iw, bq, bk, bv, cz, cxbc, cdt = jnp.split(proj, SPLIT_OFFSETS, axis=-1)
    aq = partial_rope(aq.reshape(b, t, A_HEADS, A_HEAD_DIM), pos)
    ak = partial_rope(ak.reshape(b, t, A_HEADS, A_HEAD_DIM), pos)
    av = av.reshape(b, t, A_HEADS, A_HEAD_DIM)
    iq = partial_rope(iq.reshape(b, t, IDX_HEADS, IDX_DIM), pos)
    ik = partial_rope(ik.reshape(b, t, 1, IDX_DIM), pos)[:, :, 0]
    iw = iw * IDX_HEADS ** -0.5
    bq = bq.reshape(b, t, B_HEADS, B_HEAD_DIM)
    bk = bk.reshape(b, t, B_HEADS, B_HEAD_DIM)
    bv = bv.reshape(b, t, B_HEADS, B_HEAD_DIM)
    if past is None:
        o_a = dsa_prompt(aq, iq, iw, ak, av, ik)
        o_b = band_attn_prompt(bq, bk, bv, b_rel)
        conv_buf = jnp.zeros((b, CONV_W - 1, CONV_DIM), x.dtype)
        h0 = jnp.zeros((b, C_HEADS, C_HEAD_DIM, C_STATE), jnp.float32)
        block = CHUNK
        nkeep = min(B_WIN, t)
        b_k_rows, b_v_rows = bk[:, t - nkeep:], bv[:, t - nkeep:]
    else:
        pk, pv, pki, pbk, pbv, ph, pconv = past
        o_a = dsa_sample(aq, iq, iw,
                         jnp.concatenate([pk, ak], axis=1),
                         jnp.concatenate([pv, av], axis=1),
                         jnp.concatenate([pki, ik], axis=1))
        o_b = band_attn_sample(bq, bk, bv, pbk, pbv, b_rel)
        conv_buf, h0, block = pconv, ph, t
        b_k_rows, b_v_rows = bk, bv
    o_c, h_last, conv_new = ssd_mixer(cz, cxbc, cdt, conv_buf, h0, conv_w, conv_b,
                                      dt_bias, a_log, d_skip, gate_norm, block)
    mix = jnp.concatenate([o_a.reshape(b, t, A_WIDTH), o_b.reshape(b, t, B_WIDTH), o_c], axis=-1)
    x = x + jnp.einsum('bte,ed->btd', mix, w_out)
    u = jax.nn.relu(jnp.einsum('btd,df->btf', rms_norm(x, norm2), w_up))
    x = x + jnp.einsum('btf,fd->btd', jnp.square(u), w_down)
    return x, (ak, av, ik, b_k_rows, b_v_rows, h_last, conv_new)


def stack_states(states):
    return [jnp.stack([s[i] for s in states], axis=0) for i in range(7)]


def setup_inputs(seed: int = 0) -> dict:
    key = jax.random.key(seed)
    ks = jax.random.split(key, 24)
    f32 = jnp.float32

    def nrm(k, shape, s):
        return jax.random.normal(k, shape, f32) * s

    b_cache = min(B_WIN, PAST_LEN)
    dt0 = jnp.exp(jax.random.uniform(ks[15], (DEPTH, C_HEADS), f32, math.log(1e-3), math.log(1e-1)))
    return {
        "x_prompt": nrm(ks[0], (BATCH, SEQ, D_MODEL), 1.0),
        "x_sample": nrm(ks[1], (DEC_BATCH, DEC_SEQ, D_MODEL), 1.0),
        "cache_a_k": nrm(ks[2], (DEPTH, DEC_BATCH, PAST_LEN, A_HEADS, A_HEAD_DIM), 1.0),
        "cache_a_v": nrm(ks[3], (DEPTH, DEC_BATCH, PAST_LEN, A_HEADS, A_HEAD_DIM), 1.0),
        "cache_a_kidx": nrm(ks[4], (DEPTH, DEC_BATCH, PAST_LEN, IDX_DIM), 1.0),
        "cache_b_k": nrm(ks[5], (DEPTH, DEC_BATCH, b_cache, B_HEADS, B_HEAD_DIM), 1.0),
        "cache_b_v": nrm(ks[6], (DEPTH, DEC_BATCH, b_cache, B_HEADS, B_HEAD_DIM), 1.0),
        "state_ssm": nrm(ks[7], (DEPTH, DEC_BATCH, C_HEADS, C_HEAD_DIM, C_STATE), 0.5),
        "state_conv": nrm(ks[8], (DEPTH, DEC_BATCH, CONV_W - 1, CONV_DIM), 1.0),
        "norm1": 1.0 + nrm(ks[9], (DEPTH, D_MODEL), 0.02),
        "w_in": nrm(ks[10], (DEPTH, D_MODEL, IN_COLS), D_MODEL ** -0.5),
        "w_out": nrm(ks[11], (DEPTH, D_MIX, D_MODEL), 0.5 * D_MIX ** -0.5),
        "b_rel": nrm(ks[12], (DEPTH, B_HEADS, 2 * REL_CLIP + 1), 0.1),
        "conv_w": nrm(ks[13], (DEPTH, CONV_W, CONV_DIM), CONV_W ** -0.5),
        "conv_b": nrm(ks[14], (DEPTH, CONV_DIM), 0.01),
        "dt_bias": dt0 + jnp.log(-jnp.expm1(-dt0)),
        "a_log": jnp.log(jax.random.uniform(ks[16], (DEPTH, C_HEADS), f32, 1.0, 16.0)),
        "d_skip": 1.0 + nrm(ks[17], (DEPTH, C_HEADS), 0.1),
        "gate_norm": 1.0 + nrm(ks[18], (DEPTH, C_WIDTH), 0.02),
        "norm2": 1.0 + nrm(ks[19], (DEPTH, D_MODEL), 0.02),
        "w_up": nrm(ks[20], (DEPTH, D_MODEL, D_FF), D_MODEL ** -0.5),
        "w_down": nrm(ks[21], (DEPTH, D_FF, D_MODEL), 0.5 * D_FF ** -0.5),
        "final_norm": 1.0 + nrm(ks[22], (D_MODEL,), 0.02),
    }


def reference(x_prompt, x_sample, cache_a_k, cache_a_v, cache_a_kidx, cache_b_k, cache_b_v,
              state_ssm, state_conv, norm1, w_in, w_out, b_rel, conv_w, conv_b, dt_bias,
              a_log, d_skip, gate_norm, norm2, w_up, w_down, final_norm):
    past_len = cache_a_k.shape[2]
    pos_p = jnp.arange(x_prompt.shape[1])
    pos_s = past_len + jnp.arange(x_sample.shape[1])
    xp, xs = x_prompt, x_sample
    new_p, new_s = [], []
    for l in range(DEPTH):
        lw = (norm1[l], w_in[l], w_out[l], b_rel[l], conv_w[l], conv_b[l], dt_bias[l], a_log[l],
              d_skip[l], gate_norm[l], norm2[l], w_up[l], w_down[l])
        xp, st_p = trunk_layer(xp, pos_p, lw, None)
        past = (cache_a_k[l], cache_a_v[l], cache_a_kidx[l], cache_b_k[l], cache_b_v[l],
                state_ssm[l], state_conv[l])
        xs, st_s = trunk_layer(xs, pos_s, lw, past)
        new_p.append(st_p)
        new_s.append(st_s)
    y_prompt = rms_norm(xp, final_norm)
    y_sample = rms_norm(xs, final_norm)
    p_a_k, p_a_v, p_a_kidx, p_b_k, p_b_v, p_ssm, p_conv = stack_states(new_p)
    s_a_k, s_a_v, s_a_kidx, s_b_k, s_b_v, s_ssm, s_conv = stack_states(new_s)
    return (y_prompt, y_sample, p_a_k, p_a_v, p_a_kidx, p_b_k, p_b_v, p_ssm, p_conv,
            s_a_k, s_a_v, s_a_kidx, s_b_k, s_b_v, s_ssm, s_conv)
```

```cpp
#include <hip/hip_runtime.h>
#include <cstdio>
#include <cstdint>
#include <cstddef>
namespace pg8 {
#define PG8_LAS __attribute__((address_space(3)))
typedef unsigned short bf16_t;
typedef short bf16x8 __attribute__((ext_vector_type(8)));
typedef float f32x4 __attribute__((ext_vector_type(4)));
typedef unsigned u32x4 __attribute__((ext_vector_type(4)));
constexpr int BM = 256, BK = 64, HALF = 128, HTB = HALF * BK * 2  , STAGE_BYTES = 8 * HTB, NXCD = 8, WGM = 8;

__host__ __device__ __forceinline__ int lds_byte(int r, int c) { const int st = (r >> 4) * 2 + (c >> 5), rr = r & 15, cc = c & 31, ob = rr * 64 + cc * 2; return st * 1024 + (ob ^ (((ob >> 9) & 1) << 5)); }
__host__ __device__ __forceinline__ void stage_rc(int b, int& R, int& C) { const int st = b / 1024, sb = b % 1024, swz = sb ^ (((sb >> 9) & 1) << 5); R = (st >> 1) * 16 + swz / 64; C = (st & 1) * 32 + (swz % 64) / 2; }
__host__ __device__ __forceinline__ int perm32(int rho) { const int n = rho >> 4, i = rho & 15; return 8 * (i >> 2) + 4 * n + (i & 3); }

struct Unit { int pm, pn; };
struct Gemm { const bf16_t* A; const bf16_t* Bt; int M, N, K; };

struct StaticOrder {
    int nM, nN, nwg, G, c;
    __host__ __device__ void init(int M, int N, int G_, int c_) { nM = M / BM; nN = N / BM; nwg = nM * nN; G = G_; c = c_; }
    __host__ __device__ bool next(int i, Unit& u) const {
        const long L = (long)i * G + c; if (L >= nwg) return false;
        int wgid = (int)L; { const int q = nwg / NXCD, r = nwg % NXCD, xcd = wgid % NXCD, off = wgid / NXCD; wgid = (xcd < r ? xcd * (q + 1) : r * (q + 1) + (xcd - r) * q) + off; }
        const int nig = WGM * nN, gid = wgid / nig, fm = gid * WGM, gsz = (nM - fm) < WGM ? (nM - fm) : WGM;
        u.pm = fm + ((wgid % nig) % gsz); u.pn = (wgid % nig) / gsz; return true;
    }
    __device__ __forceinline__ void a_ready(const Unit&) const {}
    __device__ __forceinline__ void done(const Unit&) const {}
};

typedef float f32x2_t __attribute__((ext_vector_type(2)));
typedef __bf16 bf16x2_t __attribute__((ext_vector_type(2)));
__device__ __forceinline__ unsigned cvt_pk_bf16(float lo, float hi) { f32x2_t v = {lo, hi}; bf16x2_t b = __builtin_convertvector(v, bf16x2_t); return __builtin_bit_cast(unsigned, b); }

template <int ACT  > struct EpiBf16 {
    static constexpr bool PERM = true, AFTER_DRAIN = false;
    bf16_t* O; int ldc;
    __device__ __forceinline__ void operator()(const f32x4 (&acc)[2][2][4][2], const Unit& u, int wr, int wc, int fr, int fq) const {
        const int row0 = u.pm * BM + wr * 64 + fr; const int col0 = u.pn * BM + wc * 32 + 8 * fq;
#pragma unroll
        for (int ai = 0; ai < 2; ++ai)
#pragma unroll
            for (int m = 0; m < 4; ++m) { bf16_t* rowp = O + (size_t)(row0 + ai * HALF + m * 16) * ldc + col0;
#pragma unroll
                for (int bj = 0; bj < 2; ++bj) { f32x4 v0 = acc[ai][bj][m][0], v1 = acc[ai][bj][m][1];
                    if (ACT == 1) {
#pragma unroll
                        for (int j = 0; j < 4; ++j) { const float a = v0[j] > 0.f ? v0[j] : 0.f, b = v1[j] > 0.f ? v1[j] : 0.f; v0[j] = a * a; v1[j] = b * b; } }
                    u32x4 w; w.x = cvt_pk_bf16(v0[0], v0[1]); w.y = cvt_pk_bf16(v0[2], v0[3]); w.z = cvt_pk_bf16(v1[0], v1[1]); w.w = cvt_pk_bf16(v1[2], v1[3]);
                    *(u32x4*)(rowp + bj * HALF) = w; } }
    }
};
struct EpiResF32 {
    static constexpr bool PERM = false, AFTER_DRAIN = false;
    float* X; int ldc;
    __device__ __forceinline__ void operator()(const f32x4 (&acc)[2][2][4][2], const Unit& u, int wr, int wc, int fr, int fq) const {
        const int row0 = u.pm * BM + wr * 64 + fr, col0 = u.pn * BM + wc * 32 + 4 * fq;
#pragma unroll
        for (int ai = 0; ai < 2; ++ai)
#pragma unroll
            for (int m = 0; m < 4; ++m) { float* rowp = X + (size_t)(row0 + ai * HALF + m * 16) * ldc + col0;
                f32x4 b[2][2];
#pragma unroll
                for (int bj = 0; bj < 2; ++bj)
#pragma unroll
                    for (int n = 0; n < 2; ++n) b[bj][n] = *(const f32x4*)(rowp + bj * HALF + n * 16);
#pragma unroll
                for (int bj = 0; bj < 2; ++bj)
#pragma unroll
                    for (int n = 0; n < 2; ++n) *(f32x4*)(rowp + bj * HALF + n * 16) = b[bj][n] + acc[ai][bj][m][n];
                asm volatile("" ::: "memory"); }
    }
};
template <class Epi, class Sched, bool ALIGN_EPI = false, bool SP2 = false>
__device__ __forceinline__ void gemm_phase(PG8_LAS unsigned char* lds, const Gemm g, const Sched& S, const Epi& E) {
    int tid_ = threadIdx.x; asm volatile("" : "+v"(tid_));
    const int tid = tid_, wid = __builtin_amdgcn_readfirstlane(tid >> 6), lane = tid & 63, wr = wid >> 2, wc = wid & 3, fr = lane & 15, fq = lane >> 4;
    const int K = g.K, nt = K / BK;
    unsigned voffA[2], voffB[2];
#pragma unroll
    for (int i = 0; i < 2; ++i) { int R, C; stage_rc(tid * 16 + i * 8192, R, C); const int Rb = Epi::PERM ? ((R & ~31) + perm32(R & 31)) : R;
        voffA[i] = (unsigned)(R * K + C) * 2u; voffB[i] = (unsigned)(Rb * K + C) * 2u; }
    const size_t kstep = (size_t)(BK * 2);
    const size_t hstep = (size_t)HALF * K * 2;
    const size_t tstep = 2 * hstep;
    const unsigned ldsw = (unsigned)wid * 1024u;
    const int aoff = lds_byte(wr * 64 + fr, fq * 8), boff = lds_byte(wc * 32 + fr, fq * 8);
#define PG8_SA(b, h) (((b) * 2 + (h)) * HTB)
#define PG8_SB(b, h) ((4 + (b) * 2 + (h)) * HTB)
#define PG8_STAGE(bufoff, gbase, voff) do { _Pragma("unroll") for (int _i = 0; _i < 2; ++_i) \
        __builtin_amdgcn_global_load_lds((const unsigned*)((const char*)(gbase) + (voff)[_i]), (PG8_LAS unsigned*)(lds + (bufoff) + ldsw + _i * 8192), 16, 0, 0); } while (0)
#define PG8_LDA(dst, b, h) do { _Pragma("unroll") for (int m = 0; m < 4; ++m) _Pragma("unroll") for (int k = 0; k < 2; ++k) dst[m][k] = *(const PG8_LAS bf16x8*)(lds + PG8_SA(b, h) + aoff + m * 2048 + k * 1024); } while (0)
#define PG8_LDB(dst, b, h) do { _Pragma("unroll") for (int n = 0; n < 2; ++n) _Pragma("unroll") for (int k = 0; k < 2; ++k) dst[n][k] = *(const PG8_LAS bf16x8*)(lds + PG8_SB(b, h) + boff + n * 2048 + k * 1024); } while (0)
#define PG8_MMA(ai, bj, At, Bt) do { __builtin_amdgcn_s_setprio(1); _Pragma("unroll") for (int m = 0; m < 4; ++m) _Pragma("unroll") for (int n = 0; n < 2; ++n) _Pragma("unroll") for (int k = 0; k < 2; ++k) \
        acc[ai][bj][m][n] = __builtin_amdgcn_mfma_f32_16x16x32_bf16(Bt[n][k], At[m][k], acc[ai][bj][m][n], 0, 0, 0); __builtin_amdgcn_s_setprio(0); } while (0)
#define PG8_WAIT_V(n) asm volatile("s_waitcnt vmcnt(" #n ")" ::: "memory")
#define PG8_WAIT_L(n) asm volatile("s_waitcnt lgkmcnt(" #n ")" ::: "memory")
#define PG8_BAR __builtin_amdgcn_s_barrier()
#define PG8_SCHED __builtin_amdgcn_sched_barrier(0)
    Unit cur, nxt; int ui = 0;
    if (!S.next(0, cur)) return;
    f32x4 acc[2][2][4][2];
#pragma unroll
    for (int a = 0; a < 2; ++a)
#pragma unroll
        for (int b = 0; b < 2; ++b)
#pragma unroll
            for (int m = 0; m < 4; ++m)
#pragma unroll
                for (int n = 0; n < 2; ++n) acc[a][b][m][n] = (f32x4){0.f, 0.f, 0.f, 0.f};
    bf16x8 At[4][2], B0[2][2], B1[2][2];
    const char* cA = (const char*)g.A + (size_t)cur.pm * tstep; const char* cB = (const char*)g.Bt + (size_t)cur.pn * tstep;
    S.a_ready(cur);
    if constexpr (SP2) {
        PG8_STAGE(PG8_SB(0, 0), cB, voffB); PG8_STAGE(PG8_SB(0, 1), cB + hstep, voffB); PG8_STAGE(PG8_SA(0, 0), cA, voffA); PG8_STAGE(PG8_SA(0, 1), cA + hstep, voffA);
        if (wr == 1) PG8_BAR;
        PG8_WAIT_V(2); PG8_BAR;
        PG8_STAGE(PG8_SB(1, 0), cB + kstep, voffB); PG8_STAGE(PG8_SA(1, 0), cA + kstep, voffA); PG8_STAGE(PG8_SB(1, 1), cB + hstep + kstep, voffB);
        PG8_WAIT_V(6); PG8_BAR;
    } else {
        PG8_STAGE(PG8_SB(0, 0), cB, voffB); PG8_STAGE(PG8_SA(0, 0), cA, voffA); PG8_STAGE(PG8_SB(0, 1), cB + hstep, voffB); PG8_STAGE(PG8_SA(0, 1), cA + hstep, voffA);
        if (wr == 1) PG8_BAR;
        PG8_WAIT_V(4); PG8_BAR;
        PG8_STAGE(PG8_SB(1, 0), cB + kstep, voffB); PG8_STAGE(PG8_SA(1, 0), cA + kstep, voffA); PG8_STAGE(PG8_SB(1, 1), cB + hstep + kstep, voffB);
        PG8_WAIT_V(6); PG8_BAR;
    }
    for (;;) {
        const bool has_next = S.next(ui + 1, nxt);
        const char* nA = has_next ? (const char*)g.A + (size_t)nxt.pm * tstep : cA; const char* nB = has_next ? (const char*)g.Bt + (size_t)nxt.pn * tstep : cB;
        for (int t = 0; t < nt; t += 2) {
            const bool last = (t == nt - 2);
            const char* a1 = cA + (size_t)(t + 1) * kstep;
            const char* a2 = last ? nA : cA + (size_t)(t + 2) * kstep; const char* b2 = last ? nB : cB + (size_t)(t + 2) * kstep;
            const char* a3 = a2 + kstep; const char* b3 = b2 + kstep;
            if (last && has_next) S.a_ready(nxt);
            if constexpr (SP2) {
            PG8_LDB(B0, 0, 0); PG8_LDB(B1, 0, 1); PG8_SCHED; PG8_LDA(At, 0, 0); PG8_STAGE(PG8_SA(1, 1), a1 + hstep, voffA);
            PG8_WAIT_V(8); PG8_WAIT_L(0); PG8_BAR; PG8_MMA(0, 0, At, B0); PG8_MMA(0, 1, At, B1); PG8_BAR; PG8_SCHED;
            PG8_LDA(At, 0, 1); PG8_STAGE(PG8_SB(0, 0), b2, voffB); PG8_STAGE(PG8_SB(0, 1), b2 + hstep, voffB); PG8_STAGE(PG8_SA(0, 0), a2, voffA);
            PG8_WAIT_V(8); PG8_WAIT_L(0); PG8_BAR; PG8_MMA(1, 0, At, B0); PG8_MMA(1, 1, At, B1); PG8_BAR; PG8_SCHED;
            PG8_LDB(B0, 1, 0); PG8_LDB(B1, 1, 1); PG8_SCHED; PG8_LDA(At, 1, 0); PG8_STAGE(PG8_SA(0, 1), a2 + hstep, voffA);
            PG8_WAIT_V(8); PG8_WAIT_L(0); PG8_BAR; PG8_MMA(0, 0, At, B0); PG8_MMA(0, 1, At, B1); PG8_BAR; PG8_SCHED;
            PG8_LDA(At, 1, 1); PG8_STAGE(PG8_SB(1, 0), b3, voffB); PG8_STAGE(PG8_SB(1, 1), b3 + hstep, voffB); PG8_STAGE(PG8_SA(1, 0), a3, voffA);
            PG8_WAIT_V(8); PG8_WAIT_L(0); PG8_BAR; PG8_MMA(1, 0, At, B0); PG8_MMA(1, 1, At, B1); PG8_BAR; PG8_SCHED;
            } else {
            PG8_LDB(B0, 0, 0); PG8_SCHED; PG8_LDA(At, 0, 0); PG8_STAGE(PG8_SA(1, 1), a1 + hstep, voffA);
            PG8_WAIT_L(8); PG8_BAR; PG8_WAIT_L(0); PG8_MMA(0, 0, At, B0); PG8_BAR; PG8_SCHED;
            PG8_LDB(B1, 0, 1); PG8_STAGE(PG8_SB(0, 0), b2, voffB);
            PG8_BAR; PG8_WAIT_L(0); PG8_MMA(0, 1, At, B1); PG8_BAR;
            PG8_LDA(At, 0, 1); PG8_STAGE(PG8_SA(0, 0), a2, voffA);
            PG8_BAR; PG8_WAIT_L(0); PG8_MMA(1, 0, At, B0); PG8_BAR; PG8_SCHED;
            PG8_STAGE(PG8_SB(0, 1), b2 + hstep, voffB);
            PG8_WAIT_V(6); PG8_BAR; PG8_MMA(1, 1, At, B1); PG8_BAR;
            PG8_LDB(B0, 1, 0); PG8_SCHED; PG8_LDA(At, 1, 0); PG8_STAGE(PG8_SA(0, 1), a2 + hstep, voffA);
            PG8_WAIT_L(8); PG8_BAR; PG8_WAIT_L(0); PG8_MMA(0, 0, At, B0); PG8_BAR; PG8_SCHED;
            PG8_LDB(B1, 1, 1); PG8_STAGE(PG8_SB(1, 0), b3, voffB);
            PG8_BAR; PG8_WAIT_L(0); PG8_MMA(0, 1, At, B1); PG8_BAR;
            PG8_LDA(At, 1, 1); PG8_STAGE(PG8_SA(1, 0), a3, voffA);
            PG8_BAR; PG8_WAIT_L(0); PG8_MMA(1, 0, At, B0); PG8_BAR; PG8_SCHED;
            PG8_STAGE(PG8_SB(1, 1), b3 + hstep, voffB);
            PG8_WAIT_V(6); PG8_BAR; PG8_MMA(1, 1, At, B1); PG8_BAR;
            }
        }
        if constexpr (ALIGN_EPI) { if (wr == 0) PG8_BAR; }
        if constexpr (!Epi::AFTER_DRAIN) { E(acc, cur, wr, wc, fr, fq); S.done(cur); }
        if (!has_next) break;
#pragma unroll
        for (int a = 0; a < 2; ++a)
#pragma unroll
            for (int b = 0; b < 2; ++b)
#pragma unroll
                for (int m = 0; m < 4; ++m)
#pragma unroll
                    for (int n = 0; n < 2; ++n) acc[a][b][m][n] = (f32x4){0.f, 0.f, 0.f, 0.f};
        cur = nxt; cA = nA; cB = nB; ++ui;
        if constexpr (ALIGN_EPI) { if (wr == 1) PG8_BAR; }
    }
    PG8_WAIT_V(0);
    if constexpr (!ALIGN_EPI) { if (wr == 0) PG8_BAR; }
    PG8_BAR;
    if constexpr (Epi::AFTER_DRAIN) { E.fused(acc, cur, wr, wc, fr, fq, lds, wid, lane); S.done(cur); }
#undef PG8_SA
#undef PG8_SB
#undef PG8_STAGE
#undef PG8_LDA
#undef PG8_LDB
#undef PG8_MMA
#undef PG8_WAIT_V
#undef PG8_WAIT_L
#undef PG8_BAR
#undef PG8_SCHED
}
}

#define DI __device__ __forceinline__
#define LAS __attribute__((address_space(3)))
typedef unsigned short bf16;
typedef short bf16x8 __attribute__((ext_vector_type(8)));
typedef short s16x4 __attribute__((ext_vector_type(4)));
typedef short v4i16_t __attribute__((ext_vector_type(4)));
typedef float f32x4 __attribute__((ext_vector_type(4)));
typedef float f32x16 __attribute__((ext_vector_type(16)));
typedef unsigned u32x4 __attribute__((ext_vector_type(4)));
typedef unsigned u32x2 __attribute__((ext_vector_type(2)));

constexpr int DM = 2048, NB = 8, SEQ = 2048, DEPTH = 4, DBAT = 32, DSEQ = 64, PAST = 1024, BWIN = 512;
constexpr int NTP = NB * SEQ, NTS = DBAT * DSEQ, NTOK = NTP + NTS;
constexpr int INC = 7264, INP = 7424, DFF = 8192;
constexpr int C_AQ = 0, C_AK = 512, C_AV = 1024, C_IQ = 1536, C_IK = 2560, C_IW = 2624, C_BQ = 2640, C_BK = 3152, C_BV = 3664, C_CZ = 4176, C_XBC = 5200, C_DT = 7248;
constexpr float EPS = 1e-5f;
constexpr int NWAVES = 8, NTHR = 512;

constexpr size_t SZ_YP = (size_t)NTP * DM, SZ_YS = (size_t)NTS * DM;
constexpr size_t SZ_PAK = (size_t)DEPTH * NB * SEQ * 512, SZ_PKI = (size_t)DEPTH * NB * SEQ * 64, SZ_PBK = (size_t)DEPTH * NB * BWIN * 512;
constexpr size_t SZ_PSSM = (size_t)DEPTH * NB * 16 * 64 * 128, SZ_PCONV = (size_t)DEPTH * NB * 3 * 2048;
constexpr size_t SZ_SAK = (size_t)DEPTH * DBAT * DSEQ * 512, SZ_SKI = (size_t)DEPTH * DBAT * DSEQ * 64, SZ_SBK = SZ_SAK;
constexpr size_t SZ_SSSM = (size_t)DEPTH * DBAT * 16 * 64 * 128, SZ_SCONV = (size_t)DEPTH * DBAT * 3 * 2048;
constexpr size_t OFF_YP = 0, OFF_YS = OFF_YP + SZ_YP, OFF_P_AK = OFF_YS + SZ_YS, OFF_P_AV = OFF_P_AK + SZ_PAK, OFF_P_KI = OFF_P_AV + SZ_PAK,
                 OFF_P_BK = OFF_P_KI + SZ_PKI, OFF_P_BV = OFF_P_BK + SZ_PBK, OFF_P_SSM = OFF_P_BV + SZ_PBK, OFF_P_CONV = OFF_P_SSM + SZ_PSSM,
                 OFF_S_AK = OFF_P_CONV + SZ_PCONV, OFF_S_AV = OFF_S_AK + SZ_SAK, OFF_S_KI = OFF_S_AV + SZ_SAK, OFF_S_BK = OFF_S_KI + SZ_SKI,
                 OFF_S_BV = OFF_S_BK + SZ_SBK, OFF_S_SSM = OFF_S_BV + SZ_SBK, OFF_S_CONV = OFF_S_SSM + SZ_SSSM, OUT_TOTAL = OFF_S_CONV + SZ_SCONV;
static_assert(OUT_TOTAL == 165085184, "output size");

constexpr size_t MiB = 1u << 20;
constexpr size_t WS_CTL = 0, CTL_ZERO_BYTES = 1 * MiB;
constexpr size_t WS_ROPE = 1 * MiB;
constexpr size_t WS_W = 2 * MiB;
constexpr size_t W_IN_B = (size_t)INP * DM * 2, W_OUT_B = (size_t)DM * DM * 2, W_UP_B = (size_t)DFF * DM * 2, W_DN_B = (size_t)DM * DFF * 2, W_LAYER_B = W_IN_B + W_OUT_B + W_UP_B + W_DN_B;
static_assert(W_LAYER_B == 101 * MiB, "weights per layer");
constexpr size_t WS_X = WS_W + DEPTH * W_LAYER_B;
constexpr size_t WS_H = WS_X + (size_t)NTOK * DM * 4;
constexpr size_t WS_MIX = WS_H + (size_t)NTOK * DM * 2;
constexpr size_t WS_PU = WS_MIX + (size_t)NTOK * DM * 2;
constexpr size_t WS_XBC = WS_PU + (size_t)NTOK * DFF * 2;
constexpr size_t WS_G = WS_XBC + (size_t)NTOK * 2048 * 2;
constexpr size_t WS_DTS = WS_G + (size_t)NTOK * 1024 * 4;
constexpr size_t WS_CAK = WS_DTS + 2 * MiB;
constexpr size_t WS_CAV = WS_CAK + (size_t)DBAT * PAST * 512 * 2;
constexpr size_t WS_CBK = WS_CAV + (size_t)DBAT * PAST * 512 * 2;
constexpr size_t WS_CBV = WS_CBK + (size_t)DBAT * BWIN * 512 * 2;
constexpr size_t WS_CKI = WS_CBV + (size_t)DBAT * BWIN * 512 * 2;
constexpr size_t WS_SC = WS_CKI + (size_t)DBAT * PAST * 64 * 2;
constexpr size_t WS_END = WS_SC + (size_t)256 * 64 * 2048 * 4;
static_assert(WS_END == 1356 * MiB, "ws map");
constexpr int CW_BAR = 4096;
constexpr int CW_Q = 16384;

constexpr int RING_BYTES = 131072, LDSCTL_OFF = RING_BYTES, LDS_BYTES = 147456;
constexpr int ATT_SEL = 0;
constexpr int ATT_K = 16384, KSTR = 1040, ATT_V = ATT_K + 32 * KSTR, VSTR = 1088, ATT_END = ATT_V + 32 * VSTR;
constexpr int CSTR = 272, XSTR = 144, MSTR = 144, HSTR = 272;
constexpr int SSD_CS = 0, SSD_BS = SSD_CS + 64 * CSTR, SSD_XD = SSD_BS + 64 * CSTR, SSD_XDW = SSD_XD + 64 * XSTR, SSD_MS = SSD_XDW + 64 * XSTR,
              SSD_HS = SSD_MS + 64 * MSTR, SSD_VEC = SSD_HS + 2 * 64 * HSTR, SSD_Y = SSD_VEC + 1024, YSTR = 272, SSD_END = SSD_Y + 64 * YSTR;
static_assert(ATT_END <= RING_BYTES && SSD_END <= RING_BYTES, "phase scratch fits the ring region");

DI float bf2f(bf16 v) { return __uint_as_float(((unsigned)v) << 16); }
DI unsigned pk2(float lo, float hi) { return pg8::cvt_pk_bf16(lo, hi); }
DI bf16 f2bf(float f) { return (bf16)(pk2(f, 0.f) & 0xffffu); }
DI float wave_sum(float v) {
#pragma unroll
    for (int o = 1; o < 64; o <<= 1) v += __shfl_xor(v, o);
    return v;
}
DI f32x16 mfma32(bf16x8 a, bf16x8 b, f32x16 c) { return __builtin_amdgcn_mfma_f32_32x32x16_bf16(a, b, c, 0, 0, 0); }
DI int crow(int i, int hh) { return (i & 3) + 8 * (i >> 2) + 4 * hh; }
DI s16x4 tr_read(LAS unsigned char* p) { return __builtin_bit_cast(s16x4, __builtin_amdgcn_ds_read_tr16_b64_v4i16((LAS v4i16_t*)p)); }
DI bf16x8 trfrag(LAS unsigned char* tile, int stride, int k0, int c0, int lane) {
    const int i16 = lane & 15, qq = i16 >> 2, p = i16 & 3, g2 = (lane >> 4) & 1, hh = lane >> 5;
    LAS unsigned char* a = tile + (k0 + 8 * hh + qq) * stride + (c0 + 16 * g2 + 4 * p) * 2;
    const s16x4 lo = tr_read(a), hi = tr_read(a + 4 * stride);
    return __builtin_shufflevector(lo, hi, 0, 1, 2, 3, 4, 5, 6, 7);
}
DI void unpack8(u32x4 v, float (&f)[8]) {
#pragma unroll
    for (int i = 0; i < 4; ++i) { f[2 * i] = __uint_as_float(v[i] << 16); f[2 * i + 1] = __uint_as_float(v[i] & 0xffff0000u); }
}
DI u32x4 pack8(const float (&f)[8]) { u32x4 o; o.x = pk2(f[0], f[1]); o.y = pk2(f[2], f[3]); o.z = pk2(f[4], f[5]); o.w = pk2(f[6], f[7]); return o; }

#define XB_TMO      128
#define XB_XCNT(j)  (256  + 64 * (j))
#define XB_XSUB(j)  (1280 + 64 * (j))
#define XB_XGEN(j)  (2304 + 64 * (j))
#define XB_TOP      3328
#define XB_TOPGEN   3392
#define XCD_BAR_WORDS 3456
#define XB_SPIN_CAP (1u << 20)
DI unsigned xb_ld(unsigned* p)              { return __hip_atomic_load(p, __ATOMIC_RELAXED, __HIP_MEMORY_SCOPE_AGENT); }
DI unsigned xb_add(unsigned* p, unsigned v) { return __hip_atomic_fetch_add(p, v, __ATOMIC_RELAXED, __HIP_MEMORY_SCOPE_AGENT); }
DI unsigned xb_xcc_id() { return (unsigned)__builtin_amdgcn_s_getreg((3 << 11) | 20) & 0xFu; }
#define XB_SPIN(cond, bar) do { unsigned _sp = 0; while (cond) { __builtin_amdgcn_s_sleep(1); \
    if ((++_sp & 255u) == 0u) { if (xb_ld(&(bar)[XB_TMO])) break; if (_sp > XB_SPIN_CAP) { atomicAdd(&(bar)[XB_TMO], 1u); break; } } } } while (0)
struct XcdBarrier { unsigned* bar; unsigned x; volatile LAS unsigned* st; };
DI XcdBarrier xcd_barrier_post(unsigned* bar, volatile LAS unsigned* st) {
    XcdBarrier b; b.bar = bar; b.x = xb_xcc_id(); b.st = st;
    if (threadIdx.x == 0) (void)xb_add(&bar[XB_XCNT(b.x)], 1u);
    return b;
}
DI void xcd_barrier_complete(unsigned* bar, unsigned x, unsigned& nloc, unsigned& nx) {
    const unsigned G = gridDim.x * gridDim.y * gridDim.z;
    unsigned sum, cnt, mine, sp = 0u;
    for (;;) {
        sum = 0u; cnt = 0u; mine = 0u;
#pragma unroll
        for (unsigned j = 0; j < 16; ++j) { const unsigned c = xb_ld(&bar[XB_XCNT(j)]); sum += c; cnt += (c > 0u) ? 1u : 0u; mine = (j == x) ? c : mine; }
        if (sum == G) break;
        __builtin_amdgcn_s_sleep(1);
        if ((++sp & 255u) == 0u) { if (xb_ld(&bar[XB_TMO])) break; if (sp > XB_SPIN_CAP) { atomicAdd(&bar[XB_TMO], 1u); break; } }
    }
    nloc = mine > 0u ? mine : 1u; nx = cnt > 0u ? cnt : 1u;
}
DI void xcd_barrier(const XcdBarrier& b) {
    asm volatile("s_waitcnt vmcnt(0)" ::: "memory");
    __syncthreads();
    if (threadIdx.x == 0) {
        unsigned* bar = b.bar;
        __builtin_amdgcn_s_waitcnt(0);
        unsigned nloc = b.st[0], nx = b.st[1];
        if (nloc == 0u) { xcd_barrier_complete(bar, b.x, nloc, nx); b.st[0] = nloc; b.st[1] = nx; }
        const unsigned old = xb_add(&bar[XB_XSUB(b.x)], 1u);
        const unsigned gen = old / nloc;
        if (old + 1u == (gen + 1u) * nloc) {
            __builtin_amdgcn_fence(__ATOMIC_RELEASE, "agent");
            asm volatile("s_waitcnt vmcnt(0)" ::: "memory");
            const unsigned og = xb_add(&bar[XB_TOP], 1u);
            const unsigned tg = og / nx;
            if (og + 1u == (tg + 1u) * nx) xb_add(&bar[XB_TOPGEN], 1u);
            else XB_SPIN(xb_ld(&bar[XB_TOPGEN]) == tg, bar);
            __builtin_amdgcn_fence(__ATOMIC_ACQUIRE, "agent");
            xb_add(&bar[XB_XGEN(b.x)], 1u);
            asm volatile("s_waitcnt vmcnt(0)" ::: "memory");
        } else {
            XB_SPIN(xb_ld(&bar[XB_XGEN(b.x)]) == gen, bar);
            __builtin_amdgcn_fence(__ATOMIC_ACQUIRE, "agent");
            asm volatile("s_waitcnt vmcnt(0)" ::: "memory");
        }
    }
    __syncthreads();
}

struct Args { const float* in[23]; float* out; unsigned char* ws; int ph_lo, ph_hi; };
static_assert(sizeof(Args) == 23 * 8 + 8 + 8 + 8, "Args has no padding");
struct Ctx {
    LAS unsigned char* lds;
    unsigned* ctl;
    int tid, lane, wave, G, bid;
    float* out;
    unsigned char* ws;
};
DI bf16* ws_bf(const Ctx& C, size_t off) { return (bf16*)(C.ws + off); }
DI float* ws_f(const Ctx& C, size_t off) { return (float*)(C.ws + off); }
DI bf16* w_in_t(const Ctx& C, int l)  { return (bf16*)(C.ws + WS_W + (size_t)l * W_LAYER_B); }
DI bf16* w_out_t(const Ctx& C, int l) { return (bf16*)(C.ws + WS_W + (size_t)l * W_LAYER_B + W_IN_B); }
DI bf16* w_up_t(const Ctx& C, int l)  { return (bf16*)(C.ws + WS_W + (size_t)l * W_LAYER_B + W_IN_B + W_OUT_B); }
DI bf16* w_dn_t(const Ctx& C, int l)  { return (bf16*)(C.ws + WS_W + (size_t)l * W_LAYER_B + W_IN_B + W_OUT_B + W_UP_B); }

DI int q_next(const Ctx& C, unsigned* head) {
    volatile LAS int* slot = (volatile LAS int*)(C.lds + LDSCTL_OFF + 64);
    __syncthreads();
    if (C.tid == 0) *slot = (int)__hip_atomic_fetch_add(head, 1u, __ATOMIC_RELAXED, __HIP_MEMORY_SCOPE_AGENT);
    __syncthreads();
    return *slot;
}

DI void p0_transpose_item(const float* W, int K, int N, bf16* WT, LAS float* scr, int item, int lane) {
    const int nblk = N / 32, kb = item / nblk, nb = item % nblk, k0 = 64 * kb, n0 = 32 * nb;
#pragma unroll 8
    for (int i = 0; i < 32; ++i) { const int kk = 2 * i + (lane >> 5); scr[kk * 33 + (lane & 31)] = W[(size_t)(k0 + kk) * N + n0 + (lane & 31)]; }
    asm volatile("s_waitcnt lgkmcnt(0)" ::: "memory");
    const int c = lane & 7;
#pragma unroll
    for (int j = 0; j < 4; ++j) { const int n = (lane >> 3) + 8 * j; const LAS float* s = scr + (8 * c) * 33 + n;
        u32x4 o; o.x = pk2(s[0 * 33], s[1 * 33]); o.y = pk2(s[2 * 33], s[3 * 33]); o.z = pk2(s[4 * 33], s[5 * 33]); o.w = pk2(s[6 * 33], s[7 * 33]);
        *(u32x4*)(WT + (size_t)(n0 + n) * K + k0 + 8 * c) = o; }
    asm volatile("s_waitcnt lgkmcnt(0)" ::: "memory");
}
DI void rms_row(const float* src, float* xcopy, const float* w, bf16* outb, float* outf, int lane) {
    f32x4 v[8]; float ss = 0.f;
#pragma unroll
    for (int j = 0; j < 8; ++j) { v[j] = ((const f32x4*)src)[lane + 64 * j]; ss += (v[j].x * v[j].x + v[j].y * v[j].y) + (v[j].z * v[j].z + v[j].w * v[j].w); }
    if (xcopy) {
#pragma unroll
        for (int j = 0; j < 8; ++j) ((f32x4*)xcopy)[lane + 64 * j] = v[j];
    }
    ss = wave_sum(ss);
    const float rs = 1.0f / sqrtf(ss * (1.0f / DM) + EPS);
#pragma unroll
    for (int j = 0; j < 8; ++j) { const f32x4 wv = ((const f32x4*)w)[lane + 64 * j]; const f32x4 o = v[j] * rs * wv;
        if (outb) { u32x2 p; p.x = pk2(o.x, o.y); p.y = pk2(o.z, o.w); ((u32x2*)outb)[lane + 64 * j] = p; }
        if (outf) ((f32x4*)outf)[lane + 64 * j] = o; }
}
DI void sincos_tab(float ang, float& c, float& s) {
    const double a = (double)ang; const double kq = rint(a * 0.63661977236758134308); const double x = a - kq * 1.57079632679489661923; const double x2 = x * x;
    const double sn = x * (1.0 + x2 * (-1.0 / 6 + x2 * (1.0 / 120 + x2 * (-1.0 / 5040 + x2 * (1.0 / 362880 + x2 * (-1.0 / 39916800 + x2 * (1.0 / 6227020800.0)))))));
    const double cn = 1.0 + x2 * (-0.5 + x2 * (1.0 / 24 + x2 * (-1.0 / 720 + x2 * (1.0 / 40320 + x2 * (-1.0 / 3628800 + x2 * (1.0 / 479001600 + x2 * (-1.0 / 87178291200.0)))))));
    const int q = ((int)kq) & 3;
    const double cc = (q == 0) ? cn : (q == 1) ? -sn : (q == 2) ? -cn : sn;
    const double sc = (q == 0) ? sn : (q == 1) ? cn : (q == 2) ? -sn : -cn;
    c = (float)cc; s = (float)sc;
}
DI void p0_prologue(const Ctx& C, const Args& A) {
    LAS float* scr = (LAS float*)(C.lds + C.wave * 16384);
    const int gw = C.bid * NWAVES + C.wave, NGW = C.G * NWAVES;
    constexpr int I_IN = (DM / 64) * (INC / 32), I_OUT = (DM / 64) * (DM / 32), I_UP = (DM / 64) * (DFF / 32), I_DN = (DFF / 64) * (DM / 32), I_L = I_IN + I_OUT + I_UP + I_DN;
    for (int it = gw; it < DEPTH * I_L; it += NGW) {
        const int l = it / I_L; int r = it % I_L;
        if (r < I_IN) { p0_transpose_item(A.in[10] + (size_t)l * DM * INC, DM, INC, w_in_t(C, l), scr, r, C.lane); continue; } r -= I_IN;
        if (r < I_OUT) { p0_transpose_item(A.in[11] + (size_t)l * DM * DM, DM, DM, w_out_t(C, l), scr, r, C.lane); continue; } r -= I_OUT;
        if (r < I_UP) { p0_transpose_item(A.in[20] + (size_t)l * DM * DFF, DM, DFF, w_up_t(C, l), scr, r, C.lane); continue; } r -= I_UP;
        p0_transpose_item(A.in[21] + (size_t)l * DFF * DM, DFF, DM, w_dn_t(C, l), scr, r, C.lane);
    }
    { const int gt = C.bid * NTHR + C.tid, NGT = C.G * NTHR; constexpr int CH_L = (INP - INC) * DM / 8;
      for (int i = gt; i < DEPTH * CH_L; i += NGT) { const int l = i / CH_L, c = i % CH_L; ((u32x4*)(w_in_t(C, l) + (size_t)INC * DM))[c] = (u32x4){0u, 0u, 0u, 0u}; }
      float* ra = ws_f(C, WS_ROPE); float* ri = ra + 2048 * 16 * 2;
      for (int i = gt; i < 2048 * 24; i += NGT) { const int pos = i / 24, k = i % 24; const bool isa = k < 16; const int fi = isa ? k : k - 16;
          const double ex = isa ? (double)fi / 16.0 : (double)fi / 8.0; const float inv = (float)exp2(-ex * 18.931568569324174  );
          const float ang = (float)pos * inv; float c, s; sincos_tab(ang, c, s);
          float* dst = isa ? ra + (pos * 16 + fi) * 2 : ri + (pos * 8 + fi) * 2; dst[0] = c; dst[1] = s; } }
    for (int m = gw; m < NTOK; m += NGW) { const float* src = m < NTP ? A.in[0] + (size_t)m * DM : A.in[1] + (size_t)(m - NTP) * DM;
        rms_row(src, ws_f(C, WS_X) + (size_t)m * DM, A.in[9], ws_bf(C, WS_H) + (size_t)m * DM, nullptr, C.lane); }
}

DI void cvt_store8(const bf16* src, float* dst) {
    const u32x4 v = *(const u32x4*)src; float f[8]; unpack8(v, f);
    ((f32x4*)dst)[0] = (f32x4){f[0], f[1], f[2], f[3]}; ((f32x4*)dst)[1] = (f32x4){f[4], f[5], f[6], f[7]};
}
DI void m0_row(const Ctx& C, const Args& A, int l, int r, int lane) {
    bf16* P = ws_bf(C, WS_PU) + (size_t)r * INP;
    const bool smp = r >= NTP; int b, t, pos;
    if (!smp) { b = r >> 11; t = r & 2047; pos = t; } else { const int rr = r - NTP; b = rr >> 6; t = rr & 63; pos = PAST + t; }
    float* out = C.out;
    float* o_ak = smp ? out + OFF_S_AK + ((size_t)(l * DBAT + b) * DSEQ + t) * 512 : out + OFF_P_AK + ((size_t)(l * NB + b) * SEQ + t) * 512;
    float* o_av = smp ? out + OFF_S_AV + ((size_t)(l * DBAT + b) * DSEQ + t) * 512 : out + OFF_P_AV + ((size_t)(l * NB + b) * SEQ + t) * 512;
    float* o_ki = smp ? out + OFF_S_KI + ((size_t)(l * DBAT + b) * DSEQ + t) * 64 : out + OFF_P_KI + ((size_t)(l * NB + b) * SEQ + t) * 64;
    const float* ropeA = ws_f(C, WS_ROPE) + (size_t)pos * 32; const float* ropeI = ws_f(C, WS_ROPE) + 2048 * 32 + (size_t)pos * 16;
    {
        const int i = lane & 15, c1 = (lane >> 4) * 128 + i, c2 = c1 + 16; const float cs = ropeA[2 * i], sn = ropeA[2 * i + 1];
        float x1 = bf2f(P[C_AQ + c1]), x2 = bf2f(P[C_AQ + c2]);
        P[C_AQ + c1] = f2bf(x1 * cs - x2 * sn); P[C_AQ + c2] = f2bf(x2 * cs + x1 * sn);
        x1 = bf2f(P[C_AK + c1]); x2 = bf2f(P[C_AK + c2]);
        const float y1 = x1 * cs - x2 * sn, y2 = x2 * cs + x1 * sn;
        P[C_AK + c1] = f2bf(y1); P[C_AK + c2] = f2bf(y2); o_ak[c1] = y1; o_ak[c2] = y2;
    }
    if (lane < 48) { const int col = (lane / 12) * 128 + 32 + (lane % 12) * 8; cvt_store8(P + C_AK + col, o_ak + col); }
    cvt_store8(P + C_AV + lane * 8, o_av + lane * 8);
#pragma unroll
    for (int k = 0; k < 2; ++k) {
        const int pid = lane + 64 * k, i = pid & 7, c1 = C_IQ + (pid >> 3) * 64 + i, c2 = c1 + 8; const float cs = ropeI[2 * i], sn = ropeI[2 * i + 1];
        const float x1 = bf2f(P[c1]), x2 = bf2f(P[c2]);
        P[c1] = f2bf(x1 * cs - x2 * sn); P[c2] = f2bf(x2 * cs + x1 * sn);
    }
    if (lane < 8) { const int i = lane; const float cs = ropeI[2 * i], sn = ropeI[2 * i + 1];
        const float x1 = bf2f(P[C_IK + i]), x2 = bf2f(P[C_IK + i + 8]); const float y1 = x1 * cs - x2 * sn, y2 = x2 * cs + x1 * sn;
        P[C_IK + i] = f2bf(y1); P[C_IK + i + 8] = f2bf(y2); o_ki[i] = y1; o_ki[i + 8] = y2;
    } else if (lane < 14) { const int col = 16 + (lane - 8) * 8; cvt_store8(P + C_IK + col, o_ki + col); }
    const bool keep = smp || t >= SEQ - BWIN;
    if (keep) {
        const size_t ro = smp ? ((size_t)(l * DBAT + b) * DSEQ + t) * 512 : ((size_t)(l * NB + b) * BWIN + (t - (SEQ - BWIN))) * 512;
        float* o_bk = out + (smp ? OFF_S_BK : OFF_P_BK) + ro; float* o_bv = out + (smp ? OFF_S_BV : OFF_P_BV) + ro;
        cvt_store8(P + C_BK + lane * 8, o_bk + lane * 8); cvt_store8(P + C_BV + lane * 8, o_bv + lane * 8);
    }
    if (lane < 16) { const float x = bf2f(P[C_DT + lane]) + A.in[15][l * 16 + lane];
        const float sp = x > 20.f ? x : log1pf(__expf(x)); ws_f(C, WS_DTS)[(size_t)r * 16 + lane] = sp; }
    const float* cw = A.in[13] + (size_t)l * 4 * 2048; const float* cb = A.in[14] + (size_t)l * 2048;
    const float* sconv = A.in[8] + (size_t)(l * DBAT + b) * 3 * 2048;
    bf16* xo = ws_bf(C, WS_XBC) + (size_t)r * 2048;
    const int stt = smp ? DSEQ - 3 : SEQ - 3;
    float* o_conv = (t >= stt) ? (smp ? out + OFF_S_CONV + ((size_t)(l * DBAT + b) * 3 + (t - stt)) * 2048 : out + OFF_P_CONV + ((size_t)(l * NB + b) * 3 + (t - stt)) * 2048) : nullptr;
#pragma unroll 1
    for (int it = 0; it < 4; ++it) {
        const int ch = (lane + 64 * it) * 8;
        float acc[8], x[8];
        { const f32x4 b0 = *(const f32x4*)(cb + ch), b1 = *(const f32x4*)(cb + ch + 4); acc[0] = b0.x; acc[1] = b0.y; acc[2] = b0.z; acc[3] = b0.w; acc[4] = b1.x; acc[5] = b1.y; acc[6] = b1.z; acc[7] = b1.w; }
#pragma unroll
        for (int j = 0; j < 4; ++j) {
            const int tt = t - 3 + j; bool have = true;
            if (tt >= 0) { unpack8(*(const u32x4*)(P + (ptrdiff_t)(j - 3) * INP + C_XBC + ch), x); }
            else if (smp) { const float* sp = sconv + (size_t)(3 + tt) * 2048 + ch; const f32x4 s0 = *(const f32x4*)sp, s1 = *(const f32x4*)(sp + 4);
                x[0] = s0.x; x[1] = s0.y; x[2] = s0.z; x[3] = s0.w; x[4] = s1.x; x[5] = s1.y; x[6] = s1.z; x[7] = s1.w; }
            else have = false;
            if (have) { const f32x4 w0 = *(const f32x4*)(cw + j * 2048 + ch), w1 = *(const f32x4*)(cw + j * 2048 + ch + 4);
                acc[0] += x[0] * w0.x; acc[1] += x[1] * w0.y; acc[2] += x[2] * w0.z; acc[3] += x[3] * w0.w; acc[4] += x[4] * w1.x; acc[5] += x[5] * w1.y; acc[6] += x[6] * w1.z; acc[7] += x[7] * w1.w; }
        }
        if (o_conv) { ((f32x4*)(o_conv + ch))[0] = (f32x4){x[0], x[1], x[2], x[3]}; ((f32x4*)(o_conv + ch))[1] = (f32x4){x[4], x[5], x[6], x[7]}; }
#pragma unroll
        for (int k = 0; k < 8; ++k) acc[k] = acc[k] / (1.f + __expf(-acc[k]));
        *(u32x4*)(xo + ch) = pack8(acc);
    }
}
DI void cvt_chunks(const float* src, bf16* dst, size_t nchunk, size_t gt, size_t ngt) {
    for (size_t i = gt; i < nchunk; i += ngt) { const f32x4 a = ((const f32x4*)src)[2 * i], b = ((const f32x4*)src)[2 * i + 1];
        u32x4 o; o.x = pk2(a.x, a.y); o.y = pk2(a.z, a.w); o.z = pk2(b.x, b.y); o.w = pk2(b.z, b.w); ((u32x4*)dst)[i] = o; }
}
DI void m0_phase(const Ctx& C, const Args& A, int l) {
    const int gw = C.bid * NWAVES + C.wave, NGW = C.G * NWAVES;
    for (int r = gw; r < NTOK; r += NGW) m0_row(C, A, l, r, C.lane);
    const size_t gt = (size_t)C.bid * NTHR + C.tid, ngt = (size_t)C.G * NTHR;
    cvt_chunks(A.in[2] + (size_t)l * DBAT * PAST * 512, ws_bf(C, WS_CAK), (size_t)DBAT * PAST * 512 / 8, gt, ngt);
    cvt_chunks(A.in[3] + (size_t)l * DBAT * PAST * 512, ws_bf(C, WS_CAV), (size_t)DBAT * PAST * 512 / 8, gt, ngt);
    cvt_chunks(A.in[4] + (size_t)l * DBAT * PAST * 64, ws_bf(C, WS_CKI), (size_t)DBAT * PAST * 64 / 8, gt, ngt);
    cvt_chunks(A.in[5] + (size_t)l * DBAT * BWIN * 512, ws_bf(C, WS_CBK), (size_t)DBAT * BWIN * 512 / 8, gt, ngt);
    cvt_chunks(A.in[6] + (size_t)l * DBAT * BWIN * 512, ws_bf(C, WS_CBV), (size_t)DBAT * BWIN * 512 / 8, gt, ngt);
}

struct KVSrc { const bf16* k0; const bf16* v0; int s0; int n0; const bf16* k1; const bf16* v1; int s1; };
template <int MODE>
DI void attn_unit(const Ctx& C, const bf16* Qp, int qstride, const KVSrc& S, int tile_lo, int tile_hi, bf16* Op, int ostride) {
    int tid = C.tid, lane = C.lane; asm volatile("" : "+v"(tid), "+v"(lane));
    const int w = C.wave, r = lane & 31, hh = lane >> 5;
    const int head = w >> 1, q = (w & 1) * 32 + r;
    LAS unsigned char* Ks = C.lds + ATT_K; LAS unsigned char* Vs = C.lds + ATT_V;
    bf16x8 qf[8];
    { const bf16* qrow = Qp + (size_t)q * qstride + head * 128 + 8 * hh;
#pragma unroll
      for (int ks = 0; ks < 8; ++ks) qf[ks] = *(const bf16x8*)(qrow + 16 * ks); }
    f32x16 o[4];
#pragma unroll
    for (int d = 0; d < 4; ++d)
#pragma unroll
        for (int i = 0; i < 16; ++i) o[d][i] = 0.f;
    float m = -1e30f, lsum = 0.f;
    constexpr float SC2 = 0.08838834764831845f * 1.4426950408889634f;
    constexpr float L2E = 1.4426950408889634f;
    u32x4 kr[4], vr[4];
#define ATT_LOAD(tile_) do { _Pragma("unroll") for (int i_ = 0; i_ < 4; ++i_) { const int ci_ = tid + 512 * i_, row_ = ci_ >> 6, ch_ = ci_ & 63, key_ = (tile_) * 32 + row_; \
        const bf16* kp_ = key_ < S.n0 ? S.k0 + (ptrdiff_t)key_ * S.s0 : S.k1 + (ptrdiff_t)(key_ - S.n0) * S.s1; const bf16* vp_ = key_ < S.n0 ? S.v0 + (ptrdiff_t)key_ * S.s0 : S.v1 + (ptrdiff_t)(key_ - S.n0) * S.s1; \
        kr[i_] = *(const u32x4*)(kp_ + ch_ * 8); vr[i_] = *(const u32x4*)(vp_ + ch_ * 8); } } while (0)
    ATT_LOAD(tile_lo);
    const int i16 = lane & 15;
    LAS unsigned char* vbase = Vs + (4 * hh + (i16 >> 2)) * VSTR + (head * 128 + 16 * ((lane >> 4) & 1) + 4 * (i16 & 3)) * 2;
    LAS unsigned char* kbase = Ks + r * KSTR + head * 256 + hh * 16;
    const LAS float* btab = (const LAS float*)(C.lds + ATT_SEL) + head * 257;
    const LAS unsigned* sel = (const LAS unsigned*)(C.lds + ATT_SEL) + q * 64;
    for (int tile = tile_lo; tile < tile_hi; ++tile) {
        __syncthreads();
#pragma unroll
        for (int i = 0; i < 4; ++i) { const int ci = tid + 512 * i, row = ci >> 6, ch = ci & 63;
            *(LAS u32x4*)(Ks + row * KSTR + ch * 16) = kr[i]; *(LAS u32x4*)(Vs + row * VSTR + ch * 16) = vr[i]; }
        __syncthreads();
        if (tile + 1 < tile_hi) ATT_LOAD(tile + 1);
        f32x16 s;
#pragma unroll
        for (int i = 0; i < 16; ++i) s[i] = 0.f;
#pragma unroll
        for (int ks = 0; ks < 8; ++ks) { const bf16x8 a = *(const LAS bf16x8*)(kbase + ks * 32); s = mfma32(a, qf[ks], s); }
        if (MODE == 0) {
            const unsigned wd = sel[tile] >> (4 * hh);
#pragma unroll
            for (int i = 0; i < 16; ++i) s[i] = ((wd >> ((i & 3) + 8 * (i >> 2))) & 1u) ? s[i] * SC2 : -INFINITY;
        } else {
            if (tile <= 11) { const float bb = btab[256] * L2E;
#pragma unroll
                for (int i = 0; i < 16; ++i) s[i] = s[i] * SC2 + bb;
            } else {
#pragma unroll
                for (int i = 0; i < 16; ++i) { int rel = BWIN + q - (tile * 32 + crow(i, hh)); rel = rel > 128 ? 128 : rel; s[i] = s[i] * SC2 + btab[rel + 128] * L2E; }
            }
        }
        float mx = s[0];
#pragma unroll
        for (int i = 1; i < 16; ++i) mx = fmaxf(mx, s[i]);
        mx = fmaxf(mx, __shfl_xor(mx, 32));
        const float mn = fmaxf(m, mx), alpha = __builtin_amdgcn_exp2f(m - mn);
        float rs = 0.f;
#pragma unroll
        for (int i = 0; i < 16; ++i) { s[i] = __builtin_amdgcn_exp2f(s[i] - mn); rs += s[i]; }
        rs += __shfl_xor(rs, 32);
        lsum = lsum * alpha + rs; m = mn;
#pragma unroll
        for (int d = 0; d < 4; ++d)
#pragma unroll
            for (int i = 0; i < 16; ++i) o[d][i] *= alpha;
        bf16x8 pf[2];
#pragma unroll
        for (int s2 = 0; s2 < 2; ++s2) { u32x4 pk; pk.x = pk2(s[8 * s2], s[8 * s2 + 1]); pk.y = pk2(s[8 * s2 + 2], s[8 * s2 + 3]); pk.z = pk2(s[8 * s2 + 4], s[8 * s2 + 5]); pk.w = pk2(s[8 * s2 + 6], s[8 * s2 + 7]);
            pf[s2] = __builtin_bit_cast(bf16x8, pk); }
#pragma unroll
        for (int d = 0; d < 4; ++d)
#pragma unroll
            for (int s2 = 0; s2 < 2; ++s2) {
                const s16x4 lo = tr_read(vbase + (16 * s2) * VSTR + d * 64), hi = tr_read(vbase + (16 * s2 + 8) * VSTR + d * 64);
                const bf16x8 vt = __builtin_shufflevector(lo, hi, 0, 1, 2, 3, 4, 5, 6, 7);
                o[d] = mfma32(vt, pf[s2], o[d]);
            }
    }
#undef ATT_LOAD
    const float inv = 1.0f / lsum;
    bf16* orow = Op + (size_t)q * ostride + head * 128 + 4 * hh;
#pragma unroll
    for (int d = 0; d < 4; ++d)
#pragma unroll
        for (int g = 0; g < 4; ++g) { u32x2 p; p.x = pk2(o[d][4 * g] * inv, o[d][4 * g + 1] * inv); p.y = pk2(o[d][4 * g + 2] * inv, o[d][4 * g + 3] * inv);
            *(u32x2*)(orow + 32 * d + 8 * g) = p; }
}

DI unsigned fkey(float f) { const unsigned u = __float_as_uint(f); return (u & 0x80000000u) ? ~u : (u | 0x80000000u); }
DI void dsa_unit(const Ctx& C, int l, int u) {
    int lane = C.lane; asm volatile("" : "+v"(lane));
    const int w = C.wave, r = lane & 31, hh = lane >> 5;
    const bf16* PROJ = ws_bf(C, WS_PU);
    int qrow0, NT, limit; KVSrc S; const bf16* ik0; const bf16* ik1; int iks0, ikn0;
    if (u < 256) { const int c = 31 - (u >> 3), b = u & 7; qrow0 = b * SEQ + c * 64; NT = 2 * (c + 1); limit = 64 * (c + 1);
        const bf16* base = PROJ + (size_t)(b * SEQ) * INP;
        S.k0 = base + C_AK; S.v0 = base + C_AV; S.s0 = INP; S.n0 = limit; S.k1 = S.k0; S.v1 = S.v0; S.s1 = INP;
        ik0 = base + C_IK; iks0 = INP; ikn0 = limit; ik1 = ik0;
    } else { const int b = u - 256; qrow0 = NTP + b * DSEQ; NT = (PAST + DSEQ) / 32; limit = PAST + DSEQ;
        const bf16* nb = PROJ + (size_t)qrow0 * INP;
        S.k0 = ws_bf(C, WS_CAK) + (size_t)b * PAST * 512; S.v0 = ws_bf(C, WS_CAV) + (size_t)b * PAST * 512; S.s0 = 512; S.n0 = PAST; S.k1 = nb + C_AK; S.v1 = nb + C_AV; S.s1 = INP;
        ik0 = ws_bf(C, WS_CKI) + (size_t)b * PAST * 64; iks0 = 64; ikn0 = PAST; ik1 = nb + C_IK;
    }
    float* SC = ws_f(C, WS_SC) + (size_t)C.bid * 64 * 2048;
    LAS unsigned* SEL = (LAS unsigned*)(C.lds + ATT_SEL);
#pragma unroll 1
    for (int pass = 0; pass < 2; ++pass) {
        bf16x8 af[2][4]; float wt[2][16];
#pragma unroll
        for (int np = 0; np < 2; ++np) { const int pp = pass * 2 + np;
            const bf16* ap = PROJ + (size_t)(qrow0 + 8 * w + 2 * pp + (r >> 4)) * INP + C_IQ + (r & 15) * 64 + 8 * hh;
#pragma unroll
            for (int ks = 0; ks < 4; ++ks) af[np][ks] = *(const bf16x8*)(ap + 16 * ks);
#pragma unroll
            for (int i = 0; i < 16; ++i) { const int qi = 8 * w + 2 * pp + (i >> 3), hd = (i & 3) + 8 * ((i >> 2) & 1) + 4 * hh;
                wt[np][i] = bf2f(PROJ[(size_t)(qrow0 + qi) * INP + C_IW + hd]) * (0.25f * 0.125f); } }
#pragma unroll 1
        for (int tile = 0; tile < NT; ++tile) {
            const int key = tile * 32 + r;
            const bf16* kp = (key < ikn0 ? ik0 + (size_t)key * iks0 : ik1 + (size_t)(key - ikn0) * INP) + 8 * hh;
            bf16x8 bk[4];
#pragma unroll
            for (int ks = 0; ks < 4; ++ks) bk[ks] = *(const bf16x8*)(kp + 16 * ks);
#pragma unroll
            for (int np = 0; np < 2; ++np) {
                f32x16 acc;
#pragma unroll
                for (int i = 0; i < 16; ++i) acc[i] = 0.f;
#pragma unroll
                for (int ks = 0; ks < 4; ++ks) acc = mfma32(af[np][ks], bk[ks], acc);
                float p0 = 0.f, p1 = 0.f;
#pragma unroll
                for (int i = 0; i < 8; ++i) { p0 += fmaxf(acc[i], 0.f) * wt[np][i]; p1 += fmaxf(acc[8 + i], 0.f) * wt[np][8 + i]; }
                const float t0 = p0 + __shfl_xor(p0, 32), t1 = p1 + __shfl_xor(p1, 32);
                const int ql = 8 * w + 2 * (pass * 2 + np) + hh;
                SC[(size_t)ql * 2048 + tile * 32 + r] = hh ? t1 : t0;
            }
        }
    }
    asm volatile("s_waitcnt vmcnt(0)" ::: "memory");
#pragma unroll 1
    for (int pp = 0; pp < 4; ++pp) {
        const int ql = 8 * w + 2 * pp + hh;
        unsigned v[64];
#pragma unroll
        for (int i = 0; i < 64; ++i) { const float f = (i < NT) ? __hip_atomic_load(SC + (size_t)ql * 2048 + i * 32 + r, __ATOMIC_RELAXED, __HIP_MEMORY_SCOPE_AGENT) : -INFINITY; v[i] = fkey(f); }
        unsigned T = 0u;
        if (limit > 256) {
#pragma unroll 1
            for (int bit = 31; bit >= 0; --bit) {
                const unsigned cand = T | (1u << bit); int c0 = 0, c1 = 0;
#pragma unroll
                for (int i = 0; i < 64; ++i) { const unsigned long long mk = __ballot(v[i] >= cand); c0 += __popc((unsigned)mk); c1 += __popc((unsigned)(mk >> 32)); }
                if ((hh ? c1 : c0) >= 256) T = cand;
            }
        }
#pragma unroll
        for (int i = 0; i < 64; ++i) { unsigned long long mk = __ballot(v[i] >= T); if (i >= NT) mk = 0ull;
            if (lane == 0) { SEL[(8 * w + 2 * pp) * 64 + i] = (unsigned)mk; SEL[(8 * w + 2 * pp + 1) * 64 + i] = (unsigned)(mk >> 32); } }
    }
    __syncthreads();
    attn_unit<0>(C, PROJ + (size_t)qrow0 * INP + C_AQ, INP, S, 0, NT, ws_bf(C, WS_MIX) + (size_t)qrow0 * DM, DM);
}

DI void band_unit(const Ctx& C, const Args& A, int l, int u) {
    const bf16* PROJ = ws_bf(C, WS_PU);
    int qrow0, tlo; KVSrc S;
    if (u < 256) { const int c = 31 - (u >> 3), b = u & 7; qrow0 = b * SEQ + c * 64; tlo = c < 8 ? (8 - c) * 2 : 0;
        const bf16* base = PROJ + ((ptrdiff_t)b * SEQ + c * 64 - BWIN) * INP;
        S.k0 = base + C_BK; S.v0 = base + C_BV; S.s0 = INP; S.n0 = BWIN + 64; S.k1 = S.k0; S.v1 = S.v0; S.s1 = INP;
    } else { const int b = u - 256; qrow0 = NTP + b * DSEQ; tlo = 0;
        const bf16* nb = PROJ + (size_t)qrow0 * INP;
        S.k0 = ws_bf(C, WS_CBK) + (size_t)b * BWIN * 512; S.v0 = ws_bf(C, WS_CBV) + (size_t)b * BWIN * 512; S.s0 = 512; S.n0 = BWIN; S.k1 = nb + C_BK; S.v1 = nb + C_BV; S.s1 = INP;
    }
    LAS float* bt = (LAS float*)(C.lds + ATT_SEL);
    const float* brel = A.in[12] + (size_t)l * 4 * 257;
    for (int i = C.tid; i < 4 * 257; i += NTHR) bt[i] = brel[i];
    __syncthreads();
    attn_unit<1>(C, PROJ + (size_t)qrow0 * INP + C_BQ, INP, S, tlo, (BWIN + 64) / 32, ws_bf(C, WS_MIX) + (size_t)qrow0 * DM + 512, DM);
}

DI void ssd_unit(const Ctx& C, const Args& A, int l, int row0, int nchunks, int h, const float* h0, float* hout) {
    int tid = C.tid, lane = C.lane; asm volatile("" : "+v"(tid), "+v"(lane));
    const int w = C.wave, r = lane & 31, hh = lane >> 5, g = h >> 2;
    LAS unsigned char* L = C.lds;
    LAS unsigned char* Cs = L + SSD_CS; LAS unsigned char* Bs = L + SSD_BS; LAS unsigned char* XD = L + SSD_XD; LAS unsigned char* XDW = L + SSD_XDW; LAS unsigned char* Ms = L + SSD_MS; LAS unsigned char* Ys = L + SSD_Y;
    LAS float* v_dt = (LAS float*)(L + SSD_VEC); LAS float* v_acs = v_dt + 64; LAS float* v_w = v_dt + 128; LAS float* v_e = v_dt + 192;
    const bf16* XBC = ws_bf(C, WS_XBC); const bf16* PROJ = ws_bf(C, WS_PU); const float* DTS = ws_f(C, WS_DTS); float* G = ws_f(C, WS_G);
    const float a_h = -expf(A.in[16][l * 16 + h]); const float dsk = A.in[17][l * 16 + h];
    f32x16 Hacc[2];
#pragma unroll
    for (int pb = 0; pb < 2; ++pb)
#pragma unroll
        for (int i = 0; i < 16; ++i) Hacc[pb][i] = 0.f;
    __syncthreads();
    if (w >= 4) { const int nb = w - 4;
#pragma unroll
        for (int pb = 0; pb < 2; ++pb)
#pragma unroll
            for (int i = 0; i < 16; ++i) { const int p = 32 * pb + crow(i, hh), n = 32 * nb + r; const float v = h0 ? h0[p * 128 + n] : 0.f; Hacc[pb][i] = v;
                *(LAS bf16*)(L + SSD_HS + p * HSTR + n * 2) = f2bf(v); } }
#pragma unroll 1
    for (int c = 0; c < nchunks; ++c) {
        const int rbase = row0 + c * 64;
        LAS unsigned char* Hcur = L + SSD_HS + (c & 1) * 64 * HSTR; LAS unsigned char* Hnxt = L + SSD_HS + ((c + 1) & 1) * 64 * HSTR;
        __syncthreads();
        if (w == 0) { const float dt = DTS[(size_t)(rbase + lane) * 16 + h]; float acs = dt * a_h;
#pragma unroll
            for (int o = 1; o < 64; o <<= 1) { const float t = __shfl_up(acs, o); if (lane >= o) acs += t; }
            const float A = __shfl(acs, 63);
            v_dt[lane] = dt; v_acs[lane] = acs; v_w[lane] = __expf(A - acs); v_e[lane] = __expf(acs); }
#pragma unroll
        for (int i = 0; i < 2; ++i) { const int ci = tid + 512 * i, row = ci >> 4, ch = ci & 15; const bf16* src = XBC + (size_t)(rbase + row) * 2048 + g * 128 + ch * 8;
            *(LAS u32x4*)(Bs + row * CSTR + ch * 16) = *(const u32x4*)(src + 1024); *(LAS u32x4*)(Cs + row * CSTR + ch * 16) = *(const u32x4*)(src + 1536); }
        __syncthreads();
        const int erow = tid >> 3, ech = tid & 7; float xraw[8];
        { float xd[8], xw[8]; unpack8(*(const u32x4*)(XBC + (size_t)(rbase + erow) * 2048 + h * 64 + ech * 8), xraw);
          const float dt = v_dt[erow], wv = v_w[erow];
#pragma unroll
          for (int k = 0; k < 8; ++k) { xd[k] = xraw[k] * dt; xw[k] = xd[k] * wv; }
          *(LAS u32x4*)(XD + erow * XSTR + ech * 16) = pack8(xd); *(LAS u32x4*)(XDW + erow * XSTR + ech * 16) = pack8(xw); }
        __syncthreads();
        if (w < 4) {
            const int lb = w >> 1, sb = w & 1; f32x16 acc;
#pragma unroll
            for (int i = 0; i < 16; ++i) acc[i] = 0.f;
            if (sb <= lb) {
#pragma unroll
                for (int ks = 0; ks < 8; ++ks) { const bf16x8 a = *(const LAS bf16x8*)(Cs + (32 * lb + r) * CSTR + (16 * ks + 8 * hh) * 2), b = *(const LAS bf16x8*)(Bs + (32 * sb + r) * CSTR + (16 * ks + 8 * hh) * 2);
                    acc = mfma32(a, b, acc); } }
            const int s = 32 * sb + r; const float acs_s = v_acs[s];
#pragma unroll
            for (int i = 0; i < 16; ++i) { const int lr = 32 * lb + crow(i, hh); const float v = (s <= lr) ? acc[i] * __expf(v_acs[lr] - acs_s) : 0.f; *(LAS bf16*)(Ms + lr * MSTR + s * 2) = f2bf(v); }
        } else {
            const int nb = w - 4; const float dec = __expf(v_acs[63]);
#pragma unroll
            for (int pb = 0; pb < 2; ++pb) {
#pragma unroll
                for (int i = 0; i < 16; ++i) Hacc[pb][i] *= dec;
#pragma unroll
                for (int ks = 0; ks < 4; ++ks) { const bf16x8 a = trfrag(XDW, XSTR, 16 * ks, 32 * pb, lane), b = trfrag(Bs, CSTR, 16 * ks, 32 * nb, lane); Hacc[pb] = mfma32(a, b, Hacc[pb]); }
#pragma unroll
                for (int i = 0; i < 16; ++i) *(LAS bf16*)(Hnxt + (32 * pb + crow(i, hh)) * HSTR + (32 * nb + r) * 2) = f2bf(Hacc[pb][i]);
            }
        }
        __syncthreads();
        if (w < 4) {
            const int lb = w >> 1, pb = w & 1; f32x16 yd, yo;
#pragma unroll
            for (int i = 0; i < 16; ++i) { yd[i] = 0.f; yo[i] = 0.f; }
#pragma unroll
            for (int ks = 0; ks < 4; ++ks) { const bf16x8 a = *(const LAS bf16x8*)(Ms + (32 * lb + r) * MSTR + (16 * ks + 8 * hh) * 2), b = trfrag(XD, XSTR, 16 * ks, 32 * pb, lane); yd = mfma32(a, b, yd); }
#pragma unroll
            for (int ks = 0; ks < 8; ++ks) { const bf16x8 a = *(const LAS bf16x8*)(Cs + (32 * lb + r) * CSTR + (16 * ks + 8 * hh) * 2), b = *(const LAS bf16x8*)(Hcur + (32 * pb + r) * HSTR + (16 * ks + 8 * hh) * 2); yo = mfma32(a, b, yo); }
            const int p = 32 * pb + r;
#pragma unroll
            for (int i = 0; i < 16; ++i) { const int lr = 32 * lb + crow(i, hh); *(LAS float*)(Ys + lr * YSTR + p * 4) = yd[i] + v_e[lr] * yo[i]; }
        }
        __syncthreads();
        {
            float z[8]; unpack8(*(const u32x4*)(PROJ + (size_t)(rbase + erow) * INP + C_CZ + h * 64 + ech * 8), z);
            const f32x4 y0 = *(const LAS f32x4*)(Ys + erow * YSTR + ech * 32), y1 = *(const LAS f32x4*)(Ys + erow * YSTR + ech * 32 + 16);
            float y[8] = {y0.x, y0.y, y0.z, y0.w, y1.x, y1.y, y1.z, y1.w};
#pragma unroll
            for (int k = 0; k < 8; ++k) { const float yy = y[k] + dsk * xraw[k]; y[k] = yy * z[k] / (1.f + __expf(-z[k])); }
            float* gp = G + (size_t)(rbase + erow) * 1024 + h * 64 + ech * 8;
            ((f32x4*)gp)[0] = (f32x4){y[0], y[1], y[2], y[3]}; ((f32x4*)gp)[1] = (f32x4){y[4], y[5], y[6], y[7]};
        }
    }
    if (w >= 4) { const int nb = w - 4;
#pragma unroll
        for (int pb = 0; pb < 2; ++pb)
#pragma unroll
            for (int i = 0; i < 16; ++i) hout[(32 * pb + crow(i, hh)) * 128 + 32 * nb + r] = Hacc[pb][i]; }
}

DI void gate_norm_phase(const Ctx& C, const Args& A, int l) {
    const int gw = C.bid * NWAVES + C.wave, NGW = C.G * NWAVES; const float* gn = A.in[18] + (size_t)l * 1024;
    for (int m = gw; m < NTOK; m += NGW) { const float* grow = ws_f(C, WS_G) + (size_t)m * 1024; bf16* orow = ws_bf(C, WS_MIX) + (size_t)m * DM + 1024;
#pragma unroll
        for (int g = 0; g < 4; ++g) { const f32x4 v = ((const f32x4*)grow)[g * 64 + C.lane]; const float ss = wave_sum((v.x * v.x + v.y * v.y) + (v.z * v.z + v.w * v.w));
            const float rs = 1.0f / sqrtf(ss * (1.0f / 256.f) + EPS); const f32x4 wv = ((const f32x4*)gn)[g * 64 + C.lane]; const f32x4 o = v * rs * wv;
            u32x2 p; p.x = pk2(o.x, o.y); p.y = pk2(o.z, o.w); ((u32x2*)orow)[g * 64 + C.lane] = p; } }
}
DI void norm_phase(const Ctx& C, const float* w, bf16* outb, float* outf) {
    const int gw = C.bid * NWAVES + C.wave, NGW = C.G * NWAVES;
    for (int m = gw; m < NTOK; m += NGW) rms_row(ws_f(C, WS_X) + (size_t)m * DM, nullptr, w, outb ? outb + (size_t)m * DM : nullptr, outf ? outf + (size_t)m * DM : nullptr, C.lane);
}

#ifndef MK_ONE_LAUNCH
#define MK_ONE_LAUNCH 0
#endif
#ifndef PHASE_MASK
#define PHASE_MASK 0xFFFF
#endif
#define EN(k) (((PHASE_MASK) >> (k)) & 1)
constexpr int PH_PER_LAYER = 9, NPHASE = 1 + DEPTH * PH_PER_LAYER;
__global__ void __launch_bounds__(NTHR, 2) fwd(Args args) {
    extern __shared__ __attribute__((aligned(16))) unsigned char lds_raw[];
    Ctx C;
    C.lds = (LAS unsigned char*)lds_raw;
    C.tid = threadIdx.x; C.lane = C.tid & 63; C.wave = __builtin_amdgcn_readfirstlane(C.tid >> 6); C.G = gridDim.x; C.bid = blockIdx.x;
    C.ws = args.ws; C.out = args.out; C.ctl = (unsigned*)(args.ws + WS_CTL);
    const Args& A = args;
    for (int u = C.tid; u < (LDS_BYTES - LDSCTL_OFF) / 4; u += NTHR) ((LAS unsigned*)(C.lds + LDSCTL_OFF))[u] = 0u;
    __syncthreads();
    const int lo = args.ph_lo, hi = args.ph_hi;
    const bool multi = (hi - lo) > 1;
    XcdBarrier bar; bar.bar = C.ctl + CW_BAR; bar.x = 0; bar.st = (volatile LAS unsigned*)(C.lds + LDSCTL_OFF);
    if (multi) bar = xcd_barrier_post(C.ctl + CW_BAR, (volatile LAS unsigned*)(C.lds + LDSCTL_OFF));
#define IN(k) (lo <= (k) && (k) < hi)
#define FRESH() do { int t_ = threadIdx.x; asm volatile("" : "+v"(t_)); C.tid = t_; C.lane = t_ & 63; int w_ = __builtin_amdgcn_readfirstlane(t_ >> 6); asm volatile("" : "+s"(w_)); C.wave = w_; } while (0)
#define SEAM(k) do { if (IN((k) + 1)) xcd_barrier(bar); } while (0)

    if (EN(0) && IN(0)) { p0_prologue(C, A); SEAM(0); }
#pragma unroll 1
    for (int l = 0; l < DEPTH; ++l) {
        const int pb = 1 + PH_PER_LAYER * l;
        if (EN(1) && IN(pb + 0)) { FRESH();
            pg8::Gemm g{ws_bf(C, WS_H), w_in_t(C, l), NTOK, INP, DM}; pg8::StaticOrder S; S.init(NTOK, INP, C.G, C.bid);
            pg8::EpiBf16<0> E{ws_bf(C, WS_PU), INP};
            pg8::gemm_phase<pg8::EpiBf16<0>, pg8::StaticOrder, true, true>(C.lds, g, S, E);
            SEAM(pb + 0);
        }
        if (EN(2) && IN(pb + 1)) { FRESH(); m0_phase(C, A, l); SEAM(pb + 1); }
        if (IN(pb + 2)) { FRESH();
            unsigned* qh = C.ctl + CW_Q + 64 * (l * 4);
            if (EN(3)) for (;;) { const int u = q_next(C, qh); if (u >= NB * 16) break;
                ssd_unit(C, A, l, (u >> 4) * SEQ, SEQ / 64, u & 15, nullptr, C.out + OFF_P_SSM + ((size_t)(l * NB + (u >> 4)) * 16 + (u & 15)) * 8192); }
            if (EN(4)) for (;;) { const int u = q_next(C, qh + 64); if (u >= 288) break; dsa_unit(C, l, u); }
            if (EN(5)) for (;;) { const int u = q_next(C, qh + 128); if (u >= 288) break; band_unit(C, A, l, u); }
            if (EN(3)) for (;;) { const int u = q_next(C, qh + 192); if (u >= DBAT * 16) break;
                ssd_unit(C, A, l, NTP + (u >> 4) * DSEQ, 1, u & 15, A.in[7] + ((size_t)(l * DBAT + (u >> 4)) * 16 + (u & 15)) * 8192, C.out + OFF_S_SSM + ((size_t)(l * DBAT + (u >> 4)) * 16 + (u & 15)) * 8192); }
            SEAM(pb + 2);
        }
        if (EN(6) && IN(pb + 3)) { FRESH(); gate_norm_phase(C, A, l); SEAM(pb + 3); }
        if (EN(7) && IN(pb + 4)) { FRESH();
            pg8::Gemm g{ws_bf(C, WS_MIX), w_out_t(C, l), NTOK, DM, DM}; pg8::StaticOrder S; S.init(NTOK, DM, C.G, C.bid);
            pg8::EpiResF32 E{ws_f(C, WS_X), DM};
            pg8::gemm_phase<pg8::EpiResF32, pg8::StaticOrder, true, true>(C.lds, g, S, E);
            SEAM(pb + 4);
        }
        if (EN(8) && IN(pb + 5)) { FRESH(); norm_phase(C, A.in[19] + (size_t)l * DM, ws_bf(C, WS_H), nullptr); SEAM(pb + 5); }
        if (EN(9) && IN(pb + 6)) { FRESH();
            pg8::Gemm g{ws_bf(C, WS_H), w_up_t(C, l), NTOK, DFF, DM}; pg8::StaticOrder S; S.init(NTOK, DFF, C.G, C.bid);
            pg8::EpiBf16<1> E{ws_bf(C, WS_PU), DFF};
            pg8::gemm_phase<pg8::EpiBf16<1>, pg8::StaticOrder, true, true>(C.lds, g, S, E);
            SEAM(pb + 6);
        }
        if (EN(10) && IN(pb + 7)) { FRESH();
            pg8::Gemm g{ws_bf(C, WS_PU), w_dn_t(C, l), NTOK, DM, DFF}; pg8::StaticOrder S; S.init(NTOK, DM, C.G, C.bid);
            pg8::EpiResF32 E{ws_f(C, WS_X), DM};
            pg8::gemm_phase<pg8::EpiResF32, pg8::StaticOrder, true, true>(C.lds, g, S, E);
            SEAM(pb + 7);
        }
        if (EN(8) && IN(pb + 8)) { FRESH();
            if (l + 1 < DEPTH) norm_phase(C, A.in[9] + (size_t)(l + 1) * DM, ws_bf(C, WS_H), nullptr);
            else norm_phase(C, A.in[22], nullptr, C.out);
            SEAM(pb + 8);
        }
    }
#undef IN
#undef SEAM
}

extern "C" void kernel_launch(void* const* d_in, const int* in_sizes, int n_in, void* d_out, int out_size, void* d_ws, size_t ws_size, hipStream_t stream) {
    static int grid = 0;
    if (grid == 0) {
        if (n_in != 23 || in_sizes[0] != NTP * DM || (size_t)out_size != OUT_TOTAL || ws_size < WS_END) {
            fprintf(stderr, "kernel_launch: unexpected shapes (n_in %d, in0 %d, out %d, ws %zu; need ws >= %zu); nothing launched\n", n_in, n_in > 0 ? in_sizes[0] : -1, out_size, ws_size, (size_t)WS_END); grid = -1; return; }
        int dev = 0, cus = 0, per_cu = 0;
        if (hipGetDevice(&dev) != hipSuccess || hipDeviceGetAttribute(&cus, hipDeviceAttributeMultiprocessorCount, dev) != hipSuccess) { fprintf(stderr, "kernel_launch: device query failed\n"); grid = -1; return; }
        if (hipFuncSetAttribute((const void*)fwd, hipFuncAttributeMaxDynamicSharedMemorySize, LDS_BYTES) != hipSuccess) { fprintf(stderr, "kernel_launch: hipFuncSetAttribute failed\n"); grid = -1; return; }
        if (hipOccupancyMaxActiveBlocksPerMultiprocessor(&per_cu, (const void*)fwd, NTHR, LDS_BYTES) != hipSuccess || per_cu < 1)
            fprintf(stderr, "kernel_launch: note: occupancy query reports %d workgroups per CU\n", per_cu);
        (void)hipGetLastError();
        grid = cus < 256 ? cus : 256;
    }
    if (grid < 0) return;
    if (hipMemsetAsync((char*)d_ws + WS_CTL, 0, CTL_ZERO_BYTES, stream) != hipSuccess) { fprintf(stderr, "kernel_launch: memset failed\n"); return; }
    Args a{};
    for (int i = 0; i < 23; ++i) a.in[i] = (const float*)d_in[i];
    a.out = (float*)d_out; a.ws = (unsigned char*)d_ws;
#if MK_ONE_LAUNCH
    a.ph_lo = 0; a.ph_hi = NPHASE;
    hipLaunchKernelGGL(fwd, dim3(grid), dim3(NTHR), LDS_BYTES, stream, a);
#else
    for (int p = 0; p < NPHASE; ++p) { a.ph_lo = p; a.ph_hi = p + 1; hipLaunchKernelGGL(fwd, dim3(grid), dim3(NTHR), LDS_BYTES, stream, a); }
#endif
    const hipError_t le = hipPeekAtLastError();
    if (le != hipSuccess) fprintf(stderr, "kernel_launch: launch failed: %s\n", hipGetErrorName(le));
}
```

```cpp
#include <hip/hip_runtime.h>
#include <cstdio>
#include <cstdint>
#include <cstddef>
namespace pg8 {
#define PG8_LAS __attribute__((address_space(3)))
typedef unsigned short bf16_t;
typedef short bf16x8 __attribute__((ext_vector_type(8)));
typedef float f32x4 __attribute__((ext_vector_type(4)));
typedef unsigned u32x4 __attribute__((ext_vector_type(4)));
constexpr int BM = 256, BK = 64, HALF = 128, HTB = HALF * BK * 2  , STAGE_BYTES = 8 * HTB, NXCD = 8, WGM = 8;

__host__ __device__ __forceinline__ int lds_byte(int r, int c) { const int st = (r >> 4) * 2 + (c >> 5), rr = r & 15, cc = c & 31, ob = rr * 64 + cc * 2; return st * 1024 + (ob ^ (((ob >> 9) & 1) << 5)); }
__host__ __device__ __forceinline__ void stage_rc(int b, int& R, int& C) { const int st = b / 1024, sb = b % 1024, swz = sb ^ (((sb >> 9) & 1) << 5); R = (st >> 1) * 16 + swz / 64; C = (st & 1) * 32 + (swz % 64) / 2; }
__host__ __device__ __forceinline__ int perm32(int rho) { const int n = rho >> 4, i = rho & 15; return 8 * (i >> 2) + 4 * n + (i & 3); }

struct Unit { int pm, pn; };
struct Gemm { const bf16_t* A; const bf16_t* Bt; int M, N, K; };

struct StaticOrder {
    int nM, nN, nwg, G, c;
    __host__ __device__ void init(int M, int N, int G_, int c_) { nM = M / BM; nN = N / BM; nwg = nM * nN; G = G_; c = c_; }
    __host__ __device__ bool next(int i, Unit& u) const {
        const long L = (long)i * G + c; if (L >= nwg) return false;
        int wgid = (int)L; { const int q = nwg / NXCD, r = nwg % NXCD, xcd = wgid % NXCD, off = wgid / NXCD; wgid = (xcd < r ? xcd * (q + 1) : r * (q + 1) + (xcd - r) * q) + off; }
        const int nig = WGM * nN, gid = wgid / nig, fm = gid * WGM, gsz = (nM - fm) < WGM ? (nM - fm) : WGM;
        u.pm = fm + ((wgid % nig) % gsz); u.pn = (wgid % nig) / gsz; return true;
    }
    __device__ __forceinline__ void a_ready(const Unit&) const {}
    __device__ __forceinline__ void done(const Unit&) const {}
};

typedef float f32x2_t __attribute__((ext_vector_type(2)));
typedef __bf16 bf16x2_t __attribute__((ext_vector_type(2)));
__device__ __forceinline__ unsigned cvt_pk_bf16(float lo, float hi) { f32x2_t v = {lo, hi}; bf16x2_t b = __builtin_convertvector(v, bf16x2_t); return __builtin_bit_cast(unsigned, b); }

template <int ACT  > struct EpiBf16 {
    static constexpr bool PERM = true, AFTER_DRAIN = false;
    bf16_t* O; int ldc;
    __device__ __forceinline__ void operator()(const f32x4 (&acc)[2][2][4][2], const Unit& u, int wr, int wc, int fr, int fq) const {
        const int row0 = u.pm * BM + wr * 64 + fr; const int col0 = u.pn * BM + wc * 32 + 8 * fq;
#pragma unroll
        for (int ai = 0; ai < 2; ++ai)
#pragma unroll
            for (int m = 0; m < 4; ++m) { bf16_t* rowp = O + (size_t)(row0 + ai * HALF + m * 16) * ldc + col0;
#pragma unroll
                for (int bj = 0; bj < 2; ++bj) { f32x4 v0 = acc[ai][bj][m][0], v1 = acc[ai][bj][m][1];
                    if (ACT == 1) {
#pragma unroll
                        for (int j = 0; j < 4; ++j) { const float a = v0[j] > 0.f ? v0[j] : 0.f, b = v1[j] > 0.f ? v1[j] : 0.f; v0[j] = a * a; v1[j] = b * b; } }
                    u32x4 w; w.x = cvt_pk_bf16(v0[0], v0[1]); w.y = cvt_pk_bf16(v0[2], v0[3]); w.z = cvt_pk_bf16(v1[0], v1[1]); w.w = cvt_pk_bf16(v1[2], v1[3]);
                    *(u32x4*)(rowp + bj * HALF) = w; } }
    }
};
struct EpiResF32 {
    static constexpr bool PERM = false, AFTER_DRAIN = false;
    float* X; int ldc;
    __device__ __forceinline__ void operator()(const f32x4 (&acc)[2][2][4][2], const Unit& u, int wr, int wc, int fr, int fq) const {
        const int row0 = u.pm * BM + wr * 64 + fr, col0 = u.pn * BM + wc * 32 + 4 * fq;
#pragma unroll
        for (int ai = 0; ai < 2; ++ai)
#pragma unroll
            for (int m = 0; m < 4; ++m) { float* rowp = X + (size_t)(row0 + ai * HALF + m * 16) * ldc + col0;
                f32x4 b[2][2];
#pragma unroll
                for (int bj = 0; bj < 2; ++bj)
#pragma unroll
                    for (int n = 0; n < 2; ++n) b[bj][n] = *(const f32x4*)(rowp + bj * HALF + n * 16);
#pragma unroll
                for (int bj = 0; bj < 2; ++bj)
#pragma unroll
                    for (int n = 0; n < 2; ++n) *(f32x4*)(rowp + bj * HALF + n * 16) = b[bj][n] + acc[ai][bj][m][n];
                asm volatile("" ::: "memory"); }
    }
};
template <class Epi, class Sched, bool ALIGN_EPI = false, bool SP2 = false>
__device__ __forceinline__ void gemm_phase(PG8_LAS unsigned char* lds, const Gemm g, const Sched& S, const Epi& E) {
    int tid_ = threadIdx.x; asm volatile("" : "+v"(tid_));
    const int tid = tid_, wid = __builtin_amdgcn_readfirstlane(tid >> 6), lane = tid & 63, wr = wid >> 2, wc = wid & 3, fr = lane & 15, fq = lane >> 4;
    const int K = g.K, nt = K / BK;
    unsigned voffA[2], voffB[2];
#pragma unroll
    for (int i = 0; i < 2; ++i) { int R, C; stage_rc(tid * 16 + i * 8192, R, C); const int Rb = Epi::PERM ? ((R & ~31) + perm32(R & 31)) : R;
        voffA[i] = (unsigned)(R * K + C) * 2u; voffB[i] = (unsigned)(Rb * K + C) * 2u; }
    const size_t kstep = (size_t)(BK * 2);
    const size_t hstep = (size_t)HALF * K * 2;
    const size_t tstep = 2 * hstep;
    const unsigned ldsw = (unsigned)wid * 1024u;
    const int aoff = lds_byte(wr * 64 + fr, fq * 8), boff = lds_byte(wc * 32 + fr, fq * 8);
#define PG8_SA(b, h) (((b) * 2 + (h)) * HTB)
#define PG8_SB(b, h) ((4 + (b) * 2 + (h)) * HTB)
#define PG8_STAGE(bufoff, gbase, voff) do { _Pragma("unroll") for (int _i = 0; _i < 2; ++_i) \
        __builtin_amdgcn_global_load_lds((const unsigned*)((const char*)(gbase) + (voff)[_i]), (PG8_LAS unsigned*)(lds + (bufoff) + ldsw + _i * 8192), 16, 0, 0); } while (0)
#define PG8_LDA(dst, b, h) do { _Pragma("unroll") for (int m = 0; m < 4; ++m) _Pragma("unroll") for (int k = 0; k < 2; ++k) dst[m][k] = *(const PG8_LAS bf16x8*)(lds + PG8_SA(b, h) + aoff + m * 2048 + k * 1024); } while (0)
#define PG8_LDB(dst, b, h) do { _Pragma("unroll") for (int n = 0; n < 2; ++n) _Pragma("unroll") for (int k = 0; k < 2; ++k) dst[n][k] = *(const PG8_LAS bf16x8*)(lds + PG8_SB(b, h) + boff + n * 2048 + k * 1024); } while (0)
#define PG8_MMA(ai, bj, At, Bt) do { __builtin_amdgcn_s_setprio(1); _Pragma("unroll") for (int m = 0; m < 4; ++m) _Pragma("unroll") for (int n = 0; n < 2; ++n) _Pragma("unroll") for (int k = 0; k < 2; ++k) \
        acc[ai][bj][m][n] = __builtin_amdgcn_mfma_f32_16x16x32_bf16(Bt[n][k], At[m][k], acc[ai][bj][m][n], 0, 0, 0); __builtin_amdgcn_s_setprio(0); } while (0)
#define PG8_WAIT_V(n) asm volatile("s_waitcnt vmcnt(" #n ")" ::: "memory")
#define PG8_WAIT_L(n) asm volatile("s_waitcnt lgkmcnt(" #n ")" ::: "memory")
#define PG8_BAR __builtin_amdgcn_s_barrier()
#define PG8_SCHED __builtin_amdgcn_sched_barrier(0)
    Unit cur, nxt; int ui = 0;
    if (!S.next(0, cur)) return;
    f32x4 acc[2][2][4][2];
#pragma unroll
    for (int a = 0; a < 2; ++a)
#pragma unroll
        for (int b = 0; b < 2; ++b)
#pragma unroll
            for (int m = 0; m < 4; ++m)
#pragma unroll
                for (int n = 0; n < 2; ++n) acc[a][b][m][n] = (f32x4){0.f, 0.f, 0.f, 0.f};
    bf16x8 At[4][2], B0[2][2], B1[2][2];
    const char* cA = (const char*)g.A + (size_t)cur.pm * tstep; const char* cB = (const char*)g.Bt + (size_t)cur.pn * tstep;
    S.a_ready(cur);
    if constexpr (SP2) {
        PG8_STAGE(PG8_SB(0, 0), cB, voffB); PG8_STAGE(PG8_SB(0, 1), cB + hstep, voffB); PG8_STAGE(PG8_SA(0, 0), cA, voffA); PG8_STAGE(PG8_SA(0, 1), cA + hstep, voffA);
        if (wr == 1) PG8_BAR;
        PG8_WAIT_V(2); PG8_BAR;
        PG8_STAGE(PG8_SB(1, 0), cB + kstep, voffB); PG8_STAGE(PG8_SA(1, 0), cA + kstep, voffA); PG8_STAGE(PG8_SB(1, 1), cB + hstep + kstep, voffB);
        PG8_WAIT_V(6); PG8_BAR;
    } else {
        PG8_STAGE(PG8_SB(0, 0), cB, voffB); PG8_STAGE(PG8_SA(0, 0), cA, voffA); PG8_STAGE(PG8_SB(0, 1), cB + hstep, voffB); PG8_STAGE(PG8_SA(0, 1), cA + hstep, voffA);
        if (wr == 1) PG8_BAR;
        PG8_WAIT_V(4); PG8_BAR;
        PG8_STAGE(PG8_SB(1, 0), cB + kstep, voffB); PG8_STAGE(PG8_SA(1, 0), cA + kstep, voffA); PG8_STAGE(PG8_SB(1, 1), cB + hstep + kstep, voffB);
        PG8_WAIT_V(6); PG8_BAR;
    }
    for (;;) {
        const bool has_next = S.next(ui + 1, nxt);
        const char* nA = has_next ? (const char*)g.A + (size_t)nxt.pm * tstep : cA; const char* nB = has_next ? (const char*)g.Bt + (size_t)nxt.pn * tstep : cB;
        for (int t = 0; t < nt; t += 2) {
            const bool last = (t == nt - 2);
            const char* a1 = cA + (size_t)(t + 1) * kstep;
            const char* a2 = last ? nA : cA + (size_t)(t + 2) * kstep; const char* b2 = last ? nB : cB + (size_t)(t + 2) * kstep;
            const char* a3 = a2 + kstep; const char* b3 = b2 + kstep;
            if (last && has_next) S.a_ready(nxt);
            if constexpr (SP2) {
            PG8_LDB(B0, 0, 0); PG8_LDB(B1, 0, 1); PG8_SCHED; PG8_LDA(At, 0, 0); PG8_STAGE(PG8_SA(1, 1), a1 + hstep, voffA);
            PG8_WAIT_V(8); PG8_WAIT_L(0); PG8_BAR; PG8_MMA(0, 0, At, B0); PG8_MMA(0, 1, At, B1); PG8_BAR; PG8_SCHED;
            PG8_LDA(At, 0, 1); PG8_STAGE(PG8_SB(0, 0), b2, voffB); PG8_STAGE(PG8_SB(0, 1), b2 + hstep, voffB); PG8_STAGE(PG8_SA(0, 0), a2, voffA);
            PG8_WAIT_V(8); PG8_WAIT_L(0); PG8_BAR; PG8_MMA(1, 0, At, B0); PG8_MMA(1, 1, At, B1); PG8_BAR; PG8_SCHED;
            PG8_LDB(B0, 1, 0); PG8_LDB(B1, 1, 1); PG8_SCHED; PG8_LDA(At, 1, 0); PG8_STAGE(PG8_SA(0, 1), a2 + hstep, voffA);
            PG8_WAIT_V(8); PG8_WAIT_L(0); PG8_BAR; PG8_MMA(0, 0, At, B0); PG8_MMA(0, 1, At, B1); PG8_BAR; PG8_SCHED;
            PG8_LDA(At, 1, 1); PG8_STAGE(PG8_SB(1, 0), b3, voffB); PG8_STAGE(PG8_SB(1, 1), b3 + hstep, voffB); PG8_STAGE(PG8_SA(1, 0), a3, voffA);
            PG8_WAIT_V(8); PG8_WAIT_L(0); PG8_BAR; PG8_MMA(1, 0, At, B0); PG8_MMA(1, 1, At, B1); PG8_BAR; PG8_SCHED;
            } else {
            PG8_LDB(B0, 0, 0); PG8_SCHED; PG8_LDA(At, 0, 0); PG8_STAGE(PG8_SA(1, 1), a1 + hstep, voffA);
            PG8_WAIT_L(8); PG8_BAR; PG8_WAIT_L(0); PG8_MMA(0, 0, At, B0); PG8_BAR; PG8_SCHED;
            PG8_LDB(B1, 0, 1); PG8_STAGE(PG8_SB(0, 0), b2, voffB);
            PG8_BAR; PG8_WAIT_L(0); PG8_MMA(0, 1, At, B1); PG8_BAR;
            PG8_LDA(At, 0, 1); PG8_STAGE(PG8_SA(0, 0), a2, voffA);
            PG8_BAR; PG8_WAIT_L(0); PG8_MMA(1, 0, At, B0); PG8_BAR; PG8_SCHED;
            PG8_STAGE(PG8_SB(0, 1), b2 + hstep, voffB);
            PG8_WAIT_V(6); PG8_BAR; PG8_MMA(1, 1, At, B1); PG8_BAR;
            PG8_LDB(B0, 1, 0); PG8_SCHED; PG8_LDA(At, 1, 0); PG8_STAGE(PG8_SA(0, 1), a2 + hstep, voffA);
            PG8_WAIT_L(8); PG8_BAR; PG8_WAIT_L(0); PG8_MMA(0, 0, At, B0); PG8_BAR; PG8_SCHED;
            PG8_LDB(B1, 1, 1); PG8_STAGE(PG8_SB(1, 0), b3, voffB);
            PG8_BAR; PG8_WAIT_L(0); PG8_MMA(0, 1, At, B1); PG8_BAR;
            PG8_LDA(At, 1, 1); PG8_STAGE(PG8_SA(1, 0), a3, voffA);
            PG8_BAR; PG8_WAIT_L(0); PG8_MMA(1, 0, At, B0); PG8_BAR; PG8_SCHED;
            PG8_STAGE(PG8_SB(1, 1), b3 + hstep, voffB);
            PG8_WAIT_V(6); PG8_BAR; PG8_MMA(1, 1, At, B1); PG8_BAR;
            }
        }
        if constexpr (ALIGN_EPI) { if (wr == 0) PG8_BAR; }
        if constexpr (!Epi::AFTER_DRAIN) { E(acc, cur, wr, wc, fr, fq); S.done(cur); }
        if (!has_next) break;
#pragma unroll
        for (int a = 0; a < 2; ++a)
#pragma unroll
            for (int b = 0; b < 2; ++b)
#pragma unroll
                for (int m = 0; m < 4; ++m)
#pragma unroll
                    for (int n = 0; n < 2; ++n) acc[a][b][m][n] = (f32x4){0.f, 0.f, 0.f, 0.f};
        cur = nxt; cA = nA; cB = nB; ++ui;
        if constexpr (ALIGN_EPI) { if (wr == 1) PG8_BAR; }
    }
    PG8_WAIT_V(0);
    if constexpr (!ALIGN_EPI) { if (wr == 0) PG8_BAR; }
    PG8_BAR;
    if constexpr (Epi::AFTER_DRAIN) { E.fused(acc, cur, wr, wc, fr, fq, lds, wid, lane); S.done(cur); }
#undef PG8_SA
#undef PG8_SB
#undef PG8_STAGE
#undef PG8_LDA
#undef PG8_LDB
#undef PG8_MMA
#undef PG8_WAIT_V
#undef PG8_WAIT_L
#undef PG8_BAR
#undef PG8_SCHED
}
}

#define DI __device__ __forceinline__
#define LAS __attribute__((address_space(3)))
typedef unsigned short bf16;
typedef short bf16x8 __attribute__((ext_vector_type(8)));
typedef short s16x4 __attribute__((ext_vector_type(4)));
typedef short v4i16_t __attribute__((ext_vector_type(4)));
typedef float f32x4 __attribute__((ext_vector_type(4)));
typedef float f32x16 __attribute__((ext_vector_type(16)));
typedef unsigned u32x4 __attribute__((ext_vector_type(4)));
typedef unsigned u32x2 __attribute__((ext_vector_type(2)));

constexpr int DM = 2048, NB = 8, SEQ = 2048, DEPTH = 4, DBAT = 32, DSEQ = 64, PAST = 1024, BWIN = 512;
constexpr int NTP = NB * SEQ, NTS = DBAT * DSEQ, NTOK = NTP + NTS;
constexpr int INC = 7264, INP = 7424, DFF = 8192;
constexpr int C_AQ = 0, C_AK = 512, C_AV = 1024, C_IQ = 1536, C_IK = 2560, C_IW = 2624, C_BQ = 2640, C_BK = 3152, C_BV = 3664, C_CZ = 4176, C_XBC = 5200, C_DT = 7248;
constexpr float EPS = 1e-5f;
constexpr int NWAVES = 8, NTHR = 512;

constexpr size_t SZ_YP = (size_t)NTP * DM, SZ_YS = (size_t)NTS * DM;
constexpr size_t SZ_PAK = (size_t)DEPTH * NB * SEQ * 512, SZ_PKI = (size_t)DEPTH * NB * SEQ * 64, SZ_PBK = (size_t)DEPTH * NB * BWIN * 512;
constexpr size_t SZ_PSSM = (size_t)DEPTH * NB * 16 * 64 * 128, SZ_PCONV = (size_t)DEPTH * NB * 3 * 2048;
constexpr size_t SZ_SAK = (size_t)DEPTH * DBAT * DSEQ * 512, SZ_SKI = (size_t)DEPTH * DBAT * DSEQ * 64, SZ_SBK = SZ_SAK;
constexpr size_t SZ_SSSM = (size_t)DEPTH * DBAT * 16 * 64 * 128, SZ_SCONV = (size_t)DEPTH * DBAT * 3 * 2048;
constexpr size_t OFF_YP = 0, OFF_YS = OFF_YP + SZ_YP, OFF_P_AK = OFF_YS + SZ_YS, OFF_P_AV = OFF_P_AK + SZ_PAK, OFF_P_KI = OFF_P_AV + SZ_PAK,
                 OFF_P_BK = OFF_P_KI + SZ_PKI, OFF_P_BV = OFF_P_BK + SZ_PBK, OFF_P_SSM = OFF_P_BV + SZ_PBK, OFF_P_CONV = OFF_P_SSM + SZ_PSSM,
                 OFF_S_AK = OFF_P_CONV + SZ_PCONV, OFF_S_AV = OFF_S_AK + SZ_SAK, OFF_S_KI = OFF_S_AV + SZ_SAK, OFF_S_BK = OFF_S_KI + SZ_SKI,
                 OFF_S_BV = OFF_S_BK + SZ_SBK, OFF_S_SSM = OFF_S_BV + SZ_SBK, OFF_S_CONV = OFF_S_SSM + SZ_SSSM, OUT_TOTAL = OFF_S_CONV + SZ_SCONV;
static_assert(OUT_TOTAL == 165085184, "output size");

constexpr size_t MiB = 1u << 20;
constexpr size_t WS_CTL = 0, CTL_ZERO_BYTES = 1 * MiB;
constexpr size_t WS_ROPE = 1 * MiB;
constexpr size_t WS_W = 2 * MiB;
constexpr size_t W_IN_B = (size_t)INP * DM * 2, W_OUT_B = (size_t)DM * DM * 2, W_UP_B = (size_t)DFF * DM * 2, W_DN_B = (size_t)DM * DFF * 2, W_LAYER_B = W_IN_B + W_OUT_B + W_UP_B + W_DN_B;
static_assert(W_LAYER_B == 101 * MiB, "weights per layer");
constexpr size_t WS_X = WS_W + DEPTH * W_LAYER_B;
constexpr size_t WS_H = WS_X + (size_t)NTOK * DM * 4;
constexpr size_t WS_MIX = WS_H + (size_t)NTOK * DM * 2;
constexpr size_t WS_PU = WS_MIX + (size_t)NTOK * DM * 2;
constexpr size_t WS_XBC = WS_PU + (size_t)NTOK * DFF * 2;
constexpr size_t WS_G = WS_XBC + (size_t)NTOK * 2048 * 2;
constexpr size_t WS_DTS = WS_G + (size_t)NTOK * 1024 * 4;
constexpr size_t WS_CAK = WS_DTS + 2 * MiB;
constexpr size_t WS_CAV = WS_CAK + (size_t)DBAT * PAST * 512 * 2;
constexpr size_t WS_CBK = WS_CAV + (size_t)DBAT * PAST * 512 * 2;
constexpr size_t WS_CBV = WS_CBK + (size_t)DBAT * BWIN * 512 * 2;
constexpr size_t WS_CKI = WS_CBV + (size_t)DBAT * BWIN * 512 * 2;
constexpr size_t WS_SC = WS_CKI + (size_t)DBAT * PAST * 64 * 2;
constexpr size_t WS_END = WS_SC + (size_t)256 * 64 * 2048 * 4;
static_assert(WS_END == 1356 * MiB, "ws map");
constexpr int CW_BAR = 4096;
constexpr int CW_Q = 16384;

constexpr int RING_BYTES = 131072, LDSCTL_OFF = RING_BYTES, LDS_BYTES = 147456;
constexpr int ATT_SEL = 0;
constexpr int ATT_K = 16384, KSTR = 1040, ATT_V = ATT_K + 32 * KSTR, VSTR = 1088, ATT_END = ATT_V + 32 * VSTR;
constexpr int CSTR = 272, XSTR = 144, MSTR = 144, HSTR = 272;
constexpr int SSD_CS = 0, SSD_BS = SSD_CS + 64 * CSTR, SSD_XD = SSD_BS + 64 * CSTR, SSD_XDW = SSD_XD + 64 * XSTR, SSD_MS = SSD_XDW + 64 * XSTR,
              SSD_HS = SSD_MS + 64 * MSTR, SSD_VEC = SSD_HS + 2 * 64 * HSTR, SSD_Y = SSD_VEC + 1024, YSTR = 272, SSD_END = SSD_Y + 64 * YSTR;
static_assert(ATT_END <= RING_BYTES && SSD_END <= RING_BYTES, "phase scratch fits the ring region");

DI float bf2f(bf16 v) { return __uint_as_float(((unsigned)v) << 16); }
DI unsigned pk2(float lo, float hi) { return pg8::cvt_pk_bf16(lo, hi); }
DI bf16 f2bf(float f) { return (bf16)(pk2(f, 0.f) & 0xffffu); }
DI float wave_sum(float v) {
#pragma unroll
    for (int o = 1; o < 64; o <<= 1) v += __shfl_xor(v, o);
    return v;
}
DI f32x16 mfma32(bf16x8 a, bf16x8 b, f32x16 c) { return __builtin_amdgcn_mfma_f32_32x32x16_bf16(a, b, c, 0, 0, 0); }
DI int crow(int i, int hh) { return (i & 3) + 8 * (i >> 2) + 4 * hh; }
DI s16x4 tr_read(LAS unsigned char* p) { return __builtin_bit_cast(s16x4, __builtin_amdgcn_ds_read_tr16_b64_v4i16((LAS v4i16_t*)p)); }
DI bf16x8 trfrag(LAS unsigned char* tile, int stride, int k0, int c0, int lane) {
    const int i16 = lane & 15, qq = i16 >> 2, p = i16 & 3, g2 = (lane >> 4) & 1, hh = lane >> 5;
    LAS unsigned char* a = tile + (k0 + 8 * hh + qq) * stride + (c0 + 16 * g2 + 4 * p) * 2;
    const s16x4 lo = tr_read(a), hi = tr_read(a + 4 * stride);
    return __builtin_shufflevector(lo, hi, 0, 1, 2, 3, 4, 5, 6, 7);
}
DI void unpack8(u32x4 v, float (&f)[8]) {
#pragma unroll
    for (int i = 0; i < 4; ++i) { f[2 * i] = __uint_as_float(v[i] << 16); f[2 * i + 1] = __uint_as_float(v[i] & 0xffff0000u); }
}
DI u32x4 pack8(const float (&f)[8]) { u32x4 o; o.x = pk2(f[0], f[1]); o.y = pk2(f[2], f[3]); o.z = pk2(f[4], f[5]); o.w = pk2(f[6], f[7]); return o; }

#define XB_TMO      128
#define XB_XCNT(j)  (256  + 64 * (j))
#define XB_XSUB(j)  (1280 + 64 * (j))
#define XB_XGEN(j)  (2304 + 64 * (j))
#define XB_TOP      3328
#define XB_TOPGEN   3392
#define XCD_BAR_WORDS 3456
#define XB_SPIN_CAP (1u << 20)
DI unsigned xb_ld(unsigned* p)              { return __hip_atomic_load(p, __ATOMIC_RELAXED, __HIP_MEMORY_SCOPE_AGENT); }
DI unsigned xb_add(unsigned* p, unsigned v) { return __hip_atomic_fetch_add(p, v, __ATOMIC_RELAXED, __HIP_MEMORY_SCOPE_AGENT); }
DI unsigned xb_xcc_id() { return (unsigned)__builtin_amdgcn_s_getreg((3 << 11) | 20) & 0xFu; }
#define XB_SPIN(cond, bar) do { unsigned _sp = 0; while (cond) { __builtin_amdgcn_s_sleep(1); \
    if ((++_sp & 255u) == 0u) { if (xb_ld(&(bar)[XB_TMO])) break; if (_sp > XB_SPIN_CAP) { atomicAdd(&(bar)[XB_TMO], 1u); break; } } } } while (0)
struct XcdBarrier { unsigned* bar; unsigned x; volatile LAS unsigned* st; };
DI XcdBarrier xcd_barrier_post(unsigned* bar, volatile LAS unsigned* st) {
    XcdBarrier b; b.bar = bar; b.x = xb_xcc_id(); b.st = st;
    if (threadIdx.x == 0) (void)xb_add(&bar[XB_XCNT(b.x)], 1u);
    return b;
}
DI void xcd_barrier_complete(unsigned* bar, unsigned x, unsigned& nloc, unsigned& nx) {
    const unsigned G = gridDim.x * gridDim.y * gridDim.z;
    unsigned sum, cnt, mine, sp = 0u;
    for (;;) {
        sum = 0u; cnt = 0u; mine = 0u;
#pragma unroll
        for (unsigned j = 0; j < 16; ++j) { const unsigned c = xb_ld(&bar[XB_XCNT(j)]); sum += c; cnt += (c > 0u) ? 1u : 0u; mine = (j == x) ? c : mine; }
        if (sum == G) break;
        __builtin_amdgcn_s_sleep(1);
        if ((++sp & 255u) == 0u) { if (xb_ld(&bar[XB_TMO])) break; if (sp > XB_SPIN_CAP) { atomicAdd(&bar[XB_TMO], 1u); break; } }
    }
    nloc = mine > 0u ? mine : 1u; nx = cnt > 0u ? cnt : 1u;
}
DI void xcd_barrier(const XcdBarrier& b) {
    asm volatile("s_waitcnt vmcnt(0)" ::: "memory");
    __syncthreads();
    if (threadIdx.x == 0) {
        unsigned* bar = b.bar;
        __builtin_amdgcn_s_waitcnt(0);
        unsigned nloc = b.st[0], nx = b.st[1];
        if (nloc == 0u) { xcd_barrier_complete(bar, b.x, nloc, nx); b.st[0] = nloc; b.st[1] = nx; }
        const unsigned old = xb_add(&bar[XB_XSUB(b.x)], 1u);
        const unsigned gen = old / nloc;
        if (old + 1u == (gen + 1u) * nloc) {
            __builtin_amdgcn_fence(__ATOMIC_RELEASE, "agent");
            asm volatile("s_waitcnt vmcnt(0)" ::: "memory");
            const unsigned og = xb_add(&bar[XB_TOP], 1u);
            const unsigned tg = og / nx;
            if (og + 1u == (tg + 1u) * nx) xb_add(&bar[XB_TOPGEN], 1u);
            else XB_SPIN(xb_ld(&bar[XB_TOPGEN]) == tg, bar);
            __builtin_amdgcn_fence(__ATOMIC_ACQUIRE, "agent");
            xb_add(&bar[XB_XGEN(b.x)], 1u);
            asm volatile("s_waitcnt vmcnt(0)" ::: "memory");
        } else {
            XB_SPIN(xb_ld(&bar[XB_XGEN(b.x)]) == gen, bar);
            __builtin_amdgcn_fence(__ATOMIC_ACQUIRE, "agent");
            asm volatile("s_waitcnt vmcnt(0)" ::: "memory");
        }
    }
    __syncthreads();
}

struct Args { const float* in[23]; float* out; unsigned char* ws; int ph_lo, ph_hi; };
static_assert(sizeof(Args) == 23 * 8 + 8 + 8 + 8, "Args has no padding");
struct Ctx {
    LAS unsigned char* lds;
    unsigned* ctl;
    int tid, lane, wave, G, bid;
    float* out;
    unsigned char* ws;
};
DI bf16* ws_bf(const Ctx& C, size_t off) { return (bf16*)(C.ws + off); }
DI float* ws_f(const Ctx& C, size_t off) { return (float*)(C.ws + off); }
DI bf16* w_in_t(const Ctx& C, int l)  { return (bf16*)(C.ws + WS_W + (size_t)l * W_LAYER_B); }
DI bf16* w_out_t(const Ctx& C, int l) { return (bf16*)(C.ws + WS_W + (size_t)l * W_LAYER_B + W_IN_B); }
DI bf16* w_up_t(const Ctx& C, int l)  { return (bf16*)(C.ws + WS_W + (size_t)l * W_LAYER_B + W_IN_B + W_OUT_B); }
DI bf16* w_dn_t(const Ctx& C, int l)  { return (bf16*)(C.ws + WS_W + (size_t)l * W_LAYER_B + W_IN_B + W_OUT_B + W_UP_B); }

DI int q_next(const Ctx& C, unsigned* head) {
    volatile LAS int* slot = (volatile LAS int*)(C.lds + LDSCTL_OFF + 64);
    __syncthreads();
    if (C.tid == 0) *slot = (int)__hip_atomic_fetch_add(head, 1u, __ATOMIC_RELAXED, __HIP_MEMORY_SCOPE_AGENT);
    __syncthreads();
    return *slot;
}

DI void p0_transpose_item(const float* W, int K, int N, bf16* WT, LAS float* scr, int item, int lane) {
    const int nblk = N / 32, kb = item / nblk, nb = item % nblk, k0 = 64 * kb, n0 = 32 * nb;
#pragma unroll 8
    for (int i = 0; i < 32; ++i) { const int kk = 2 * i + (lane >> 5); scr[kk * 33 + (lane & 31)] = W[(size_t)(k0 + kk) * N + n0 + (lane & 31)]; }
    asm volatile("s_waitcnt lgkmcnt(0)" ::: "memory");
    const int c = lane & 7;
#pragma unroll
    for (int j = 0; j < 4; ++j) { const int n = (lane >> 3) + 8 * j; const LAS float* s = scr + (8 * c) * 33 + n;
        u32x4 o; o.x = pk2(s[0 * 33], s[1 * 33]); o.y = pk2(s[2 * 33], s[3 * 33]); o.z = pk2(s[4 * 33], s[5 * 33]); o.w = pk2(s[6 * 33], s[7 * 33]);
        *(u32x4*)(WT + (size_t)(n0 + n) * K + k0 + 8 * c) = o; }
    asm volatile("s_waitcnt lgkmcnt(0)" ::: "memory");
}
DI void rms_row(const float* src, float* xcopy, const float* w, bf16* outb, float* outf, int lane) {
    f32x4 v[8]; float ss = 0.f;
#pragma unroll
    for (int j = 0; j < 8; ++j) { v[j] = ((const f32x4*)src)[lane + 64 * j]; ss += (v[j].x * v[j].x + v[j].y * v[j].y) + (v[j].z * v[j].z + v[j].w * v[j].w); }
    if (xcopy) {
#pragma unroll
        for (int j = 0; j < 8; ++j) ((f32x4*)xcopy)[lane + 64 * j] = v[j];
    }
    ss = wave_sum(ss);
    const float rs = 1.0f / sqrtf(ss * (1.0f / DM) + EPS);
#pragma unroll
    for (int j = 0; j < 8; ++j) { const f32x4 wv = ((const f32x4*)w)[lane + 64 * j]; const f32x4 o = v[j] * rs * wv;
        if (outb) { u32x2 p; p.x = pk2(o.x, o.y); p.y = pk2(o.z, o.w); ((u32x2*)outb)[lane + 64 * j] = p; }
        if (outf) ((f32x4*)outf)[lane + 64 * j] = o; }
}
DI void sincos_tab(float ang, float& c, float& s) {
    const double a = (double)ang; const double kq = rint(a * 0.63661977236758134308); const double x = a - kq * 1.57079632679489661923; const double x2 = x * x;
    const double sn = x * (1.0 + x2 * (-1.0 / 6 + x2 * (1.0 / 120 + x2 * (-1.0 / 5040 + x2 * (1.0 / 362880 + x2 * (-1.0 / 39916800 + x2 * (1.0 / 6227020800.0)))))));
    const double cn = 1.0 + x2 * (-0.5 + x2 * (1.0 / 24 + x2 * (-1.0 / 720 + x2 * (1.0 / 40320 + x2 * (-1.0 / 3628800 + x2 * (1.0 / 479001600 + x2 * (-1.0 / 87178291200.0)))))));
    const int q = ((int)kq) & 3;
    const double cc = (q == 0) ? cn : (q == 1) ? -sn : (q == 2) ? -cn : sn;
    const double sc = (q == 0) ? sn : (q == 1) ? cn : (q == 2) ? -sn : -cn;
    c = (float)cc; s = (float)sc;
}
DI void p0_prologue(const Ctx& C, const Args& A) {
    LAS float* scr = (LAS float*)(C.lds + C.wave * 16384);
    const int gw = C.bid * NWAVES + C.wave, NGW = C.G * NWAVES;
    constexpr int I_IN = (DM / 64) * (INC / 32), I_OUT = (DM / 64) * (DM / 32), I_UP = (DM / 64) * (DFF / 32), I_DN = (DFF / 64) * (DM / 32), I_L = I_IN + I_OUT + I_UP + I_DN;
    for (int it = gw; it < DEPTH * I_L; it += NGW) {
        const int l = it / I_L; int r = it % I_L;
        if (r < I_IN) { p0_transpose_item(A.in[10] + (size_t)l * DM * INC, DM, INC, w_in_t(C, l), scr, r, C.lane); continue; } r -= I_IN;
        if (r < I_OUT) { p0_transpose_item(A.in[11] + (size_t)l * DM * DM, DM, DM, w_out_t(C, l), scr, r, C.lane); continue; } r -= I_OUT;
        if (r < I_UP) { p0_transpose_item(A.in[20] + (size_t)l * DM * DFF, DM, DFF, w_up_t(C, l), scr, r, C.lane); continue; } r -= I_UP;
        p0_transpose_item(A.in[21] + (size_t)l * DFF * DM, DFF, DM, w_dn_t(C, l), scr, r, C.lane);
    }
    { const int gt = C.bid * NTHR + C.tid, NGT = C.G * NTHR; constexpr int CH_L = (INP - INC) * DM / 8;
      for (int i = gt; i < DEPTH * CH_L; i += NGT) { const int l = i / CH_L, c = i % CH_L; ((u32x4*)(w_in_t(C, l) + (size_t)INC * DM))[c] = (u32x4){0u, 0u, 0u, 0u}; }
      float* ra = ws_f(C, WS_ROPE); float* ri = ra + 2048 * 16 * 2;
      for (int i = gt; i < 2048 * 24; i += NGT) { const int pos = i / 24, k = i % 24; const bool isa = k < 16; const int fi = isa ? k : k - 16;
          const double ex = isa ? (double)fi / 16.0 : (double)fi / 8.0; const float inv = (float)exp2(-ex * 18.931568569324174  );
          const float ang = (float)pos * inv; float c, s; sincos_tab(ang, c, s);
          float* dst = isa ? ra + (pos * 16 + fi) * 2 : ri + (pos * 8 + fi) * 2; dst[0] = c; dst[1] = s; } }
    for (int m = gw; m < NTOK; m += NGW) { const float* src = m < NTP ? A.in[0] + (size_t)m * DM : A.in[1] + (size_t)(m - NTP) * DM;
        rms_row(src, ws_f(C, WS_X) + (size_t)m * DM, A.in[9], ws_bf(C, WS_H) + (size_t)m * DM, nullptr, C.lane); }
}

DI void cvt_store8(const bf16* src, float* dst) {
    const u32x4 v = *(const u32x4*)src; float f[8]; unpack8(v, f);
    ((f32x4*)dst)[0] = (f32x4){f[0], f[1], f[2], f[3]}; ((f32x4*)dst)[1] = (f32x4){f[4], f[5], f[6], f[7]};
}
DI void m0_row(const Ctx& C, const Args& A, int l, int r, int lane) {
    bf16* P = ws_bf(C, WS_PU) + (size_t)r * INP;
    const bool smp = r >= NTP; int b, t, pos;
    if (!smp) { b = r >> 11; t = r & 2047; pos = t; } else { const int rr = r - NTP; b = rr >> 6; t = rr & 63; pos = PAST + t; }
    float* out = C.out;
    float* o_ak = smp ? out + OFF_S_AK + ((size_t)(l * DBAT + b) * DSEQ + t) * 512 : out + OFF_P_AK + ((size_t)(l * NB + b) * SEQ + t) * 512;
    float* o_av = smp ? out + OFF_S_AV + ((size_t)(l * DBAT + b) * DSEQ + t) * 512 : out + OFF_P_AV + ((size_t)(l * NB + b) * SEQ + t) * 512;
    float* o_ki = smp ? out + OFF_S_KI + ((size_t)(l * DBAT + b) * DSEQ + t) * 64 : out + OFF_P_KI + ((size_t)(l * NB + b) * SEQ + t) * 64;
    const float* ropeA = ws_f(C, WS_ROPE) + (size_t)pos * 32; const float* ropeI = ws_f(C, WS_ROPE) + 2048 * 32 + (size_t)pos * 16;
    {
        const int i = lane & 15, c1 = (lane >> 4) * 128 + i, c2 = c1 + 16; const float cs = ropeA[2 * i], sn = ropeA[2 * i + 1];
        float x1 = bf2f(P[C_AQ + c1]), x2 = bf2f(P[C_AQ + c2]);
        P[C_AQ + c1] = f2bf(x1 * cs - x2 * sn); P[C_AQ + c2] = f2bf(x2 * cs + x1 * sn);
        x1 = bf2f(P[C_AK + c1]); x2 = bf2f(P[C_AK + c2]);
        const float y1 = x1 * cs - x2 * sn, y2 = x2 * cs + x1 * sn;
        P[C_AK + c1] = f2bf(y1); P[C_AK + c2] = f2bf(y2); o_ak[c1] = y1; o_ak[c2] = y2;
    }
    if (lane < 48) { const int col = (lane / 12) * 128 + 32 + (lane % 12) * 8; cvt_store8(P + C_AK + col, o_ak + col); }
    cvt_store8(P + C_AV + lane * 8, o_av + lane * 8);
#pragma unroll
    for (int k = 0; k < 2; ++k) {
        const int pid = lane + 64 * k, i = pid & 7, c1 = C_IQ + (pid >> 3) * 64 + i, c2 = c1 + 8; const float cs = ropeI[2 * i], sn = ropeI[2 * i + 1];
        const float x1 = bf2f(P[c1]), x2 = bf2f(P[c2]);
        P[c1] = f2bf(x1 * cs - x2 * sn); P[c2] = f2bf(x2 * cs + x1 * sn);
    }
    if (lane < 8) { const int i = lane; const float cs = ropeI[2 * i], sn = ropeI[2 * i + 1];
        const float x1 = bf2f(P[C_IK + i]), x2 = bf2f(P[C_IK + i + 8]); const float y1 = x1 * cs - x2 * sn, y2 = x2 * cs + x1 * sn;
        P[C_IK + i] = f2bf(y1); P[C_IK + i + 8] = f2bf(y2); o_ki[i] = y1; o_ki[i + 8] = y2;
    } else if (lane < 14) { const int col = 16 + (lane - 8) * 8; cvt_store8(P + C_IK + col, o_ki + col); }
    const bool keep = smp || t >= SEQ - BWIN;
    if (keep) {
        const size_t ro = smp ? ((size_t)(l * DBAT + b) * DSEQ + t) * 512 : ((size_t)(l * NB + b) * BWIN + (t - (SEQ - BWIN))) * 512;
        float* o_bk = out + (smp ? OFF_S_BK : OFF_P_BK) + ro; float* o_bv = out + (smp ? OFF_S_BV : OFF_P_BV) + ro;
        cvt_store8(P + C_BK + lane * 8, o_bk + lane * 8); cvt_store8(P + C_BV + lane * 8, o_bv + lane * 8);
    }
    if (lane < 16) { const float x = bf2f(P[C_DT + lane]) + A.in[15][l * 16 + lane];
        const float sp = x > 20.f ? x : log1pf(__expf(x)); ws_f(C, WS_DTS)[(size_t)r * 16 + lane] = sp; }
    const float* cw = A.in[13] + (size_t)l * 4 * 2048; const float* cb = A.in[14] + (size_t)l * 2048;
    const float* sconv = A.in[8] + (size_t)(l * DBAT + b) * 3 * 2048;
    bf16* xo = ws_bf(C, WS_XBC) + (size_t)r * 2048;
    const int stt = smp ? DSEQ - 3 : SEQ - 3;
    float* o_conv = (t >= stt) ? (smp ? out + OFF_S_CONV + ((size_t)(l * DBAT + b) * 3 + (t - stt)) * 2048 : out + OFF_P_CONV + ((size_t)(l * NB + b) * 3 + (t - stt)) * 2048) : nullptr;
#pragma unroll 1
    for (int it = 0; it < 4; ++it) {
        const int ch = (lane + 64 * it) * 8;
        float acc[8], x[8];
        { const f32x4 b0 = *(const f32x4*)(cb + ch), b1 = *(const f32x4*)(cb + ch + 4); acc[0] = b0.x; acc[1] = b0.y; acc[2] = b0.z; acc[3] = b0.w; acc[4] = b1.x; acc[5] = b1.y; acc[6] = b1.z; acc[7] = b1.w; }
#pragma unroll
        for (int j = 0; j < 4; ++j) {
            const int tt = t - 3 + j; bool have = true;
            if (tt >= 0) { unpack8(*(const u32x4*)(P + (ptrdiff_t)(j - 3) * INP + C_XBC + ch), x); }
            else if (smp) { const float* sp = sconv + (size_t)(3 + tt) * 2048 + ch; const f32x4 s0 = *(const f32x4*)sp, s1 = *(const f32x4*)(sp + 4);
                x[0] = s0.x; x[1] = s0.y; x[2] = s0.z; x[3] = s0.w; x[4] = s1.x; x[5] = s1.y; x[6] = s1.z; x[7] = s1.w; }
            else have = false;
            if (have) { const f32x4 w0 = *(const f32x4*)(cw + j * 2048 + ch), w1 = *(const f32x4*)(cw + j * 2048 + ch + 4);
                acc[0] += x[0] * w0.x; acc[1] += x[1] * w0.y; acc[2] += x[2] * w0.z; acc[3] += x[3] * w0.w; acc[4] += x[4] * w1.x; acc[5] += x[5] * w1.y; acc[6] += x[6] * w1.z; acc[7] += x[7] * w1.w; }
        }
        if (o_conv) { ((f32x4*)(o_conv + ch))[0] = (f32x4){x[0], x[1], x[2], x[3]}; ((f32x4*)(o_conv + ch))[1] = (f32x4){x[4], x[5], x[6], x[7]}; }
#pragma unroll
        for (int k = 0; k < 8; ++k) acc[k] = acc[k] / (1.f + __expf(-acc[k]));
        *(u32x4*)(xo + ch) = pack8(acc);
    }
}
DI void cvt_chunks(const float* src, bf16* dst, size_t nchunk, size_t gt, size_t ngt) {
    for (size_t i = gt; i < nchunk; i += ngt) { const f32x4 a = ((const f32x4*)src)[2 * i], b = ((const f32x4*)src)[2 * i + 1];
        u32x4 o; o.x = pk2(a.x, a.y); o.y = pk2(a.z, a.w); o.z = pk2(b.x, b.y); o.w = pk2(b.z, b.w); ((u32x4*)dst)[i] = o; }
}
DI void m0_phase(const Ctx& C, const Args& A, int l) {
    const int gw = C.bid * NWAVES + C.wave, NGW = C.G * NWAVES;
    for (int r = gw; r < NTOK; r += NGW) m0_row(C, A, l, r, C.lane);
    const size_t gt = (size_t)C.bid * NTHR + C.tid, ngt = (size_t)C.G * NTHR;
    cvt_chunks(A.in[2] + (size_t)l * DBAT * PAST * 512, ws_bf(C, WS_CAK), (size_t)DBAT * PAST * 512 / 8, gt, ngt);
    cvt_chunks(A.in[3] + (size_t)l * DBAT * PAST * 512, ws_bf(C, WS_CAV), (size_t)DBAT * PAST * 512 / 8, gt, ngt);
    cvt_chunks(A.in[4] + (size_t)l * DBAT * PAST * 64, ws_bf(C, WS_CKI), (size_t)DBAT * PAST * 64 / 8, gt, ngt);
    cvt_chunks(A.in[5] + (size_t)l * DBAT * BWIN * 512, ws_bf(C, WS_CBK), (size_t)DBAT * BWIN * 512 / 8, gt, ngt);
    cvt_chunks(A.in[6] + (size_t)l * DBAT * BWIN * 512, ws_bf(C, WS_CBV), (size_t)DBAT * BWIN * 512 / 8, gt, ngt);
}

struct KVSrc { const bf16* k0; const bf16* v0; int s0; int n0; const bf16* k1; const bf16* v1; int s1; };
template <int MODE>
DI void attn_unit(const Ctx& C, const bf16* Qp, int qstride, const KVSrc& S, int tile_lo, int tile_hi, bf16* Op, int ostride) {
    int tid = C.tid, lane = C.lane; asm volatile("" : "+v"(tid), "+v"(lane));
    const int w = C.wave, r = lane & 31, hh = lane >> 5;
    const int head = w >> 1, q = (w & 1) * 32 + r;
    LAS unsigned char* Ks = C.lds + ATT_K; LAS unsigned char* Vs = C.lds + ATT_V;
    bf16x8 qf[8];
    { const bf16* qrow = Qp + (size_t)q * qstride + head * 128 + 8 * hh;
#pragma unroll
      for (int ks = 0; ks < 8; ++ks) qf[ks] = *(const bf16x8*)(qrow + 16 * ks); }
    f32x16 o[4];
#pragma unroll
    for (int d = 0; d < 4; ++d)
#pragma unroll
        for (int i = 0; i < 16; ++i) o[d][i] = 0.f;
    float m = -1e30f, lsum = 0.f;
    constexpr float SC2 = 0.08838834764831845f * 1.4426950408889634f;
    constexpr float L2E = 1.4426950408889634f;
    u32x4 kr[4], vr[4];
#define ATT_LOAD(tile_) do { _Pragma("unroll") for (int i_ = 0; i_ < 4; ++i_) { const int ci_ = tid + 512 * i_, row_ = ci_ >> 6, ch_ = ci_ & 63, key_ = (tile_) * 32 + row_; \
        const bf16* kp_ = key_ < S.n0 ? S.k0 + (ptrdiff_t)key_ * S.s0 : S.k1 + (ptrdiff_t)(key_ - S.n0) * S.s1; const bf16* vp_ = key_ < S.n0 ? S.v0 + (ptrdiff_t)key_ * S.s0 : S.v1 + (ptrdiff_t)(key_ - S.n0) * S.s1; \
        kr[i_] = *(const u32x4*)(kp_ + ch_ * 8); vr[i_] = *(const u32x4*)(vp_ + ch_ * 8); } } while (0)
    ATT_LOAD(tile_lo);
    const int i16 = lane & 15;
    LAS unsigned char* vbase = Vs + (4 * hh + (i16 >> 2)) * VSTR + (head * 128 + 16 * ((lane >> 4) & 1) + 4 * (i16 & 3)) * 2;
    LAS unsigned char* kbase = Ks + r * KSTR + head * 256 + hh * 16;
    const LAS float* btab = (const LAS float*)(C.lds + ATT_SEL) + head * 257;
    const LAS unsigned* sel = (const LAS unsigned*)(C.lds + ATT_SEL) + q * 64;
    for (int tile = tile_lo; tile < tile_hi; ++tile) {
        __syncthreads();
#pragma unroll
        for (int i = 0; i < 4; ++i) { const int ci = tid + 512 * i, row = ci >> 6, ch = ci & 63;
            *(LAS u32x4*)(Ks + row * KSTR + ch * 16) = kr[i]; *(LAS u32x4*)(Vs + row * VSTR + ch * 16) = vr[i]; }
        __syncthreads();
        if (tile + 1 < tile_hi) ATT_LOAD(tile + 1);
        f32x16 s;
#pragma unroll
        for (int i = 0; i < 16; ++i) s[i] = 0.f;
#pragma unroll
        for (int ks = 0; ks < 8; ++ks) { const bf16x8 a = *(const LAS bf16x8*)(kbase + ks * 32); s = mfma32(a, qf[ks], s); }
        if (MODE == 0) {
            const unsigned wd = sel[tile] >> (4 * hh);
#pragma unroll
            for (int i = 0; i < 16; ++i) s[i] = ((wd >> ((i & 3) + 8 * (i >> 2))) & 1u) ? s[i] * SC2 : -INFINITY;
        } else {
            if (tile <= 11) { const float bb = btab[256] * L2E;
#pragma unroll
                for (int i = 0; i < 16; ++i) s[i] = s[i] * SC2 + bb;
            } else {
#pragma unroll
                for (int i = 0; i < 16; ++i) { int rel = BWIN + q - (tile * 32 + crow(i, hh)); rel = rel > 128 ? 128 : rel; s[i] = s[i] * SC2 + btab[rel + 128] * L2E; }
            }
        }
        float mx = s[0];
#pragma unroll
        for (int i = 1; i < 16; ++i) mx = fmaxf(mx, s[i]);
        mx = fmaxf(mx, __shfl_xor(mx, 32));
        const float mn = fmaxf(m, mx), alpha = __builtin_amdgcn_exp2f(m - mn);
        float rs = 0.f;
#pragma unroll
        for (int i = 0; i < 16; ++i) { s[i] = __builtin_amdgcn_exp2f(s[i] - mn); rs += s[i]; }
        rs += __shfl_xor(rs, 32);
        lsum = lsum * alpha + rs; m = mn;
#pragma unroll
        for (int d = 0; d < 4; ++d)
#pragma unroll
            for (int i = 0; i < 16; ++i) o[d][i] *= alpha;
        bf16x8 pf[2];
#pragma unroll
        for (int s2 = 0; s2 < 2; ++s2) { u32x4 pk; pk.x = pk2(s[8 * s2], s[8 * s2 + 1]); pk.y = pk2(s[8 * s2 + 2], s[8 * s2 + 3]); pk.z = pk2(s[8 * s2 + 4], s[8 * s2 + 5]); pk.w = pk2(s[8 * s2 + 6], s[8 * s2 + 7]);
            pf[s2] = __builtin_bit_cast(bf16x8, pk); }
#pragma unroll
        for (int d = 0; d < 4; ++d)
#pragma unroll
            for (int s2 = 0; s2 < 2; ++s2) {
                const s16x4 lo = tr_read(vbase + (16 * s2) * VSTR + d * 64), hi = tr_read(vbase + (16 * s2 + 8) * VSTR + d * 64);
                const bf16x8 vt = __builtin_shufflevector(lo, hi, 0, 1, 2, 3, 4, 5, 6, 7);
                o[d] = mfma32(vt, pf[s2], o[d]);
            }
    }
#undef ATT_LOAD
    const float inv = 1.0f / lsum;
    bf16* orow = Op + (size_t)q * ostride + head * 128 + 4 * hh;
#pragma unroll
    for (int d = 0; d < 4; ++d)
#pragma unroll
        for (int g = 0; g < 4; ++g) { u32x2 p; p.x = pk2(o[d][4 * g] * inv, o[d][4 * g + 1] * inv); p.y = pk2(o[d][4 * g + 2] * inv, o[d][4 * g + 3] * inv);
            *(u32x2*)(orow + 32 * d + 8 * g) = p; }
}

DI unsigned fkey(float f) { const unsigned u = __float_as_uint(f); return (u & 0x80000000u) ? ~u : (u | 0x80000000u); }
DI void dsa_unit(const Ctx& C, int l, int u) {
    int lane = C.lane; asm volatile("" : "+v"(lane));
    const int w = C.wave, r = lane & 31, hh = lane >> 5;
    const bf16* PROJ = ws_bf(C, WS_PU);
    int qrow0, NT, limit; KVSrc S; const bf16* ik0; const bf16* ik1; int iks0, ikn0;
    if (u < 256) { const int c = 31 - (u >> 3), b = u & 7; qrow0 = b * SEQ + c * 64; NT = 2 * (c + 1); limit = 64 * (c + 1);
        const bf16* base = PROJ + (size_t)(b * SEQ) * INP;
        S.k0 = base + C_AK; S.v0 = base + C_AV; S.s0 = INP; S.n0 = limit; S.k1 = S.k0; S.v1 = S.v0; S.s1 = INP;
        ik0 = base + C_IK; iks0 = INP; ikn0 = limit; ik1 = ik0;
    } else { const int b = u - 256; qrow0 = NTP + b * DSEQ; NT = (PAST + DSEQ) / 32; limit = PAST + DSEQ;
        const bf16* nb = PROJ + (size_t)qrow0 * INP;
        S.k0 = ws_bf(C, WS_CAK) + (size_t)b * PAST * 512; S.v0 = ws_bf(C, WS_CAV) + (size_t)b * PAST * 512; S.s0 = 512; S.n0 = PAST; S.k1 = nb + C_AK; S.v1 = nb + C_AV; S.s1 = INP;
        ik0 = ws_bf(C, WS_CKI) + (size_t)b * PAST * 64; iks0 = 64; ikn0 = PAST; ik1 = nb + C_IK;
    }
    float* SC = ws_f(C, WS_SC) + (size_t)C.bid * 64 * 2048;
    LAS unsigned* SEL = (LAS unsigned*)(C.lds + ATT_SEL);
#pragma unroll 1
    for (int pass = 0; pass < 2; ++pass) {
        bf16x8 af[2][4]; float wt[2][16];
#pragma unroll
        for (int np = 0; np < 2; ++np) { const int pp = pass * 2 + np;
            const bf16* ap = PROJ + (size_t)(qrow0 + 8 * w + 2 * pp + (r >> 4)) * INP + C_IQ + (r & 15) * 64 + 8 * hh;
#pragma unroll
            for (int ks = 0; ks < 4; ++ks) af[np][ks] = *(const bf16x8*)(ap + 16 * ks);
#pragma unroll
            for (int i = 0; i < 16; ++i) { const int qi = 8 * w + 2 * pp + (i >> 3), hd = (i & 3) + 8 * ((i >> 2) & 1) + 4 * hh;
                wt[np][i] = bf2f(PROJ[(size_t)(qrow0 + qi) * INP + C_IW + hd]) * (0.25f * 0.125f); } }
#pragma unroll 1
        for (int tile = 0; tile < NT; ++tile) {
            const int key = tile * 32 + r;
            const bf16* kp = (key < ikn0 ? ik0 + (size_t)key * iks0 : ik1 + (size_t)(key - ikn0) * INP) + 8 * hh;
            bf16x8 bk[4];
#pragma unroll
            for (int ks = 0; ks < 4; ++ks) bk[ks] = *(const bf16x8*)(kp + 16 * ks);
#pragma unroll
            for (int np = 0; np < 2; ++np) {
                f32x16 acc;
#pragma unroll
                for (int i = 0; i < 16; ++i) acc[i] = 0.f;
#pragma unroll
                for (int ks = 0; ks < 4; ++ks) acc = mfma32(af[np][ks], bk[ks], acc);
                float p0 = 0.f, p1 = 0.f;
#pragma unroll
                for (int i = 0; i < 8; ++i) { p0 += fmaxf(acc[i], 0.f) * wt[np][i]; p1 += fmaxf(acc[8 + i], 0.f) * wt[np][8 + i]; }
                const float t0 = p0 + __shfl_xor(p0, 32), t1 = p1 + __shfl_xor(p1, 32);
                const int ql = 8 * w + 2 * (pass * 2 + np) + hh;
                SC[(size_t)ql * 2048 + tile * 32 + r] = hh ? t1 : t0;
            }
        }
    }
    asm volatile("s_waitcnt vmcnt(0)" ::: "memory");
#pragma unroll 1
    for (int pp = 0; pp < 4; ++pp) {
        const int ql = 8 * w + 2 * pp + hh;
        unsigned v[64];
#pragma unroll
        for (int i = 0; i < 64; ++i) { const float f = (i < NT) ? __hip_atomic_load(SC + (size_t)ql * 2048 + i * 32 + r, __ATOMIC_RELAXED, __HIP_MEMORY_SCOPE_AGENT) : -INFINITY; v[i] = fkey(f); }
        unsigned T = 0u;
        if (limit > 256) {
#pragma unroll 1
            for (int bit = 31; bit >= 0; --bit) {
                const unsigned cand = T | (1u << bit); int c0 = 0, c1 = 0;
#pragma unroll
                for (int i = 0; i < 64; ++i) { const unsigned long long mk = __ballot(v[i] >= cand); c0 += __popc((unsigned)mk); c1 += __popc((unsigned)(mk >> 32)); }
                if ((hh ? c1 : c0) >= 256) T = cand;
            }
        }
#pragma unroll
        for (int i = 0; i < 64; ++i) { unsigned long long mk = __ballot(v[i] >= T); if (i >= NT) mk = 0ull;
            if (lane == 0) { SEL[(8 * w + 2 * pp) * 64 + i] = (unsigned)mk; SEL[(8 * w + 2 * pp + 1) * 64 + i] = (unsigned)(mk >> 32); } }
    }
    __syncthreads();
    attn_unit<0>(C, PROJ + (size_t)qrow0 * INP + C_AQ, INP, S, 0, NT, ws_bf(C, WS_MIX) + (size_t)qrow0 * DM, DM);
}

DI void band_unit(const Ctx& C, const Args& A, int l, int u) {
    const bf16* PROJ = ws_bf(C, WS_PU);
    int qrow0, tlo; KVSrc S;
    if (u < 256) { const int c = 31 - (u >> 3), b = u & 7; qrow0 = b * SEQ + c * 64; tlo = c < 8 ? (8 - c) * 2 : 0;
        const bf16* base = PROJ + ((ptrdiff_t)b * SEQ + c * 64 - BWIN) * INP;
        S.k0 = base + C_BK; S.v0 = base + C_BV; S.s0 = INP; S.n0 = BWIN + 64; S.k1 = S.k0; S.v1 = S.v0; S.s1 = INP;
    } else { const int b = u - 256; qrow0 = NTP + b * DSEQ; tlo = 0;
        const bf16* nb = PROJ + (size_t)qrow0 * INP;
        S.k0 = ws_bf(C, WS_CBK) + (size_t)b * BWIN * 512; S.v0 = ws_bf(C, WS_CBV) + (size_t)b * BWIN * 512; S.s0 = 512; S.n0 = BWIN; S.k1 = nb + C_BK; S.v1 = nb + C_BV; S.s1 = INP;
    }
    LAS float* bt = (LAS float*)(C.lds + ATT_SEL);
    const float* brel = A.in[12] + (size_t)l * 4 * 257;
    for (int i = C.tid; i < 4 * 257; i += NTHR) bt[i] = brel[i];
    __syncthreads();
    attn_unit<1>(C, PROJ + (size_t)qrow0 * INP + C_BQ, INP, S, tlo, (BWIN + 64) / 32, ws_bf(C, WS_MIX) + (size_t)qrow0 * DM + 512, DM);
}

DI void ssd_unit(const Ctx& C, const Args& A, int l, int row0, int nchunks, int h, const float* h0, float* hout) {
    int tid = C.tid, lane = C.lane; asm volatile("" : "+v"(tid), "+v"(lane));
    const int w = C.wave, r = lane & 31, hh = lane >> 5, g = h >> 2;
    LAS unsigned char* L = C.lds;
    LAS unsigned char* Cs = L + SSD_CS; LAS unsigned char* Bs = L + SSD_BS; LAS unsigned char* XD = L + SSD_XD; LAS unsigned char* XDW = L + SSD_XDW; LAS unsigned char* Ms = L + SSD_MS; LAS unsigned char* Ys = L + SSD_Y;
    LAS float* v_dt = (LAS float*)(L + SSD_VEC); LAS float* v_acs = v_dt + 64; LAS float* v_w = v_dt + 128; LAS float* v_e = v_dt + 192;
    const bf16* XBC = ws_bf(C, WS_XBC); const bf16* PROJ = ws_bf(C, WS_PU); const float* DTS = ws_f(C, WS_DTS); float* G = ws_f(C, WS_G);
    const float a_h = -expf(A.in[16][l * 16 + h]); const float dsk = A.in[17][l * 16 + h];
    f32x16 Hacc[2];
#pragma unroll
    for (int pb = 0; pb < 2; ++pb)
#pragma unroll
        for (int i = 0; i < 16; ++i) Hacc[pb][i] = 0.f;
    __syncthreads();
    if (w >= 4) { const int nb = w - 4;
#pragma unroll
        for (int pb = 0; pb < 2; ++pb)
#pragma unroll
            for (int i = 0; i < 16; ++i) { const int p = 32 * pb + crow(i, hh), n = 32 * nb + r; const float v = h0 ? h0[p * 128 + n] : 0.f; Hacc[pb][i] = v;
                *(LAS bf16*)(L + SSD_HS + p * HSTR + n * 2) = f2bf(v); } }
#pragma unroll 1
    for (int c = 0; c < nchunks; ++c) {
        const int rbase = row0 + c * 64;
        LAS unsigned char* Hcur = L + SSD_HS + (c & 1) * 64 * HSTR; LAS unsigned char* Hnxt = L + SSD_HS + ((c + 1) & 1) * 64 * HSTR;
        __syncthreads();
        if (w == 0) { const float dt = DTS[(size_t)(rbase + lane) * 16 + h]; float acs = dt * a_h;
#pragma unroll
            for (int o = 1; o < 64; o <<= 1) { const float t = __shfl_up(acs, o); if (lane >= o) acs += t; }
            const float A = __shfl(acs, 63);
            v_dt[lane] = dt; v_acs[lane] = acs; v_w[lane] = __expf(A - acs); v_e[lane] = __expf(acs); }
#pragma unroll
        for (int i = 0; i < 2; ++i) { const int ci = tid + 512 * i, row = ci >> 4, ch = ci & 15; const bf16* src = XBC + (size_t)(rbase + row) * 2048 + g * 128 + ch * 8;
            *(LAS u32x4*)(Bs + row * CSTR + ch * 16) = *(const u32x4*)(src + 1024); *(LAS u32x4*)(Cs + row * CSTR + ch * 16) = *(const u32x4*)(src + 1536); }
        __syncthreads();
        const int erow = tid >> 3, ech = tid & 7; float xraw[8];
        { float xd[8], xw[8]; unpack8(*(const u32x4*)(XBC + (size_t)(rbase + erow) * 2048 + h * 64 + ech * 8), xraw);
          const float dt = v_dt[erow], wv = v_w[erow];
#pragma unroll
          for (int k = 0; k < 8; ++k) { xd[k] = xraw[k] * dt; xw[k] = xd[k] * wv; }
          *(LAS u32x4*)(XD + erow * XSTR + ech * 16) = pack8(xd); *(LAS u32x4*)(XDW + erow * XSTR + ech * 16) = pack8(xw); }
        __syncthreads();
        if (w < 4) {
            const int lb = w >> 1, sb = w & 1; f32x16 acc;
#pragma unroll
            for (int i = 0; i < 16; ++i) acc[i] = 0.f;
            if (sb <= lb) {
#pragma unroll
                for (int ks = 0; ks < 8; ++ks) { const bf16x8 a = *(const LAS bf16x8*)(Cs + (32 * lb + r) * CSTR + (16 * ks + 8 * hh) * 2), b = *(const LAS bf16x8*)(Bs + (32 * sb + r) * CSTR + (16 * ks + 8 * hh) * 2);
                    acc = mfma32(a, b, acc); } }
            const int s = 32 * sb + r; const float acs_s = v_acs[s];
#pragma unroll
            for (int i = 0; i < 16; ++i) { const int lr = 32 * lb + crow(i, hh); const float v = (s <= lr) ? acc[i] * __expf(v_acs[lr] - acs_s) : 0.f; *(LAS bf16*)(Ms + lr * MSTR + s * 2) = f2bf(v); }
        } else {
            const int nb = w - 4; const float dec = __expf(v_acs[63]);
#pragma unroll
            for (int pb = 0; pb < 2; ++pb) {
#pragma unroll
                for (int i = 0; i < 16; ++i) Hacc[pb][i] *= dec;
#pragma unroll
                for (int ks = 0; ks < 4; ++ks) { const bf16x8 a = trfrag(XDW, XSTR, 16 * ks, 32 * pb, lane), b = trfrag(Bs, CSTR, 16 * ks, 32 * nb, lane); Hacc[pb] = mfma32(a, b, Hacc[pb]); }
#pragma unroll
                for (int i = 0; i < 16; ++i) *(LAS bf16*)(Hnxt + (32 * pb + crow(i, hh)) * HSTR + (32 * nb + r) * 2) = f2bf(Hacc[pb][i]);
            }
        }
        __syncthreads();
        if (w < 4) {
            const int lb = w >> 1, pb = w & 1; f32x16 yd, yo;
#pragma unroll
            for (int i = 0; i < 16; ++i) { yd[i] = 0.f; yo[i] = 0.f; }
#pragma unroll
            for (int ks = 0; ks < 4; ++ks) { const bf16x8 a = *(const LAS bf16x8*)(Ms + (32 * lb + r) * MSTR + (16 * ks + 8 * hh) * 2), b = trfrag(XD, XSTR, 16 * ks, 32 * pb, lane); yd = mfma32(a, b, yd); }
#pragma unroll
            for (int ks = 0; ks < 8; ++ks) { const bf16x8 a = *(const LAS bf16x8*)(Cs + (32 * lb + r) * CSTR + (16 * ks + 8 * hh) * 2), b = *(const LAS bf16x8*)(Hcur + (32 * pb + r) * HSTR + (16 * ks + 8 * hh) * 2); yo = mfma32(a, b, yo); }
            const int p = 32 * pb + r;
#pragma unroll
            for (int i = 0; i < 16; ++i) { const int lr = 32 * lb + crow(i, hh); *(LAS float*)(Ys + lr * YSTR + p * 4) = yd[i] + v_e[lr] * yo[i]; }
        }
        __syncthreads();
        {
            float z[8]; unpack8(*(const u32x4*)(PROJ + (size_t)(rbase + erow) * INP + C_CZ + h * 64 + ech * 8), z);
            const f32x4 y0 = *(const LAS f32x4*)(Ys + erow * YSTR + ech * 32), y1 = *(const LAS f32x4*)(Ys + erow * YSTR + ech * 32 + 16);
            float y[8] = {y0.x, y0.y, y0.z, y0.w, y1.x, y1.y, y1.z, y1.w};
#pragma unroll
            for (int k = 0; k < 8; ++k) { const float yy = y[k] + dsk * xraw[k]; y[k] = yy * z[k] / (1.f + __expf(-z[k])); }
            float* gp = G + (size_t)(rbase + erow) * 1024 + h * 64 + ech * 8;
            ((f32x4*)gp)[0] = (f32x4){y[0], y[1], y[2], y[3]}; ((f32x4*)gp)[1] = (f32x4){y[4], y[5], y[6], y[7]};
        }
    }
    if (w >= 4) { const int nb = w - 4;
#pragma unroll
        for (int pb = 0; pb < 2; ++pb)
#pragma unroll
            for (int i = 0; i < 16; ++i) hout[(32 * pb + crow(i, hh)) * 128 + 32 * nb + r] = Hacc[pb][i]; }
}

DI void gate_norm_phase(const Ctx& C, const Args& A, int l) {
    const int gw = C.bid * NWAVES + C.wave, NGW = C.G * NWAVES; const float* gn = A.in[18] + (size_t)l * 1024;
    for (int m = gw; m < NTOK; m += NGW) { const float* grow = ws_f(C, WS_G) + (size_t)m * 1024; bf16* orow = ws_bf(C, WS_MIX) + (size_t)m * DM + 1024;
#pragma unroll
        for (int g = 0; g < 4; ++g) { const f32x4 v = ((const f32x4*)grow)[g * 64 + C.lane]; const float ss = wave_sum((v.x * v.x + v.y * v.y) + (v.z * v.z + v.w * v.w));
            const float rs = 1.0f / sqrtf(ss * (1.0f / 256.f) + EPS); const f32x4 wv = ((const f32x4*)gn)[g * 64 + C.lane]; const f32x4 o = v * rs * wv;
            u32x2 p; p.x = pk2(o.x, o.y); p.y = pk2(o.z, o.w); ((u32x2*)orow)[g * 64 + C.lane] = p; } }
}
DI void norm_phase(const Ctx& C, const float* w, bf16* outb, float* outf) {
    const int gw = C.bid * NWAVES + C.wave, NGW = C.G * NWAVES;
    for (int m = gw; m < NTOK; m += NGW) rms_row(ws_f(C, WS_X) + (size_t)m * DM, nullptr, w, outb ? outb + (size_t)m * DM : nullptr, outf ? outf + (size_t)m * DM : nullptr, C.lane);
}

#ifndef MK_ONE_LAUNCH
#define MK_ONE_LAUNCH 1
#endif
#ifndef PHASE_MASK
#define PHASE_MASK 0xFFFF
#endif
#define EN(k) (((PHASE_MASK) >> (k)) & 1)
constexpr int PH_PER_LAYER = 9, NPHASE = 1 + DEPTH * PH_PER_LAYER;
__global__ void __launch_bounds__(NTHR, 2) fwd(Args args) {
    extern __shared__ __attribute__((aligned(16))) unsigned char lds_raw[];
    Ctx C;
    C.lds = (LAS unsigned char*)lds_raw;
    C.tid = threadIdx.x; C.lane = C.tid & 63; C.wave = __builtin_amdgcn_readfirstlane(C.tid >> 6); C.G = gridDim.x; C.bid = blockIdx.x;
    C.ws = args.ws; C.out = args.out; C.ctl = (unsigned*)(args.ws + WS_CTL);
    const Args& A = args;
    for (int u = C.tid; u < (LDS_BYTES - LDSCTL_OFF) / 4; u += NTHR) ((LAS unsigned*)(C.lds + LDSCTL_OFF))[u] = 0u;
    __syncthreads();
    const int lo = args.ph_lo, hi = args.ph_hi;
    const bool multi = (hi - lo) > 1;
    XcdBarrier bar; bar.bar = C.ctl + CW_BAR; bar.x = 0; bar.st = (volatile LAS unsigned*)(C.lds + LDSCTL_OFF);
    if (multi) bar = xcd_barrier_post(C.ctl + CW_BAR, (volatile LAS unsigned*)(C.lds + LDSCTL_OFF));
#define IN(k) (lo <= (k) && (k) < hi)
#define FRESH() do { int t_ = threadIdx.x; asm volatile("" : "+v"(t_)); C.tid = t_; C.lane = t_ & 63; int w_ = __builtin_amdgcn_readfirstlane(t_ >> 6); asm volatile("" : "+s"(w_)); C.wave = w_; } while (0)
#define SEAM(k) do { if (IN((k) + 1)) xcd_barrier(bar); } while (0)

    if (EN(0) && IN(0)) { p0_prologue(C, A); SEAM(0); }
#pragma unroll 1
    for (int l = 0; l < DEPTH; ++l) {
        const int pb = 1 + PH_PER_LAYER * l;
        if (EN(1) && IN(pb + 0)) { FRESH();
            pg8::Gemm g{ws_bf(C, WS_H), w_in_t(C, l), NTOK, INP, DM}; pg8::StaticOrder S; S.init(NTOK, INP, C.G, C.bid);
            pg8::EpiBf16<0> E{ws_bf(C, WS_PU), INP};
            pg8::gemm_phase<pg8::EpiBf16<0>, pg8::StaticOrder, true, true>(C.lds, g, S, E);
            SEAM(pb + 0);
        }
        if (EN(2) && IN(pb + 1)) { FRESH(); m0_phase(C, A, l); SEAM(pb + 1); }
        if (IN(pb + 2)) { FRESH();
            unsigned* qh = C.ctl + CW_Q + 64 * (l * 4);
            if (EN(3)) for (;;) { const int u = q_next(C, qh); if (u >= NB * 16) break;
                ssd_unit(C, A, l, (u >> 4) * SEQ, SEQ / 64, u & 15, nullptr, C.out + OFF_P_SSM + ((size_t)(l * NB + (u >> 4)) * 16 + (u & 15)) * 8192); }
            if (EN(4)) for (;;) { const int u = q_next(C, qh + 64); if (u >= 288) break; dsa_unit(C, l, u); }
            if (EN(5)) for (;;) { const int u = q_next(C, qh + 128); if (u >= 288) break; band_unit(C, A, l, u); }
            if (EN(3)) for (;;) { const int u = q_next(C, qh + 192); if (u >= DBAT * 16) break;
                ssd_unit(C, A, l, NTP + (u >> 4) * DSEQ, 1, u & 15, A.in[7] + ((size_t)(l * DBAT + (u >> 4)) * 16 + (u & 15)) * 8192, C.out + OFF_S_SSM + ((size_t)(l * DBAT + (u >> 4)) * 16 + (u & 15)) * 8192); }
            SEAM(pb + 2);
        }
        if (EN(6) && IN(pb + 3)) { FRESH(); gate_norm_phase(C, A, l); SEAM(pb + 3); }
        if (EN(7) && IN(pb + 4)) { FRESH();
            pg8::Gemm g{ws_bf(C, WS_MIX), w_out_t(C, l), NTOK, DM, DM}; pg8::StaticOrder S; S.init(NTOK, DM, C.G, C.bid);
            pg8::EpiResF32 E{ws_f(C, WS_X), DM};
            pg8::gemm_phase<pg8::EpiResF32, pg8::StaticOrder, true, true>(C.lds, g, S, E);
            SEAM(pb + 4);
        }
        if (EN(8) && IN(pb + 5)) { FRESH(); norm_phase(C, A.in[19] + (size_t)l * DM, ws_bf(C, WS_H), nullptr); SEAM(pb + 5); }
        if (EN(9) && IN(pb + 6)) { FRESH();
            pg8::Gemm g{ws_bf(C, WS_H), w_up_t(C, l), NTOK, DFF, DM}; pg8::StaticOrder S; S.init(NTOK, DFF, C.G, C.bid);
            pg8::EpiBf16<1> E{ws_bf(C, WS_PU), DFF};
            pg8::gemm_phase<pg8::EpiBf16<1>, pg8::StaticOrder, true, true>(C.lds, g, S, E);
            SEAM(pb + 6);
        }
        if (EN(10) && IN(pb + 7)) { FRESH();
            pg8::Gemm g{ws_bf(C, WS_PU), w_dn_t(C, l), NTOK, DM, DFF}; pg8::StaticOrder S; S.init(NTOK, DM, C.G, C.bid);
            pg8::EpiResF32 E{ws_f(C, WS_X), DM};
            pg8::gemm_phase<pg8::EpiResF32, pg8::StaticOrder, true, true>(C.lds, g, S, E);
            SEAM(pb + 7);
        }
        if (EN(8) && IN(pb + 8)) { FRESH();
            if (l + 1 < DEPTH) norm_phase(C, A.in[9] + (size_t)(l + 1) * DM, ws_bf(C, WS_H), nullptr);
            else norm_phase(C, A.in[22], nullptr, C.out);
            SEAM(pb + 8);
        }
    }
#undef IN
#undef SEAM
}

extern "C" void kernel_launch(void* const* d_in, const int* in_sizes, int n_in, void* d_out, int out_size, void* d_ws, size_t ws_size, hipStream_t stream) {
    static int grid = 0;
    if (grid == 0) {
        if (n_in != 23 || in_sizes[0] != NTP * DM || (size_t)out_size != OUT_TOTAL || ws_size < WS_END) {
            fprintf(stderr, "kernel_launch: unexpected shapes (n_in %d, in0 %d, out %d, ws %zu; need ws >= %zu); nothing launched\n", n_in, n_in > 0 ? in_sizes[0] : -1, out_size, ws_size, (size_t)WS_END); grid = -1; return; }
        int dev = 0, cus = 0, per_cu = 0;
        if (hipGetDevice(&dev) != hipSuccess || hipDeviceGetAttribute(&cus, hipDeviceAttributeMultiprocessorCount, dev) != hipSuccess) { fprintf(stderr, "kernel_launch: device query failed\n"); grid = -1; return; }
        if (hipFuncSetAttribute((const void*)fwd, hipFuncAttributeMaxDynamicSharedMemorySize, LDS_BYTES) != hipSuccess) { fprintf(stderr, "kernel_launch: hipFuncSetAttribute failed\n"); grid = -1; return; }
        if (hipOccupancyMaxActiveBlocksPerMultiprocessor(&per_cu, (const void*)fwd, NTHR, LDS_BYTES) != hipSuccess || per_cu < 1)
            fprintf(stderr, "kernel_launch: note: occupancy query reports %d workgroups per CU\n", per_cu);
        (void)hipGetLastError();
        grid = cus < 256 ? cus : 256;
    }
    if (grid < 0) return;
    if (hipMemsetAsync((char*)d_ws + WS_CTL, 0, CTL_ZERO_BYTES, stream) != hipSuccess) { fprintf(stderr, "kernel_launch: memset failed\n"); return; }
    Args a{};
    for (int i = 0; i < 23; ++i) a.in[i] = (const float*)d_in[i];
    a.out = (float*)d_out; a.ws = (unsigned char*)d_ws;
#if MK_ONE_LAUNCH
    a.ph_lo = 0; a.ph_hi = NPHASE;
    hipLaunchKernelGGL(fwd, dim3(grid), dim3(NTHR), LDS_BYTES, stream, a);
#else
    for (int p = 0; p < NPHASE; ++p) { a.ph_lo = p; a.ph_hi = p + 1; hipLaunchKernelGGL(fwd, dim3(grid), dim3(NTHR), LDS_BYTES, stream, a); }
#endif
    const hipError_t le = hipPeekAtLastError();
    if (le != hipSuccess) fprintf(stderr, "kernel_launch: launch failed: %s\n", hipGetErrorName(le));
}
```

```cpp
#include <hip/hip_runtime.h>
#include <cstdio>
#include <cstdint>
#include <cstddef>
namespace pg8 {
#define PG8_LAS __attribute__((address_space(3)))
typedef unsigned short bf16_t;
typedef short bf16x8 __attribute__((ext_vector_type(8)));
typedef float f32x4 __attribute__((ext_vector_type(4)));
typedef unsigned u32x4 __attribute__((ext_vector_type(4)));
constexpr int BM = 256, BK = 64, HALF = 128, HTB = HALF * BK * 2  , STAGE_BYTES = 8 * HTB, NXCD = 8, WGM = 8;

__host__ __device__ __forceinline__ int lds_byte(int r, int c) { const int st = (r >> 4) * 2 + (c >> 5), rr = r & 15, cc = c & 31, ob = rr * 64 + cc * 2; return st * 1024 + (ob ^ (((ob >> 9) & 1) << 5)); }
__host__ __device__ __forceinline__ void stage_rc(int b, int& R, int& C) { const int st = b / 1024, sb = b % 1024, swz = sb ^ (((sb >> 9) & 1) << 5); R = (st >> 1) * 16 + swz / 64; C = (st & 1) * 32 + (swz % 64) / 2; }
__host__ __device__ __forceinline__ int perm32(int rho) { const int n = rho >> 4, i = rho & 15; return 8 * (i >> 2) + 4 * n + (i & 3); }

struct Unit { int pm, pn; };
struct Gemm { const bf16_t* A; const bf16_t* Bt; int M, N, K; };

struct StaticOrder {
    int nM, nN, nwg, G, c;
    __host__ __device__ void init(int M, int N, int G_, int c_) { nM = M / BM; nN = N / BM; nwg = nM * nN; G = G_; c = c_; }
    __host__ __device__ bool next(int i, Unit& u) const {
        const long L = (long)i * G + c; if (L >= nwg) return false;
        int wgid = (int)L; { const int q = nwg / NXCD, r = nwg % NXCD, xcd = wgid % NXCD, off = wgid / NXCD; wgid = (xcd < r ? xcd * (q + 1) : r * (q + 1) + (xcd - r) * q) + off; }
        const int nig = WGM * nN, gid = wgid / nig, fm = gid * WGM, gsz = (nM - fm) < WGM ? (nM - fm) : WGM;
        u.pm = fm + ((wgid % nig) % gsz); u.pn = (wgid % nig) / gsz; return true;
    }
    __device__ __forceinline__ void a_ready(const Unit&) const {}
    __device__ __forceinline__ void done(const Unit&) const {}
};

typedef float f32x2_t __attribute__((ext_vector_type(2)));
typedef __bf16 bf16x2_t __attribute__((ext_vector_type(2)));
__device__ __forceinline__ unsigned cvt_pk_bf16(float lo, float hi) { f32x2_t v = {lo, hi}; bf16x2_t b = __builtin_convertvector(v, bf16x2_t); return __builtin_bit_cast(unsigned, b); }

template <int ACT  > struct EpiBf16 {
    static constexpr bool PERM = true, AFTER_DRAIN = false;
    bf16_t* O; int ldc;
    __device__ __forceinline__ void operator()(const f32x4 (&acc)[2][2][4][2], const Unit& u, int wr, int wc, int fr, int fq) const {
        const int row0 = u.pm * BM + wr * 64 + fr; const int col0 = u.pn * BM + wc * 32 + 8 * fq;
#pragma unroll
        for (int ai = 0; ai < 2; ++ai)
#pragma unroll
            for (int m = 0; m < 4; ++m) { bf16_t* rowp = O + (size_t)(row0 + ai * HALF + m * 16) * ldc + col0;
#pragma unroll
                for (int bj = 0; bj < 2; ++bj) { f32x4 v0 = acc[ai][bj][m][0], v1 = acc[ai][bj][m][1];
                    if (ACT == 1) {
#pragma unroll
                        for (int j = 0; j < 4; ++j) { const float a = v0[j] > 0.f ? v0[j] : 0.f, b = v1[j] > 0.f ? v1[j] : 0.f; v0[j] = a * a; v1[j] = b * b; } }
                    u32x4 w; w.x = cvt_pk_bf16(v0[0], v0[1]); w.y = cvt_pk_bf16(v0[2], v0[3]); w.z = cvt_pk_bf16(v1[0], v1[1]); w.w = cvt_pk_bf16(v1[2], v1[3]);
                    *(u32x4*)(rowp + bj * HALF) = w; } }
    }
};
struct EpiResF32 {
    static constexpr bool PERM = false, AFTER_DRAIN = false;
    float* X; int ldc;
    __device__ __forceinline__ void operator()(const f32x4 (&acc)[2][2][4][2], const Unit& u, int wr, int wc, int fr, int fq) const {
        const int row0 = u.pm * BM + wr * 64 + fr, col0 = u.pn * BM + wc * 32 + 4 * fq;
#pragma unroll
        for (int ai = 0; ai < 2; ++ai)
#pragma unroll
            for (int m = 0; m < 4; ++m) { float* rowp = X + (size_t)(row0 + ai * HALF + m * 16) * ldc + col0;
                f32x4 b[2][2];
#pragma unroll
                for (int bj = 0; bj < 2; ++bj)
#pragma unroll
                    for (int n = 0; n < 2; ++n) b[bj][n] = *(const f32x4*)(rowp + bj * HALF + n * 16);
#pragma unroll
                for (int bj = 0; bj < 2; ++bj)
#pragma unroll
                    for (int n = 0; n < 2; ++n) *(f32x4*)(rowp + bj * HALF + n * 16) = b[bj][n] + acc[ai][bj][m][n];
                asm volatile("" ::: "memory"); }
    }
};
template <class Epi, class Sched, bool ALIGN_EPI = false, bool SP2 = false>
__device__ __forceinline__ void gemm_phase(PG8_LAS unsigned char* lds, const Gemm g, const Sched& S, const Epi& E) {
    int tid_ = threadIdx.x; asm volatile("" : "+v"(tid_));
    const int tid = tid_, wid = __builtin_amdgcn_readfirstlane(tid >> 6), lane = tid & 63, wr = wid >> 2, wc = wid & 3, fr = lane & 15, fq = lane >> 4;
    const int K = g.K, nt = K / BK;
    unsigned voffA[2], voffB[2];
#pragma unroll
    for (int i = 0; i < 2; ++i) { int R, C; stage_rc(tid * 16 + i * 8192, R, C); const int Rb = Epi::PERM ? ((R & ~31) + perm32(R & 31)) : R;
        voffA[i] = (unsigned)(R * K + C) * 2u; voffB[i] = (unsigned)(Rb * K + C) * 2u; }
    const size_t kstep = (size_t)(BK * 2);
    const size_t hstep = (size_t)HALF * K * 2;
    const size_t tstep = 2 * hstep;
    const unsigned ldsw = (unsigned)wid * 1024u;
    const int aoff = lds_byte(wr * 64 + fr, fq * 8), boff = lds_byte(wc * 32 + fr, fq * 8);
#define PG8_SA(b, h) (((b) * 2 + (h)) * HTB)
#define PG8_SB(b, h) ((4 + (b) * 2 + (h)) * HTB)
#define PG8_STAGE(bufoff, gbase, voff) do { _Pragma("unroll") for (int _i = 0; _i < 2; ++_i) \
        __builtin_amdgcn_global_load_lds((const unsigned*)((const char*)(gbase) + (voff)[_i]), (PG8_LAS unsigned*)(lds + (bufoff) + ldsw + _i * 8192), 16, 0, 0); } while (0)
#define PG8_LDA(dst, b, h) do { _Pragma("unroll") for (int m = 0; m < 4; ++m) _Pragma("unroll") for (int k = 0; k < 2; ++k) dst[m][k] = *(const PG8_LAS bf16x8*)(lds + PG8_SA(b, h) + aoff + m * 2048 + k * 1024); } while (0)
#define PG8_LDB(dst, b, h) do { _Pragma("unroll") for (int n = 0; n < 2; ++n) _Pragma("unroll") for (int k = 0; k < 2; ++k) dst[n][k] = *(const PG8_LAS bf16x8*)(lds + PG8_SB(b, h) + boff + n * 2048 + k * 1024); } while (0)
#define PG8_MMA(ai, bj, At, Bt) do { __builtin_amdgcn_s_setprio(1); _Pragma("unroll") for (int m = 0; m < 4; ++m) _Pragma("unroll") for (int n = 0; n < 2; ++n) _Pragma("unroll") for (int k = 0; k < 2; ++k) \
        acc[ai][bj][m][n] = __builtin_amdgcn_mfma_f32_16x16x32_bf16(Bt[n][k], At[m][k], acc[ai][bj][m][n], 0, 0, 0); __builtin_amdgcn_s_setprio(0); } while (0)
#define PG8_WAIT_V(n) asm volatile("s_waitcnt vmcnt(" #n ")" ::: "memory")
#define PG8_WAIT_L(n) asm volatile("s_waitcnt lgkmcnt(" #n ")" ::: "memory")
#define PG8_BAR __builtin_amdgcn_s_barrier()
#define PG8_SCHED __builtin_amdgcn_sched_barrier(0)
    Unit cur, nxt; int ui = 0;
    if (!S.next(0, cur)) return;
    f32x4 acc[2][2][4][2];
#pragma unroll
    for (int a = 0; a < 2; ++a)
#pragma unroll
        for (int b = 0; b < 2; ++b)
#pragma unroll
            for (int m = 0; m < 4; ++m)
#pragma unroll
                for (int n = 0; n < 2; ++n) acc[a][b][m][n] = (f32x4){0.f, 0.f, 0.f, 0.f};
    bf16x8 At[4][2], B0[2][2], B1[2][2];
    const char* cA = (const char*)g.A + (size_t)cur.pm * tstep; const char* cB = (const char*)g.Bt + (size_t)cur.pn * tstep;
    S.a_ready(cur);
    if constexpr (SP2) {
        PG8_STAGE(PG8_SB(0, 0), cB, voffB); PG8_STAGE(PG8_SB(0, 1), cB + hstep, voffB); PG8_STAGE(PG8_SA(0, 0), cA, voffA); PG8_STAGE(PG8_SA(0, 1), cA + hstep, voffA);
        if (wr == 1) PG8_BAR;
        PG8_WAIT_V(2); PG8_BAR;
        PG8_STAGE(PG8_SB(1, 0), cB + kstep, voffB); PG8_STAGE(PG8_SA(1, 0), cA + kstep, voffA); PG8_STAGE(PG8_SB(1, 1), cB + hstep + kstep, voffB);
        PG8_WAIT_V(6); PG8_BAR;
    } else {
        PG8_STAGE(PG8_SB(0, 0), cB, voffB); PG8_STAGE(PG8_SA(0, 0), cA, voffA); PG8_STAGE(PG8_SB(0, 1), cB + hstep, voffB); PG8_STAGE(PG8_SA(0, 1), cA + hstep, voffA);
        if (wr == 1) PG8_BAR;
        PG8_WAIT_V(4); PG8_BAR;
        PG8_STAGE(PG8_SB(1, 0), cB + kstep, voffB); PG8_STAGE(PG8_SA(1, 0), cA + kstep, voffA); PG8_STAGE(PG8_SB(1, 1), cB + hstep + kstep, voffB);
        PG8_WAIT_V(6); PG8_BAR;
    }
    for (;;) {
        const bool has_next = S.next(ui + 1, nxt);
        const char* nA = has_next ? (const char*)g.A + (size_t)nxt.pm * tstep : cA; const char* nB = has_next ? (const char*)g.Bt + (size_t)nxt.pn * tstep : cB;
        for (int t = 0; t < nt; t += 2) {
            const bool last = (t == nt - 2);
            const char* a1 = cA + (size_t)(t + 1) * kstep;
            const char* a2 = last ? nA : cA + (size_t)(t + 2) * kstep; const char* b2 = last ? nB : cB + (size_t)(t + 2) * kstep;
            const char* a3 = a2 + kstep; const char* b3 = b2 + kstep;
            if (last && has_next) S.a_ready(nxt);
            if constexpr (SP2) {
            PG8_LDB(B0, 0, 0); PG8_LDB(B1, 0, 1); PG8_SCHED; PG8_LDA(At, 0, 0); PG8_STAGE(PG8_SA(1, 1), a1 + hstep, voffA);
            PG8_WAIT_V(8); PG8_WAIT_L(0); PG8_BAR; PG8_MMA(0, 0, At, B0); PG8_MMA(0, 1, At, B1); PG8_BAR; PG8_SCHED;
            PG8_LDA(At, 0, 1); PG8_STAGE(PG8_SB(0, 0), b2, voffB); PG8_STAGE(PG8_SB(0, 1), b2 + hstep, voffB); PG8_STAGE(PG8_SA(0, 0), a2, voffA);
            PG8_WAIT_V(8); PG8_WAIT_L(0); PG8_BAR; PG8_MMA(1, 0, At, B0); PG8_MMA(1, 1, At, B1); PG8_BAR; PG8_SCHED;
            PG8_LDB(B0, 1, 0); PG8_LDB(B1, 1, 1); PG8_SCHED; PG8_LDA(At, 1, 0); PG8_STAGE(PG8_SA(0, 1), a2 + hstep, voffA);
            PG8_WAIT_V(8); PG8_WAIT_L(0); PG8_BAR; PG8_MMA(0, 0, At, B0); PG8_MMA(0, 1, At, B1); PG8_BAR; PG8_SCHED;
            PG8_LDA(At, 1, 1); PG8_STAGE(PG8_SB(1, 0), b3, voffB); PG8_STAGE(PG8_SB(1, 1), b3 + hstep, voffB); PG8_STAGE(PG8_SA(1, 0), a3, voffA);
            PG8_WAIT_V(8); PG8_WAIT_L(0); PG8_BAR; PG8_MMA(1, 0, At, B0); PG8_MMA(1, 1, At, B1); PG8_BAR; PG8_SCHED;
            } else {
            PG8_LDB(B0, 0, 0); PG8_SCHED; PG8_LDA(At, 0, 0); PG8_STAGE(PG8_SA(1, 1), a1 + hstep, voffA);
            PG8_WAIT_L(8); PG8_BAR; PG8_WAIT_L(0); PG8_MMA(0, 0, At, B0); PG8_BAR; PG8_SCHED;
            PG8_LDB(B1, 0, 1); PG8_STAGE(PG8_SB(0, 0), b2, voffB);
            PG8_BAR; PG8_WAIT_L(0); PG8_MMA(0, 1, At, B1); PG8_BAR;
            PG8_LDA(At, 0, 1); PG8_STAGE(PG8_SA(0, 0), a2, voffA);
            PG8_BAR; PG8_WAIT_L(0); PG8_MMA(1, 0, At, B0); PG8_BAR; PG8_SCHED;
            PG8_STAGE(PG8_SB(0, 1), b2 + hstep, voffB);
            PG8_WAIT_V(6); PG8_BAR; PG8_MMA(1, 1, At, B1); PG8_BAR;
            PG8_LDB(B0, 1, 0); PG8_SCHED; PG8_LDA(At, 1, 0); PG8_STAGE(PG8_SA(0, 1), a2 + hstep, voffA);
            PG8_WAIT_L(8); PG8_BAR; PG8_WAIT_L(0); PG8_MMA(0, 0, At, B0); PG8_BAR; PG8_SCHED;
            PG8_LDB(B1, 1, 1); PG8_STAGE(PG8_SB(1, 0), b3, voffB);
            PG8_BAR; PG8_WAIT_L(0); PG8_MMA(0, 1, At, B1); PG8_BAR;
            PG8_LDA(At, 1, 1); PG8_STAGE(PG8_SA(1, 0), a3, voffA);
            PG8_BAR; PG8_WAIT_L(0); PG8_MMA(1, 0, At, B0); PG8_BAR; PG8_SCHED;
            PG8_STAGE(PG8_SB(1, 1), b3 + hstep, voffB);
            PG8_WAIT_V(6); PG8_BAR; PG8_MMA(1, 1, At, B1); PG8_BAR;
            }
        }
        if constexpr (ALIGN_EPI) { if (wr == 0) PG8_BAR; }
        if constexpr (!Epi::AFTER_DRAIN) { E(acc, cur, wr, wc, fr, fq); S.done(cur); }
        if (!has_next) break;
#pragma unroll
        for (int a = 0; a < 2; ++a)
#pragma unroll
            for (int b = 0; b < 2; ++b)
#pragma unroll
                for (int m = 0; m < 4; ++m)
#pragma unroll
                    for (int n = 0; n < 2; ++n) acc[a][b][m][n] = (f32x4){0.f, 0.f, 0.f, 0.f};
        cur = nxt; cA = nA; cB = nB; ++ui;
        if constexpr (ALIGN_EPI) { if (wr == 1) PG8_BAR; }
    }
    PG8_WAIT_V(0);
    if constexpr (!ALIGN_EPI) { if (wr == 0) PG8_BAR; }
    PG8_BAR;
    if constexpr (Epi::AFTER_DRAIN) { E.fused(acc, cur, wr, wc, fr, fq, lds, wid, lane); S.done(cur); }
#undef PG8_SA
#undef PG8_SB
#undef PG8_STAGE
#undef PG8_LDA
#undef PG8_LDB
#undef PG8_MMA
#undef PG8_WAIT_V
#undef PG8_WAIT_L
#undef PG8_BAR
#undef PG8_SCHED
}
}

#define DI __device__ __forceinline__
#define LAS __attribute__((address_space(3)))
typedef unsigned short bf16;
typedef short bf16x8 __attribute__((ext_vector_type(8)));
typedef short s16x4 __attribute__((ext_vector_type(4)));
typedef short v4i16_t __attribute__((ext_vector_type(4)));
typedef float f32x4 __attribute__((ext_vector_type(4)));
typedef float f32x16 __attribute__((ext_vector_type(16)));
typedef unsigned u32x4 __attribute__((ext_vector_type(4)));
typedef unsigned u32x2 __attribute__((ext_vector_type(2)));

constexpr int DM = 2048, NB = 8, SEQ = 2048, DEPTH = 4, DBAT = 32, DSEQ = 64, PAST = 1024, BWIN = 512;
constexpr int NTP = NB * SEQ, NTS = DBAT * DSEQ, NTOK = NTP + NTS;
constexpr int INC = 7264, INP = 7424, DFF = 8192;
constexpr int C_AQ = 0, C_AK = 512, C_AV = 1024, C_IQ = 1536, C_IK = 2560, C_IW = 2624, C_BQ = 2640, C_BK = 3152, C_BV = 3664, C_CZ = 4176, C_XBC = 5200, C_DT = 7248;
constexpr float EPS = 1e-5f;
constexpr int NWAVES = 8, NTHR = 512;

constexpr size_t SZ_YP = (size_t)NTP * DM, SZ_YS = (size_t)NTS * DM;
constexpr size_t SZ_PAK = (size_t)DEPTH * NB * SEQ * 512, SZ_PKI = (size_t)DEPTH * NB * SEQ * 64, SZ_PBK = (size_t)DEPTH * NB * BWIN * 512;
constexpr size_t SZ_PSSM = (size_t)DEPTH * NB * 16 * 64 * 128, SZ_PCONV = (size_t)DEPTH * NB * 3 * 2048;
constexpr size_t SZ_SAK = (size_t)DEPTH * DBAT * DSEQ * 512, SZ_SKI = (size_t)DEPTH * DBAT * DSEQ * 64, SZ_SBK = SZ_SAK;
constexpr size_t SZ_SSSM = (size_t)DEPTH * DBAT * 16 * 64 * 128, SZ_SCONV = (size_t)DEPTH * DBAT * 3 * 2048;
constexpr size_t OFF_YP = 0, OFF_YS = OFF_YP + SZ_YP, OFF_P_AK = OFF_YS + SZ_YS, OFF_P_AV = OFF_P_AK + SZ_PAK, OFF_P_KI = OFF_P_AV + SZ_PAK,
                 OFF_P_BK = OFF_P_KI + SZ_PKI, OFF_P_BV = OFF_P_BK + SZ_PBK, OFF_P_SSM = OFF_P_BV + SZ_PBK, OFF_P_CONV = OFF_P_SSM + SZ_PSSM,
                 OFF_S_AK = OFF_P_CONV + SZ_PCONV, OFF_S_AV = OFF_S_AK + SZ_SAK, OFF_S_KI = OFF_S_AV + SZ_SAK, OFF_S_BK = OFF_S_KI + SZ_SKI,
                 OFF_S_BV = OFF_S_BK + SZ_SBK, OFF_S_SSM = OFF_S_BV + SZ_SBK, OFF_S_CONV = OFF_S_SSM + SZ_SSSM, OUT_TOTAL = OFF_S_CONV + SZ_SCONV;
static_assert(OUT_TOTAL == 165085184, "output size");

constexpr size_t MiB = 1u << 20;
constexpr size_t WS_CTL = 0, CTL_ZERO_BYTES = 1 * MiB;
constexpr size_t WS_ROPE = 1 * MiB;
constexpr size_t WS_W = 2 * MiB;
constexpr size_t W_IN_B = (size_t)INP * DM * 2, W_OUT_B = (size_t)DM * DM * 2, W_UP_B = (size_t)DFF * DM * 2, W_DN_B = (size_t)DM * DFF * 2, W_LAYER_B = W_IN_B + W_OUT_B + W_UP_B + W_DN_B;
static_assert(W_LAYER_B == 101 * MiB, "weights per layer");
constexpr size_t WS_X = WS_W + DEPTH * W_LAYER_B;
constexpr size_t WS_H = WS_X + (size_t)NTOK * DM * 4;
constexpr size_t WS_MIX = WS_H + (size_t)NTOK * DM * 2;
constexpr size_t WS_PU = WS_MIX + (size_t)NTOK * DM * 2;
constexpr size_t WS_XBC = WS_PU + (size_t)NTOK * DFF * 2;
constexpr size_t WS_G = WS_XBC + (size_t)NTOK * 2048 * 2;
constexpr size_t WS_DTS = WS_G + (size_t)NTOK * 1024 * 4;
constexpr size_t WS_CAK = WS_DTS + 2 * MiB;
constexpr size_t WS_CAV = WS_CAK + (size_t)DBAT * PAST * 512 * 2;
constexpr size_t WS_CBK = WS_CAV + (size_t)DBAT * PAST * 512 * 2;
constexpr size_t WS_CBV = WS_CBK + (size_t)DBAT * BWIN * 512 * 2;
constexpr size_t WS_CKI = WS_CBV + (size_t)DBAT * BWIN * 512 * 2;
constexpr size_t WS_SC = WS_CKI + (size_t)DBAT * PAST * 64 * 2;
constexpr size_t WS_END = WS_SC + (size_t)256 * 64 * 2048 * 4;
static_assert(WS_END == 1356 * MiB, "ws map");
constexpr int CW_BAR = 4096;
constexpr int CW_Q = 16384;

constexpr int RING_BYTES = 131072, LDSCTL_OFF = RING_BYTES, LDS_BYTES = 147456;
constexpr int ATT_SEL = 0;
constexpr int ATT_V = 16384, VSTR = 1088, ATT_END = ATT_V + 2 * 32 * VSTR;
constexpr int CSTR = 272, XSTR = 144, MSTR = 144, HSTR = 272;
constexpr int SSD_CS = 0, SSD_BS = SSD_CS + 64 * CSTR, SSD_XD = SSD_BS + 64 * CSTR, SSD_XDW = SSD_XD + 64 * XSTR, SSD_MS = SSD_XDW + 64 * XSTR,
              SSD_HS = SSD_MS + 64 * MSTR, SSD_VEC = SSD_HS + 2 * 64 * HSTR, SSD_Y = SSD_VEC + 1024, YSTR = 272, SSD_END = SSD_Y + 64 * YSTR;
static_assert(ATT_END <= RING_BYTES && SSD_END <= RING_BYTES, "phase scratch fits the ring region");

DI float bf2f(bf16 v) { return __uint_as_float(((unsigned)v) << 16); }
DI unsigned pk2(float lo, float hi) { return pg8::cvt_pk_bf16(lo, hi); }
DI bf16 f2bf(float f) { return (bf16)(pk2(f, 0.f) & 0xffffu); }
DI float wave_sum(float v) {
#pragma unroll
    for (int o = 1; o < 64; o <<= 1) v += __shfl_xor(v, o);
    return v;
}
DI f32x16 mfma32(bf16x8 a, bf16x8 b, f32x16 c) { return __builtin_amdgcn_mfma_f32_32x32x16_bf16(a, b, c, 0, 0, 0); }
DI int crow(int i, int hh) { return (i & 3) + 8 * (i >> 2) + 4 * hh; }
DI s16x4 tr_read(LAS unsigned char* p) { return __builtin_bit_cast(s16x4, __builtin_amdgcn_ds_read_tr16_b64_v4i16((LAS v4i16_t*)p)); }
DI bf16x8 trfrag(LAS unsigned char* tile, int stride, int k0, int c0, int lane) {
    const int i16 = lane & 15, qq = i16 >> 2, p = i16 & 3, g2 = (lane >> 4) & 1, hh = lane >> 5;
    LAS unsigned char* a = tile + (k0 + 8 * hh + qq) * stride + (c0 + 16 * g2 + 4 * p) * 2;
    const s16x4 lo = tr_read(a), hi = tr_read(a + 4 * stride);
    return __builtin_shufflevector(lo, hi, 0, 1, 2, 3, 4, 5, 6, 7);
}
DI void unpack8(u32x4 v, float (&f)[8]) {
#pragma unroll
    for (int i = 0; i < 4; ++i) { f[2 * i] = __uint_as_float(v[i] << 16); f[2 * i + 1] = __uint_as_float(v[i] & 0xffff0000u); }
}
DI u32x4 pack8(const float (&f)[8]) { u32x4 o; o.x = pk2(f[0], f[1]); o.y = pk2(f[2], f[3]); o.z = pk2(f[4], f[5]); o.w = pk2(f[6], f[7]); return o; }

#define XB_TMO      128
#define XB_XCNT(j)  (256  + 64 * (j))
#define XB_XSUB(j)  (1280 + 64 * (j))
#define XB_XGEN(j)  (2304 + 64 * (j))
#define XB_TOP      3328
#define XB_TOPGEN   3392
#define XCD_BAR_WORDS 3456
#define XB_SPIN_CAP (1u << 20)
DI unsigned xb_ld(unsigned* p)              { return __hip_atomic_load(p, __ATOMIC_RELAXED, __HIP_MEMORY_SCOPE_AGENT); }
DI unsigned xb_add(unsigned* p, unsigned v) { return __hip_atomic_fetch_add(p, v, __ATOMIC_RELAXED, __HIP_MEMORY_SCOPE_AGENT); }
DI unsigned xb_xcc_id() { return (unsigned)__builtin_amdgcn_s_getreg((3 << 11) | 20) & 0xFu; }
#define XB_SPIN(cond, bar) do { unsigned _sp = 0; while (cond) { __builtin_amdgcn_s_sleep(1); \
    if ((++_sp & 255u) == 0u) { if (xb_ld(&(bar)[XB_TMO])) break; if (_sp > XB_SPIN_CAP) { atomicAdd(&(bar)[XB_TMO], 1u); break; } } } } while (0)
struct XcdBarrier { unsigned* bar; unsigned x; volatile LAS unsigned* st; };
DI XcdBarrier xcd_barrier_post(unsigned* bar, volatile LAS unsigned* st) {
    XcdBarrier b; b.bar = bar; b.x = xb_xcc_id(); b.st = st;
    if (threadIdx.x == 0) (void)xb_add(&bar[XB_XCNT(b.x)], 1u);
    return b;
}
DI void xcd_barrier_complete(unsigned* bar, unsigned x, unsigned& nloc, unsigned& nx) {
    const unsigned G = gridDim.x * gridDim.y * gridDim.z;
    unsigned sum, cnt, mine, sp = 0u;
    for (;;) {
        sum = 0u; cnt = 0u; mine = 0u;
#pragma unroll
        for (unsigned j = 0; j < 16; ++j) { const unsigned c = xb_ld(&bar[XB_XCNT(j)]); sum += c; cnt += (c > 0u) ? 1u : 0u; mine = (j == x) ? c : mine; }
        if (sum == G) break;
        __builtin_amdgcn_s_sleep(1);
        if ((++sp & 255u) == 0u) { if (xb_ld(&bar[XB_TMO])) break; if (sp > XB_SPIN_CAP) { atomicAdd(&bar[XB_TMO], 1u); break; } }
    }
    nloc = mine > 0u ? mine : 1u; nx = cnt > 0u ? cnt : 1u;
}
DI void xcd_barrier(const XcdBarrier& b) {
    asm volatile("s_waitcnt vmcnt(0)" ::: "memory");
    __syncthreads();
    if (threadIdx.x == 0) {
        unsigned* bar = b.bar;
        __builtin_amdgcn_s_waitcnt(0);
        unsigned nloc = b.st[0], nx = b.st[1];
        if (nloc == 0u) { xcd_barrier_complete(bar, b.x, nloc, nx); b.st[0] = nloc; b.st[1] = nx; }
        const unsigned old = xb_add(&bar[XB_XSUB(b.x)], 1u);
        const unsigned gen = old / nloc;
        if (old + 1u == (gen + 1u) * nloc) {
            __builtin_amdgcn_fence(__ATOMIC_RELEASE, "agent");
            asm volatile("s_waitcnt vmcnt(0)" ::: "memory");
            const unsigned og = xb_add(&bar[XB_TOP], 1u);
            const unsigned tg = og / nx;
            if (og + 1u == (tg + 1u) * nx) xb_add(&bar[XB_TOPGEN], 1u);
            else XB_SPIN(xb_ld(&bar[XB_TOPGEN]) == tg, bar);
            __builtin_amdgcn_fence(__ATOMIC_ACQUIRE, "agent");
            xb_add(&bar[XB_XGEN(b.x)], 1u);
            asm volatile("s_waitcnt vmcnt(0)" ::: "memory");
        } else {
            XB_SPIN(xb_ld(&bar[XB_XGEN(b.x)]) == gen, bar);
            __builtin_amdgcn_fence(__ATOMIC_ACQUIRE, "agent");
            asm volatile("s_waitcnt vmcnt(0)" ::: "memory");
        }
    }
    __syncthreads();
}

struct Args { const float* in[23]; float* out; unsigned char* ws; int ph_lo, ph_hi; };
static_assert(sizeof(Args) == 23 * 8 + 8 + 8 + 8, "Args has no padding");
struct Ctx {
    LAS unsigned char* lds;
    unsigned* ctl;
    int tid, lane, wave, G, bid;
    float* out;
    unsigned char* ws;
};
DI bf16* ws_bf(const Ctx& C, size_t off) { return (bf16*)(C.ws + off); }
DI float* ws_f(const Ctx& C, size_t off) { return (float*)(C.ws + off); }
DI bf16* w_in_t(const Ctx& C, int l)  { return (bf16*)(C.ws + WS_W + (size_t)l * W_LAYER_B); }
DI bf16* w_out_t(const Ctx& C, int l) { return (bf16*)(C.ws + WS_W + (size_t)l * W_LAYER_B + W_IN_B); }
DI bf16* w_up_t(const Ctx& C, int l)  { return (bf16*)(C.ws + WS_W + (size_t)l * W_LAYER_B + W_IN_B + W_OUT_B); }
DI bf16* w_dn_t(const Ctx& C, int l)  { return (bf16*)(C.ws + WS_W + (size_t)l * W_LAYER_B + W_IN_B + W_OUT_B + W_UP_B); }

DI int q_next(const Ctx& C, unsigned* head) {
    volatile LAS int* slot = (volatile LAS int*)(C.lds + LDSCTL_OFF + 64);
    __syncthreads();
    if (C.tid == 0) *slot = (int)__hip_atomic_fetch_add(head, 1u, __ATOMIC_RELAXED, __HIP_MEMORY_SCOPE_AGENT);
    __syncthreads();
    return *slot;
}

DI void p0_transpose_item(const float* W, int K, int N, bf16* WT, LAS float* scr, int item, int lane) {
    const int nblk = N / 32, kb = item / nblk, nb = item % nblk, k0 = 64 * kb, n0 = 32 * nb;
#pragma unroll 8
    for (int i = 0; i < 32; ++i) { const int kk = 2 * i + (lane >> 5); scr[kk * 33 + (lane & 31)] = W[(size_t)(k0 + kk) * N + n0 + (lane & 31)]; }
    asm volatile("s_waitcnt lgkmcnt(0)" ::: "memory");
    const int c = lane & 7;
#pragma unroll
    for (int j = 0; j < 4; ++j) { const int n = (lane >> 3) + 8 * j; const LAS float* s = scr + (8 * c) * 33 + n;
        u32x4 o; o.x = pk2(s[0 * 33], s[1 * 33]); o.y = pk2(s[2 * 33], s[3 * 33]); o.z = pk2(s[4 * 33], s[5 * 33]); o.w = pk2(s[6 * 33], s[7 * 33]);
        *(u32x4*)(WT + (size_t)(n0 + n) * K + k0 + 8 * c) = o; }
    asm volatile("s_waitcnt lgkmcnt(0)" ::: "memory");
}
DI void rms_row(const float* src, float* xcopy, const float* w, bf16* outb, float* outf, int lane) {
    f32x4 v[8]; float ss = 0.f;
#pragma unroll
    for (int j = 0; j < 8; ++j) { v[j] = ((const f32x4*)src)[lane + 64 * j]; ss += (v[j].x * v[j].x + v[j].y * v[j].y) + (v[j].z * v[j].z + v[j].w * v[j].w); }
    if (xcopy) {
#pragma unroll
        for (int j = 0; j < 8; ++j) ((f32x4*)xcopy)[lane + 64 * j] = v[j];
    }
    ss = wave_sum(ss);
    const float rs = 1.0f / sqrtf(ss * (1.0f / DM) + EPS);
#pragma unroll
    for (int j = 0; j < 8; ++j) { const f32x4 wv = ((const f32x4*)w)[lane + 64 * j]; const f32x4 o = v[j] * rs * wv;
        if (outb) { u32x2 p; p.x = pk2(o.x, o.y); p.y = pk2(o.z, o.w); ((u32x2*)outb)[lane + 64 * j] = p; }
        if (outf) ((f32x4*)outf)[lane + 64 * j] = o; }
}
DI void sincos_tab(float ang, float& c, float& s) {
    const double a = (double)ang; const double kq = rint(a * 0.63661977236758134308); const double x = a - kq * 1.57079632679489661923; const double x2 = x * x;
    const double sn = x * (1.0 + x2 * (-1.0 / 6 + x2 * (1.0 / 120 + x2 * (-1.0 / 5040 + x2 * (1.0 / 362880 + x2 * (-1.0 / 39916800 + x2 * (1.0 / 6227020800.0)))))));
    const double cn = 1.0 + x2 * (-0.5 + x2 * (1.0 / 24 + x2 * (-1.0 / 720 + x2 * (1.0 / 40320 + x2 * (-1.0 / 3628800 + x2 * (1.0 / 479001600 + x2 * (-1.0 / 87178291200.0)))))));
    const int q = ((int)kq) & 3;
    const double cc = (q == 0) ? cn : (q == 1) ? -sn : (q == 2) ? -cn : sn;
    const double sc = (q == 0) ? sn : (q == 1) ? cn : (q == 2) ? -sn : -cn;
    c = (float)cc; s = (float)sc;
}
DI void p0_prologue(const Ctx& C, const Args& A) {
    LAS float* scr = (LAS float*)(C.lds + C.wave * 16384);
    const int gw = C.bid * NWAVES + C.wave, NGW = C.G * NWAVES;
    constexpr int I_IN = (DM / 64) * (INC / 32), I_OUT = (DM / 64) * (DM / 32), I_UP = (DM / 64) * (DFF / 32), I_DN = (DFF / 64) * (DM / 32), I_L = I_IN + I_OUT + I_UP + I_DN;
    for (int it = gw; it < DEPTH * I_L; it += NGW) {
        const int l = it / I_L; int r = it % I_L;
        if (r < I_IN) { p0_transpose_item(A.in[10] + (size_t)l * DM * INC, DM, INC, w_in_t(C, l), scr, r, C.lane); continue; } r -= I_IN;
        if (r < I_OUT) { p0_transpose_item(A.in[11] + (size_t)l * DM * DM, DM, DM, w_out_t(C, l), scr, r, C.lane); continue; } r -= I_OUT;
        if (r < I_UP) { p0_transpose_item(A.in[20] + (size_t)l * DM * DFF, DM, DFF, w_up_t(C, l), scr, r, C.lane); continue; } r -= I_UP;
        p0_transpose_item(A.in[21] + (size_t)l * DFF * DM, DFF, DM, w_dn_t(C, l), scr, r, C.lane);
    }
    { const int gt = C.bid * NTHR + C.tid, NGT = C.G * NTHR; constexpr int CH_L = (INP - INC) * DM / 8;
      for (int i = gt; i < DEPTH * CH_L; i += NGT) { const int l = i / CH_L, c = i % CH_L; ((u32x4*)(w_in_t(C, l) + (size_t)INC * DM))[c] = (u32x4){0u, 0u, 0u, 0u}; }
      float* ra = ws_f(C, WS_ROPE); float* ri = ra + 2048 * 16 * 2;
      for (int i = gt; i < 2048 * 24; i += NGT) { const int pos = i / 24, k = i % 24; const bool isa = k < 16; const int fi = isa ? k : k - 16;
          const double ex = isa ? (double)fi / 16.0 : (double)fi / 8.0; const float inv = (float)exp2(-ex * 18.931568569324174  );
          const float ang = (float)pos * inv; float c, s; sincos_tab(ang, c, s);
          float* dst = isa ? ra + (pos * 16 + fi) * 2 : ri + (pos * 8 + fi) * 2; dst[0] = c; dst[1] = s; } }
    for (int m = gw; m < NTOK; m += NGW) { const float* src = m < NTP ? A.in[0] + (size_t)m * DM : A.in[1] + (size_t)(m - NTP) * DM;
        rms_row(src, ws_f(C, WS_X) + (size_t)m * DM, A.in[9], ws_bf(C, WS_H) + (size_t)m * DM, nullptr, C.lane); }
}

DI void cvt_store8(const bf16* src, float* dst) {
    const u32x4 v = *(const u32x4*)src; float f[8]; unpack8(v, f);
    ((f32x4*)dst)[0] = (f32x4){f[0], f[1], f[2], f[3]}; ((f32x4*)dst)[1] = (f32x4){f[4], f[5], f[6], f[7]};
}
DI void m0_row(const Ctx& C, const Args& A, int l, int r, int lane) {
    bf16* P = ws_bf(C, WS_PU) + (size_t)r * INP;
    const bool smp = r >= NTP; int b, t, pos;
    if (!smp) { b = r >> 11; t = r & 2047; pos = t; } else { const int rr = r - NTP; b = rr >> 6; t = rr & 63; pos = PAST + t; }
    float* out = C.out;
    float* o_ak = smp ? out + OFF_S_AK + ((size_t)(l * DBAT + b) * DSEQ + t) * 512 : out + OFF_P_AK + ((size_t)(l * NB + b) * SEQ + t) * 512;
    float* o_av = smp ? out + OFF_S_AV + ((size_t)(l * DBAT + b) * DSEQ + t) * 512 : out + OFF_P_AV + ((size_t)(l * NB + b) * SEQ + t) * 512;
    float* o_ki = smp ? out + OFF_S_KI + ((size_t)(l * DBAT + b) * DSEQ + t) * 64 : out + OFF_P_KI + ((size_t)(l * NB + b) * SEQ + t) * 64;
    const float* ropeA = ws_f(C, WS_ROPE) + (size_t)pos * 32; const float* ropeI = ws_f(C, WS_ROPE) + 2048 * 32 + (size_t)pos * 16;
    {
        const int i = lane & 15, c1 = (lane >> 4) * 128 + i, c2 = c1 + 16; const float cs = ropeA[2 * i], sn = ropeA[2 * i + 1];
        float x1 = bf2f(P[C_AQ + c1]), x2 = bf2f(P[C_AQ + c2]);
        P[C_AQ + c1] = f2bf(x1 * cs - x2 * sn); P[C_AQ + c2] = f2bf(x2 * cs + x1 * sn);
        x1 = bf2f(P[C_AK + c1]); x2 = bf2f(P[C_AK + c2]);
        const float y1 = x1 * cs - x2 * sn, y2 = x2 * cs + x1 * sn;
        P[C_AK + c1] = f2bf(y1); P[C_AK + c2] = f2bf(y2); o_ak[c1] = y1; o_ak[c2] = y2;
    }
    if (lane < 48) { const int col = (lane / 12) * 128 + 32 + (lane % 12) * 8; cvt_store8(P + C_AK + col, o_ak + col); }
    cvt_store8(P + C_AV + lane * 8, o_av + lane * 8);
#pragma unroll
    for (int k = 0; k < 2; ++k) {
        const int pid = lane + 64 * k, i = pid & 7, c1 = C_IQ + (pid >> 3) * 64 + i, c2 = c1 + 8; const float cs = ropeI[2 * i], sn = ropeI[2 * i + 1];
        const float x1 = bf2f(P[c1]), x2 = bf2f(P[c2]);
        P[c1] = f2bf(x1 * cs - x2 * sn); P[c2] = f2bf(x2 * cs + x1 * sn);
    }
    if (lane < 8) { const int i = lane; const float cs = ropeI[2 * i], sn = ropeI[2 * i + 1];
        const float x1 = bf2f(P[C_IK + i]), x2 = bf2f(P[C_IK + i + 8]); const float y1 = x1 * cs - x2 * sn, y2 = x2 * cs + x1 * sn;
        P[C_IK + i] = f2bf(y1); P[C_IK + i + 8] = f2bf(y2); o_ki[i] = y1; o_ki[i + 8] = y2;
    } else if (lane < 14) { const int col = 16 + (lane - 8) * 8; cvt_store8(P + C_IK + col, o_ki + col); }
    const bool keep = smp || t >= SEQ - BWIN;
    if (keep) {
        const size_t ro = smp ? ((size_t)(l * DBAT + b) * DSEQ + t) * 512 : ((size_t)(l * NB + b) * BWIN + (t - (SEQ - BWIN))) * 512;
        float* o_bk = out + (smp ? OFF_S_BK : OFF_P_BK) + ro; float* o_bv = out + (smp ? OFF_S_BV : OFF_P_BV) + ro;
        cvt_store8(P + C_BK + lane * 8, o_bk + lane * 8); cvt_store8(P + C_BV + lane * 8, o_bv + lane * 8);
    }
    if (lane < 16) { const float x = bf2f(P[C_DT + lane]) + A.in[15][l * 16 + lane];
        const float sp = x > 20.f ? x : log1pf(__expf(x)); ws_f(C, WS_DTS)[(size_t)r * 16 + lane] = sp; }
    const float* cw = A.in[13] + (size_t)l * 4 * 2048; const float* cb = A.in[14] + (size_t)l * 2048;
    const float* sconv = A.in[8] + (size_t)(l * DBAT + b) * 3 * 2048;
    bf16* xo = ws_bf(C, WS_XBC) + (size_t)r * 2048;
    const int stt = smp ? DSEQ - 3 : SEQ - 3;
    float* o_conv = (t >= stt) ? (smp ? out + OFF_S_CONV + ((size_t)(l * DBAT + b) * 3 + (t - stt)) * 2048 : out + OFF_P_CONV + ((size_t)(l * NB + b) * 3 + (t - stt)) * 2048) : nullptr;
#pragma unroll 1
    for (int it = 0; it < 4; ++it) {
        const int ch = (lane + 64 * it) * 8;
        float acc[8], x[8];
        { const f32x4 b0 = *(const f32x4*)(cb + ch), b1 = *(const f32x4*)(cb + ch + 4); acc[0] = b0.x; acc[1] = b0.y; acc[2] = b0.z; acc[3] = b0.w; acc[4] = b1.x; acc[5] = b1.y; acc[6] = b1.z; acc[7] = b1.w; }
#pragma unroll
        for (int j = 0; j < 4; ++j) {
            const int tt = t - 3 + j; bool have = true;
            if (tt >= 0) { unpack8(*(const u32x4*)(P + (ptrdiff_t)(j - 3) * INP + C_XBC + ch), x); }
            else if (smp) { const float* sp = sconv + (size_t)(3 + tt) * 2048 + ch; const f32x4 s0 = *(const f32x4*)sp, s1 = *(const f32x4*)(sp + 4);
                x[0] = s0.x; x[1] = s0.y; x[2] = s0.z; x[3] = s0.w; x[4] = s1.x; x[5] = s1.y; x[6] = s1.z; x[7] = s1.w; }
            else have = false;
            if (have) { const f32x4 w0 = *(const f32x4*)(cw + j * 2048 + ch), w1 = *(const f32x4*)(cw + j * 2048 + ch + 4);
                acc[0] += x[0] * w0.x; acc[1] += x[1] * w0.y; acc[2] += x[2] * w0.z; acc[3] += x[3] * w0.w; acc[4] += x[4] * w1.x; acc[5] += x[5] * w1.y; acc[6] += x[6] * w1.z; acc[7] += x[7] * w1.w; }
        }
        if (o_conv) { ((f32x4*)(o_conv + ch))[0] = (f32x4){x[0], x[1], x[2], x[3]}; ((f32x4*)(o_conv + ch))[1] = (f32x4){x[4], x[5], x[6], x[7]}; }
#pragma unroll
        for (int k = 0; k < 8; ++k) acc[k] = acc[k] / (1.f + __expf(-acc[k]));
        *(u32x4*)(xo + ch) = pack8(acc);
    }
}
DI void cvt_chunks(const float* src, bf16* dst, size_t nchunk, size_t gt, size_t ngt) {
    for (size_t i = gt; i < nchunk; i += ngt) { const f32x4 a = ((const f32x4*)src)[2 * i], b = ((const f32x4*)src)[2 * i + 1];
        u32x4 o; o.x = pk2(a.x, a.y); o.y = pk2(a.z, a.w); o.z = pk2(b.x, b.y); o.w = pk2(b.z, b.w); ((u32x4*)dst)[i] = o; }
}
DI void m0_phase(const Ctx& C, const Args& A, int l) {
    const int gw = C.bid * NWAVES + C.wave, NGW = C.G * NWAVES;
    for (int r = gw; r < NTOK; r += NGW) m0_row(C, A, l, r, C.lane);
    const size_t gt = (size_t)C.bid * NTHR + C.tid, ngt = (size_t)C.G * NTHR;
    cvt_chunks(A.in[2] + (size_t)l * DBAT * PAST * 512, ws_bf(C, WS_CAK), (size_t)DBAT * PAST * 512 / 8, gt, ngt);
    cvt_chunks(A.in[3] + (size_t)l * DBAT * PAST * 512, ws_bf(C, WS_CAV), (size_t)DBAT * PAST * 512 / 8, gt, ngt);
    cvt_chunks(A.in[4] + (size_t)l * DBAT * PAST * 64, ws_bf(C, WS_CKI), (size_t)DBAT * PAST * 64 / 8, gt, ngt);
    cvt_chunks(A.in[5] + (size_t)l * DBAT * BWIN * 512, ws_bf(C, WS_CBK), (size_t)DBAT * BWIN * 512 / 8, gt, ngt);
    cvt_chunks(A.in[6] + (size_t)l * DBAT * BWIN * 512, ws_bf(C, WS_CBV), (size_t)DBAT * BWIN * 512 / 8, gt, ngt);
}

struct KVSrc { const bf16* k0; const bf16* v0; int s0; int n0; const bf16* k1; const bf16* v1; int s1; };
template <int MODE>
DI void attn_unit(const Ctx& C, const bf16* Qp, int qstride, const KVSrc& S, int tile_lo, int tile_hi, bf16* Op, int ostride) {
    int tid = C.tid, lane = C.lane; asm volatile("" : "+v"(tid), "+v"(lane));
    const int w = C.wave, r = lane & 31, hh = lane >> 5;
    const int head = w >> 1, q = (w & 1) * 32 + r;
    LAS unsigned char* Vs = C.lds + ATT_V;
    bf16x8 qf[8];
    { const bf16* qrow = Qp + (size_t)q * qstride + head * 128 + 8 * hh;
#pragma unroll
      for (int ks = 0; ks < 8; ++ks) qf[ks] = *(const bf16x8*)(qrow + 16 * ks); }
    f32x16 o[4];
#pragma unroll
    for (int d = 0; d < 4; ++d)
#pragma unroll
        for (int i = 0; i < 16; ++i) o[d][i] = 0.f;
    float m = -1e30f, lsum = 0.f;
    constexpr float SC2 = 0.08838834764831845f * 1.4426950408889634f;
    constexpr float L2E = 1.4426950408889634f;
    bf16x8 kf[8]; u32x4 vr[4];
#define ATT_KLOAD(tile_) do { const int key_ = (tile_) * 32 + r; const bf16* kp_ = (key_ < S.n0 ? S.k0 + (ptrdiff_t)key_ * S.s0 : S.k1 + (ptrdiff_t)(key_ - S.n0) * S.s1) + head * 128 + 8 * hh; \
        _Pragma("unroll") for (int ks_ = 0; ks_ < 8; ++ks_) kf[ks_] = *(const bf16x8*)(kp_ + 16 * ks_); } while (0)
#define ATT_VLOAD(tile_) do { _Pragma("unroll") for (int i_ = 0; i_ < 4; ++i_) { const int ci_ = tid + 512 * i_, row_ = ci_ >> 6, ch_ = ci_ & 63, key_ = (tile_) * 32 + row_; \
        const bf16* vp_ = key_ < S.n0 ? S.v0 + (ptrdiff_t)key_ * S.s0 : S.v1 + (ptrdiff_t)(key_ - S.n0) * S.s1; vr[i_] = *(const u32x4*)(vp_ + ch_ * 8); } } while (0)
#define ATT_VSTORE(buf_) do { _Pragma("unroll") for (int i_ = 0; i_ < 4; ++i_) { const int ci_ = tid + 512 * i_, row_ = ci_ >> 6, ch_ = ci_ & 63; \
        *(LAS u32x4*)(Vs + (buf_) * (32 * VSTR) + row_ * VSTR + ch_ * 16) = vr[i_]; } } while (0)
    ATT_KLOAD(tile_lo); ATT_VLOAD(tile_lo);
    __syncthreads();
    ATT_VSTORE(0);
    if (tile_lo + 1 < tile_hi) ATT_VLOAD(tile_lo + 1);
    __syncthreads();
    const int i16 = lane & 15;
    LAS unsigned char* vbase = Vs + (4 * hh + (i16 >> 2)) * VSTR + (head * 128 + 16 * ((lane >> 4) & 1) + 4 * (i16 & 3)) * 2;
    const LAS float* btab = (const LAS float*)(C.lds + ATT_SEL) + head * 257;
    const LAS unsigned* sel = (const LAS unsigned*)(C.lds + ATT_SEL) + q * 64;
#pragma unroll 1
    for (int tile = tile_lo; tile < tile_hi; ++tile) {
        const int cur = (tile - tile_lo) & 1;
        f32x16 s;
#pragma unroll
        for (int i = 0; i < 16; ++i) s[i] = 0.f;
#pragma unroll
        for (int ks = 0; ks < 8; ++ks) s = mfma32(kf[ks], qf[ks], s);
        if (tile + 1 < tile_hi) ATT_KLOAD(tile + 1);
        if (MODE == 0) {
            const unsigned wd = sel[tile] >> (4 * hh);
#pragma unroll
            for (int i = 0; i < 16; ++i) s[i] = ((wd >> ((i & 3) + 8 * (i >> 2))) & 1u) ? s[i] * SC2 : -INFINITY;
        } else {
            if (tile <= 11) { const float bb = btab[256] * L2E;
#pragma unroll
                for (int i = 0; i < 16; ++i) s[i] = s[i] * SC2 + bb;
            } else {
#pragma unroll
                for (int i = 0; i < 16; ++i) { int rel = BWIN + q - (tile * 32 + crow(i, hh)); rel = rel > 128 ? 128 : rel; s[i] = s[i] * SC2 + btab[rel + 128] * L2E; }
            }
        }
        float mx = s[0];
#pragma unroll
        for (int i = 1; i < 16; ++i) mx = fmaxf(mx, s[i]);
        mx = fmaxf(mx, __shfl_xor(mx, 32));
        const float mn = fmaxf(m, mx), alpha = __builtin_amdgcn_exp2f(m - mn);
        float rs = 0.f;
#pragma unroll
        for (int i = 0; i < 16; ++i) { s[i] = __builtin_amdgcn_exp2f(s[i] - mn); rs += s[i]; }
        rs += __shfl_xor(rs, 32);
        lsum = lsum * alpha + rs; m = mn;
#pragma unroll
        for (int d = 0; d < 4; ++d)
#pragma unroll
            for (int i = 0; i < 16; ++i) o[d][i] *= alpha;
        bf16x8 pf[2];
#pragma unroll
        for (int s2 = 0; s2 < 2; ++s2) { u32x4 pk; pk.x = pk2(s[8 * s2], s[8 * s2 + 1]); pk.y = pk2(s[8 * s2 + 2], s[8 * s2 + 3]); pk.z = pk2(s[8 * s2 + 4], s[8 * s2 + 5]); pk.w = pk2(s[8 * s2 + 6], s[8 * s2 + 7]);
            pf[s2] = __builtin_bit_cast(bf16x8, pk); }
        LAS unsigned char* vb = vbase + cur * (32 * VSTR);
#pragma unroll
        for (int d = 0; d < 4; ++d)
#pragma unroll
            for (int s2 = 0; s2 < 2; ++s2) {
                const s16x4 lo = tr_read(vb + (16 * s2) * VSTR + d * 64), hi = tr_read(vb + (16 * s2 + 8) * VSTR + d * 64);
                const bf16x8 vt = __builtin_shufflevector(lo, hi, 0, 1, 2, 3, 4, 5, 6, 7);
                o[d] = mfma32(vt, pf[s2], o[d]);
            }
        if (tile + 1 < tile_hi) { ATT_VSTORE(cur ^ 1); if (tile + 2 < tile_hi) ATT_VLOAD(tile + 2); }
        __syncthreads();
    }
#undef ATT_KLOAD
#undef ATT_VLOAD
#undef ATT_VSTORE
    const float inv = 1.0f / lsum;
    bf16* orow = Op + (size_t)q * ostride + head * 128 + 4 * hh;
#pragma unroll
    for (int d = 0; d < 4; ++d)
#pragma unroll
        for (int g = 0; g < 4; ++g) { u32x2 p; p.x = pk2(o[d][4 * g] * inv, o[d][4 * g + 1] * inv); p.y = pk2(o[d][4 * g + 2] * inv, o[d][4 * g + 3] * inv);
            *(u32x2*)(orow + 32 * d + 8 * g) = p; }
}

DI unsigned fkey(float f) { const unsigned u = __float_as_uint(f); return (u & 0x80000000u) ? ~u : (u | 0x80000000u); }
DI void dsa_unit(const Ctx& C, int l, int u) {
    int lane = C.lane; asm volatile("" : "+v"(lane));
    const int w = C.wave, r = lane & 31, hh = lane >> 5;
    const bf16* PROJ = ws_bf(C, WS_PU);
    int qrow0, NT, limit; KVSrc S; const bf16* ik0; const bf16* ik1; int iks0, ikn0;
    if (u < 256) { const int c = 31 - (u >> 3), b = u & 7; qrow0 = b * SEQ + c * 64; NT = 2 * (c + 1); limit = 64 * (c + 1);
        const bf16* base = PROJ + (size_t)(b * SEQ) * INP;
        S.k0 = base + C_AK; S.v0 = base + C_AV; S.s0 = INP; S.n0 = limit; S.k1 = S.k0; S.v1 = S.v0; S.s1 = INP;
        ik0 = base + C_IK; iks0 = INP; ikn0 = limit; ik1 = ik0;
    } else { const int b = u - 256; qrow0 = NTP + b * DSEQ; NT = (PAST + DSEQ) / 32; limit = PAST + DSEQ;
        const bf16* nb = PROJ + (size_t)qrow0 * INP;
        S.k0 = ws_bf(C, WS_CAK) + (size_t)b * PAST * 512; S.v0 = ws_bf(C, WS_CAV) + (size_t)b * PAST * 512; S.s0 = 512; S.n0 = PAST; S.k1 = nb + C_AK; S.v1 = nb + C_AV; S.s1 = INP;
        ik0 = ws_bf(C, WS_CKI) + (size_t)b * PAST * 64; iks0 = 64; ikn0 = PAST; ik1 = nb + C_IK;
    }
    float* SC = ws_f(C, WS_SC) + (size_t)C.bid * 64 * 2048;
    LAS unsigned* SEL = (LAS unsigned*)(C.lds + ATT_SEL);
#pragma unroll 1
    for (int pass = 0; pass < 2; ++pass) {
        bf16x8 af[2][4]; float wt[2][16];
#pragma unroll
        for (int np = 0; np < 2; ++np) { const int pp = pass * 2 + np;
            const bf16* ap = PROJ + (size_t)(qrow0 + 8 * w + 2 * pp + (r >> 4)) * INP + C_IQ + (r & 15) * 64 + 8 * hh;
#pragma unroll
            for (int ks = 0; ks < 4; ++ks) af[np][ks] = *(const bf16x8*)(ap + 16 * ks);
#pragma unroll
            for (int i = 0; i < 16; ++i) { const int qi = 8 * w + 2 * pp + (i >> 3), hd = (i & 3) + 8 * ((i >> 2) & 1) + 4 * hh;
                wt[np][i] = bf2f(PROJ[(size_t)(qrow0 + qi) * INP + C_IW + hd]) * (0.25f * 0.125f); } }
        bf16x8 bk[4], bn[4];
#define IDX_LOAD(dst_, tile_) do { const int key_ = (tile_) * 32 + r; const bf16* kp_ = (key_ < ikn0 ? ik0 + (size_t)key_ * iks0 : ik1 + (size_t)(key_ - ikn0) * INP) + 8 * hh; \
            _Pragma("unroll") for (int ks_ = 0; ks_ < 4; ++ks_) dst_[ks_] = *(const bf16x8*)(kp_ + 16 * ks_); } while (0)
        IDX_LOAD(bn, 0);
#pragma unroll 1
        for (int tile = 0; tile < NT; ++tile) {
#pragma unroll
            for (int ks = 0; ks < 4; ++ks) bk[ks] = bn[ks];
            if (tile + 1 < NT) IDX_LOAD(bn, tile + 1);
#pragma unroll
            for (int np = 0; np < 2; ++np) {
                f32x16 acc;
#pragma unroll
                for (int i = 0; i < 16; ++i) acc[i] = 0.f;
#pragma unroll
                for (int ks = 0; ks < 4; ++ks) acc = mfma32(af[np][ks], bk[ks], acc);
                float p0 = 0.f, p1 = 0.f;
#pragma unroll
                for (int i = 0; i < 8; ++i) { p0 += fmaxf(acc[i], 0.f) * wt[np][i]; p1 += fmaxf(acc[8 + i], 0.f) * wt[np][8 + i]; }
                const float t0 = p0 + __shfl_xor(p0, 32), t1 = p1 + __shfl_xor(p1, 32);
                const int ql = 8 * w + 2 * (pass * 2 + np) + hh;
                SC[(size_t)ql * 2048 + tile * 32 + r] = hh ? t1 : t0;
            }
        }
    }
#undef IDX_LOAD
    asm volatile("s_waitcnt vmcnt(0)" ::: "memory");
#pragma unroll 1
    for (int pp = 0; pp < 4; ++pp) {
        const int ql = 8 * w + 2 * pp + hh;
        unsigned v[64];
#pragma unroll
        for (int i = 0; i < 64; ++i) { const float f = (i < NT) ? __hip_atomic_load(SC + (size_t)ql * 2048 + i * 32 + r, __ATOMIC_RELAXED, __HIP_MEMORY_SCOPE_AGENT) : -INFINITY; v[i] = fkey(f); }
        unsigned T = 0u;
        if (limit > 256) {
#pragma unroll 1
            for (int bit = 31; bit >= 8; --bit) {
                const unsigned cand = T | (1u << bit); int c0 = 0, c1 = 0;
#pragma unroll
                for (int i = 0; i < 64; ++i) { const unsigned long long mk = __ballot(v[i] >= cand); c0 += __popc((unsigned)mk); c1 += __popc((unsigned)(mk >> 32)); }
                if ((hh ? c1 : c0) >= 256) T = cand;
            }
        }
#pragma unroll
        for (int i = 0; i < 64; ++i) { unsigned long long mk = __ballot(v[i] >= T); if (i >= NT) mk = 0ull;
            if (lane == 0) { SEL[(8 * w + 2 * pp) * 64 + i] = (unsigned)mk; SEL[(8 * w + 2 * pp + 1) * 64 + i] = (unsigned)(mk >> 32); } }
    }
    __syncthreads();
    attn_unit<0>(C, PROJ + (size_t)qrow0 * INP + C_AQ, INP, S, 0, NT, ws_bf(C, WS_MIX) + (size_t)qrow0 * DM, DM);
}

DI void band_unit(const Ctx& C, const Args& A, int l, int u) {
    const bf16* PROJ = ws_bf(C, WS_PU);
    int qrow0, tlo; KVSrc S;
    if (u < 256) { const int c = 31 - (u >> 3), b = u & 7; qrow0 = b * SEQ + c * 64; tlo = c < 8 ? (8 - c) * 2 : 0;
        const bf16* base = PROJ + ((ptrdiff_t)b * SEQ + c * 64 - BWIN) * INP;
        S.k0 = base + C_BK; S.v0 = base + C_BV; S.s0 = INP; S.n0 = BWIN + 64; S.k1 = S.k0; S.v1 = S.v0; S.s1 = INP;
    } else { const int b = u - 256; qrow0 = NTP + b * DSEQ; tlo = 0;
        const bf16* nb = PROJ + (size_t)qrow0 * INP;
        S.k0 = ws_bf(C, WS_CBK) + (size_t)b * BWIN * 512; S.v0 = ws_bf(C, WS_CBV) + (size_t)b * BWIN * 512; S.s0 = 512; S.n0 = BWIN; S.k1 = nb + C_BK; S.v1 = nb + C_BV; S.s1 = INP;
    }
    LAS float* bt = (LAS float*)(C.lds + ATT_SEL);
    const float* brel = A.in[12] + (size_t)l * 4 * 257;
    for (int i = C.tid; i < 4 * 257; i += NTHR) bt[i] = brel[i];
    __syncthreads();
    attn_unit<1>(C, PROJ + (size_t)qrow0 * INP + C_BQ, INP, S, tlo, (BWIN + 64) / 32, ws_bf(C, WS_MIX) + (size_t)qrow0 * DM + 512, DM);
}

DI void ssd_unit(const Ctx& C, const Args& A, int l, int row0, int nchunks, int h, const float* h0, float* hout) {
    int tid = C.tid, lane = C.lane; asm volatile("" : "+v"(tid), "+v"(lane));
    const int w = C.wave, r = lane & 31, hh = lane >> 5, g = h >> 2;
    LAS unsigned char* L = C.lds;
    LAS unsigned char* Cs = L + SSD_CS; LAS unsigned char* Bs = L + SSD_BS; LAS unsigned char* XD = L + SSD_XD; LAS unsigned char* XDW = L + SSD_XDW; LAS unsigned char* Ms = L + SSD_MS; LAS unsigned char* Ys = L + SSD_Y;
    LAS float* v_acs = (LAS float*)(L + SSD_VEC); LAS float* v_e = v_acs + 64;
    const bf16* XBC = ws_bf(C, WS_XBC); const bf16* PROJ = ws_bf(C, WS_PU); const float* DTS = ws_f(C, WS_DTS); float* G = ws_f(C, WS_G);
    const float a_h = -expf(A.in[16][l * 16 + h]); const float dsk = A.in[17][l * 16 + h];
    const int erow = tid >> 3, ech = tid & 7;
    f32x16 Hacc[2];
#pragma unroll
    for (int pb = 0; pb < 2; ++pb)
#pragma unroll
        for (int i = 0; i < 16; ++i) Hacc[pb][i] = 0.f;
    u32x4 pC[2], pB[2], pX, pZ; float pDt;
#define SSD_LOAD(c_) do { const int rb_ = row0 + (c_) * 64; \
        _Pragma("unroll") for (int i_ = 0; i_ < 2; ++i_) { const int ci_ = tid + 512 * i_; const bf16* src_ = XBC + (size_t)(rb_ + (ci_ >> 4)) * 2048 + g * 128 + (ci_ & 15) * 8; pB[i_] = *(const u32x4*)(src_ + 1024); pC[i_] = *(const u32x4*)(src_ + 1536); } \
        pX = *(const u32x4*)(XBC + (size_t)(rb_ + erow) * 2048 + h * 64 + ech * 8); pZ = *(const u32x4*)(PROJ + (size_t)(rb_ + erow) * INP + C_CZ + h * 64 + ech * 8); \
        pDt = DTS[(size_t)(rb_ + lane) * 16 + h]; } while (0)
    SSD_LOAD(0);
    __syncthreads();
    if (w >= 4) { const int nb = w - 4;
#pragma unroll
        for (int pb = 0; pb < 2; ++pb)
#pragma unroll
            for (int i = 0; i < 16; ++i) { const int p = 32 * pb + crow(i, hh), n = 32 * nb + r; const float v = h0 ? h0[p * 128 + n] : 0.f; Hacc[pb][i] = v;
                *(LAS bf16*)(L + SSD_HS + p * HSTR + n * 2) = f2bf(v); } }
#pragma unroll 1
    for (int c = 0; c < nchunks; ++c) {
        const int rbase = row0 + c * 64;
        LAS unsigned char* Hcur = L + SSD_HS + (c & 1) * 64 * HSTR; LAS unsigned char* Hnxt = L + SSD_HS + ((c + 1) & 1) * 64 * HSTR;
        const float dtl = pDt; float acs = dtl * a_h;
#pragma unroll
        for (int o = 1; o < 64; o <<= 1) { const float t = __shfl_up(acs, o); if (lane >= o) acs += t; }
        const float Atot = __shfl(acs, 63);
        const float wl = __expf(Atot - acs);
        if (w == 0) { v_acs[lane] = acs; v_e[lane] = __expf(acs); }
#pragma unroll
        for (int i = 0; i < 2; ++i) { const int ci = tid + 512 * i, row = ci >> 4, ch = ci & 15; *(LAS u32x4*)(Bs + row * CSTR + ch * 16) = pB[i]; *(LAS u32x4*)(Cs + row * CSTR + ch * 16) = pC[i]; }
        float xraw[8]; unpack8(pX, xraw); const u32x4 zc = pZ;
        { float xd[8], xw[8]; const float dt = __shfl(dtl, erow & 63), wv = __shfl(wl, erow & 63);
#pragma unroll
          for (int k = 0; k < 8; ++k) { xd[k] = xraw[k] * dt; xw[k] = xd[k] * wv; }
          *(LAS u32x4*)(XD + erow * XSTR + ech * 16) = pack8(xd); *(LAS u32x4*)(XDW + erow * XSTR + ech * 16) = pack8(xw); }
        if (c + 1 < nchunks) SSD_LOAD(c + 1);
        __syncthreads();
        if (w < 4) {
            const int lb = w >> 1, sb = w & 1; f32x16 acc;
#pragma unroll
            for (int i = 0; i < 16; ++i) acc[i] = 0.f;
            if (sb <= lb) {
#pragma unroll
                for (int ks = 0; ks < 8; ++ks) { const bf16x8 a = *(const LAS bf16x8*)(Cs + (32 * lb + r) * CSTR + (16 * ks + 8 * hh) * 2), b = *(const LAS bf16x8*)(Bs + (32 * sb + r) * CSTR + (16 * ks + 8 * hh) * 2);
                    acc = mfma32(a, b, acc); } }
            const int s = 32 * sb + r; const float acs_s = v_acs[s];
#pragma unroll
            for (int i = 0; i < 16; ++i) { const int lr = 32 * lb + crow(i, hh); const float v = (s <= lr) ? acc[i] * __expf(v_acs[lr] - acs_s) : 0.f; *(LAS bf16*)(Ms + lr * MSTR + s * 2) = f2bf(v); }
        } else {
            const int nb = w - 4; const float dec = __expf(Atot);
#pragma unroll
            for (int pb = 0; pb < 2; ++pb) {
#pragma unroll
                for (int i = 0; i < 16; ++i) Hacc[pb][i] *= dec;
#pragma unroll
                for (int ks = 0; ks < 4; ++ks) { const bf16x8 a = trfrag(XDW, XSTR, 16 * ks, 32 * pb, lane), b = trfrag(Bs, CSTR, 16 * ks, 32 * nb, lane); Hacc[pb] = mfma32(a, b, Hacc[pb]); }
#pragma unroll
                for (int i = 0; i < 16; ++i) *(LAS bf16*)(Hnxt + (32 * pb + crow(i, hh)) * HSTR + (32 * nb + r) * 2) = f2bf(Hacc[pb][i]);
            }
        }
        __syncthreads();
        if (w < 4) {
            const int lb = w >> 1, pb = w & 1; f32x16 yd, yo;
#pragma unroll
            for (int i = 0; i < 16; ++i) { yd[i] = 0.f; yo[i] = 0.f; }
#pragma unroll
            for (int ks = 0; ks < 4; ++ks) { const bf16x8 a = *(const LAS bf16x8*)(Ms + (32 * lb + r) * MSTR + (16 * ks + 8 * hh) * 2), b = trfrag(XD, XSTR, 16 * ks, 32 * pb, lane); yd = mfma32(a, b, yd); }
#pragma unroll
            for (int ks = 0; ks < 8; ++ks) { const bf16x8 a = *(const LAS bf16x8*)(Cs + (32 * lb + r) * CSTR + (16 * ks + 8 * hh) * 2), b = *(const LAS bf16x8*)(Hcur + (32 * pb + r) * HSTR + (16 * ks + 8 * hh) * 2); yo = mfma32(a, b, yo); }
            const int p = 32 * pb + r;
#pragma unroll
            for (int i = 0; i < 16; ++i) { const int lr = 32 * lb + crow(i, hh); *(LAS float*)(Ys + lr * YSTR + p * 4) = yd[i] + v_e[lr] * yo[i]; }
        }
        __syncthreads();
        {
            float z[8]; unpack8(zc, z);
            const f32x4 y0 = *(const LAS f32x4*)(Ys + erow * YSTR + ech * 32), y1 = *(const LAS f32x4*)(Ys + erow * YSTR + ech * 32 + 16);
            float y[8] = {y0.x, y0.y, y0.z, y0.w, y1.x, y1.y, y1.z, y1.w};
#pragma unroll
            for (int k = 0; k < 8; ++k) { const float yy = y[k] + dsk * xraw[k]; y[k] = yy * z[k] / (1.f + __expf(-z[k])); }
            float* gp = G + (size_t)(rbase + erow) * 1024 + h * 64 + ech * 8;
            ((f32x4*)gp)[0] = (f32x4){y[0], y[1], y[2], y[3]}; ((f32x4*)gp)[1] = (f32x4){y[4], y[5], y[6], y[7]};
        }
    }
#undef SSD_LOAD
    if (w >= 4) { const int nb = w - 4;
#pragma unroll
        for (int pb = 0; pb < 2; ++pb)
#pragma unroll
            for (int i = 0; i < 16; ++i) hout[(32 * pb + crow(i, hh)) * 128 + 32 * nb + r] = Hacc[pb][i]; }
}

DI void gate_norm_phase(const Ctx& C, const Args& A, int l) {
    const int gw = C.bid * NWAVES + C.wave, NGW = C.G * NWAVES; const float* gn = A.in[18] + (size_t)l * 1024;
    for (int m = gw; m < NTOK; m += NGW) { const float* grow = ws_f(C, WS_G) + (size_t)m * 1024; bf16* orow = ws_bf(C, WS_MIX) + (size_t)m * DM + 1024;
#pragma unroll
        for (int g = 0; g < 4; ++g) { const f32x4 v = ((const f32x4*)grow)[g * 64 + C.lane]; const float ss = wave_sum((v.x * v.x + v.y * v.y) + (v.z * v.z + v.w * v.w));
            const float rs = 1.0f / sqrtf(ss * (1.0f / 256.f) + EPS); const f32x4 wv = ((const f32x4*)gn)[g * 64 + C.lane]; const f32x4 o = v * rs * wv;
            u32x2 p; p.x = pk2(o.x, o.y); p.y = pk2(o.z, o.w); ((u32x2*)orow)[g * 64 + C.lane] = p; } }
}
DI void norm_phase(const Ctx& C, const float* w, bf16* outb, float* outf) {
    const int gw = C.bid * NWAVES + C.wave, NGW = C.G * NWAVES;
    for (int m = gw; m < NTOK; m += NGW) rms_row(ws_f(C, WS_X) + (size_t)m * DM, nullptr, w, outb ? outb + (size_t)m * DM : nullptr, outf ? outf + (size_t)m * DM : nullptr, C.lane);
}

#ifndef MK_ONE_LAUNCH
#define MK_ONE_LAUNCH 1
#endif
#ifndef PHASE_MASK
#define PHASE_MASK 0xFFFF
#endif
#define EN(k) (((PHASE_MASK) >> (k)) & 1)
constexpr int PH_PER_LAYER = 9, NPHASE = 1 + DEPTH * PH_PER_LAYER;
__global__ void __launch_bounds__(NTHR, 2) fwd(Args args) {
    extern __shared__ __attribute__((aligned(16))) unsigned char lds_raw[];
    Ctx C;
    C.lds = (LAS unsigned char*)lds_raw;
    C.tid = threadIdx.x; C.lane = C.tid & 63; C.wave = __builtin_amdgcn_readfirstlane(C.tid >> 6); C.G = gridDim.x; C.bid = blockIdx.x;
    C.ws = args.ws; C.out = args.out; C.ctl = (unsigned*)(args.ws + WS_CTL);
    const Args& A = args;
    for (int u = C.tid; u < (LDS_BYTES - LDSCTL_OFF) / 4; u += NTHR) ((LAS unsigned*)(C.lds + LDSCTL_OFF))[u] = 0u;
    __syncthreads();
    const int lo = args.ph_lo, hi = args.ph_hi;
    const bool multi = (hi - lo) > 1;
    XcdBarrier bar; bar.bar = C.ctl + CW_BAR; bar.x = 0; bar.st = (volatile LAS unsigned*)(C.lds + LDSCTL_OFF);
    if (multi) bar = xcd_barrier_post(C.ctl + CW_BAR, (volatile LAS unsigned*)(C.lds + LDSCTL_OFF));
#define IN(k) (lo <= (k) && (k) < hi)
#define FRESH() do { int t_ = threadIdx.x; asm volatile("" : "+v"(t_)); C.tid = t_; C.lane = t_ & 63; int w_ = __builtin_amdgcn_readfirstlane(t_ >> 6); asm volatile("" : "+s"(w_)); C.wave = w_; } while (0)
#define SEAM(k) do { if (IN((k) + 1)) xcd_barrier(bar); } while (0)

    if (EN(0) && IN(0)) { p0_prologue(C, A);
#if defined(PROBE_P02)
        __syncthreads(); p0_prologue(C, A);
#endif
        SEAM(0); }
#pragma unroll 1
    for (int l = 0; l < DEPTH; ++l) {
        const int pb = 1 + PH_PER_LAYER * l;
        if (EN(1) && IN(pb + 0)) { FRESH();
            pg8::Gemm g{ws_bf(C, WS_H), w_in_t(C, l), NTOK, INP, DM}; pg8::StaticOrder S; S.init(NTOK, INP, C.G, C.bid);
            pg8::EpiBf16<0> E{ws_bf(C, WS_PU), INP};
            pg8::gemm_phase<pg8::EpiBf16<0>, pg8::StaticOrder, true, true>(C.lds, g, S, E);
            SEAM(pb + 0);
        }
        if (EN(2) && IN(pb + 1)) { FRESH(); m0_phase(C, A, l); SEAM(pb + 1); }
        if (IN(pb + 2)) { FRESH();
            unsigned* qh = C.ctl + CW_Q + 64 * (l * 4);
            if (EN(3)) for (;;) { const int u = q_next(C, qh); if (u >= NB * 16) break;
                ssd_unit(C, A, l, (u >> 4) * SEQ, SEQ / 64, u & 15, nullptr, C.out + OFF_P_SSM + ((size_t)(l * NB + (u >> 4)) * 16 + (u & 15)) * 8192); }
            if (EN(4)) for (;;) { const int u = q_next(C, qh + 64); if (u >= 288) break; dsa_unit(C, l, u); }
            if (EN(5)) for (;;) { const int u = q_next(C, qh + 128); if (u >= 288) break; band_unit(C, A, l, u); }
            if (EN(3)) for (;;) { const int u = q_next(C, qh + 192); if (u >= DBAT * 16) break;
                ssd_unit(C, A, l, NTP + (u >> 4) * DSEQ, 1, u & 15, A.in[7] + ((size_t)(l * DBAT + (u >> 4)) * 16 + (u & 15)) * 8192, C.out + OFF_S_SSM + ((size_t)(l * DBAT + (u >> 4)) * 16 + (u & 15)) * 8192); }
#if defined(PROBE_MIX2)
            { unsigned* qh2 = C.ctl + CW_Q + 64 * (16 + l * 4);
            for (;;) { const int u = q_next(C, qh2); if (u >= NB * 16) break;
                ssd_unit(C, A, l, (u >> 4) * SEQ, SEQ / 64, u & 15, nullptr, C.out + OFF_P_SSM + ((size_t)(l * NB + (u >> 4)) * 16 + (u & 15)) * 8192); }
            for (;;) { const int u = q_next(C, qh2 + 64); if (u >= 288) break; dsa_unit(C, l, u); }
            for (;;) { const int u = q_next(C, qh2 + 128); if (u >= 288) break; band_unit(C, A, l, u); }
            for (;;) { const int u = q_next(C, qh2 + 192); if (u >= DBAT * 16) break;
                ssd_unit(C, A, l, NTP + (u >> 4) * DSEQ, 1, u & 15, A.in[7] + ((size_t)(l * DBAT + (u >> 4)) * 16 + (u & 15)) * 8192, C.out + OFF_S_SSM + ((size_t)(l * DBAT + (u >> 4)) * 16 + (u & 15)) * 8192); } }
#endif
            SEAM(pb + 2);
        }
        if (EN(6) && IN(pb + 3)) { FRESH(); gate_norm_phase(C, A, l); SEAM(pb + 3); }
        if (EN(7) && IN(pb + 4)) { FRESH();
            pg8::Gemm g{ws_bf(C, WS_MIX), w_out_t(C, l), NTOK, DM, DM}; pg8::StaticOrder S; S.init(NTOK, DM, C.G, C.bid);
            pg8::EpiResF32 E{ws_f(C, WS_X), DM};
            pg8::gemm_phase<pg8::EpiResF32, pg8::StaticOrder, true, true>(C.lds, g, S, E);
            SEAM(pb + 4);
        }
        if (EN(8) && IN(pb + 5)) { FRESH(); norm_phase(C, A.in[19] + (size_t)l * DM, ws_bf(C, WS_H), nullptr); SEAM(pb + 5); }
        if (EN(9) && IN(pb + 6)) { FRESH();
            pg8::Gemm g{ws_bf(C, WS_H), w_up_t(C, l), NTOK, DFF, DM}; pg8::StaticOrder S; S.init(NTOK, DFF, C.G, C.bid);
            pg8::EpiBf16<1> E{ws_bf(C, WS_PU), DFF};
            pg8::gemm_phase<pg8::EpiBf16<1>, pg8::StaticOrder, true, true>(C.lds, g, S, E);
#if defined(PROBE_UP2)
            __syncthreads(); pg8::gemm_phase<pg8::EpiBf16<1>, pg8::StaticOrder, true, true>(C.lds, g, S, E);
#endif
            SEAM(pb + 6);
        }
        if (EN(10) && IN(pb + 7)) { FRESH();
            pg8::Gemm g{ws_bf(C, WS_PU), w_dn_t(C, l), NTOK, DM, DFF}; pg8::StaticOrder S; S.init(NTOK, DM, C.G, C.bid);
            pg8::EpiResF32 E{ws_f(C, WS_X), DM};
            pg8::gemm_phase<pg8::EpiResF32, pg8::StaticOrder, true, true>(C.lds, g, S, E);
            SEAM(pb + 7);
        }
        if (EN(8) && IN(pb + 8)) { FRESH();
            if (l + 1 < DEPTH) norm_phase(C, A.in[9] + (size_t)(l + 1) * DM, ws_bf(C, WS_H), nullptr);
            else norm_phase(C, A.in[22], nullptr, C.out);
            SEAM(pb + 8);
        }
    }
#undef IN
#undef SEAM
}

extern "C" void kernel_launch(void* const* d_in, const int* in_sizes, int n_in, void* d_out, int out_size, void* d_ws, size_t ws_size, hipStream_t stream) {
    static int grid = 0;
    if (grid == 0) {
        if (n_in != 23 || in_sizes[0] != NTP * DM || (size_t)out_size != OUT_TOTAL || ws_size < WS_END) {
            fprintf(stderr, "kernel_launch: unexpected shapes (n_in %d, in0 %d, out %d, ws %zu; need ws >= %zu); nothing launched\n", n_in, n_in > 0 ? in_sizes[0] : -1, out_size, ws_size, (size_t)WS_END); grid = -1; return; }
        int dev = 0, cus = 0, per_cu = 0;
        if (hipGetDevice(&dev) != hipSuccess || hipDeviceGetAttribute(&cus, hipDeviceAttributeMultiprocessorCount, dev) != hipSuccess) { fprintf(stderr, "kernel_launch: device query failed\n"); grid = -1; return; }
        if (hipFuncSetAttribute((const void*)fwd, hipFuncAttributeMaxDynamicSharedMemorySize, LDS_BYTES) != hipSuccess) { fprintf(stderr, "kernel_launch: hipFuncSetAttribute failed\n"); grid = -1; return; }
        if (hipOccupancyMaxActiveBlocksPerMultiprocessor(&per_cu, (const void*)fwd, NTHR, LDS_BYTES) != hipSuccess || per_cu < 1)
            fprintf(stderr, "kernel_launch: note: occupancy query reports %d workgroups per CU\n", per_cu);
        (void)hipGetLastError();
        grid = cus < 256 ? cus : 256;
    }
    if (grid < 0) return;
    if (hipMemsetAsync((char*)d_ws + WS_CTL, 0, CTL_ZERO_BYTES, stream) != hipSuccess) { fprintf(stderr, "kernel_launch: memset failed\n"); return; }
    Args a{};
    for (int i = 0; i < 23; ++i) a.in[i] = (const float*)d_in[i];
    a.out = (float*)d_out; a.ws = (unsigned char*)d_ws;
#if MK_ONE_LAUNCH
    a.ph_lo = 0; a.ph_hi = NPHASE;
    hipLaunchKernelGGL(fwd, dim3(grid), dim3(NTHR), LDS_BYTES, stream, a);
#else
    for (int p = 0; p < NPHASE; ++p) { a.ph_lo = p; a.ph_hi = p + 1; hipLaunchKernelGGL(fwd, dim3(grid), dim3(NTHR), LDS_BYTES, stream, a); }
#endif
    const hipError_t le = hipPeekAtLastError();
    if (le != hipSuccess) fprintf(stderr, "kernel_launch: launch failed: %s\n", hipGetErrorName(le));
}
```

```cpp
#include <hip/hip_runtime.h>
#include <cstdio>
#include <cstdint>
#include <cstddef>
namespace pg8 {
#define PG8_LAS __attribute__((address_space(3)))
typedef unsigned short bf16_t;
typedef short bf16x8 __attribute__((ext_vector_type(8)));
typedef float f32x4 __attribute__((ext_vector_type(4)));
typedef unsigned u32x4 __attribute__((ext_vector_type(4)));
constexpr int BM = 256, BK = 64, HALF = 128, HTB = HALF * BK * 2  , STAGE_BYTES = 8 * HTB, NXCD = 8, WGM = 8;

__host__ __device__ __forceinline__ int lds_byte(int r, int c) { const int st = (r >> 4) * 2 + (c >> 5), rr = r & 15, cc = c & 31, ob = rr * 64 + cc * 2; return st * 1024 + (ob ^ (((ob >> 9) & 1) << 5)); }
__host__ __device__ __forceinline__ void stage_rc(int b, int& R, int& C) { const int st = b / 1024, sb = b % 1024, swz = sb ^ (((sb >> 9) & 1) << 5); R = (st >> 1) * 16 + swz / 64; C = (st & 1) * 32 + (swz % 64) / 2; }
__host__ __device__ __forceinline__ int perm32(int rho) { const int n = rho >> 4, i = rho & 15; return 8 * (i >> 2) + 4 * n + (i & 3); }

struct Unit { int pm, pn; };
struct Gemm { const bf16_t* A; const bf16_t* Bt; int M, N, K; };

struct StaticOrder {
    int nM, nN, nwg, G, c;
    __host__ __device__ void init(int M, int N, int G_, int c_) { nM = M / BM; nN = N / BM; nwg = nM * nN; G = G_; c = c_; }
    __host__ __device__ bool next(int i, Unit& u) const {
        const long L = (long)i * G + c; if (L >= nwg) return false;
        int wgid = (int)L; { const int q = nwg / NXCD, r = nwg % NXCD, xcd = wgid % NXCD, off = wgid / NXCD; wgid = (xcd < r ? xcd * (q + 1) : r * (q + 1) + (xcd - r) * q) + off; }
        const int nig = WGM * nN, gid = wgid / nig, fm = gid * WGM, gsz = (nM - fm) < WGM ? (nM - fm) : WGM;
        u.pm = fm + ((wgid % nig) % gsz); u.pn = (wgid % nig) / gsz; return true;
    }
    __device__ __forceinline__ void a_ready(const Unit&) const {}
    __device__ __forceinline__ void done(const Unit&) const {}
};

typedef float f32x2_t __attribute__((ext_vector_type(2)));
typedef __bf16 bf16x2_t __attribute__((ext_vector_type(2)));
__device__ __forceinline__ unsigned cvt_pk_bf16(float lo, float hi) { f32x2_t v = {lo, hi}; bf16x2_t b = __builtin_convertvector(v, bf16x2_t); return __builtin_bit_cast(unsigned, b); }

template <int ACT  > struct EpiBf16 {
    static constexpr bool PERM = true, AFTER_DRAIN = false;
    bf16_t* O; int ldc;
    __device__ __forceinline__ void operator()(const f32x4 (&acc)[2][2][4][2], const Unit& u, int wr, int wc, int fr, int fq) const {
        const int row0 = u.pm * BM + wr * 64 + fr; const int col0 = u.pn * BM + wc * 32 + 8 * fq;
#pragma unroll
        for (int ai = 0; ai < 2; ++ai)
#pragma unroll
            for (int m = 0; m < 4; ++m) { bf16_t* rowp = O + (size_t)(row0 + ai * HALF + m * 16) * ldc + col0;
#pragma unroll
                for (int bj = 0; bj < 2; ++bj) { f32x4 v0 = acc[ai][bj][m][0], v1 = acc[ai][bj][m][1];
                    if (ACT == 1) {
#pragma unroll
                        for (int j = 0; j < 4; ++j) { const float a = v0[j] > 0.f ? v0[j] : 0.f, b = v1[j] > 0.f ? v1[j] : 0.f; v0[j] = a * a; v1[j] = b * b; } }
                    u32x4 w; w.x = cvt_pk_bf16(v0[0], v0[1]); w.y = cvt_pk_bf16(v0[2], v0[3]); w.z = cvt_pk_bf16(v1[0], v1[1]); w.w = cvt_pk_bf16(v1[2], v1[3]);
                    *(u32x4*)(rowp + bj * HALF) = w; } }
    }
};
struct EpiResF32 {
    static constexpr bool PERM = false, AFTER_DRAIN = false;
    float* X; int ldc;
    __device__ __forceinline__ void operator()(const f32x4 (&acc)[2][2][4][2], const Unit& u, int wr, int wc, int fr, int fq) const {
        const int row0 = u.pm * BM + wr * 64 + fr, col0 = u.pn * BM + wc * 32 + 4 * fq;
#pragma unroll
        for (int ai = 0; ai < 2; ++ai)
#pragma unroll
            for (int m = 0; m < 4; ++m) { float* rowp = X + (size_t)(row0 + ai * HALF + m * 16) * ldc + col0;
                f32x4 b[2][2];
#pragma unroll
                for (int bj = 0; bj < 2; ++bj)
#pragma unroll
                    for (int n = 0; n < 2; ++n) b[bj][n] = *(const f32x4*)(rowp + bj * HALF + n * 16);
#pragma unroll
                for (int bj = 0; bj < 2; ++bj)
#pragma unroll
                    for (int n = 0; n < 2; ++n) *(f32x4*)(rowp + bj * HALF + n * 16) = b[bj][n] + acc[ai][bj][m][n];
                asm volatile("" ::: "memory"); }
    }
};
template <class Epi, class Sched, bool ALIGN_EPI = false, bool SP2 = false>
__device__ __forceinline__ void gemm_phase(PG8_LAS unsigned char* lds, const Gemm g, const Sched& S, const Epi& E) {
    int tid_ = threadIdx.x; asm volatile("" : "+v"(tid_));
    const int tid = tid_, wid = __builtin_amdgcn_readfirstlane(tid >> 6), lane = tid & 63, wr = wid >> 2, wc = wid & 3, fr = lane & 15, fq = lane >> 4;
    const int K = g.K, nt = K / BK;
    unsigned voffA[2], voffB[2];
#pragma unroll
    for (int i = 0; i < 2; ++i) { int R, C; stage_rc(tid * 16 + i * 8192, R, C); const int Rb = Epi::PERM ? ((R & ~31) + perm32(R & 31)) : R;
        voffA[i] = (unsigned)(R * K + C) * 2u; voffB[i] = (unsigned)(Rb * K + C) * 2u; }
    const size_t kstep = (size_t)(BK * 2);
    const size_t hstep = (size_t)HALF * K * 2;
    const size_t tstep = 2 * hstep;
    const unsigned ldsw = (unsigned)wid * 1024u;
    const int aoff = lds_byte(wr * 64 + fr, fq * 8), boff = lds_byte(wc * 32 + fr, fq * 8);
#define PG8_SA(b, h) (((b) * 2 + (h)) * HTB)
#define PG8_SB(b, h) ((4 + (b) * 2 + (h)) * HTB)
#define PG8_STAGE(bufoff, gbase, voff) do { _Pragma("unroll") for (int _i = 0; _i < 2; ++_i) \
        __builtin_amdgcn_global_load_lds((const unsigned*)((const char*)(gbase) + (voff)[_i]), (PG8_LAS unsigned*)(lds + (bufoff) + ldsw + _i * 8192), 16, 0, 0); } while (0)
#define PG8_LDA(dst, b, h) do { _Pragma("unroll") for (int m = 0; m < 4; ++m) _Pragma("unroll") for (int k = 0; k < 2; ++k) dst[m][k] = *(const PG8_LAS bf16x8*)(lds + PG8_SA(b, h) + aoff + m * 2048 + k * 1024); } while (0)
#define PG8_LDB(dst, b, h) do { _Pragma("unroll") for (int n = 0; n < 2; ++n) _Pragma("unroll") for (int k = 0; k < 2; ++k) dst[n][k] = *(const PG8_LAS bf16x8*)(lds + PG8_SB(b, h) + boff + n * 2048 + k * 1024); } while (0)
#define PG8_MMA(ai, bj, At, Bt) do { __builtin_amdgcn_s_setprio(1); _Pragma("unroll") for (int m = 0; m < 4; ++m) _Pragma("unroll") for (int n = 0; n < 2; ++n) _Pragma("unroll") for (int k = 0; k < 2; ++k) \
        acc[ai][bj][m][n] = __builtin_amdgcn_mfma_f32_16x16x32_bf16(Bt[n][k], At[m][k], acc[ai][bj][m][n], 0, 0, 0); __builtin_amdgcn_s_setprio(0); } while (0)
#define PG8_WAIT_V(n) asm volatile("s_waitcnt vmcnt(" #n ")" ::: "memory")
#define PG8_WAIT_L(n) asm volatile("s_waitcnt lgkmcnt(" #n ")" ::: "memory")
#define PG8_BAR __builtin_amdgcn_s_barrier()
#define PG8_SCHED __builtin_amdgcn_sched_barrier(0)
    Unit cur, nxt; int ui = 0;
    if (!S.next(0, cur)) return;
    f32x4 acc[2][2][4][2];
#pragma unroll
    for (int a = 0; a < 2; ++a)
#pragma unroll
        for (int b = 0; b < 2; ++b)
#pragma unroll
            for (int m = 0; m < 4; ++m)
#pragma unroll
                for (int n = 0; n < 2; ++n) acc[a][b][m][n] = (f32x4){0.f, 0.f, 0.f, 0.f};
    bf16x8 At[4][2], B0[2][2], B1[2][2];
    const char* cA = (const char*)g.A + (size_t)cur.pm * tstep; const char* cB = (const char*)g.Bt + (size_t)cur.pn * tstep;
    S.a_ready(cur);
    if constexpr (SP2) {
        PG8_STAGE(PG8_SB(0, 0), cB, voffB); PG8_STAGE(PG8_SB(0, 1), cB + hstep, voffB); PG8_STAGE(PG8_SA(0, 0), cA, voffA); PG8_STAGE(PG8_SA(0, 1), cA + hstep, voffA);
        if (wr == 1) PG8_BAR;
        PG8_WAIT_V(2); PG8_BAR;
        PG8_STAGE(PG8_SB(1, 0), cB + kstep, voffB); PG8_STAGE(PG8_SA(1, 0), cA + kstep, voffA); PG8_STAGE(PG8_SB(1, 1), cB + hstep + kstep, voffB);
        PG8_WAIT_V(6); PG8_BAR;
    } else {
        PG8_STAGE(PG8_SB(0, 0), cB, voffB); PG8_STAGE(PG8_SA(0, 0), cA, voffA); PG8_STAGE(PG8_SB(0, 1), cB + hstep, voffB); PG8_STAGE(PG8_SA(0, 1), cA + hstep, voffA);
        if (wr == 1) PG8_BAR;
        PG8_WAIT_V(4); PG8_BAR;
        PG8_STAGE(PG8_SB(1, 0), cB + kstep, voffB); PG8_STAGE(PG8_SA(1, 0), cA + kstep, voffA); PG8_STAGE(PG8_SB(1, 1), cB + hstep + kstep, voffB);
        PG8_WAIT_V(6); PG8_BAR;
    }
    for (;;) {
        const bool has_next = S.next(ui + 1, nxt);
        const char* nA = has_next ? (const char*)g.A + (size_t)nxt.pm * tstep : cA; const char* nB = has_next ? (const char*)g.Bt + (size_t)nxt.pn * tstep : cB;
        for (int t = 0; t < nt; t += 2) {
            const bool last = (t == nt - 2);
            const char* a1 = cA + (size_t)(t + 1) * kstep;
            const char* a2 = last ? nA : cA + (size_t)(t + 2) * kstep; const char* b2 = last ? nB : cB + (size_t)(t + 2) * kstep;
            const char* a3 = a2 + kstep; const char* b3 = b2 + kstep;
            if (last && has_next) S.a_ready(nxt);
            if constexpr (SP2) {
            PG8_LDB(B0, 0, 0); PG8_LDB(B1, 0, 1); PG8_SCHED; PG8_LDA(At, 0, 0); PG8_STAGE(PG8_SA(1, 1), a1 + hstep, voffA);
            PG8_WAIT_V(8); PG8_WAIT_L(0); PG8_BAR; PG8_MMA(0, 0, At, B0); PG8_MMA(0, 1, At, B1); PG8_BAR; PG8_SCHED;
            PG8_LDA(At, 0, 1); PG8_STAGE(PG8_SB(0, 0), b2, voffB); PG8_STAGE(PG8_SB(0, 1), b2 + hstep, voffB); PG8_STAGE(PG8_SA(0, 0), a2, voffA);
            PG8_WAIT_V(8); PG8_WAIT_L(0); PG8_BAR; PG8_MMA(1, 0, At, B0); PG8_MMA(1, 1, At, B1); PG8_BAR; PG8_SCHED;
            PG8_LDB(B0, 1, 0); PG8_LDB(B1, 1, 1); PG8_SCHED; PG8_LDA(At, 1, 0); PG8_STAGE(PG8_SA(0, 1), a2 + hstep, voffA);
            PG8_WAIT_V(8); PG8_WAIT_L(0); PG8_BAR; PG8_MMA(0, 0, At, B0); PG8_MMA(0, 1, At, B1); PG8_BAR; PG8_SCHED;
            PG8_LDA(At, 1, 1); PG8_STAGE(PG8_SB(1, 0), b3, voffB); PG8_STAGE(PG8_SB(1, 1), b3 + hstep, voffB); PG8_STAGE(PG8_SA(1, 0), a3, voffA);
            PG8_WAIT_V(8); PG8_WAIT_L(0); PG8_BAR; PG8_MMA(1, 0, At, B0); PG8_MMA(1, 1, At, B1); PG8_BAR; PG8_SCHED;
            } else {
            PG8_LDB(B0, 0, 0); PG8_SCHED; PG8_LDA(At, 0, 0); PG8_STAGE(PG8_SA(1, 1), a1 + hstep, voffA);
            PG8_WAIT_L(8); PG8_BAR; PG8_WAIT_L(0); PG8_MMA(0, 0, At, B0); PG8_BAR; PG8_SCHED;
            PG8_LDB(B1, 0, 1); PG8_STAGE(PG8_SB(0, 0), b2, voffB);
            PG8_BAR; PG8_WAIT_L(0); PG8_MMA(0, 1, At, B1); PG8_BAR;
            PG8_LDA(At, 0, 1); PG8_STAGE(PG8_SA(0, 0), a2, voffA);
            PG8_BAR; PG8_WAIT_L(0); PG8_MMA(1, 0, At, B0); PG8_BAR; PG8_SCHED;
            PG8_STAGE(PG8_SB(0, 1), b2 + hstep, voffB);
            PG8_WAIT_V(6); PG8_BAR; PG8_MMA(1, 1, At, B1); PG8_BAR;
            PG8_LDB(B0, 1, 0); PG8_SCHED; PG8_LDA(At, 1, 0); PG8_STAGE(PG8_SA(0, 1), a2 + hstep, voffA);
            PG8_WAIT_L(8); PG8_BAR; PG8_WAIT_L(0); PG8_MMA(0, 0, At, B0); PG8_BAR; PG8_SCHED;
            PG8_LDB(B1, 1, 1); PG8_STAGE(PG8_SB(1, 0), b3, voffB);
            PG8_BAR; PG8_WAIT_L(0); PG8_MMA(0, 1, At, B1); PG8_BAR;
            PG8_LDA(At, 1, 1); PG8_STAGE(PG8_SA(1, 0), a3, voffA);
            PG8_BAR; PG8_WAIT_L(0); PG8_MMA(1, 0, At, B0); PG8_BAR; PG8_SCHED;
            PG8_STAGE(PG8_SB(1, 1), b3 + hstep, voffB);
            PG8_WAIT_V(6); PG8_BAR; PG8_MMA(1, 1, At, B1); PG8_BAR;
            }
        }
        if constexpr (ALIGN_EPI) { if (wr == 0) PG8_BAR; }
        if constexpr (!Epi::AFTER_DRAIN) { E(acc, cur, wr, wc, fr, fq); S.done(cur); }
        if (!has_next) break;
#pragma unroll
        for (int a = 0; a < 2; ++a)
#pragma unroll
            for (int b = 0; b < 2; ++b)
#pragma unroll
                for (int m = 0; m < 4; ++m)
#pragma unroll
                    for (int n = 0; n < 2; ++n) acc[a][b][m][n] = (f32x4){0.f, 0.f, 0.f, 0.f};
        cur = nxt; cA = nA; cB = nB; ++ui;
        if constexpr (ALIGN_EPI) { if (wr == 1) PG8_BAR; }
    }
    PG8_WAIT_V(0);
    if constexpr (!ALIGN_EPI) { if (wr == 0) PG8_BAR; }
    PG8_BAR;
    if constexpr (Epi::AFTER_DRAIN) { E.fused(acc, cur, wr, wc, fr, fq, lds, wid, lane); S.done(cur); }
#undef PG8_SA
#undef PG8_SB
#undef PG8_STAGE
#undef PG8_LDA
#undef PG8_LDB
#undef PG8_MMA
#undef PG8_WAIT_V
#undef PG8_WAIT_L
#undef PG8_BAR
#undef PG8_SCHED
}
}

#define DI __device__ __forceinline__
#define LAS __attribute__((address_space(3)))
typedef unsigned short bf16;
typedef short bf16x8 __attribute__((ext_vector_type(8)));
typedef short s16x4 __attribute__((ext_vector_type(4)));
typedef short v4i16_t __attribute__((ext_vector_type(4)));
typedef float f32x4 __attribute__((ext_vector_type(4)));
typedef float f32x16 __attribute__((ext_vector_type(16)));
typedef unsigned u32x4 __attribute__((ext_vector_type(4)));
typedef unsigned u32x2 __attribute__((ext_vector_type(2)));

constexpr int DM = 2048, NB = 8, SEQ = 2048, DEPTH = 4, DBAT = 32, DSEQ = 64, PAST = 1024, BWIN = 512;
constexpr int NTP = NB * SEQ, NTS = DBAT * DSEQ, NTOK = NTP + NTS;
constexpr int INC = 7264, INP = 7424, DFF = 8192;
constexpr int C_AQ = 0, C_AK = 512, C_AV = 1024, C_IQ = 1536, C_IK = 2560, C_IW = 2624, C_BQ = 2640, C_BK = 3152, C_BV = 3664, C_CZ = 4176, C_XBC = 5200, C_DT = 7248;
constexpr float EPS = 1e-5f;
constexpr int NWAVES = 8, NTHR = 512;

constexpr size_t SZ_YP = (size_t)NTP * DM, SZ_YS = (size_t)NTS * DM;
constexpr size_t SZ_PAK = (size_t)DEPTH * NB * SEQ * 512, SZ_PKI = (size_t)DEPTH * NB * SEQ * 64, SZ_PBK = (size_t)DEPTH * NB * BWIN * 512;
constexpr size_t SZ_PSSM = (size_t)DEPTH * NB * 16 * 64 * 128, SZ_PCONV = (size_t)DEPTH * NB * 3 * 2048;
constexpr size_t SZ_SAK = (size_t)DEPTH * DBAT * DSEQ * 512, SZ_SKI = (size_t)DEPTH * DBAT * DSEQ * 64, SZ_SBK = SZ_SAK;
constexpr size_t SZ_SSSM = (size_t)DEPTH * DBAT * 16 * 64 * 128, SZ_SCONV = (size_t)DEPTH * DBAT * 3 * 2048;
constexpr size_t OFF_YP = 0, OFF_YS = OFF_YP + SZ_YP, OFF_P_AK = OFF_YS + SZ_YS, OFF_P_AV = OFF_P_AK + SZ_PAK, OFF_P_KI = OFF_P_AV + SZ_PAK,
                 OFF_P_BK = OFF_P_KI + SZ_PKI, OFF_P_BV = OFF_P_BK + SZ_PBK, OFF_P_SSM = OFF_P_BV + SZ_PBK, OFF_P_CONV = OFF_P_SSM + SZ_PSSM,
                 OFF_S_AK = OFF_P_CONV + SZ_PCONV, OFF_S_AV = OFF_S_AK + SZ_SAK, OFF_S_KI = OFF_S_AV + SZ_SAK, OFF_S_BK = OFF_S_KI + SZ_SKI,
                 OFF_S_BV = OFF_S_BK + SZ_SBK, OFF_S_SSM = OFF_S_BV + SZ_SBK, OFF_S_CONV = OFF_S_SSM + SZ_SSSM, OUT_TOTAL = OFF_S_CONV + SZ_SCONV;
static_assert(OUT_TOTAL == 165085184, "output size");

constexpr size_t MiB = 1u << 20;
constexpr size_t WS_CTL = 0, CTL_ZERO_BYTES = 1 * MiB;
constexpr size_t WS_ROPE = 1 * MiB;
constexpr size_t WS_W = 2 * MiB;
constexpr size_t W_IN_B = (size_t)INP * DM * 2, W_OUT_B = (size_t)DM * DM * 2, W_UP_B = (size_t)DFF * DM * 2, W_DN_B = (size_t)DM * DFF * 2, W_LAYER_B = W_IN_B + W_OUT_B + W_UP_B + W_DN_B;
static_assert(W_LAYER_B == 101 * MiB, "weights per layer");
constexpr size_t WS_X = WS_W + DEPTH * W_LAYER_B;
constexpr size_t WS_H = WS_X + (size_t)NTOK * DM * 4;
constexpr size_t WS_MIX = WS_H + (size_t)NTOK * DM * 2;
constexpr size_t WS_PU = WS_MIX + (size_t)NTOK * DM * 2;
constexpr size_t WS_XBC = WS_PU + (size_t)NTOK * DFF * 2;
constexpr size_t WS_G = WS_XBC + (size_t)NTOK * 2048 * 2;
constexpr size_t WS_DTS = WS_G + (size_t)NTOK * 1024 * 4;
constexpr size_t WS_CAK = WS_DTS + 2 * MiB;
constexpr size_t WS_CAV = WS_CAK + (size_t)DBAT * PAST * 512 * 2;
constexpr size_t WS_CBK = WS_CAV + (size_t)DBAT * PAST * 512 * 2;
constexpr size_t WS_CBV = WS_CBK + (size_t)DBAT * BWIN * 512 * 2;
constexpr size_t WS_CKI = WS_CBV + (size_t)DBAT * BWIN * 512 * 2;
constexpr size_t WS_SC = WS_CKI + (size_t)DBAT * PAST * 64 * 2;
constexpr size_t WS_END = WS_SC + (size_t)256 * 64 * 2048 * 4;
static_assert(WS_END == 1356 * MiB, "ws map");
constexpr int CW_BAR = 4096;
constexpr int CW_Q = 16384;

constexpr int RING_BYTES = 131072, LDSCTL_OFF = RING_BYTES, LDS_BYTES = 147456;
constexpr int ATT_SEL = 0;
constexpr int ATT_V = 16384, VSTR = 1088, ATT_END = ATT_V + 2 * 32 * VSTR;
constexpr int CSTR = 272, XSTR = 144, MSTR = 144, HSTR = 272;
constexpr int SSD_CS = 0, SSD_BS = SSD_CS + 64 * CSTR, SSD_XD = SSD_BS + 64 * CSTR, SSD_XDW = SSD_XD + 64 * XSTR, SSD_MS = SSD_XDW + 64 * XSTR,
              SSD_HS = SSD_MS + 64 * MSTR, SSD_VEC = SSD_HS + 2 * 64 * HSTR, SSD_Y = SSD_VEC + 1024, YSTR = 272, SSD_END = SSD_Y + 64 * YSTR;
static_assert(ATT_END <= RING_BYTES && SSD_END <= RING_BYTES, "phase scratch fits the ring region");

DI float bf2f(bf16 v) { return __uint_as_float(((unsigned)v) << 16); }
DI unsigned pk2(float lo, float hi) { return pg8::cvt_pk_bf16(lo, hi); }
DI bf16 f2bf(float f) { return (bf16)(pk2(f, 0.f) & 0xffffu); }
DI float wave_sum(float v) {
#pragma unroll
    for (int o = 1; o < 64; o <<= 1) v += __shfl_xor(v, o);
    return v;
}
DI f32x16 mfma32(bf16x8 a, bf16x8 b, f32x16 c) { return __builtin_amdgcn_mfma_f32_32x32x16_bf16(a, b, c, 0, 0, 0); }
DI int crow(int i, int hh) { return (i & 3) + 8 * (i >> 2) + 4 * hh; }
DI s16x4 tr_read(LAS unsigned char* p) { return __builtin_bit_cast(s16x4, __builtin_amdgcn_ds_read_tr16_b64_v4i16((LAS v4i16_t*)p)); }
DI bf16x8 trfrag(LAS unsigned char* tile, int stride, int k0, int c0, int lane) {
    const int i16 = lane & 15, qq = i16 >> 2, p = i16 & 3, g2 = (lane >> 4) & 1, hh = lane >> 5;
    LAS unsigned char* a = tile + (k0 + 8 * hh + qq) * stride + (c0 + 16 * g2 + 4 * p) * 2;
    const s16x4 lo = tr_read(a), hi = tr_read(a + 4 * stride);
    return __builtin_shufflevector(lo, hi, 0, 1, 2, 3, 4, 5, 6, 7);
}
DI void unpack8(u32x4 v, float (&f)[8]) {
#pragma unroll
    for (int i = 0; i < 4; ++i) { f[2 * i] = __uint_as_float(v[i] << 16); f[2 * i + 1] = __uint_as_float(v[i] & 0xffff0000u); }
}
DI u32x4 pack8(const float (&f)[8]) { u32x4 o; o.x = pk2(f[0], f[1]); o.y = pk2(f[2], f[3]); o.z = pk2(f[4], f[5]); o.w = pk2(f[6], f[7]); return o; }

#define XB_TMO      128
#define XB_XCNT(j)  (256  + 64 * (j))
#define XB_XSUB(j)  (1280 + 64 * (j))
#define XB_XGEN(j)  (2304 + 64 * (j))
#define XB_TOP      3328
#define XB_TOPGEN   3392
#define XCD_BAR_WORDS 3456
#define XB_SPIN_CAP (1u << 20)
DI unsigned xb_ld(unsigned* p)              { return __hip_atomic_load(p, __ATOMIC_RELAXED, __HIP_MEMORY_SCOPE_AGENT); }
DI unsigned xb_add(unsigned* p, unsigned v) { return __hip_atomic_fetch_add(p, v, __ATOMIC_RELAXED, __HIP_MEMORY_SCOPE_AGENT); }
DI unsigned xb_xcc_id() { return (unsigned)__builtin_amdgcn_s_getreg((3 << 11) | 20) & 0xFu; }
#define XB_SPIN(cond, bar) do { unsigned _sp = 0; while (cond) { __builtin_amdgcn_s_sleep(1); \
    if ((++_sp & 255u) == 0u) { if (xb_ld(&(bar)[XB_TMO])) break; if (_sp > XB_SPIN_CAP) { atomicAdd(&(bar)[XB_TMO], 1u); break; } } } } while (0)
struct XcdBarrier { unsigned* bar; unsigned x; volatile LAS unsigned* st; };
DI XcdBarrier xcd_barrier_post(unsigned* bar, volatile LAS unsigned* st) {
    XcdBarrier b; b.bar = bar; b.x = xb_xcc_id(); b.st = st;
    if (threadIdx.x == 0) (void)xb_add(&bar[XB_XCNT(b.x)], 1u);
    return b;
}
DI void xcd_barrier_complete(unsigned* bar, unsigned x, unsigned& nloc, unsigned& nx) {
    const unsigned G = gridDim.x * gridDim.y * gridDim.z;
    unsigned sum, cnt, mine, sp = 0u;
    for (;;) {
        sum = 0u; cnt = 0u; mine = 0u;
#pragma unroll
        for (unsigned j = 0; j < 16; ++j) { const unsigned c = xb_ld(&bar[XB_XCNT(j)]); sum += c; cnt += (c > 0u) ? 1u : 0u; mine = (j == x) ? c : mine; }
        if (sum == G) break;
        __builtin_amdgcn_s_sleep(1);
        if ((++sp & 255u) == 0u) { if (xb_ld(&bar[XB_TMO])) break; if (sp > XB_SPIN_CAP) { atomicAdd(&bar[XB_TMO], 1u); break; } }
    }
    nloc = mine > 0u ? mine : 1u; nx = cnt > 0u ? cnt : 1u;
}
DI void xcd_barrier(const XcdBarrier& b) {
    asm volatile("s_waitcnt vmcnt(0)" ::: "memory");
    __syncthreads();
    if (threadIdx.x == 0) {
        unsigned* bar = b.bar;
        __builtin_amdgcn_s_waitcnt(0);
        unsigned nloc = b.st[0], nx = b.st[1];
        if (nloc == 0u) { xcd_barrier_complete(bar, b.x, nloc, nx); b.st[0] = nloc; b.st[1] = nx; }
        const unsigned old = xb_add(&bar[XB_XSUB(b.x)], 1u);
        const unsigned gen = old / nloc;
        if (old + 1u == (gen + 1u) * nloc) {
            __builtin_amdgcn_fence(__ATOMIC_RELEASE, "agent");
            asm volatile("s_waitcnt vmcnt(0)" ::: "memory");
            const unsigned og = xb_add(&bar[XB_TOP], 1u);
            const unsigned tg = og / nx;
            if (og + 1u == (tg + 1u) * nx) xb_add(&bar[XB_TOPGEN], 1u);
            else XB_SPIN(xb_ld(&bar[XB_TOPGEN]) == tg, bar);
            __builtin_amdgcn_fence(__ATOMIC_ACQUIRE, "agent");
            xb_add(&bar[XB_XGEN(b.x)], 1u);
            asm volatile("s_waitcnt vmcnt(0)" ::: "memory");
        } else {
            XB_SPIN(xb_ld(&bar[XB_XGEN(b.x)]) == gen, bar);
            __builtin_amdgcn_fence(__ATOMIC_ACQUIRE, "agent");
            asm volatile("s_waitcnt vmcnt(0)" ::: "memory");
        }
    }
    __syncthreads();
}

struct Args { const float* in[23]; float* out; unsigned char* ws; int ph_lo, ph_hi; };
static_assert(sizeof(Args) == 23 * 8 + 8 + 8 + 8, "Args has no padding");
struct Ctx {
    LAS unsigned char* lds;
    unsigned* ctl;
    int tid, lane, wave, G, bid;
    float* out;
    unsigned char* ws;
};
DI bf16* ws_bf(const Ctx& C, size_t off) { return (bf16*)(C.ws + off); }
DI float* ws_f(const Ctx& C, size_t off) { return (float*)(C.ws + off); }
DI bf16* w_in_t(const Ctx& C, int l)  { return (bf16*)(C.ws + WS_W + (size_t)l * W_LAYER_B); }
DI bf16* w_out_t(const Ctx& C, int l) { return (bf16*)(C.ws + WS_W + (size_t)l * W_LAYER_B + W_IN_B); }
DI bf16* w_up_t(const Ctx& C, int l)  { return (bf16*)(C.ws + WS_W + (size_t)l * W_LAYER_B + W_IN_B + W_OUT_B); }
DI bf16* w_dn_t(const Ctx& C, int l)  { return (bf16*)(C.ws + WS_W + (size_t)l * W_LAYER_B + W_IN_B + W_OUT_B + W_UP_B); }

DI int q_next(const Ctx& C, unsigned* head) {
    volatile LAS int* slot = (volatile LAS int*)(C.lds + LDSCTL_OFF + 64);
    __syncthreads();
    if (C.tid == 0) *slot = (int)__hip_atomic_fetch_add(head, 1u, __ATOMIC_RELAXED, __HIP_MEMORY_SCOPE_AGENT);
    __syncthreads();
    return *slot;
}

DI void p0_transpose_item(const float* W, int K, int N, bf16* WT, LAS float* scr, int item, int lane) {
    const int nblk = N / 32, kb = item / nblk, nb = item % nblk, k0 = 64 * kb, n0 = 32 * nb;
#pragma unroll 8
    for (int i = 0; i < 32; ++i) { const int kk = 2 * i + (lane >> 5); scr[kk * 33 + (lane & 31)] = W[(size_t)(k0 + kk) * N + n0 + (lane & 31)]; }
    asm volatile("s_waitcnt lgkmcnt(0)" ::: "memory");
    const int c = lane & 7;
#pragma unroll
    for (int j = 0; j < 4; ++j) { const int n = (lane >> 3) + 8 * j; const LAS float* s = scr + (8 * c) * 33 + n;
        u32x4 o; o.x = pk2(s[0 * 33], s[1 * 33]); o.y = pk2(s[2 * 33], s[3 * 33]); o.z = pk2(s[4 * 33], s[5 * 33]); o.w = pk2(s[6 * 33], s[7 * 33]);
        *(u32x4*)(WT + (size_t)(n0 + n) * K + k0 + 8 * c) = o; }
    asm volatile("s_waitcnt lgkmcnt(0)" ::: "memory");
}
DI void rms_row(const float* src, float* xcopy, const float* w, bf16* outb, float* outf, int lane) {
    f32x4 v[8]; float ss = 0.f;
#pragma unroll
    for (int j = 0; j < 8; ++j) { v[j] = ((const f32x4*)src)[lane + 64 * j]; ss += (v[j].x * v[j].x + v[j].y * v[j].y) + (v[j].z * v[j].z + v[j].w * v[j].w); }
    if (xcopy) {
#pragma unroll
        for (int j = 0; j < 8; ++j) ((f32x4*)xcopy)[lane + 64 * j] = v[j];
    }
    ss = wave_sum(ss);
    const float rs = 1.0f / sqrtf(ss * (1.0f / DM) + EPS);
#pragma unroll
    for (int j = 0; j < 8; ++j) { const f32x4 wv = ((const f32x4*)w)[lane + 64 * j]; const f32x4 o = v[j] * rs * wv;
        if (outb) { u32x2 p; p.x = pk2(o.x, o.y); p.y = pk2(o.z, o.w); ((u32x2*)outb)[lane + 64 * j] = p; }
        if (outf) ((f32x4*)outf)[lane + 64 * j] = o; }
}
DI void sincos_tab(float ang, float& c, float& s) {
    const double a = (double)ang; const double kq = rint(a * 0.63661977236758134308); const double x = a - kq * 1.57079632679489661923; const double x2 = x * x;
    const double sn = x * (1.0 + x2 * (-1.0 / 6 + x2 * (1.0 / 120 + x2 * (-1.0 / 5040 + x2 * (1.0 / 362880 + x2 * (-1.0 / 39916800 + x2 * (1.0 / 6227020800.0)))))));
    const double cn = 1.0 + x2 * (-0.5 + x2 * (1.0 / 24 + x2 * (-1.0 / 720 + x2 * (1.0 / 40320 + x2 * (-1.0 / 3628800 + x2 * (1.0 / 479001600 + x2 * (-1.0 / 87178291200.0)))))));
    const int q = ((int)kq) & 3;
    const double cc = (q == 0) ? cn : (q == 1) ? -sn : (q == 2) ? -cn : sn;
    const double sc = (q == 0) ? sn : (q == 1) ? cn : (q == 2) ? -sn : -cn;
    c = (float)cc; s = (float)sc;
}
DI void p0_prologue(const Ctx& C, const Args& A) {
    LAS float* scr = (LAS float*)(C.lds + C.wave * 16384);
    const int gw = C.bid * NWAVES + C.wave, NGW = C.G * NWAVES;
    constexpr int I_IN = (DM / 64) * (INC / 32), I_OUT = (DM / 64) * (DM / 32), I_UP = (DM / 64) * (DFF / 32), I_DN = (DFF / 64) * (DM / 32), I_L = I_IN + I_OUT + I_UP + I_DN;
    for (int it = gw; it < DEPTH * I_L; it += NGW) {
        const int l = it / I_L; int r = it % I_L;
        if (r < I_IN) { p0_transpose_item(A.in[10] + (size_t)l * DM * INC, DM, INC, w_in_t(C, l), scr, r, C.lane); continue; } r -= I_IN;
        if (r < I_OUT) { p0_transpose_item(A.in[11] + (size_t)l * DM * DM, DM, DM, w_out_t(C, l), scr, r, C.lane); continue; } r -= I_OUT;
        if (r < I_UP) { p0_transpose_item(A.in[20] + (size_t)l * DM * DFF, DM, DFF, w_up_t(C, l), scr, r, C.lane); continue; } r -= I_UP;
        p0_transpose_item(A.in[21] + (size_t)l * DFF * DM, DFF, DM, w_dn_t(C, l), scr, r, C.lane);
    }
    { const int gt = C.bid * NTHR + C.tid, NGT = C.G * NTHR; constexpr int CH_L = (INP - INC) * DM / 8;
      for (int i = gt; i < DEPTH * CH_L; i += NGT) { const int l = i / CH_L, c = i % CH_L; ((u32x4*)(w_in_t(C, l) + (size_t)INC * DM))[c] = (u32x4){0u, 0u, 0u, 0u}; }
      float* ra = ws_f(C, WS_ROPE); float* ri = ra + 2048 * 16 * 2;
      for (int i = gt; i < 2048 * 24; i += NGT) { const int pos = i / 24, k = i % 24; const bool isa = k < 16; const int fi = isa ? k : k - 16;
          const double ex = isa ? (double)fi / 16.0 : (double)fi / 8.0; const float inv = (float)exp2(-ex * 18.931568569324174  );
          const float ang = (float)pos * inv; float c, s; sincos_tab(ang, c, s);
          float* dst = isa ? ra + (pos * 16 + fi) * 2 : ri + (pos * 8 + fi) * 2; dst[0] = c; dst[1] = s; } }
    for (int m = gw; m < NTOK; m += NGW) { const float* src = m < NTP ? A.in[0] + (size_t)m * DM : A.in[1] + (size_t)(m - NTP) * DM;
        rms_row(src, ws_f(C, WS_X) + (size_t)m * DM, A.in[9], ws_bf(C, WS_H) + (size_t)m * DM, nullptr, C.lane); }
}

DI void cvt_store8(const bf16* src, float* dst) {
    const u32x4 v = *(const u32x4*)src; float f[8]; unpack8(v, f);
    ((f32x4*)dst)[0] = (f32x4){f[0], f[1], f[2], f[3]}; ((f32x4*)dst)[1] = (f32x4){f[4], f[5], f[6], f[7]};
}
DI void m0_row(const Ctx& C, const Args& A, int l, int r, int lane) {
    bf16* P = ws_bf(C, WS_PU) + (size_t)r * INP;
    const bool smp = r >= NTP; int b, t, pos;
    if (!smp) { b = r >> 11; t = r & 2047; pos = t; } else { const int rr = r - NTP; b = rr >> 6; t = rr & 63; pos = PAST + t; }
    float* out = C.out;
    float* o_ak = smp ? out + OFF_S_AK + ((size_t)(l * DBAT + b) * DSEQ + t) * 512 : out + OFF_P_AK + ((size_t)(l * NB + b) * SEQ + t) * 512;
    float* o_av = smp ? out + OFF_S_AV + ((size_t)(l * DBAT + b) * DSEQ + t) * 512 : out + OFF_P_AV + ((size_t)(l * NB + b) * SEQ + t) * 512;
    float* o_ki = smp ? out + OFF_S_KI + ((size_t)(l * DBAT + b) * DSEQ + t) * 64 : out + OFF_P_KI + ((size_t)(l * NB + b) * SEQ + t) * 64;
    const float* ropeA = ws_f(C, WS_ROPE) + (size_t)pos * 32; const float* ropeI = ws_f(C, WS_ROPE) + 2048 * 32 + (size_t)pos * 16;
    {
        const int i = lane & 15, c1 = (lane >> 4) * 128 + i, c2 = c1 + 16; const float cs = ropeA[2 * i], sn = ropeA[2 * i + 1];
        float x1 = bf2f(P[C_AQ + c1]), x2 = bf2f(P[C_AQ + c2]);
        P[C_AQ + c1] = f2bf(x1 * cs - x2 * sn); P[C_AQ + c2] = f2bf(x2 * cs + x1 * sn);
        x1 = bf2f(P[C_AK + c1]); x2 = bf2f(P[C_AK + c2]);
        const float y1 = x1 * cs - x2 * sn, y2 = x2 * cs + x1 * sn;
        P[C_AK + c1] = f2bf(y1); P[C_AK + c2] = f2bf(y2); o_ak[c1] = y1; o_ak[c2] = y2;
    }
    if (lane < 48) { const int col = (lane / 12) * 128 + 32 + (lane % 12) * 8; cvt_store8(P + C_AK + col, o_ak + col); }
    cvt_store8(P + C_AV + lane * 8, o_av + lane * 8);
#pragma unroll
    for (int k = 0; k < 2; ++k) {
        const int pid = lane + 64 * k, i = pid & 7, c1 = C_IQ + (pid >> 3) * 64 + i, c2 = c1 + 8; const float cs = ropeI[2 * i], sn = ropeI[2 * i + 1];
        const float x1 = bf2f(P[c1]), x2 = bf2f(P[c2]);
        P[c1] = f2bf(x1 * cs - x2 * sn); P[c2] = f2bf(x2 * cs + x1 * sn);
    }
    if (lane < 8) { const int i = lane; const float cs = ropeI[2 * i], sn = ropeI[2 * i + 1];
        const float x1 = bf2f(P[C_IK + i]), x2 = bf2f(P[C_IK + i + 8]); const float y1 = x1 * cs - x2 * sn, y2 = x2 * cs + x1 * sn;
        P[C_IK + i] = f2bf(y1); P[C_IK + i + 8] = f2bf(y2); o_ki[i] = y1; o_ki[i + 8] = y2;
    } else if (lane < 14) { const int col = 16 + (lane - 8) * 8; cvt_store8(P + C_IK + col, o_ki + col); }
    const bool keep = smp || t >= SEQ - BWIN;
    if (keep) {
        const size_t ro = smp ? ((size_t)(l * DBAT + b) * DSEQ + t) * 512 : ((size_t)(l * NB + b) * BWIN + (t - (SEQ - BWIN))) * 512;
        float* o_bk = out + (smp ? OFF_S_BK : OFF_P_BK) + ro; float* o_bv = out + (smp ? OFF_S_BV : OFF_P_BV) + ro;
        cvt_store8(P + C_BK + lane * 8, o_bk + lane * 8); cvt_store8(P + C_BV + lane * 8, o_bv + lane * 8);
    }
    if (lane < 16) { const float x = bf2f(P[C_DT + lane]) + A.in[15][l * 16 + lane];
        const float sp = x > 20.f ? x : log1pf(__expf(x)); ws_f(C, WS_DTS)[(size_t)r * 16 + lane] = sp; }
    const float* cw = A.in[13] + (size_t)l * 4 * 2048; const float* cb = A.in[14] + (size_t)l * 2048;
    const float* sconv = A.in[8] + (size_t)(l * DBAT + b) * 3 * 2048;
    bf16* xo = ws_bf(C, WS_XBC) + (size_t)r * 2048;
    const int stt = smp ? DSEQ - 3 : SEQ - 3;
    float* o_conv = (t >= stt) ? (smp ? out + OFF_S_CONV + ((size_t)(l * DBAT + b) * 3 + (t - stt)) * 2048 : out + OFF_P_CONV + ((size_t)(l * NB + b) * 3 + (t - stt)) * 2048) : nullptr;
#pragma unroll 1
    for (int it = 0; it < 4; ++it) {
        const int ch = (lane + 64 * it) * 8;
        float acc[8], x[8];
        { const f32x4 b0 = *(const f32x4*)(cb + ch), b1 = *(const f32x4*)(cb + ch + 4); acc[0] = b0.x; acc[1] = b0.y; acc[2] = b0.z; acc[3] = b0.w; acc[4] = b1.x; acc[5] = b1.y; acc[6] = b1.z; acc[7] = b1.w; }
#pragma unroll
        for (int j = 0; j < 4; ++j) {
            const int tt = t - 3 + j; bool have = true;
            if (tt >= 0) { unpack8(*(const u32x4*)(P + (ptrdiff_t)(j - 3) * INP + C_XBC + ch), x); }
            else if (smp) { const float* sp = sconv + (size_t)(3 + tt) * 2048 + ch; const f32x4 s0 = *(const f32x4*)sp, s1 = *(const f32x4*)(sp + 4);
                x[0] = s0.x; x[1] = s0.y; x[2] = s0.z; x[3] = s0.w; x[4] = s1.x; x[5] = s1.y; x[6] = s1.z; x[7] = s1.w; }
            else have = false;
            if (have) { const f32x4 w0 = *(const f32x4*)(cw + j * 2048 + ch), w1 = *(const f32x4*)(cw + j * 2048 + ch + 4);
                acc[0] += x[0] * w0.x; acc[1] += x[1] * w0.y; acc[2] += x[2] * w0.z; acc[3] += x[3] * w0.w; acc[4] += x[4] * w1.x; acc[5] += x[5] * w1.y; acc[6] += x[6] * w1.z; acc[7] += x[7] * w1.w; }
        }
        if (o_conv) { ((f32x4*)(o_conv + ch))[0] = (f32x4){x[0], x[1], x[2], x[3]}; ((f32x4*)(o_conv + ch))[1] = (f32x4){x[4], x[5], x[6], x[7]}; }
#pragma unroll
        for (int k = 0; k < 8; ++k) acc[k] = acc[k] / (1.f + __expf(-acc[k]));
        *(u32x4*)(xo + ch) = pack8(acc);
    }
}
DI void cvt_chunks(const float* src, bf16* dst, size_t nchunk, size_t gt, size_t ngt) {
    for (size_t i = gt; i < nchunk; i += ngt) { const f32x4 a = ((const f32x4*)src)[2 * i], b = ((const f32x4*)src)[2 * i + 1];
        u32x4 o; o.x = pk2(a.x, a.y); o.y = pk2(a.z, a.w); o.z = pk2(b.x, b.y); o.w = pk2(b.z, b.w); ((u32x4*)dst)[i] = o; }
}
DI void m0_phase(const Ctx& C, const Args& A, int l) {
    const int gw = C.bid * NWAVES + C.wave, NGW = C.G * NWAVES;
    for (int r = gw; r < NTOK; r += NGW) m0_row(C, A, l, r, C.lane);
    const size_t gt = (size_t)C.bid * NTHR + C.tid, ngt = (size_t)C.G * NTHR;
    cvt_chunks(A.in[2] + (size_t)l * DBAT * PAST * 512, ws_bf(C, WS_CAK), (size_t)DBAT * PAST * 512 / 8, gt, ngt);
    cvt_chunks(A.in[3] + (size_t)l * DBAT * PAST * 512, ws_bf(C, WS_CAV), (size_t)DBAT * PAST * 512 / 8, gt, ngt);
    cvt_chunks(A.in[4] + (size_t)l * DBAT * PAST * 64, ws_bf(C, WS_CKI), (size_t)DBAT * PAST * 64 / 8, gt, ngt);
    cvt_chunks(A.in[5] + (size_t)l * DBAT * BWIN * 512, ws_bf(C, WS_CBK), (size_t)DBAT * BWIN * 512 / 8, gt, ngt);
    cvt_chunks(A.in[6] + (size_t)l * DBAT * BWIN * 512, ws_bf(C, WS_CBV), (size_t)DBAT * BWIN * 512 / 8, gt, ngt);
}

struct KVSrc { const bf16* k0; const bf16* v0; int s0; int n0; const bf16* k1; const bf16* v1; int s1; };
template <int MODE>
DI void attn_unit(const Ctx& C, const bf16* Qp, int qstride, const KVSrc& S, int tile_lo, int tile_hi, bf16* Op, int ostride) {
    int tid = C.tid, lane = C.lane; asm volatile("" : "+v"(tid), "+v"(lane));
    const int w = C.wave, r = lane & 31, hh = lane >> 5;
    const int head = w >> 1, q = (w & 1) * 32 + r;
    LAS unsigned char* Vs = C.lds + ATT_V;
    bf16x8 qf[8];
    { const bf16* qrow = Qp + (size_t)q * qstride + head * 128 + 8 * hh;
#pragma unroll
      for (int ks = 0; ks < 8; ++ks) qf[ks] = *(const bf16x8*)(qrow + 16 * ks); }
    f32x16 o[4];
#pragma unroll
    for (int d = 0; d < 4; ++d)
#pragma unroll
        for (int i = 0; i < 16; ++i) o[d][i] = 0.f;
    float m = -1e30f, lsum = 0.f;
    constexpr float SC2 = 0.08838834764831845f * 1.4426950408889634f;
    constexpr float L2E = 1.4426950408889634f;
    bf16x8 kf[8]; u32x4 vr[4];
#define ATT_KLOAD(tile_) do { const int key_ = (tile_) * 32 + r; const bf16* kp_ = (key_ < S.n0 ? S.k0 + (ptrdiff_t)key_ * S.s0 : S.k1 + (ptrdiff_t)(key_ - S.n0) * S.s1) + head * 128 + 8 * hh; \
        _Pragma("unroll") for (int ks_ = 0; ks_ < 8; ++ks_) kf[ks_] = *(const bf16x8*)(kp_ + 16 * ks_); } while (0)
#define ATT_VLOAD(tile_) do { _Pragma("unroll") for (int i_ = 0; i_ < 4; ++i_) { const int ci_ = tid + 512 * i_, row_ = ci_ >> 6, ch_ = ci_ & 63, key_ = (tile_) * 32 + row_; \
        const bf16* vp_ = key_ < S.n0 ? S.v0 + (ptrdiff_t)key_ * S.s0 : S.v1 + (ptrdiff_t)(key_ - S.n0) * S.s1; vr[i_] = *(const u32x4*)(vp_ + ch_ * 8); } } while (0)
#define ATT_VSTORE(buf_) do { _Pragma("unroll") for (int i_ = 0; i_ < 4; ++i_) { const int ci_ = tid + 512 * i_, row_ = ci_ >> 6, ch_ = ci_ & 63; \
        *(LAS u32x4*)(Vs + (buf_) * (32 * VSTR) + row_ * VSTR + ch_ * 16) = vr[i_]; } } while (0)
    ATT_KLOAD(tile_lo); ATT_VLOAD(tile_lo);
    __syncthreads();
    ATT_VSTORE(0);
    if (tile_lo + 1 < tile_hi) ATT_VLOAD(tile_lo + 1);
    __syncthreads();
    const int i16 = lane & 15;
    LAS unsigned char* vbase = Vs + (4 * hh + (i16 >> 2)) * VSTR + (head * 128 + 16 * ((lane >> 4) & 1) + 4 * (i16 & 3)) * 2;
    const LAS float* btab = (const LAS float*)(C.lds + ATT_SEL) + head * 257;
    const LAS unsigned* sel = (const LAS unsigned*)(C.lds + ATT_SEL) + q * 64;
#pragma unroll 1
    for (int tile = tile_lo; tile < tile_hi; ++tile) {
        const int cur = (tile - tile_lo) & 1;
        f32x16 s;
        if (MODE == 0) {
            const unsigned nwd = ~(sel[tile] >> (4 * hh));
#pragma unroll
            for (int i = 0; i < 16; ++i) { const int mb = ((int)(nwd << (31 - ((i & 3) + 8 * (i >> 2))))) >> 31; s[i] = __int_as_float(mb & (int)0xFF800000); }
        } else {
            if (tile <= 11) { const float bb = btab[256] * (L2E / SC2);
#pragma unroll
                for (int i = 0; i < 16; ++i) s[i] = bb;
            } else {
#pragma unroll
                for (int i = 0; i < 16; ++i) { int rel = BWIN + q - (tile * 32 + crow(i, hh)); rel = rel > 128 ? 128 : rel; s[i] = btab[rel + 128] * (L2E / SC2); }
            }
        }
#pragma unroll
        for (int ks = 0; ks < 8; ++ks) s = mfma32(kf[ks], qf[ks], s);
        if (tile + 1 < tile_hi) ATT_KLOAD(tile + 1);
        float mx = s[0];
#pragma unroll
        for (int i = 1; i < 16; ++i) mx = fmaxf(mx, s[i]);
        mx = fmaxf(mx, __shfl_xor(mx, 32)) * SC2;
        const bool need = mx > m + 8.0f;
        if (__any(need)) {
            const float mn = need ? mx : m, alpha = __builtin_amdgcn_exp2f(m - mn);
            lsum *= alpha; m = mn;
#pragma unroll
            for (int d = 0; d < 4; ++d)
#pragma unroll
                for (int i = 0; i < 16; ++i) o[d][i] *= alpha;
        }
        float rs = 0.f;
#pragma unroll
        for (int i = 0; i < 16; ++i) { s[i] = __builtin_amdgcn_exp2f(__builtin_fmaf(s[i], SC2, -m)); rs += s[i]; }
        rs += __shfl_xor(rs, 32);
        lsum += rs;
        bf16x8 pf[2];
#pragma unroll
        for (int s2 = 0; s2 < 2; ++s2) { u32x4 pk; pk.x = pk2(s[8 * s2], s[8 * s2 + 1]); pk.y = pk2(s[8 * s2 + 2], s[8 * s2 + 3]); pk.z = pk2(s[8 * s2 + 4], s[8 * s2 + 5]); pk.w = pk2(s[8 * s2 + 6], s[8 * s2 + 7]);
            pf[s2] = __builtin_bit_cast(bf16x8, pk); }
        LAS unsigned char* vb = vbase + cur * (32 * VSTR);
#pragma unroll
        for (int d = 0; d < 4; ++d)
#pragma unroll
            for (int s2 = 0; s2 < 2; ++s2) {
                const s16x4 lo = tr_read(vb + (16 * s2) * VSTR + d * 64), hi = tr_read(vb + (16 * s2 + 8) * VSTR + d * 64);
                const bf16x8 vt = __builtin_shufflevector(lo, hi, 0, 1, 2, 3, 4, 5, 6, 7);
                o[d] = mfma32(vt, pf[s2], o[d]);
            }
        if (tile + 1 < tile_hi) { ATT_VSTORE(cur ^ 1); if (tile + 2 < tile_hi) ATT_VLOAD(tile + 2); }
        __syncthreads();
    }
#undef ATT_KLOAD
#undef ATT_VLOAD
#undef ATT_VSTORE
    const float inv = 1.0f / lsum;
    bf16* orow = Op + (size_t)q * ostride + head * 128 + 4 * hh;
#pragma unroll
    for (int d = 0; d < 4; ++d)
#pragma unroll
        for (int g = 0; g < 4; ++g) { u32x2 p; p.x = pk2(o[d][4 * g] * inv, o[d][4 * g + 1] * inv); p.y = pk2(o[d][4 * g + 2] * inv, o[d][4 * g + 3] * inv);
            *(u32x2*)(orow + 32 * d + 8 * g) = p; }
}

DI unsigned fkey(float f) { const unsigned u = __float_as_uint(f); return (u & 0x80000000u) ? ~u : (u | 0x80000000u); }
template <int NR>
DI void topk_pair(const float* SCq  , LAS unsigned* SELa  , int NT, int r, int hh, int lane) {
    unsigned v[NR];
#pragma unroll
    for (int i = 0; i < NR; ++i) { const float f = (i < NT) ? __hip_atomic_load(SCq + i * 32 + r, __ATOMIC_RELAXED, __HIP_MEMORY_SCOPE_AGENT) : -INFINITY; v[i] = fkey(f); }
    unsigned T = 0u;
#pragma unroll 1
    for (int bit = 31; bit >= 8; --bit) {
        const unsigned cand = T | (1u << bit); unsigned cnt = 0u;
#pragma unroll
        for (int i = 0; i < NR; ++i) asm("v_cmp_ge_u32 vcc, %1, %2\n\tv_addc_co_u32 %0, vcc, 0, %0, vcc" : "+v"(cnt) : "v"(v[i]), "v"(cand) : "vcc");
        unsigned t0 = 0u, t1 = 0u;
#pragma unroll
        for (int b = 0; b < 7; ++b) { const unsigned long long mk = __ballot((cnt >> b) & 1u); t0 += (unsigned)__popc((unsigned)mk) << b; t1 += (unsigned)__popc((unsigned)(mk >> 32)) << b; }
        if ((hh ? t1 : t0) >= 256u) T = cand;
    }
#pragma unroll
    for (int i = 0; i < NR; ++i) { unsigned long long mk = __ballot(v[i] >= T); if (i >= NT) mk = 0ull;
        if (lane == 0) { SELa[i] = (unsigned)mk; SELa[64 + i] = (unsigned)(mk >> 32); } }
}
DI void dsa_unit(const Ctx& C, int l, int u) {
    int lane = C.lane; asm volatile("" : "+v"(lane));
    const int w = C.wave, r = lane & 31, hh = lane >> 5;
    const bf16* PROJ = ws_bf(C, WS_PU);
    int qrow0, NT, limit; KVSrc S; const bf16* ik0; const bf16* ik1; int iks0, ikn0;
    if (u < 256) { const int c = 31 - (u >> 3), b = u & 7; qrow0 = b * SEQ + c * 64; NT = 2 * (c + 1); limit = 64 * (c + 1);
        const bf16* base = PROJ + (size_t)(b * SEQ) * INP;
        S.k0 = base + C_AK; S.v0 = base + C_AV; S.s0 = INP; S.n0 = limit; S.k1 = S.k0; S.v1 = S.v0; S.s1 = INP;
        ik0 = base + C_IK; iks0 = INP; ikn0 = limit; ik1 = ik0;
    } else { const int b = u - 256; qrow0 = NTP + b * DSEQ; NT = (PAST + DSEQ) / 32; limit = PAST + DSEQ;
        const bf16* nb = PROJ + (size_t)qrow0 * INP;
        S.k0 = ws_bf(C, WS_CAK) + (size_t)b * PAST * 512; S.v0 = ws_bf(C, WS_CAV) + (size_t)b * PAST * 512; S.s0 = 512; S.n0 = PAST; S.k1 = nb + C_AK; S.v1 = nb + C_AV; S.s1 = INP;
        ik0 = ws_bf(C, WS_CKI) + (size_t)b * PAST * 64; iks0 = 64; ikn0 = PAST; ik1 = nb + C_IK;
    }
    float* SC = ws_f(C, WS_SC) + (size_t)C.bid * 64 * 2048;
    LAS unsigned* SEL = (LAS unsigned*)(C.lds + ATT_SEL);
    if (limit > 256) {
#pragma unroll 1
    for (int pass = 0; pass < 2; ++pass) {
        bf16x8 af[2][4]; float wt[2][16];
#pragma unroll
        for (int np = 0; np < 2; ++np) { const int pp = pass * 2 + np;
            const bf16* ap = PROJ + (size_t)(qrow0 + 8 * w + 2 * pp + (r >> 4)) * INP + C_IQ + (r & 15) * 64 + 8 * hh;
#pragma unroll
            for (int ks = 0; ks < 4; ++ks) af[np][ks] = *(const bf16x8*)(ap + 16 * ks);
#pragma unroll
            for (int i = 0; i < 16; ++i) { const int qi = 8 * w + 2 * pp + (i >> 3), hd = (i & 3) + 8 * ((i >> 2) & 1) + 4 * hh;
                wt[np][i] = bf2f(PROJ[(size_t)(qrow0 + qi) * INP + C_IW + hd]) * (0.25f * 0.125f); } }
        bf16x8 bk[4], bn[4];
#define IDX_LOAD(dst_, tile_) do { const int key_ = (tile_) * 32 + r; const bf16* kp_ = (key_ < ikn0 ? ik0 + (size_t)key_ * iks0 : ik1 + (size_t)(key_ - ikn0) * INP) + 8 * hh; \
            _Pragma("unroll") for (int ks_ = 0; ks_ < 4; ++ks_) dst_[ks_] = *(const bf16x8*)(kp_ + 16 * ks_); } while (0)
        IDX_LOAD(bn, 0);
#pragma unroll 1
        for (int tile = 0; tile < NT; ++tile) {
#pragma unroll
            for (int ks = 0; ks < 4; ++ks) bk[ks] = bn[ks];
            if (tile + 1 < NT) IDX_LOAD(bn, tile + 1);
#pragma unroll
            for (int np = 0; np < 2; ++np) {
                f32x16 acc;
#pragma unroll
                for (int i = 0; i < 16; ++i) acc[i] = 0.f;
#pragma unroll
                for (int ks = 0; ks < 4; ++ks) acc = mfma32(af[np][ks], bk[ks], acc);
                float p0 = 0.f, p1 = 0.f;
#pragma unroll
                for (int i = 0; i < 8; ++i) { p0 += fmaxf(acc[i], 0.f) * wt[np][i]; p1 += fmaxf(acc[8 + i], 0.f) * wt[np][8 + i]; }
                const float t0 = p0 + __shfl_xor(p0, 32), t1 = p1 + __shfl_xor(p1, 32);
                const int ql = 8 * w + 2 * (pass * 2 + np) + hh;
                SC[(size_t)ql * 2048 + tile * 32 + r] = hh ? t1 : t0;
            }
        }
    }
#undef IDX_LOAD
    asm volatile("s_waitcnt vmcnt(0)" ::: "memory");
#pragma unroll 1
    for (int pp = 0; pp < 4; ++pp) {
        const float* SCq = SC + (size_t)(8 * w + 2 * pp + hh) * 2048; LAS unsigned* SELa = SEL + (8 * w + 2 * pp) * 64;
        if (NT <= 16) topk_pair<16>(SCq, SELa, NT, r, hh, lane);
        else if (NT <= 32) topk_pair<32>(SCq, SELa, NT, r, hh, lane);
        else if (NT <= 48) topk_pair<48>(SCq, SELa, NT, r, hh, lane);
        else topk_pair<64>(SCq, SELa, NT, r, hh, lane);
    }
    } else {
        for (int i = lane; i < 8 * 64; i += 64) SEL[8 * w * 64 + i] = ((i & 63) < NT) ? 0xffffffffu : 0u;
    }
    __syncthreads();
    attn_unit<0>(C, PROJ + (size_t)qrow0 * INP + C_AQ, INP, S, 0, NT, ws_bf(C, WS_MIX) + (size_t)qrow0 * DM, DM);
}

DI void band_unit(const Ctx& C, const Args& A, int l, int u) {
    const bf16* PROJ = ws_bf(C, WS_PU);
    int qrow0, tlo; KVSrc S;
    if (u < 256) { const int c = 31 - (u >> 3), b = u & 7; qrow0 = b * SEQ + c * 64; tlo = c < 8 ? (8 - c) * 2 : 0;
        const bf16* base = PROJ + ((ptrdiff_t)b * SEQ + c * 64 - BWIN) * INP;
        S.k0 = base + C_BK; S.v0 = base + C_BV; S.s0 = INP; S.n0 = BWIN + 64; S.k1 = S.k0; S.v1 = S.v0; S.s1 = INP;
    } else { const int b = u - 256; qrow0 = NTP + b * DSEQ; tlo = 0;
        const bf16* nb = PROJ + (size_t)qrow0 * INP;
        S.k0 = ws_bf(C, WS_CBK) + (size_t)b * BWIN * 512; S.v0 = ws_bf(C, WS_CBV) + (size_t)b * BWIN * 512; S.s0 = 512; S.n0 = BWIN; S.k1 = nb + C_BK; S.v1 = nb + C_BV; S.s1 = INP;
    }
    LAS float* bt = (LAS float*)(C.lds + ATT_SEL);
    const float* brel = A.in[12] + (size_t)l * 4 * 257;
    for (int i = C.tid; i < 4 * 257; i += NTHR) bt[i] = brel[i];
    __syncthreads();
    attn_unit<1>(C, PROJ + (size_t)qrow0 * INP + C_BQ, INP, S, tlo, (BWIN + 64) / 32, ws_bf(C, WS_MIX) + (size_t)qrow0 * DM + 512, DM);
}

DI void ssd_unit(const Ctx& C, const Args& A, int l, int row0, int nchunks, int h, const float* h0, float* hout) {
    int tid = C.tid, lane = C.lane; asm volatile("" : "+v"(tid), "+v"(lane));
    const int w = C.wave, r = lane & 31, hh = lane >> 5, g = h >> 2;
    LAS unsigned char* L = C.lds;
    LAS unsigned char* Cs = L + SSD_CS; LAS unsigned char* Bs = L + SSD_BS; LAS unsigned char* XD = L + SSD_XD; LAS unsigned char* XDW = L + SSD_XDW; LAS unsigned char* Ms = L + SSD_MS; LAS unsigned char* Ys = L + SSD_Y;
    LAS float* v_acs = (LAS float*)(L + SSD_VEC); LAS float* v_e = v_acs + 64;
    const bf16* XBC = ws_bf(C, WS_XBC); const bf16* PROJ = ws_bf(C, WS_PU); const float* DTS = ws_f(C, WS_DTS); float* G = ws_f(C, WS_G);
    const float a_h = -expf(A.in[16][l * 16 + h]); const float dsk = A.in[17][l * 16 + h];
    const int erow = tid >> 3, ech = tid & 7;
    f32x16 Hacc[2];
#pragma unroll
    for (int pb = 0; pb < 2; ++pb)
#pragma unroll
        for (int i = 0; i < 16; ++i) Hacc[pb][i] = 0.f;
    u32x4 pC[2], pB[2], pX, pZ; float pDt;
#define SSD_LOAD(c_) do { const int rb_ = row0 + (c_) * 64; \
        _Pragma("unroll") for (int i_ = 0; i_ < 2; ++i_) { const int ci_ = tid + 512 * i_; const bf16* src_ = XBC + (size_t)(rb_ + (ci_ >> 4)) * 2048 + g * 128 + (ci_ & 15) * 8; pB[i_] = *(const u32x4*)(src_ + 1024); pC[i_] = *(const u32x4*)(src_ + 1536); } \
        pX = *(const u32x4*)(XBC + (size_t)(rb_ + erow) * 2048 + h * 64 + ech * 8); pZ = *(const u32x4*)(PROJ + (size_t)(rb_ + erow) * INP + C_CZ + h * 64 + ech * 8); \
        pDt = DTS[(size_t)(rb_ + lane) * 16 + h]; } while (0)
    SSD_LOAD(0);
    __syncthreads();
    if (w >= 4) { const int nb = w - 4;
#pragma unroll
        for (int pb = 0; pb < 2; ++pb)
#pragma unroll
            for (int i = 0; i < 16; ++i) { const int p = 32 * pb + crow(i, hh), n = 32 * nb + r; const float v = h0 ? h0[p * 128 + n] : 0.f; Hacc[pb][i] = v;
                *(LAS bf16*)(L + SSD_HS + p * HSTR + n * 2) = f2bf(v); } }
#pragma unroll 1
    for (int c = 0; c < nchunks; ++c) {
        const int rbase = row0 + c * 64;
        LAS unsigned char* Hcur = L + SSD_HS + (c & 1) * 64 * HSTR; LAS unsigned char* Hnxt = L + SSD_HS + ((c + 1) & 1) * 64 * HSTR;
        const float dtl = pDt; float acs = dtl * a_h;
#pragma unroll
        for (int o = 1; o < 64; o <<= 1) { const float t = __shfl_up(acs, o); if (lane >= o) acs += t; }
        const float Atot = __shfl(acs, 63);
        const float wl = __expf(Atot - acs);
        if (w == 0) { v_acs[lane] = acs; v_e[lane] = __expf(acs); }
#pragma unroll
        for (int i = 0; i < 2; ++i) { const int ci = tid + 512 * i, row = ci >> 4, ch = ci & 15; *(LAS u32x4*)(Bs + row * CSTR + ch * 16) = pB[i]; *(LAS u32x4*)(Cs + row * CSTR + ch * 16) = pC[i]; }
        float xraw[8]; unpack8(pX, xraw); const u32x4 zc = pZ;
        { float xd[8], xw[8]; const float dt = __shfl(dtl, erow & 63), wv = __shfl(wl, erow & 63);
#pragma unroll
          for (int k = 0; k < 8; ++k) { xd[k] = xraw[k] * dt; xw[k] = xd[k] * wv; }
          *(LAS u32x4*)(XD + erow * XSTR + ech * 16) = pack8(xd); *(LAS u32x4*)(XDW + erow * XSTR + ech * 16) = pack8(xw); }
        if (c + 1 < nchunks) SSD_LOAD(c + 1);
        __syncthreads();
        if (w < 4) {
            const int lb = w >> 1, sb = w & 1; f32x16 acc;
#pragma unroll
            for (int i = 0; i < 16; ++i) acc[i] = 0.f;
            if (sb <= lb) {
#pragma unroll
                for (int ks = 0; ks < 8; ++ks) { const bf16x8 a = *(const LAS bf16x8*)(Cs + (32 * lb + r) * CSTR + (16 * ks + 8 * hh) * 2), b = *(const LAS bf16x8*)(Bs + (32 * sb + r) * CSTR + (16 * ks + 8 * hh) * 2);
                    acc = mfma32(a, b, acc); } }
            const int s = 32 * sb + r; const float acs_s = v_acs[s];
#pragma unroll
            for (int i = 0; i < 16; ++i) { const int lr = 32 * lb + crow(i, hh); const float v = (s <= lr) ? acc[i] * __expf(v_acs[lr] - acs_s) : 0.f; *(LAS bf16*)(Ms + lr * MSTR + s * 2) = f2bf(v); }
        } else {
            const int nb = w - 4; const float dec = __expf(Atot);
#pragma unroll
            for (int pb = 0; pb < 2; ++pb) {
#pragma unroll
                for (int i = 0; i < 16; ++i) Hacc[pb][i] *= dec;
#pragma unroll
                for (int ks = 0; ks < 4; ++ks) { const bf16x8 a = trfrag(XDW, XSTR, 16 * ks, 32 * pb, lane), b = trfrag(Bs, CSTR, 16 * ks, 32 * nb, lane); Hacc[pb] = mfma32(a, b, Hacc[pb]); }
#pragma unroll
                for (int i = 0; i < 16; ++i) *(LAS bf16*)(Hnxt + (32 * pb + crow(i, hh)) * HSTR + (32 * nb + r) * 2) = f2bf(Hacc[pb][i]);
            }
        }
        __syncthreads();
        if (w < 4) {
            const int lb = w >> 1, pb = w & 1; f32x16 yd, yo;
#pragma unroll
            for (int i = 0; i < 16; ++i) { yd[i] = 0.f; yo[i] = 0.f; }
#pragma unroll
            for (int ks = 0; ks < 4; ++ks) { const bf16x8 a = *(const LAS bf16x8*)(Ms + (32 * lb + r) * MSTR + (16 * ks + 8 * hh) * 2), b = trfrag(XD, XSTR, 16 * ks, 32 * pb, lane); yd = mfma32(a, b, yd); }
#pragma unroll
            for (int ks = 0; ks < 8; ++ks) { const bf16x8 a = *(const LAS bf16x8*)(Cs + (32 * lb + r) * CSTR + (16 * ks + 8 * hh) * 2), b = *(const LAS bf16x8*)(Hcur + (32 * pb + r) * HSTR + (16 * ks + 8 * hh) * 2); yo = mfma32(a, b, yo); }
            const int p = 32 * pb + r;
#pragma unroll
            for (int i = 0; i < 16; ++i) { const int lr = 32 * lb + crow(i, hh); *(LAS float*)(Ys + lr * YSTR + p * 4) = yd[i] + v_e[lr] * yo[i]; }
        }
        __syncthreads();
        {
            float z[8]; unpack8(zc, z);
            const f32x4 y0 = *(const LAS f32x4*)(Ys + erow * YSTR + ech * 32), y1 = *(const LAS f32x4*)(Ys + erow * YSTR + ech * 32 + 16);
            float y[8] = {y0.x, y0.y, y0.z, y0.w, y1.x, y1.y, y1.z, y1.w};
#pragma unroll
            for (int k = 0; k < 8; ++k) { const float yy = y[k] + dsk * xraw[k]; y[k] = yy * z[k] / (1.f + __expf(-z[k])); }
            float* gp = G + (size_t)(rbase + erow) * 1024 + h * 64 + ech * 8;
            ((f32x4*)gp)[0] = (f32x4){y[0], y[1], y[2], y[3]}; ((f32x4*)gp)[1] = (f32x4){y[4], y[5], y[6], y[7]};
        }
    }
#undef SSD_LOAD
    if (w >= 4) { const int nb = w - 4;
#pragma unroll
        for (int pb = 0; pb < 2; ++pb)
#pragma unroll
            for (int i = 0; i < 16; ++i) hout[(32 * pb + crow(i, hh)) * 128 + 32 * nb + r] = Hacc[pb][i]; }
}

DI void gate_norm_phase(const Ctx& C, const Args& A, int l) {
    const int gw = C.bid * NWAVES + C.wave, NGW = C.G * NWAVES; const float* gn = A.in[18] + (size_t)l * 1024;
    for (int m = gw; m < NTOK; m += NGW) { const float* grow = ws_f(C, WS_G) + (size_t)m * 1024; bf16* orow = ws_bf(C, WS_MIX) + (size_t)m * DM + 1024;
#pragma unroll
        for (int g = 0; g < 4; ++g) { const f32x4 v = ((const f32x4*)grow)[g * 64 + C.lane]; const float ss = wave_sum((v.x * v.x + v.y * v.y) + (v.z * v.z + v.w * v.w));
            const float rs = 1.0f / sqrtf(ss * (1.0f / 256.f) + EPS); const f32x4 wv = ((const f32x4*)gn)[g * 64 + C.lane]; const f32x4 o = v * rs * wv;
            u32x2 p; p.x = pk2(o.x, o.y); p.y = pk2(o.z, o.w); ((u32x2*)orow)[g * 64 + C.lane] = p; } }
}
DI void norm_phase(const Ctx& C, const float* w, bf16* outb, float* outf) {
    const int gw = C.bid * NWAVES + C.wave, NGW = C.G * NWAVES;
    for (int m = gw; m < NTOK; m += NGW) rms_row(ws_f(C, WS_X) + (size_t)m * DM, nullptr, w, outb ? outb + (size_t)m * DM : nullptr, outf ? outf + (size_t)m * DM : nullptr, C.lane);
}

#ifndef MK_ONE_LAUNCH
#define MK_ONE_LAUNCH 1
#endif
#ifndef PHASE_MASK
#define PHASE_MASK 0xFFFF
#endif
#define EN(k) (((PHASE_MASK) >> (k)) & 1)
constexpr int PH_PER_LAYER = 9, NPHASE = 1 + DEPTH * PH_PER_LAYER;
__global__ void __launch_bounds__(NTHR, 2) fwd(Args args) {
    extern __shared__ __attribute__((aligned(16))) unsigned char lds_raw[];
    Ctx C;
    C.lds = (LAS unsigned char*)lds_raw;
    C.tid = threadIdx.x; C.lane = C.tid & 63; C.wave = __builtin_amdgcn_readfirstlane(C.tid >> 6); C.G = gridDim.x; C.bid = blockIdx.x;
    C.ws = args.ws; C.out = args.out; C.ctl = (unsigned*)(args.ws + WS_CTL);
    const Args& A = args;
    for (int u = C.tid; u < (LDS_BYTES - LDSCTL_OFF) / 4; u += NTHR) ((LAS unsigned*)(C.lds + LDSCTL_OFF))[u] = 0u;
    __syncthreads();
    const int lo = args.ph_lo, hi = args.ph_hi;
    const bool multi = (hi - lo) > 1;
    XcdBarrier bar; bar.bar = C.ctl + CW_BAR; bar.x = 0; bar.st = (volatile LAS unsigned*)(C.lds + LDSCTL_OFF);
    if (multi) bar = xcd_barrier_post(C.ctl + CW_BAR, (volatile LAS unsigned*)(C.lds + LDSCTL_OFF));
#define IN(k) (lo <= (k) && (k) < hi)
#define FRESH() do { int t_ = threadIdx.x; asm volatile("" : "+v"(t_)); C.tid = t_; C.lane = t_ & 63; int w_ = __builtin_amdgcn_readfirstlane(t_ >> 6); asm volatile("" : "+s"(w_)); C.wave = w_; } while (0)
#define SEAM(k) do { if (IN((k) + 1)) xcd_barrier(bar); } while (0)

    if (EN(0) && IN(0)) { p0_prologue(C, A);
#if defined(PROBE_P02)
        __syncthreads(); p0_prologue(C, A);
#endif
        SEAM(0); }
#pragma unroll 1
    for (int l = 0; l < DEPTH; ++l) {
        const int pb = 1 + PH_PER_LAYER * l;
        if (EN(1) && IN(pb + 0)) { FRESH();
            pg8::Gemm g{ws_bf(C, WS_H), w_in_t(C, l), NTOK, INP, DM}; pg8::StaticOrder S; S.init(NTOK, INP, C.G, C.bid);
            pg8::EpiBf16<0> E{ws_bf(C, WS_PU), INP};
            pg8::gemm_phase<pg8::EpiBf16<0>, pg8::StaticOrder, true, true>(C.lds, g, S, E);
            SEAM(pb + 0);
        }
        if (EN(2) && IN(pb + 1)) { FRESH(); m0_phase(C, A, l); SEAM(pb + 1); }
        if (IN(pb + 2)) { FRESH();
            unsigned* qh = C.ctl + CW_Q + 64 * (l * 4);
            if (EN(3)) for (;;) { const int u = q_next(C, qh); if (u >= NB * 16) break;
                ssd_unit(C, A, l, (u >> 4) * SEQ, SEQ / 64, u & 15, nullptr, C.out + OFF_P_SSM + ((size_t)(l * NB + (u >> 4)) * 16 + (u & 15)) * 8192); }
            if (EN(4)) for (;;) { const int u = q_next(C, qh + 64); if (u >= 288) break; dsa_unit(C, l, u); }
            if (EN(5)) for (;;) { const int u = q_next(C, qh + 128); if (u >= 288) break; band_unit(C, A, l, u); }
            if (EN(3)) for (;;) { const int u = q_next(C, qh + 192); if (u >= DBAT * 16) break;
                ssd_unit(C, A, l, NTP + (u >> 4) * DSEQ, 1, u & 15, A.in[7] + ((size_t)(l * DBAT + (u >> 4)) * 16 + (u & 15)) * 8192, C.out + OFF_S_SSM + ((size_t)(l * DBAT + (u >> 4)) * 16 + (u & 15)) * 8192); }
#if defined(PROBE_MIXK)
            { unsigned* qh2 = C.ctl + CW_Q + 64 * (16 + l * 4);
            if (PROBE_MIXK & 1) for (;;) { const int u = q_next(C, qh2); if (u >= NB * 16) break;
                ssd_unit(C, A, l, (u >> 4) * SEQ, SEQ / 64, u & 15, nullptr, C.out + OFF_P_SSM + ((size_t)(l * NB + (u >> 4)) * 16 + (u & 15)) * 8192); }
            if (PROBE_MIXK & 2) for (;;) { const int u = q_next(C, qh2 + 64); if (u >= 288) break; dsa_unit(C, l, u); }
            if (PROBE_MIXK & 4) for (;;) { const int u = q_next(C, qh2 + 128); if (u >= 288) break; band_unit(C, A, l, u); }
            if (PROBE_MIXK & 8) for (;;) { const int u = q_next(C, qh2 + 192); if (u >= DBAT * 16) break;
                ssd_unit(C, A, l, NTP + (u >> 4) * DSEQ, 1, u & 15, A.in[7] + ((size_t)(l * DBAT + (u >> 4)) * 16 + (u & 15)) * 8192, C.out + OFF_S_SSM + ((size_t)(l * DBAT + (u >> 4)) * 16 + (u & 15)) * 8192); } }
#endif
            SEAM(pb + 2);
        }
        if (EN(6) && IN(pb + 3)) { FRESH(); gate_norm_phase(C, A, l); SEAM(pb + 3); }
        if (EN(7) && IN(pb + 4)) { FRESH();
            pg8::Gemm g{ws_bf(C, WS_MIX), w_out_t(C, l), NTOK, DM, DM}; pg8::StaticOrder S; S.init(NTOK, DM, C.G, C.bid);
            pg8::EpiResF32 E{ws_f(C, WS_X), DM};
            pg8::gemm_phase<pg8::EpiResF32, pg8::StaticOrder, true, true>(C.lds, g, S, E);
            SEAM(pb + 4);
        }
        if (EN(8) && IN(pb + 5)) { FRESH(); norm_phase(C, A.in[19] + (size_t)l * DM, ws_bf(C, WS_H), nullptr); SEAM(pb + 5); }
        if (EN(9) && IN(pb + 6)) { FRESH();
            pg8::Gemm g{ws_bf(C, WS_H), w_up_t(C, l), NTOK, DFF, DM}; pg8::StaticOrder S; S.init(NTOK, DFF, C.G, C.bid);
            pg8::EpiBf16<1> E{ws_bf(C, WS_PU), DFF};
            pg8::gemm_phase<pg8::EpiBf16<1>, pg8::StaticOrder, true, true>(C.lds, g, S, E);
#if defined(PROBE_UP2)
            __syncthreads(); pg8::gemm_phase<pg8::EpiBf16<1>, pg8::StaticOrder, true, true>(C.lds, g, S, E);
#endif
            SEAM(pb + 6);
        }
        if (EN(10) && IN(pb + 7)) { FRESH();
            pg8::Gemm g{ws_bf(C, WS_PU), w_dn_t(C, l), NTOK, DM, DFF}; pg8::StaticOrder S; S.init(NTOK, DM, C.G, C.bid);
            pg8::EpiResF32 E{ws_f(C, WS_X), DM};
            pg8::gemm_phase<pg8::EpiResF32, pg8::StaticOrder, true, true>(C.lds, g, S, E);
            SEAM(pb + 7);
        }
        if (EN(8) && IN(pb + 8)) { FRESH();
            if (l + 1 < DEPTH) norm_phase(C, A.in[9] + (size_t)(l + 1) * DM, ws_bf(C, WS_H), nullptr);
            else norm_phase(C, A.in[22], nullptr, C.out);
            SEAM(pb + 8);
        }
    }
#undef IN
#undef SEAM
}

extern "C" void kernel_launch(void* const* d_in, const int* in_sizes, int n_in, void* d_out, int out_size, void* d_ws, size_t ws_size, hipStream_t stream) {
    static int grid = 0;
    if (grid == 0) {
        if (n_in != 23 || in_sizes[0] != NTP * DM || (size_t)out_size != OUT_TOTAL || ws_size < WS_END) {
            fprintf(stderr, "kernel_launch: unexpected shapes (n_in %d, in0 %d, out %d, ws %zu; need ws >= %zu); nothing launched\n", n_in, n_in > 0 ? in_sizes[0] : -1, out_size, ws_size, (size_t)WS_END); grid = -1; return; }
        int dev = 0, cus = 0, per_cu = 0;
        if (hipGetDevice(&dev) != hipSuccess || hipDeviceGetAttribute(&cus, hipDeviceAttributeMultiprocessorCount, dev) != hipSuccess) { fprintf(stderr, "kernel_launch: device query failed\n"); grid = -1; return; }
        if (hipFuncSetAttribute((const void*)fwd, hipFuncAttributeMaxDynamicSharedMemorySize, LDS_BYTES) != hipSuccess) { fprintf(stderr, "kernel_launch: hipFuncSetAttribute failed\n"); grid = -1; return; }
        if (hipOccupancyMaxActiveBlocksPerMultiprocessor(&per_cu, (const void*)fwd, NTHR, LDS_BYTES) != hipSuccess || per_cu < 1)
            fprintf(stderr, "kernel_launch: note: occupancy query reports %d workgroups per CU\n", per_cu);
        (void)hipGetLastError();
        grid = cus < 256 ? cus : 256;
    }
    if (grid < 0) return;
    if (hipMemsetAsync((char*)d_ws + WS_CTL, 0, CTL_ZERO_BYTES, stream) != hipSuccess) { fprintf(stderr, "kernel_launch: memset failed\n"); return; }
    Args a{};
    for (int i = 0; i < 23; ++i) a.in[i] = (const float*)d_in[i];
    a.out = (float*)d_out; a.ws = (unsigned char*)d_ws;
#if MK_ONE_LAUNCH
    a.ph_lo = 0; a.ph_hi = NPHASE;
    hipLaunchKernelGGL(fwd, dim3(grid), dim3(NTHR), LDS_BYTES, stream, a);
#else
    for (int p = 0; p < NPHASE; ++p) { a.ph_lo = p; a.ph_hi = p + 1; hipLaunchKernelGGL(fwd, dim3(grid), dim3(NTHR), LDS_BYTES, stream, a); }
#endif
    const hipError_t le = hipPeekAtLastError();
    if (le != hipSuccess) fprintf(stderr, "kernel_launch: launch failed: %s\n", hipGetErrorName(le));
}
```

```cpp
#include <hip/hip_runtime.h>
#include <cstdio>
#include <cstdint>
#include <cstddef>
namespace pg8 {
#define PG8_LAS __attribute__((address_space(3)))
typedef unsigned short bf16_t;
typedef short bf16x8 __attribute__((ext_vector_type(8)));
typedef float f32x4 __attribute__((ext_vector_type(4)));
typedef unsigned u32x4 __attribute__((ext_vector_type(4)));
constexpr int BM = 256, BK = 64, HALF = 128, HTB = HALF * BK * 2  , STAGE_BYTES = 8 * HTB, NXCD = 8, WGM = 8;

__host__ __device__ __forceinline__ int lds_byte(int r, int c) { const int st = (r >> 4) * 2 + (c >> 5), rr = r & 15, cc = c & 31, ob = rr * 64 + cc * 2; return st * 1024 + (ob ^ (((ob >> 9) & 1) << 5)); }
__host__ __device__ __forceinline__ void stage_rc(int b, int& R, int& C) { const int st = b / 1024, sb = b % 1024, swz = sb ^ (((sb >> 9) & 1) << 5); R = (st >> 1) * 16 + swz / 64; C = (st & 1) * 32 + (swz % 64) / 2; }
__host__ __device__ __forceinline__ int perm32(int rho) { const int n = rho >> 4, i = rho & 15; return 8 * (i >> 2) + 4 * n + (i & 3); }

struct Unit { int pm, pn, kq; };
struct Gemm { const bf16_t* A; const bf16_t* Bt; int M, N, K, ld; };

struct StaticOrder {
    int nM, nN, nwg, G, c;
    __host__ __device__ void init(int M, int N, int G_, int c_) { nM = M / BM; nN = N / BM; nwg = nM * nN; G = G_; c = c_; }
    __host__ __device__ bool next(int i, Unit& u) const {
        const long L = (long)i * G + c; if (L >= nwg) return false;
        int wgid = (int)L; { const int q = nwg / NXCD, r = nwg % NXCD, xcd = wgid % NXCD, off = wgid / NXCD; wgid = (xcd < r ? xcd * (q + 1) : r * (q + 1) + (xcd - r) * q) + off; }
        const int nig = WGM * nN, gid = wgid / nig, fm = gid * WGM, gsz = (nM - fm) < WGM ? (nM - fm) : WGM;
        u.pm = fm + ((wgid % nig) % gsz); u.pn = (wgid % nig) / gsz; u.kq = 0; return true;
    }
    __device__ __forceinline__ void a_ready(const Unit&) const {}
    __device__ __forceinline__ void done(const Unit&) const {}
};

struct SplitOrder {
    int pm0, npm, nN, nsplit, G, c;
    __host__ __device__ void init(int pm0_, int npm_, int nN_, int nsplit_, int G_, int c_) { pm0 = pm0_; npm = npm_; nN = nN_; nsplit = nsplit_; G = G_; c = c_; }
    __host__ __device__ bool next(int i, Unit& u) const {
        const long L = (long)i * G + c; if (L >= (long)npm * nN * nsplit) return false;
        const int w = (int)L; u.kq = w % nsplit; u.pn = (w / nsplit) % nN; u.pm = pm0 + w / (nsplit * nN); return true;
    }
    __device__ __forceinline__ void a_ready(const Unit&) const {}
    __device__ __forceinline__ void done(const Unit&) const {}
};

typedef float f32x2_t __attribute__((ext_vector_type(2)));
typedef __bf16 bf16x2_t __attribute__((ext_vector_type(2)));
__device__ __forceinline__ unsigned cvt_pk_bf16(float lo, float hi) { f32x2_t v = {lo, hi}; bf16x2_t b = __builtin_convertvector(v, bf16x2_t); return __builtin_bit_cast(unsigned, b); }

template <int ACT  > struct EpiBf16 {
    static constexpr bool PERM = true, AFTER_DRAIN = false;
    bf16_t* O; int ldc;
    __device__ __forceinline__ void operator()(const f32x4 (&acc)[2][2][4][2], const Unit& u, int wr, int wc, int fr, int fq) const {
        const int row0 = u.pm * BM + wr * 64 + fr; const int col0 = u.pn * BM + wc * 32 + 8 * fq;
#pragma unroll
        for (int ai = 0; ai < 2; ++ai)
#pragma unroll
            for (int m = 0; m < 4; ++m) { bf16_t* rowp = O + (size_t)(row0 + ai * HALF + m * 16) * ldc + col0;
#pragma unroll
                for (int bj = 0; bj < 2; ++bj) { f32x4 v0 = acc[ai][bj][m][0], v1 = acc[ai][bj][m][1];
                    if (ACT == 1) {
#pragma unroll
                        for (int j = 0; j < 4; ++j) { const float a = v0[j] > 0.f ? v0[j] : 0.f, b = v1[j] > 0.f ? v1[j] : 0.f; v0[j] = a * a; v1[j] = b * b; } }
                    u32x4 w; w.x = cvt_pk_bf16(v0[0], v0[1]); w.y = cvt_pk_bf16(v0[2], v0[3]); w.z = cvt_pk_bf16(v1[0], v1[1]); w.w = cvt_pk_bf16(v1[2], v1[3]);
                    *(u32x4*)(rowp + bj * HALF) = w; } }
    }
};
struct EpiResF32 {
    static constexpr bool PERM = false, AFTER_DRAIN = false;
    float* X; int ldc;
    __device__ __forceinline__ void operator()(const f32x4 (&acc)[2][2][4][2], const Unit& u, int wr, int wc, int fr, int fq) const {
        const int row0 = u.pm * BM + wr * 64 + fr, col0 = u.pn * BM + wc * 32 + 4 * fq;
#pragma unroll
        for (int ai = 0; ai < 2; ++ai)
#pragma unroll
            for (int m = 0; m < 4; ++m) { float* rowp = X + (size_t)(row0 + ai * HALF + m * 16) * ldc + col0;
                f32x4 b[2][2];
#pragma unroll
                for (int bj = 0; bj < 2; ++bj)
#pragma unroll
                    for (int n = 0; n < 2; ++n) b[bj][n] = *(const f32x4*)(rowp + bj * HALF + n * 16);
#pragma unroll
                for (int bj = 0; bj < 2; ++bj)
#pragma unroll
                    for (int n = 0; n < 2; ++n) *(f32x4*)(rowp + bj * HALF + n * 16) = b[bj][n] + acc[ai][bj][m][n];
                asm volatile("" ::: "memory"); }
    }
};

struct EpiSplitRes {
    static constexpr bool PERM = false, AFTER_DRAIN = false;
    float* X; int ldc; float* P; size_t pstride; int row0;
    __device__ __forceinline__ void operator()(const f32x4 (&acc)[2][2][4][2], const Unit& u, int wr, int wc, int fr, int fq) const {
        const int rowa = u.pm * BM + wr * 64 + fr, col0 = u.pn * BM + wc * 32 + 4 * fq;
        if (u.kq == 0) {
#pragma unroll
            for (int ai = 0; ai < 2; ++ai)
#pragma unroll
                for (int m = 0; m < 4; ++m) { float* rowp = X + (size_t)(rowa + ai * HALF + m * 16) * ldc + col0;
                    f32x4 b[2][2];
#pragma unroll
                    for (int bj = 0; bj < 2; ++bj)
#pragma unroll
                        for (int n = 0; n < 2; ++n) b[bj][n] = *(const f32x4*)(rowp + bj * HALF + n * 16);
#pragma unroll
                    for (int bj = 0; bj < 2; ++bj)
#pragma unroll
                        for (int n = 0; n < 2; ++n) *(f32x4*)(rowp + bj * HALF + n * 16) = b[bj][n] + acc[ai][bj][m][n];
                    asm volatile("" ::: "memory"); }
        } else {
            float* base = P + (size_t)(u.kq - 1) * pstride;
#pragma unroll
            for (int ai = 0; ai < 2; ++ai)
#pragma unroll
                for (int m = 0; m < 4; ++m) { float* rowp = base + (size_t)(rowa - row0 + ai * HALF + m * 16) * ldc + col0;
#pragma unroll
                    for (int bj = 0; bj < 2; ++bj)
#pragma unroll
                        for (int n = 0; n < 2; ++n) *(f32x4*)(rowp + bj * HALF + n * 16) = acc[ai][bj][m][n]; }
        }
    }
};
template <class Epi, class Sched, bool ALIGN_EPI = false, bool SP2 = false>
__device__ __forceinline__ void gemm_phase(PG8_LAS unsigned char* lds, const Gemm g, const Sched& S, const Epi& E) {
    int tid_ = threadIdx.x; asm volatile("" : "+v"(tid_));
    const int tid = tid_, wid = __builtin_amdgcn_readfirstlane(tid >> 6), lane = tid & 63, wr = wid >> 2, wc = wid & 3, fr = lane & 15, fq = lane >> 4;
    const int K = g.K, nt = K / BK, ld = g.ld;
    unsigned voffA[2], voffB[2];
#pragma unroll
    for (int i = 0; i < 2; ++i) { int R, C; stage_rc(tid * 16 + i * 8192, R, C); const int Rb = Epi::PERM ? ((R & ~31) + perm32(R & 31)) : R;
        voffA[i] = (unsigned)(R * ld + C) * 2u; voffB[i] = (unsigned)(Rb * ld + C) * 2u; }
    const size_t kstep = (size_t)(BK * 2);
    const size_t hstep = (size_t)HALF * ld * 2;
    const size_t tstep = 2 * hstep;
    const unsigned ldsw = (unsigned)wid * 1024u;
    const int aoff = lds_byte(wr * 64 + fr, fq * 8), boff = lds_byte(wc * 32 + fr, fq * 8);
#define PG8_SA(b, h) (((b) * 2 + (h)) * HTB)
#define PG8_SB(b, h) ((4 + (b) * 2 + (h)) * HTB)
#define PG8_STAGE(bufoff, gbase, voff) do { _Pragma("unroll") for (int _i = 0; _i < 2; ++_i) \
        __builtin_amdgcn_global_load_lds((const unsigned*)((const char*)(gbase) + (voff)[_i]), (PG8_LAS unsigned*)(lds + (bufoff) + ldsw + _i * 8192), 16, 0, 0); } while (0)
#define PG8_LDA(dst, b, h) do { _Pragma("unroll") for (int m = 0; m < 4; ++m) _Pragma("unroll") for (int k = 0; k < 2; ++k) dst[m][k] = *(const PG8_LAS bf16x8*)(lds + PG8_SA(b, h) + aoff + m * 2048 + k * 1024); } while (0)
#define PG8_LDB(dst, b, h) do { _Pragma("unroll") for (int n = 0; n < 2; ++n) _Pragma("unroll") for (int k = 0; k < 2; ++k) dst[n][k] = *(const PG8_LAS bf16x8*)(lds + PG8_SB(b, h) + boff + n * 2048 + k * 1024); } while (0)
#define PG8_MMA(ai, bj, At, Bt) do { __builtin_amdgcn_s_setprio(1); _Pragma("unroll") for (int m = 0; m < 4; ++m) _Pragma("unroll") for (int n = 0; n < 2; ++n) _Pragma("unroll") for (int k = 0; k < 2; ++k) \
        acc[ai][bj][m][n] = __builtin_amdgcn_mfma_f32_16x16x32_bf16(Bt[n][k], At[m][k], acc[ai][bj][m][n], 0, 0, 0); __builtin_amdgcn_s_setprio(0); } while (0)
#define PG8_WAIT_V(n) asm volatile("s_waitcnt vmcnt(" #n ")" ::: "memory")
#define PG8_WAIT_L(n) asm volatile("s_waitcnt lgkmcnt(" #n ")" ::: "memory")
#define PG8_BAR __builtin_amdgcn_s_barrier()
#define PG8_SCHED __builtin_amdgcn_sched_barrier(0)
    Unit cur, nxt; int ui = 0;
    if (!S.next(0, cur)) return;
    f32x4 acc[2][2][4][2];
#pragma unroll
    for (int a = 0; a < 2; ++a)
#pragma unroll
        for (int b = 0; b < 2; ++b)
#pragma unroll
            for (int m = 0; m < 4; ++m)
#pragma unroll
                for (int n = 0; n < 2; ++n) acc[a][b][m][n] = (f32x4){0.f, 0.f, 0.f, 0.f};
    bf16x8 At[4][2], B0[2][2], B1[2][2];
    const char* cA = (const char*)g.A + (size_t)cur.pm * tstep + (size_t)cur.kq * K * 2; const char* cB = (const char*)g.Bt + (size_t)cur.pn * tstep + (size_t)cur.kq * K * 2;
    S.a_ready(cur);
    if constexpr (SP2) {
        PG8_STAGE(PG8_SB(0, 0), cB, voffB); PG8_STAGE(PG8_SB(0, 1), cB + hstep, voffB); PG8_STAGE(PG8_SA(0, 0), cA, voffA); PG8_STAGE(PG8_SA(0, 1), cA + hstep, voffA);
        if (wr == 1) PG8_BAR;
        PG8_WAIT_V(2); PG8_BAR;
        PG8_STAGE(PG8_SB(1, 0), cB + kstep, voffB); PG8_STAGE(PG8_SA(1, 0), cA + kstep, voffA); PG8_STAGE(PG8_SB(1, 1), cB + hstep + kstep, voffB);
        PG8_WAIT_V(6); PG8_BAR;
    } else {
        PG8_STAGE(PG8_SB(0, 0), cB, voffB); PG8_STAGE(PG8_SA(0, 0), cA, voffA); PG8_STAGE(PG8_SB(0, 1), cB + hstep, voffB); PG8_STAGE(PG8_SA(0, 1), cA + hstep, voffA);
        if (wr == 1) PG8_BAR;
        PG8_WAIT_V(4); PG8_BAR;
        PG8_STAGE(PG8_SB(1, 0), cB + kstep, voffB); PG8_STAGE(PG8_SA(1, 0), cA + kstep, voffA); PG8_STAGE(PG8_SB(1, 1), cB + hstep + kstep, voffB);
        PG8_WAIT_V(6); PG8_BAR;
    }
    for (;;) {
        const bool has_next = S.next(ui + 1, nxt);
        const char* nA = has_next ? (const char*)g.A + (size_t)nxt.pm * tstep + (size_t)nxt.kq * K * 2 : cA; const char* nB = has_next ? (const char*)g.Bt + (size_t)nxt.pn * tstep + (size_t)nxt.kq * K * 2 : cB;
        for (int t = 0; t < nt; t += 2) {
            const bool last = (t == nt - 2);
            const char* a1 = cA + (size_t)(t + 1) * kstep;
            const char* a2 = last ? nA : cA + (size_t)(t + 2) * kstep; const char* b2 = last ? nB : cB + (size_t)(t + 2) * kstep;
            const char* a3 = a2 + kstep; const char* b3 = b2 + kstep;
            if (last && has_next) S.a_ready(nxt);
            if constexpr (SP2) {
            PG8_LDB(B0, 0, 0); PG8_LDB(B1, 0, 1); PG8_SCHED; PG8_LDA(At, 0, 0); PG8_STAGE(PG8_SA(1, 1), a1 + hstep, voffA);
            PG8_WAIT_V(8); PG8_WAIT_L(0); PG8_BAR; PG8_MMA(0, 0, At, B0); PG8_MMA(0, 1, At, B1); PG8_BAR; PG8_SCHED;
            PG8_LDA(At, 0, 1); PG8_STAGE(PG8_SB(0, 0), b2, voffB); PG8_STAGE(PG8_SB(0, 1), b2 + hstep, voffB); PG8_STAGE(PG8_SA(0, 0), a2, voffA);
            PG8_WAIT_V(8); PG8_WAIT_L(0); PG8_BAR; PG8_MMA(1, 0, At, B0); PG8_MMA(1, 1, At, B1); PG8_BAR; PG8_SCHED;
            PG8_LDB(B0, 1, 0); PG8_LDB(B1, 1, 1); PG8_SCHED; PG8_LDA(At, 1, 0); PG8_STAGE(PG8_SA(0, 1), a2 + hstep, voffA);
            PG8_WAIT_V(8); PG8_WAIT_L(0); PG8_BAR; PG8_MMA(0, 0, At, B0); PG8_MMA(0, 1, At, B1); PG8_BAR; PG8_SCHED;
            PG8_LDA(At, 1, 1); PG8_STAGE(PG8_SB(1, 0), b3, voffB); PG8_STAGE(PG8_SB(1, 1), b3 + hstep, voffB); PG8_STAGE(PG8_SA(1, 0), a3, voffA);
            PG8_WAIT_V(8); PG8_WAIT_L(0); PG8_BAR; PG8_MMA(1, 0, At, B0); PG8_MMA(1, 1, At, B1); PG8_BAR; PG8_SCHED;
            } else {
            PG8_LDB(B0, 0, 0); PG8_SCHED; PG8_LDA(At, 0, 0); PG8_STAGE(PG8_SA(1, 1), a1 + hstep, voffA);
            PG8_WAIT_L(8); PG8_BAR; PG8_WAIT_L(0); PG8_MMA(0, 0, At, B0); PG8_BAR; PG8_SCHED;
            PG8_LDB(B1, 0, 1); PG8_STAGE(PG8_SB(0, 0), b2, voffB);
            PG8_BAR; PG8_WAIT_L(0); PG8_MMA(0, 1, At, B1); PG8_BAR;
            PG8_LDA(At, 0, 1); PG8_STAGE(PG8_SA(0, 0), a2, voffA);
            PG8_BAR; PG8_WAIT_L(0); PG8_MMA(1, 0, At, B0); PG8_BAR; PG8_SCHED;
            PG8_STAGE(PG8_SB(0, 1), b2 + hstep, voffB);
            PG8_WAIT_V(6); PG8_BAR; PG8_MMA(1, 1, At, B1); PG8_BAR;
            PG8_LDB(B0, 1, 0); PG8_SCHED; PG8_LDA(At, 1, 0); PG8_STAGE(PG8_SA(0, 1), a2 + hstep, voffA);
            PG8_WAIT_L(8); PG8_BAR; PG8_WAIT_L(0); PG8_MMA(0, 0, At, B0); PG8_BAR; PG8_SCHED;
            PG8_LDB(B1, 1, 1); PG8_STAGE(PG8_SB(1, 0), b3, voffB);
            PG8_BAR; PG8_WAIT_L(0); PG8_MMA(0, 1, At, B1); PG8_BAR;
            PG8_LDA(At, 1, 1); PG8_STAGE(PG8_SA(1, 0), a3, voffA);
            PG8_BAR; PG8_WAIT_L(0); PG8_MMA(1, 0, At, B0); PG8_BAR; PG8_SCHED;
            PG8_STAGE(PG8_SB(1, 1), b3 + hstep, voffB);
            PG8_WAIT_V(6); PG8_BAR; PG8_MMA(1, 1, At, B1); PG8_BAR;
            }
        }
        if constexpr (ALIGN_EPI) { if (wr == 0) PG8_BAR; }
        if constexpr (!Epi::AFTER_DRAIN) { E(acc, cur, wr, wc, fr, fq); S.done(cur); }
        if (!has_next) break;
#pragma unroll
        for (int a = 0; a < 2; ++a)
#pragma unroll
            for (int b = 0; b < 2; ++b)
#pragma unroll
                for (int m = 0; m < 4; ++m)
#pragma unroll
                    for (int n = 0; n < 2; ++n) acc[a][b][m][n] = (f32x4){0.f, 0.f, 0.f, 0.f};
        cur = nxt; cA = nA; cB = nB; ++ui;
        if constexpr (ALIGN_EPI) { if (wr == 1) PG8_BAR; }
    }
    PG8_WAIT_V(0);
    if constexpr (!ALIGN_EPI) { if (wr == 0) PG8_BAR; }
    PG8_BAR;
    if constexpr (Epi::AFTER_DRAIN) { E.fused(acc, cur, wr, wc, fr, fq, lds, wid, lane); S.done(cur); }
#undef PG8_SA
#undef PG8_SB
#undef PG8_STAGE
#undef PG8_LDA
#undef PG8_LDB
#undef PG8_MMA
#undef PG8_WAIT_V
#undef PG8_WAIT_L
#undef PG8_BAR
#undef PG8_SCHED
}
}

#define DI __device__ __forceinline__
#define LAS __attribute__((address_space(3)))
typedef unsigned short bf16;
typedef short bf16x8 __attribute__((ext_vector_type(8)));
typedef short s16x4 __attribute__((ext_vector_type(4)));
typedef short v4i16_t __attribute__((ext_vector_type(4)));
typedef float f32x4 __attribute__((ext_vector_type(4)));
typedef float f32x16 __attribute__((ext_vector_type(16)));
typedef unsigned u32x4 __attribute__((ext_vector_type(4)));
typedef unsigned u32x2 __attribute__((ext_vector_type(2)));

constexpr int DM = 2048, NB = 8, SEQ = 2048, DEPTH = 4, DBAT = 32, DSEQ = 64, PAST = 1024, BWIN = 512;
constexpr int NTP = NB * SEQ, NTS = DBAT * DSEQ, NTOK = NTP + NTS;
constexpr int INC = 7264, INP = 7424, DFF = 8192;
constexpr int C_AQ = 0, C_AK = 512, C_AV = 1024, C_IQ = 1536, C_IK = 2560, C_IW = 2624, C_BQ = 2640, C_BK = 3152, C_BV = 3664, C_CZ = 4176, C_XBC = 5200, C_DT = 7248;
constexpr float EPS = 1e-5f;
constexpr int NWAVES = 8, NTHR = 512;

constexpr size_t SZ_YP = (size_t)NTP * DM, SZ_YS = (size_t)NTS * DM;
constexpr size_t SZ_PAK = (size_t)DEPTH * NB * SEQ * 512, SZ_PKI = (size_t)DEPTH * NB * SEQ * 64, SZ_PBK = (size_t)DEPTH * NB * BWIN * 512;
constexpr size_t SZ_PSSM = (size_t)DEPTH * NB * 16 * 64 * 128, SZ_PCONV = (size_t)DEPTH * NB * 3 * 2048;
constexpr size_t SZ_SAK = (size_t)DEPTH * DBAT * DSEQ * 512, SZ_SKI = (size_t)DEPTH * DBAT * DSEQ * 64, SZ_SBK = SZ_SAK;
constexpr size_t SZ_SSSM = (size_t)DEPTH * DBAT * 16 * 64 * 128, SZ_SCONV = (size_t)DEPTH * DBAT * 3 * 2048;
constexpr size_t OFF_YP = 0, OFF_YS = OFF_YP + SZ_YP, OFF_P_AK = OFF_YS + SZ_YS, OFF_P_AV = OFF_P_AK + SZ_PAK, OFF_P_KI = OFF_P_AV + SZ_PAK,
                 OFF_P_BK = OFF_P_KI + SZ_PKI, OFF_P_BV = OFF_P_BK + SZ_PBK, OFF_P_SSM = OFF_P_BV + SZ_PBK, OFF_P_CONV = OFF_P_SSM + SZ_PSSM,
                 OFF_S_AK = OFF_P_CONV + SZ_PCONV, OFF_S_AV = OFF_S_AK + SZ_SAK, OFF_S_KI = OFF_S_AV + SZ_SAK, OFF_S_BK = OFF_S_KI + SZ_SKI,
                 OFF_S_BV = OFF_S_BK + SZ_SBK, OFF_S_SSM = OFF_S_BV + SZ_SBK, OFF_S_CONV = OFF_S_SSM + SZ_SSSM, OUT_TOTAL = OFF_S_CONV + SZ_SCONV;
static_assert(OUT_TOTAL == 165085184, "output size");

constexpr size_t MiB = 1u << 20;
constexpr size_t WS_CTL = 0, CTL_ZERO_BYTES = 1 * MiB;
constexpr size_t WS_ROPE = 1 * MiB;
constexpr size_t WS_W = 2 * MiB;
constexpr size_t W_IN_B = (size_t)INP * DM * 2, W_OUT_B = (size_t)DM * DM * 2, W_UP_B = (size_t)DFF * DM * 2, W_DN_B = (size_t)DM * DFF * 2, W_LAYER_B = W_IN_B + W_OUT_B + W_UP_B + W_DN_B;
static_assert(W_LAYER_B == 101 * MiB, "weights per layer");
constexpr size_t WS_X = WS_W + DEPTH * W_LAYER_B;
constexpr size_t WS_H = WS_X + (size_t)NTOK * DM * 4;
constexpr size_t WS_MIX = WS_H + (size_t)NTOK * DM * 2;
constexpr size_t WS_PU = WS_MIX + (size_t)NTOK * DM * 2;
constexpr size_t WS_XBC = WS_PU + (size_t)NTOK * DFF * 2;
constexpr size_t WS_G = WS_XBC + (size_t)NTOK * 2048 * 2;
constexpr size_t WS_DTS = WS_G + (size_t)NTOK * 1024 * 4;
constexpr size_t WS_CAK = WS_DTS + 2 * MiB;
constexpr size_t WS_CAV = WS_CAK + (size_t)DBAT * PAST * 512 * 2;
constexpr size_t WS_CBK = WS_CAV + (size_t)DBAT * PAST * 512 * 2;
constexpr size_t WS_CBV = WS_CBK + (size_t)DBAT * BWIN * 512 * 2;
constexpr size_t WS_CKI = WS_CBV + (size_t)DBAT * BWIN * 512 * 2;
constexpr size_t WS_SC = WS_CKI + (size_t)DBAT * PAST * 64 * 2;
constexpr size_t WS_END = WS_SC + (size_t)256 * 64 * 2048 * 4;
static_assert(WS_END == 1356 * MiB, "ws map");
constexpr int CW_BAR = 4096;
constexpr int CW_Q = 16384;

constexpr int RING_BYTES = 131072, LDSCTL_OFF = RING_BYTES, LDS_BYTES = 147456;
constexpr int ATT_SEL = 0;
constexpr int ATT_V = 16384, VSTR = 1088, ATT_END = ATT_V + 2 * 32 * VSTR;
constexpr int CSTR = 272, XSTR = 144, MSTR = 144, HSTR = 272;
constexpr int SSD_CS = 0, SSD_BS = SSD_CS + 64 * CSTR, SSD_XD = SSD_BS + 64 * CSTR, SSD_XDW = SSD_XD + 64 * XSTR, SSD_MS = SSD_XDW + 64 * XSTR,
              SSD_HS = SSD_MS + 64 * MSTR, SSD_VEC = SSD_HS + 2 * 64 * HSTR, SSD_Y = SSD_VEC + 1024, YSTR = 272, SSD_END = SSD_Y + 64 * YSTR;
static_assert(ATT_END <= RING_BYTES && SSD_END <= RING_BYTES, "phase scratch fits the ring region");

DI float bf2f(bf16 v) { return __uint_as_float(((unsigned)v) << 16); }
DI unsigned pk2(float lo, float hi) { return pg8::cvt_pk_bf16(lo, hi); }
DI bf16 f2bf(float f) { return (bf16)(pk2(f, 0.f) & 0xffffu); }
DI float wave_sum(float v) {
#pragma unroll
    for (int o = 1; o < 64; o <<= 1) v += __shfl_xor(v, o);
    return v;
}
DI f32x16 mfma32(bf16x8 a, bf16x8 b, f32x16 c) { return __builtin_amdgcn_mfma_f32_32x32x16_bf16(a, b, c, 0, 0, 0); }
DI int crow(int i, int hh) { return (i & 3) + 8 * (i >> 2) + 4 * hh; }
DI s16x4 tr_read(LAS unsigned char* p) { return __builtin_bit_cast(s16x4, __builtin_amdgcn_ds_read_tr16_b64_v4i16((LAS v4i16_t*)p)); }
DI bf16x8 trfrag(LAS unsigned char* tile, int stride, int k0, int c0, int lane) {
    const int i16 = lane & 15, qq = i16 >> 2, p = i16 & 3, g2 = (lane >> 4) & 1, hh = lane >> 5;
    LAS unsigned char* a = tile + (k0 + 8 * hh + qq) * stride + (c0 + 16 * g2 + 4 * p) * 2;
    const s16x4 lo = tr_read(a), hi = tr_read(a + 4 * stride);
    return __builtin_shufflevector(lo, hi, 0, 1, 2, 3, 4, 5, 6, 7);
}
DI void unpack8(u32x4 v, float (&f)[8]) {
#pragma unroll
    for (int i = 0; i < 4; ++i) { f[2 * i] = __uint_as_float(v[i] << 16); f[2 * i + 1] = __uint_as_float(v[i] & 0xffff0000u); }
}
DI u32x4 pack8(const float (&f)[8]) { u32x4 o; o.x = pk2(f[0], f[1]); o.y = pk2(f[2], f[3]); o.z = pk2(f[4], f[5]); o.w = pk2(f[6], f[7]); return o; }

#define XB_TMO      128
#define XB_XCNT(j)  (256  + 64 * (j))
#define XB_XSUB(j)  (1280 + 64 * (j))
#define XB_XGEN(j)  (2304 + 64 * (j))
#define XB_TOP      3328
#define XB_TOPGEN   3392
#define XCD_BAR_WORDS 3456
#define XB_SPIN_CAP (1u << 20)
DI unsigned xb_ld(unsigned* p)              { return __hip_atomic_load(p, __ATOMIC_RELAXED, __HIP_MEMORY_SCOPE_AGENT); }
DI unsigned xb_add(unsigned* p, unsigned v) { return __hip_atomic_fetch_add(p, v, __ATOMIC_RELAXED, __HIP_MEMORY_SCOPE_AGENT); }
DI unsigned xb_xcc_id() { return (unsigned)__builtin_amdgcn_s_getreg((3 << 11) | 20) & 0xFu; }
#define XB_SPIN(cond, bar) do { unsigned _sp = 0; while (cond) { __builtin_amdgcn_s_sleep(1); \
    if ((++_sp & 255u) == 0u) { if (xb_ld(&(bar)[XB_TMO])) break; if (_sp > XB_SPIN_CAP) { atomicAdd(&(bar)[XB_TMO], 1u); break; } } } } while (0)
struct XcdBarrier { unsigned* bar; unsigned x; volatile LAS unsigned* st; };
DI XcdBarrier xcd_barrier_post(unsigned* bar, volatile LAS unsigned* st) {
    XcdBarrier b; b.bar = bar; b.x = xb_xcc_id(); b.st = st;
    if (threadIdx.x == 0) (void)xb_add(&bar[XB_XCNT(b.x)], 1u);
    return b;
}
DI void xcd_barrier_complete(unsigned* bar, unsigned x, unsigned& nloc, unsigned& nx) {
    const unsigned G = gridDim.x * gridDim.y * gridDim.z;
    unsigned sum, cnt, mine, sp = 0u;
    for (;;) {
        sum = 0u; cnt = 0u; mine = 0u;
#pragma unroll
        for (unsigned j = 0; j < 16; ++j) { const unsigned c = xb_ld(&bar[XB_XCNT(j)]); sum += c; cnt += (c > 0u) ? 1u : 0u; mine = (j == x) ? c : mine; }
        if (sum == G) break;
        __builtin_amdgcn_s_sleep(1);
        if ((++sp & 255u) == 0u) { if (xb_ld(&bar[XB_TMO])) break; if (sp > XB_SPIN_CAP) { atomicAdd(&bar[XB_TMO], 1u); break; } }
    }
    nloc = mine > 0u ? mine : 1u; nx = cnt > 0u ? cnt : 1u;
}
DI void xcd_barrier(const XcdBarrier& b) {
    asm volatile("s_waitcnt vmcnt(0)" ::: "memory");
    __syncthreads();
    if (threadIdx.x == 0) {
        unsigned* bar = b.bar;
        __builtin_amdgcn_s_waitcnt(0);
        unsigned nloc = b.st[0], nx = b.st[1];
        if (nloc == 0u) { xcd_barrier_complete(bar, b.x, nloc, nx); b.st[0] = nloc; b.st[1] = nx; }
        const unsigned old = xb_add(&bar[XB_XSUB(b.x)], 1u);
        const unsigned gen = old / nloc;
        if (old + 1u == (gen + 1u) * nloc) {
            __builtin_amdgcn_fence(__ATOMIC_RELEASE, "agent");
            asm volatile("s_waitcnt vmcnt(0)" ::: "memory");
            const unsigned og = xb_add(&bar[XB_TOP], 1u);
            const unsigned tg = og / nx;
            if (og + 1u == (tg + 1u) * nx) xb_add(&bar[XB_TOPGEN], 1u);
            else XB_SPIN(xb_ld(&bar[XB_TOPGEN]) == tg, bar);
            __builtin_amdgcn_fence(__ATOMIC_ACQUIRE, "agent");
            xb_add(&bar[XB_XGEN(b.x)], 1u);
            asm volatile("s_waitcnt vmcnt(0)" ::: "memory");
        } else {
            XB_SPIN(xb_ld(&bar[XB_XGEN(b.x)]) == gen, bar);
            __builtin_amdgcn_fence(__ATOMIC_ACQUIRE, "agent");
            asm volatile("s_waitcnt vmcnt(0)" ::: "memory");
        }
    }
    __syncthreads();
}

struct Args { const float* in[23]; float* out; unsigned char* ws; int ph_lo, ph_hi; };
static_assert(sizeof(Args) == 23 * 8 + 8 + 8 + 8, "Args has no padding");
struct Ctx {
    LAS unsigned char* lds;
    unsigned* ctl;
    int tid, lane, wave, G, bid;
    float* out;
    unsigned char* ws;
};
DI bf16* ws_bf(const Ctx& C, size_t off) { return (bf16*)(C.ws + off); }
DI float* ws_f(const Ctx& C, size_t off) { return (float*)(C.ws + off); }
DI bf16* w_in_t(const Ctx& C, int l)  { return (bf16*)(C.ws + WS_W + (size_t)l * W_LAYER_B); }
DI bf16* w_out_t(const Ctx& C, int l) { return (bf16*)(C.ws + WS_W + (size_t)l * W_LAYER_B + W_IN_B); }
DI bf16* w_up_t(const Ctx& C, int l)  { return (bf16*)(C.ws + WS_W + (size_t)l * W_LAYER_B + W_IN_B + W_OUT_B); }
DI bf16* w_dn_t(const Ctx& C, int l)  { return (bf16*)(C.ws + WS_W + (size_t)l * W_LAYER_B + W_IN_B + W_OUT_B + W_UP_B); }

DI int q_next(const Ctx& C, unsigned* head) {
    volatile LAS int* slot = (volatile LAS int*)(C.lds + LDSCTL_OFF + 64);
    __syncthreads();
    if (C.tid == 0) *slot = (int)__hip_atomic_fetch_add(head, 1u, __ATOMIC_RELAXED, __HIP_MEMORY_SCOPE_AGENT);
    __syncthreads();
    return *slot;
}

DI void p0_transpose_item(const float* W, int K, int N, bf16* WT, LAS float* scr, int item, int lane) {
    const int nblk = N / 32, kb = item / nblk, nb = item % nblk, k0 = 64 * kb, n0 = 32 * nb;
#pragma unroll 8
    for (int i = 0; i < 32; ++i) { const int kk = 2 * i + (lane >> 5); scr[kk * 33 + (lane & 31)] = W[(size_t)(k0 + kk) * N + n0 + (lane & 31)]; }
    asm volatile("s_waitcnt lgkmcnt(0)" ::: "memory");
    const int c = lane & 7;
#pragma unroll
    for (int j = 0; j < 4; ++j) { const int n = (lane >> 3) + 8 * j; const LAS float* s = scr + (8 * c) * 33 + n;
        u32x4 o; o.x = pk2(s[0 * 33], s[1 * 33]); o.y = pk2(s[2 * 33], s[3 * 33]); o.z = pk2(s[4 * 33], s[5 * 33]); o.w = pk2(s[6 * 33], s[7 * 33]);
        *(u32x4*)(WT + (size_t)(n0 + n) * K + k0 + 8 * c) = o; }
    asm volatile("s_waitcnt lgkmcnt(0)" ::: "memory");
}
DI void rms_row(const float* src, float* xcopy, const float* w, bf16* outb, float* outf, int lane, const float* part = nullptr, size_t pstride = 0) {
    f32x4 v[8]; float ss = 0.f;
#pragma unroll
    for (int j = 0; j < 8; ++j) { v[j] = ((const f32x4*)src)[lane + 64 * j];
        if (part) { v[j] += ((const f32x4*)part)[lane + 64 * j]; v[j] += ((const f32x4*)(part + pstride))[lane + 64 * j]; v[j] += ((const f32x4*)(part + 2 * pstride))[lane + 64 * j]; }
        ss += (v[j].x * v[j].x + v[j].y * v[j].y) + (v[j].z * v[j].z + v[j].w * v[j].w); }
    if (xcopy) {
#pragma unroll
        for (int j = 0; j < 8; ++j) ((f32x4*)xcopy)[lane + 64 * j] = v[j];
    }
    ss = wave_sum(ss);
    const float rs = 1.0f / sqrtf(ss * (1.0f / DM) + EPS);
#pragma unroll
    for (int j = 0; j < 8; ++j) { const f32x4 wv = ((const f32x4*)w)[lane + 64 * j]; const f32x4 o = v[j] * rs * wv;
        if (outb) { u32x2 p; p.x = pk2(o.x, o.y); p.y = pk2(o.z, o.w); ((u32x2*)outb)[lane + 64 * j] = p; }
        if (outf) ((f32x4*)outf)[lane + 64 * j] = o; }
}
DI void sincos_tab(float ang, float& c, float& s) {
    const double a = (double)ang; const double kq = rint(a * 0.63661977236758134308); const double x = a - kq * 1.57079632679489661923; const double x2 = x * x;
    const double sn = x * (1.0 + x2 * (-1.0 / 6 + x2 * (1.0 / 120 + x2 * (-1.0 / 5040 + x2 * (1.0 / 362880 + x2 * (-1.0 / 39916800 + x2 * (1.0 / 6227020800.0)))))));
    const double cn = 1.0 + x2 * (-0.5 + x2 * (1.0 / 24 + x2 * (-1.0 / 720 + x2 * (1.0 / 40320 + x2 * (-1.0 / 3628800 + x2 * (1.0 / 479001600 + x2 * (-1.0 / 87178291200.0)))))));
    const int q = ((int)kq) & 3;
    const double cc = (q == 0) ? cn : (q == 1) ? -sn : (q == 2) ? -cn : sn;
    const double sc = (q == 0) ? sn : (q == 1) ? cn : (q == 2) ? -sn : -cn;
    c = (float)cc; s = (float)sc;
}
DI void p0_prologue(const Ctx& C, const Args& A) {
    LAS float* scr = (LAS float*)(C.lds + C.wave * 16384);
    const int gw = C.bid * NWAVES + C.wave, NGW = C.G * NWAVES;
    constexpr int I_IN = (DM / 64) * (INC / 32), I_OUT = (DM / 64) * (DM / 32), I_UP = (DM / 64) * (DFF / 32), I_DN = (DFF / 64) * (DM / 32), I_L = I_IN + I_OUT + I_UP + I_DN;
    for (int it = gw; it < DEPTH * I_L; it += NGW) {
        const int l = it / I_L; int r = it % I_L;
        if (r < I_IN) { p0_transpose_item(A.in[10] + (size_t)l * DM * INC, DM, INC, w_in_t(C, l), scr, r, C.lane); continue; } r -= I_IN;
        if (r < I_OUT) { p0_transpose_item(A.in[11] + (size_t)l * DM * DM, DM, DM, w_out_t(C, l), scr, r, C.lane); continue; } r -= I_OUT;
        if (r < I_UP) { p0_transpose_item(A.in[20] + (size_t)l * DM * DFF, DM, DFF, w_up_t(C, l), scr, r, C.lane); continue; } r -= I_UP;
        p0_transpose_item(A.in[21] + (size_t)l * DFF * DM, DFF, DM, w_dn_t(C, l), scr, r, C.lane);
    }
    { const int gt = C.bid * NTHR + C.tid, NGT = C.G * NTHR; constexpr int CH_L = (INP - INC) * DM / 8;
      for (int i = gt; i < DEPTH * CH_L; i += NGT) { const int l = i / CH_L, c = i % CH_L; ((u32x4*)(w_in_t(C, l) + (size_t)INC * DM))[c] = (u32x4){0u, 0u, 0u, 0u}; }
      float* ra = ws_f(C, WS_ROPE); float* ri = ra + 2048 * 16 * 2;
      for (int i = gt; i < 2048 * 24; i += NGT) { const int pos = i / 24, k = i % 24; const bool isa = k < 16; const int fi = isa ? k : k - 16;
          const double ex = isa ? (double)fi / 16.0 : (double)fi / 8.0; const float inv = (float)exp2(-ex * 18.931568569324174  );
          const float ang = (float)pos * inv; float c, s; sincos_tab(ang, c, s);
          float* dst = isa ? ra + (pos * 16 + fi) * 2 : ri + (pos * 8 + fi) * 2; dst[0] = c; dst[1] = s; } }
    for (int m = gw; m < NTOK; m += NGW) { const float* src = m < NTP ? A.in[0] + (size_t)m * DM : A.in[1] + (size_t)(m - NTP) * DM;
        rms_row(src, ws_f(C, WS_X) + (size_t)m * DM, A.in[9], ws_bf(C, WS_H) + (size_t)m * DM, nullptr, C.lane); }
}

DI void cvt_store8(const bf16* src, float* dst) {
    const u32x4 v = *(const u32x4*)src; float f[8]; unpack8(v, f);
    ((f32x4*)dst)[0] = (f32x4){f[0], f[1], f[2], f[3]}; ((f32x4*)dst)[1] = (f32x4){f[4], f[5], f[6], f[7]};
}
DI void m0_row(const Ctx& C, const Args& A, int l, int r, int lane) {
    bf16* P = ws_bf(C, WS_PU) + (size_t)r * INP;
    const bool smp = r >= NTP; int b, t, pos;
    if (!smp) { b = r >> 11; t = r & 2047; pos = t; } else { const int rr = r - NTP; b = rr >> 6; t = rr & 63; pos = PAST + t; }
    float* out = C.out;
    float* o_ak = smp ? out + OFF_S_AK + ((size_t)(l * DBAT + b) * DSEQ + t) * 512 : out + OFF_P_AK + ((size_t)(l * NB + b) * SEQ + t) * 512;
    float* o_av = smp ? out + OFF_S_AV + ((size_t)(l * DBAT + b) * DSEQ + t) * 512 : out + OFF_P_AV + ((size_t)(l * NB + b) * SEQ + t) * 512;
    float* o_ki = smp ? out + OFF_S_KI + ((size_t)(l * DBAT + b) * DSEQ + t) * 64 : out + OFF_P_KI + ((size_t)(l * NB + b) * SEQ + t) * 64;
    const float* ropeA = ws_f(C, WS_ROPE) + (size_t)pos * 32; const float* ropeI = ws_f(C, WS_ROPE) + 2048 * 32 + (size_t)pos * 16;
    {
        const int i = lane & 15, c1 = (lane >> 4) * 128 + i, c2 = c1 + 16; const float cs = ropeA[2 * i], sn = ropeA[2 * i + 1];
        float x1 = bf2f(P[C_AQ + c1]), x2 = bf2f(P[C_AQ + c2]);
        P[C_AQ + c1] = f2bf(x1 * cs - x2 * sn); P[C_AQ + c2] = f2bf(x2 * cs + x1 * sn);
        x1 = bf2f(P[C_AK + c1]); x2 = bf2f(P[C_AK + c2]);
        const float y1 = x1 * cs - x2 * sn, y2 = x2 * cs + x1 * sn;
        P[C_AK + c1] = f2bf(y1); P[C_AK + c2] = f2bf(y2); o_ak[c1] = y1; o_ak[c2] = y2;
    }
    if (lane < 48) { const int col = (lane / 12) * 128 + 32 + (lane % 12) * 8; cvt_store8(P + C_AK + col, o_ak + col); }
    cvt_store8(P + C_AV + lane * 8, o_av + lane * 8);
#pragma unroll
    for (int k = 0; k < 2; ++k) {
        const int pid = lane + 64 * k, i = pid & 7, c1 = C_IQ + (pid >> 3) * 64 + i, c2 = c1 + 8; const float cs = ropeI[2 * i], sn = ropeI[2 * i + 1];
        const float x1 = bf2f(P[c1]), x2 = bf2f(P[c2]);
        P[c1] = f2bf(x1 * cs - x2 * sn); P[c2] = f2bf(x2 * cs + x1 * sn);
    }
    if (lane < 8) { const int i = lane; const float cs = ropeI[2 * i], sn = ropeI[2 * i + 1];
        const float x1 = bf2f(P[C_IK + i]), x2 = bf2f(P[C_IK + i + 8]); const float y1 = x1 * cs - x2 * sn, y2 = x2 * cs + x1 * sn;
        P[C_IK + i] = f2bf(y1); P[C_IK + i + 8] = f2bf(y2); o_ki[i] = y1; o_ki[i + 8] = y2;
    } else if (lane < 14) { const int col = 16 + (lane - 8) * 8; cvt_store8(P + C_IK + col, o_ki + col); }
    const bool keep = smp || t >= SEQ - BWIN;
    if (keep) {
        const size_t ro = smp ? ((size_t)(l * DBAT + b) * DSEQ + t) * 512 : ((size_t)(l * NB + b) * BWIN + (t - (SEQ - BWIN))) * 512;
        float* o_bk = out + (smp ? OFF_S_BK : OFF_P_BK) + ro; float* o_bv = out + (smp ? OFF_S_BV : OFF_P_BV) + ro;
        cvt_store8(P + C_BK + lane * 8, o_bk + lane * 8); cvt_store8(P + C_BV + lane * 8, o_bv + lane * 8);
    }
    if (lane < 16) { const float x = bf2f(P[C_DT + lane]) + A.in[15][l * 16 + lane];
        const float sp = x > 20.f ? x : log1pf(__expf(x)); ws_f(C, WS_DTS)[(size_t)r * 16 + lane] = sp; }
    const float* cw = A.in[13] + (size_t)l * 4 * 2048; const float* cb = A.in[14] + (size_t)l * 2048;
    const float* sconv = A.in[8] + (size_t)(l * DBAT + b) * 3 * 2048;
    bf16* xo = ws_bf(C, WS_XBC) + (size_t)r * 2048;
    const int stt = smp ? DSEQ - 3 : SEQ - 3;
    float* o_conv = (t >= stt) ? (smp ? out + OFF_S_CONV + ((size_t)(l * DBAT + b) * 3 + (t - stt)) * 2048 : out + OFF_P_CONV + ((size_t)(l * NB + b) * 3 + (t - stt)) * 2048) : nullptr;
#pragma unroll 1
    for (int it = 0; it < 4; ++it) {
        const int ch = (lane + 64 * it) * 8;
        float acc[8], x[8];
        { const f32x4 b0 = *(const f32x4*)(cb + ch), b1 = *(const f32x4*)(cb + ch + 4); acc[0] = b0.x; acc[1] = b0.y; acc[2] = b0.z; acc[3] = b0.w; acc[4] = b1.x; acc[5] = b1.y; acc[6] = b1.z; acc[7] = b1.w; }
#pragma unroll
        for (int j = 0; j < 4; ++j) {
            const int tt = t - 3 + j; bool have = true;
            if (tt >= 0) { unpack8(*(const u32x4*)(P + (ptrdiff_t)(j - 3) * INP + C_XBC + ch), x); }
            else if (smp) { const float* sp = sconv + (size_t)(3 + tt) * 2048 + ch; const f32x4 s0 = *(const f32x4*)sp, s1 = *(const f32x4*)(sp + 4);
                x[0] = s0.x; x[1] = s0.y; x[2] = s0.z; x[3] = s0.w; x[4] = s1.x; x[5] = s1.y; x[6] = s1.z; x[7] = s1.w; }
            else have = false;
            if (have) { const f32x4 w0 = *(const f32x4*)(cw + j * 2048 + ch), w1 = *(const f32x4*)(cw + j * 2048 + ch + 4);
                acc[0] += x[0] * w0.x; acc[1] += x[1] * w0.y; acc[2] += x[2] * w0.z; acc[3] += x[3] * w0.w; acc[4] += x[4] * w1.x; acc[5] += x[5] * w1.y; acc[6] += x[6] * w1.z; acc[7] += x[7] * w1.w; }
        }
        if (o_conv) { ((f32x4*)(o_conv + ch))[0] = (f32x4){x[0], x[1], x[2], x[3]}; ((f32x4*)(o_conv + ch))[1] = (f32x4){x[4], x[5], x[6], x[7]}; }
#pragma unroll
        for (int k = 0; k < 8; ++k) acc[k] = acc[k] / (1.f + __expf(-acc[k]));
        *(u32x4*)(xo + ch) = pack8(acc);
    }
}
DI void cvt_chunks(const float* src, bf16* dst, size_t nchunk, size_t gt, size_t ngt) {
    for (size_t i = gt; i < nchunk; i += ngt) { const f32x4 a = ((const f32x4*)src)[2 * i], b = ((const f32x4*)src)[2 * i + 1];
        u32x4 o; o.x = pk2(a.x, a.y); o.y = pk2(a.z, a.w); o.z = pk2(b.x, b.y); o.w = pk2(b.z, b.w); ((u32x4*)dst)[i] = o; }
}
DI void m0_phase(const Ctx& C, const Args& A, int l) {
    const int gw = C.bid * NWAVES + C.wave, NGW = C.G * NWAVES;
    for (int r = gw; r < NTOK; r += NGW) m0_row(C, A, l, r, C.lane);
    const size_t gt = (size_t)C.bid * NTHR + C.tid, ngt = (size_t)C.G * NTHR;
    cvt_chunks(A.in[2] + (size_t)l * DBAT * PAST * 512, ws_bf(C, WS_CAK), (size_t)DBAT * PAST * 512 / 8, gt, ngt);
    cvt_chunks(A.in[3] + (size_t)l * DBAT * PAST * 512, ws_bf(C, WS_CAV), (size_t)DBAT * PAST * 512 / 8, gt, ngt);
    cvt_chunks(A.in[4] + (size_t)l * DBAT * PAST * 64, ws_bf(C, WS_CKI), (size_t)DBAT * PAST * 64 / 8, gt, ngt);
    cvt_chunks(A.in[5] + (size_t)l * DBAT * BWIN * 512, ws_bf(C, WS_CBK), (size_t)DBAT * BWIN * 512 / 8, gt, ngt);
    cvt_chunks(A.in[6] + (size_t)l * DBAT * BWIN * 512, ws_bf(C, WS_CBV), (size_t)DBAT * BWIN * 512 / 8, gt, ngt);
}

struct KVSrc { const bf16* k0; const bf16* v0; int s0; int n0; const bf16* k1; const bf16* v1; int s1; };
template <int MODE>
DI void attn_unit(const Ctx& C, const bf16* Qp, int qstride, const KVSrc& S, int tile_lo, int tile_hi, bf16* Op, int ostride) {
    int tid = C.tid, lane = C.lane; asm volatile("" : "+v"(tid), "+v"(lane));
    const int w = C.wave, r = lane & 31, hh = lane >> 5;
    const int head = w >> 1, q = (w & 1) * 32 + r;
    LAS unsigned char* Vs = C.lds + ATT_V;
    bf16x8 qf[8];
    { const bf16* qrow = Qp + (size_t)q * qstride + head * 128 + 8 * hh;
#pragma unroll
      for (int ks = 0; ks < 8; ++ks) qf[ks] = *(const bf16x8*)(qrow + 16 * ks); }
    f32x16 o[4];
#pragma unroll
    for (int d = 0; d < 4; ++d)
#pragma unroll
        for (int i = 0; i < 16; ++i) o[d][i] = 0.f;
    float m = -1e30f, lsum = 0.f;
    constexpr float SC2 = 0.08838834764831845f * 1.4426950408889634f;
    constexpr float L2E = 1.4426950408889634f;
    bf16x8 kf[8]; u32x4 vr[4];
#define ATT_KLOAD(tile_) do { const int key_ = (tile_) * 32 + r; const bf16* kp_ = (key_ < S.n0 ? S.k0 + (ptrdiff_t)key_ * S.s0 : S.k1 + (ptrdiff_t)(key_ - S.n0) * S.s1) + head * 128 + 8 * hh; \
        _Pragma("unroll") for (int ks_ = 0; ks_ < 8; ++ks_) kf[ks_] = *(const bf16x8*)(kp_ + 16 * ks_); } while (0)
#define ATT_VLOAD(tile_) do { _Pragma("unroll") for (int i_ = 0; i_ < 4; ++i_) { const int ci_ = tid + 512 * i_, row_ = ci_ >> 6, ch_ = ci_ & 63, key_ = (tile_) * 32 + row_; \
        const bf16* vp_ = key_ < S.n0 ? S.v0 + (ptrdiff_t)key_ * S.s0 : S.v1 + (ptrdiff_t)(key_ - S.n0) * S.s1; vr[i_] = *(const u32x4*)(vp_ + ch_ * 8); } } while (0)
#define ATT_VSTORE(buf_) do { _Pragma("unroll") for (int i_ = 0; i_ < 4; ++i_) { const int ci_ = tid + 512 * i_, row_ = ci_ >> 6, ch_ = ci_ & 63; \
        *(LAS u32x4*)(Vs + (buf_) * (32 * VSTR) + row_ * VSTR + ch_ * 16) = vr[i_]; } } while (0)
    ATT_KLOAD(tile_lo); ATT_VLOAD(tile_lo);
    __syncthreads();
    ATT_VSTORE(0);
    if (tile_lo + 1 < tile_hi) ATT_VLOAD(tile_lo + 1);
    __syncthreads();
    const int i16 = lane & 15;
    LAS unsigned char* vbase = Vs + (4 * hh + (i16 >> 2)) * VSTR + (head * 128 + 16 * ((lane >> 4) & 1) + 4 * (i16 & 3)) * 2;
    const LAS float* btab = (const LAS float*)(C.lds + ATT_SEL) + head * 257;
    const LAS unsigned* sel = (const LAS unsigned*)(C.lds + ATT_SEL) + q * 64;
#pragma unroll 1
    for (int tile = tile_lo; tile < tile_hi; ++tile) {
        const int cur = (tile - tile_lo) & 1;
        f32x16 s;
        if (MODE == 0) {
            const unsigned nwd = ~(sel[tile] >> (4 * hh));
#pragma unroll
            for (int i = 0; i < 16; ++i) { const int mb = ((int)(nwd << (31 - ((i & 3) + 8 * (i >> 2))))) >> 31; s[i] = __int_as_float(mb & (int)0xFF800000); }
        } else {
            if (tile <= 11) { const float bb = btab[256] * (L2E / SC2);
#pragma unroll
                for (int i = 0; i < 16; ++i) s[i] = bb;
            } else {
#pragma unroll
                for (int i = 0; i < 16; ++i) { int rel = BWIN + q - (tile * 32 + crow(i, hh)); rel = rel > 128 ? 128 : rel; s[i] = btab[rel + 128] * (L2E / SC2); }
            }
        }
#pragma unroll
        for (int ks = 0; ks < 8; ++ks) s = mfma32(kf[ks], qf[ks], s);
        if (tile + 1 < tile_hi) ATT_KLOAD(tile + 1);
        float mx = s[0];
#pragma unroll
        for (int i = 1; i < 16; ++i) mx = fmaxf(mx, s[i]);
        mx = fmaxf(mx, __shfl_xor(mx, 32)) * SC2;
        const bool need = mx > m + 8.0f;
        if (__any(need)) {
            const float mn = need ? mx : m, alpha = __builtin_amdgcn_exp2f(m - mn);
            lsum *= alpha; m = mn;
#pragma unroll
            for (int d = 0; d < 4; ++d)
#pragma unroll
                for (int i = 0; i < 16; ++i) o[d][i] *= alpha;
        }
        float rs = 0.f;
#pragma unroll
        for (int i = 0; i < 16; ++i) { s[i] = __builtin_amdgcn_exp2f(__builtin_fmaf(s[i], SC2, -m)); rs += s[i]; }
        rs += __shfl_xor(rs, 32);
        lsum += rs;
        bf16x8 pf[2];
#pragma unroll
        for (int s2 = 0; s2 < 2; ++s2) { u32x4 pk; pk.x = pk2(s[8 * s2], s[8 * s2 + 1]); pk.y = pk2(s[8 * s2 + 2], s[8 * s2 + 3]); pk.z = pk2(s[8 * s2 + 4], s[8 * s2 + 5]); pk.w = pk2(s[8 * s2 + 6], s[8 * s2 + 7]);
            pf[s2] = __builtin_bit_cast(bf16x8, pk); }
        LAS unsigned char* vb = vbase + cur * (32 * VSTR);
#pragma unroll
        for (int d = 0; d < 4; ++d)
#pragma unroll
            for (int s2 = 0; s2 < 2; ++s2) {
                const s16x4 lo = tr_read(vb + (16 * s2) * VSTR + d * 64), hi = tr_read(vb + (16 * s2 + 8) * VSTR + d * 64);
                const bf16x8 vt = __builtin_shufflevector(lo, hi, 0, 1, 2, 3, 4, 5, 6, 7);
                o[d] = mfma32(vt, pf[s2], o[d]);
            }
        if (tile + 1 < tile_hi) { ATT_VSTORE(cur ^ 1); if (tile + 2 < tile_hi) ATT_VLOAD(tile + 2); }
        __syncthreads();
    }
#undef ATT_KLOAD
#undef ATT_VLOAD
#undef ATT_VSTORE
    const float inv = 1.0f / lsum;
    bf16* orow = Op + (size_t)q * ostride + head * 128 + 4 * hh;
#pragma unroll
    for (int d = 0; d < 4; ++d)
#pragma unroll
        for (int g = 0; g < 4; ++g) { u32x2 p; p.x = pk2(o[d][4 * g] * inv, o[d][4 * g + 1] * inv); p.y = pk2(o[d][4 * g + 2] * inv, o[d][4 * g + 3] * inv);
            *(u32x2*)(orow + 32 * d + 8 * g) = p; }
}

DI unsigned fkey(float f) { const unsigned u = __float_as_uint(f); return (u & 0x80000000u) ? ~u : (u | 0x80000000u); }
template <int NR>
DI void topk_pair(const float* SCq  , LAS unsigned* SELa  , int NT, int r, int hh, int lane) {
    unsigned v[NR];
#pragma unroll
    for (int i = 0; i < NR; ++i) { const float f = (i < NT) ? SCq[i * 32 + r] : -INFINITY; v[i] = fkey(f); }
    unsigned T = 0u;
#pragma unroll 1
    for (int bit = 31; bit >= 8; --bit) {
        const unsigned cand = T | (1u << bit); unsigned cnt = 0u;
#pragma unroll
        for (int i = 0; i < NR; ++i) asm("v_cmp_ge_u32 vcc, %1, %2\n\tv_addc_co_u32 %0, vcc, 0, %0, vcc" : "+v"(cnt) : "v"(v[i]), "v"(cand) : "vcc");
        unsigned t0 = 0u, t1 = 0u;
#pragma unroll
        for (int b = 0; b < 7; ++b) { const unsigned long long mk = __ballot((cnt >> b) & 1u); t0 += (unsigned)__popc((unsigned)mk) << b; t1 += (unsigned)__popc((unsigned)(mk >> 32)) << b; }
        if ((hh ? t1 : t0) >= 256u) T = cand;
    }
#pragma unroll
    for (int i = 0; i < NR; ++i) { unsigned long long mk = __ballot(v[i] >= T); if (i >= NT) mk = 0ull;
        if (lane == 0) { SELa[i] = (unsigned)mk; SELa[64 + i] = (unsigned)(mk >> 32); } }
}
DI void dsa_unit(const Ctx& C, int l, int u) {
    int lane = C.lane; asm volatile("" : "+v"(lane));
    const int w = C.wave, r = lane & 31, hh = lane >> 5;
    const bf16* PROJ = ws_bf(C, WS_PU);
    int qrow0, NT, limit; KVSrc S; const bf16* ik0; const bf16* ik1; int iks0, ikn0;
    if (u < 256) { const int c = 31 - (u >> 3), b = u & 7; qrow0 = b * SEQ + c * 64; NT = 2 * (c + 1); limit = 64 * (c + 1);
        const bf16* base = PROJ + (size_t)(b * SEQ) * INP;
        S.k0 = base + C_AK; S.v0 = base + C_AV; S.s0 = INP; S.n0 = limit; S.k1 = S.k0; S.v1 = S.v0; S.s1 = INP;
        ik0 = base + C_IK; iks0 = INP; ikn0 = limit; ik1 = ik0;
    } else { const int b = u - 256; qrow0 = NTP + b * DSEQ; NT = (PAST + DSEQ) / 32; limit = PAST + DSEQ;
        const bf16* nb = PROJ + (size_t)qrow0 * INP;
        S.k0 = ws_bf(C, WS_CAK) + (size_t)b * PAST * 512; S.v0 = ws_bf(C, WS_CAV) + (size_t)b * PAST * 512; S.s0 = 512; S.n0 = PAST; S.k1 = nb + C_AK; S.v1 = nb + C_AV; S.s1 = INP;
        ik0 = ws_bf(C, WS_CKI) + (size_t)b * PAST * 64; iks0 = 64; ikn0 = PAST; ik1 = nb + C_IK;
    }
    float* SC = ws_f(C, WS_SC) + (size_t)C.bid * 64 * 2048;
    LAS unsigned* SEL = (LAS unsigned*)(C.lds + ATT_SEL);
    if (limit > 256) {
#ifndef REP_IDX
#define REP_IDX 1
#endif
#ifndef REP_TOPK
#define REP_TOPK 1
#endif
#ifndef REP_ATT
#define REP_ATT 1
#endif
#pragma unroll 1
    for (int pass = 0; pass < 2 * REP_IDX; ++pass) {
        bf16x8 af[2][4]; float wt[2][16];
#pragma unroll
        for (int np = 0; np < 2; ++np) { const int pp = (pass & 1) * 2 + np;
            const bf16* ap = PROJ + (size_t)(qrow0 + 8 * w + 2 * pp + (r >> 4)) * INP + C_IQ + (r & 15) * 64 + 8 * hh;
#pragma unroll
            for (int ks = 0; ks < 4; ++ks) af[np][ks] = *(const bf16x8*)(ap + 16 * ks);
#pragma unroll
            for (int i = 0; i < 16; ++i) { const int qi = 8 * w + 2 * pp + (i >> 3), hd = (i & 3) + 8 * ((i >> 2) & 1) + 4 * hh;
                wt[np][i] = bf2f(PROJ[(size_t)(qrow0 + qi) * INP + C_IW + hd]) * (0.25f * 0.125f); } }
        bf16x8 bk[4], bn[4];
#define IDX_LOAD(dst_, tile_) do { const int key_ = (tile_) * 32 + r; const bf16* kp_ = (key_ < ikn0 ? ik0 + (size_t)key_ * iks0 : ik1 + (size_t)(key_ - ikn0) * INP) + 8 * hh; \
            _Pragma("unroll") for (int ks_ = 0; ks_ < 4; ++ks_) dst_[ks_] = *(const bf16x8*)(kp_ + 16 * ks_); } while (0)
        IDX_LOAD(bn, 0);
#pragma unroll 1
        for (int tile = 0; tile < NT; ++tile) {
#pragma unroll
            for (int ks = 0; ks < 4; ++ks) bk[ks] = bn[ks];
            if (tile + 1 < NT) IDX_LOAD(bn, tile + 1);
#pragma unroll
            for (int np = 0; np < 2; ++np) {
                f32x16 acc;
#pragma unroll
                for (int i = 0; i < 16; ++i) acc[i] = 0.f;
#pragma unroll
                for (int ks = 0; ks < 4; ++ks) acc = mfma32(af[np][ks], bk[ks], acc);
                float p0 = 0.f, p1 = 0.f;
#pragma unroll
                for (int i = 0; i < 8; ++i) { p0 += fmaxf(acc[i], 0.f) * wt[np][i]; p1 += fmaxf(acc[8 + i], 0.f) * wt[np][8 + i]; }
                const float t0 = p0 + __shfl_xor(p0, 32), t1 = p1 + __shfl_xor(p1, 32);
                const int ql = 8 * w + 2 * ((pass & 1) * 2 + np) + hh;
                SC[(size_t)ql * 2048 + tile * 32 + r] = hh ? t1 : t0;
            }
        }
    }
#undef IDX_LOAD
    asm volatile("s_waitcnt vmcnt(0)" ::: "memory");
    __builtin_amdgcn_fence(__ATOMIC_ACQUIRE, "agent");
    asm volatile("s_waitcnt vmcnt(0)" ::: "memory");
#pragma unroll 1
    for (int pq = 0; pq < 4 * REP_TOPK; ++pq) { const int pp = pq & 3;
        const float* SCq = SC + (size_t)(8 * w + 2 * pp + hh) * 2048; LAS unsigned* SELa = SEL + (8 * w + 2 * pp) * 64;
        if (NT <= 16) topk_pair<16>(SCq, SELa, NT, r, hh, lane);
        else if (NT <= 32) topk_pair<32>(SCq, SELa, NT, r, hh, lane);
        else if (NT <= 48) topk_pair<48>(SCq, SELa, NT, r, hh, lane);
        else topk_pair<64>(SCq, SELa, NT, r, hh, lane);
    }
    } else {
        for (int i = lane; i < 8 * 64; i += 64) SEL[8 * w * 64 + i] = ((i & 63) < NT) ? 0xffffffffu : 0u;
    }
    __syncthreads();
#pragma unroll 1
    for (int rep = 0; rep < REP_ATT; ++rep)
    attn_unit<0>(C, PROJ + (size_t)qrow0 * INP + C_AQ, INP, S, 0, NT, ws_bf(C, WS_MIX) + (size_t)qrow0 * DM, DM);
}

DI void band_unit(const Ctx& C, const Args& A, int l, int u) {
    const bf16* PROJ = ws_bf(C, WS_PU);
    int qrow0, tlo; KVSrc S;
    if (u < 256) { const int c = 31 - (u >> 3), b = u & 7; qrow0 = b * SEQ + c * 64; tlo = c < 8 ? (8 - c) * 2 : 0;
        const bf16* base = PROJ + ((ptrdiff_t)b * SEQ + c * 64 - BWIN) * INP;
        S.k0 = base + C_BK; S.v0 = base + C_BV; S.s0 = INP; S.n0 = BWIN + 64; S.k1 = S.k0; S.v1 = S.v0; S.s1 = INP;
    } else { const int b = u - 256; qrow0 = NTP + b * DSEQ; tlo = 0;
        const bf16* nb = PROJ + (size_t)qrow0 * INP;
        S.k0 = ws_bf(C, WS_CBK) + (size_t)b * BWIN * 512; S.v0 = ws_bf(C, WS_CBV) + (size_t)b * BWIN * 512; S.s0 = 512; S.n0 = BWIN; S.k1 = nb + C_BK; S.v1 = nb + C_BV; S.s1 = INP;
    }
    LAS float* bt = (LAS float*)(C.lds + ATT_SEL);
    const float* brel = A.in[12] + (size_t)l * 4 * 257;
    for (int i = C.tid; i < 4 * 257; i += NTHR) bt[i] = brel[i];
    __syncthreads();
    attn_unit<1>(C, PROJ + (size_t)qrow0 * INP + C_BQ, INP, S, tlo, (BWIN + 64) / 32, ws_bf(C, WS_MIX) + (size_t)qrow0 * DM + 512, DM);
}

DI void ssd_unit(const Ctx& C, const Args& A, int l, int row0, int nchunks, int h, const float* h0, float* hout) {
    int tid = C.tid, lane = C.lane; asm volatile("" : "+v"(tid), "+v"(lane));
    const int w = C.wave, r = lane & 31, hh = lane >> 5, g = h >> 2;
    LAS unsigned char* L = C.lds;
    LAS unsigned char* Cs = L + SSD_CS; LAS unsigned char* Bs = L + SSD_BS; LAS unsigned char* XD = L + SSD_XD; LAS unsigned char* XDW = L + SSD_XDW; LAS unsigned char* Ms = L + SSD_MS; LAS unsigned char* Ys = L + SSD_Y;
    LAS float* v_acs = (LAS float*)(L + SSD_VEC); LAS float* v_e = v_acs + 64;
    const bf16* XBC = ws_bf(C, WS_XBC); const bf16* PROJ = ws_bf(C, WS_PU); const float* DTS = ws_f(C, WS_DTS); float* G = ws_f(C, WS_G);
    const float a_h = -expf(A.in[16][l * 16 + h]); const float dsk = A.in[17][l * 16 + h];
    const int erow = tid >> 3, ech = tid & 7;
    f32x16 Hacc[2];
#pragma unroll
    for (int pb = 0; pb < 2; ++pb)
#pragma unroll
        for (int i = 0; i < 16; ++i) Hacc[pb][i] = 0.f;
    u32x4 pC[2], pB[2], pX, pZ; float pDt;
#define SSD_LOAD(c_) do { const int rb_ = row0 + (c_) * 64; \
        _Pragma("unroll") for (int i_ = 0; i_ < 2; ++i_) { const int ci_ = tid + 512 * i_; const bf16* src_ = XBC + (size_t)(rb_ + (ci_ >> 4)) * 2048 + g * 128 + (ci_ & 15) * 8; pB[i_] = *(const u32x4*)(src_ + 1024); pC[i_] = *(const u32x4*)(src_ + 1536); } \
        pX = *(const u32x4*)(XBC + (size_t)(rb_ + erow) * 2048 + h * 64 + ech * 8); pZ = *(const u32x4*)(PROJ + (size_t)(rb_ + erow) * INP + C_CZ + h * 64 + ech * 8); \
        pDt = DTS[(size_t)(rb_ + lane) * 16 + h]; } while (0)
    SSD_LOAD(0);
    __syncthreads();
    if (w >= 4) { const int nb = w - 4;
#pragma unroll
        for (int pb = 0; pb < 2; ++pb)
#pragma unroll
            for (int i = 0; i < 16; ++i) { const int p = 32 * pb + crow(i, hh), n = 32 * nb + r; const float v = h0 ? h0[p * 128 + n] : 0.f; Hacc[pb][i] = v;
                *(LAS bf16*)(L + SSD_HS + p * HSTR + n * 2) = f2bf(v); } }
#pragma unroll 1
    for (int c = 0; c < nchunks; ++c) {
        const int rbase = row0 + c * 64;
        LAS unsigned char* Hcur = L + SSD_HS + (c & 1) * 64 * HSTR; LAS unsigned char* Hnxt = L + SSD_HS + ((c + 1) & 1) * 64 * HSTR;
        const float dtl = pDt; float acs = dtl * a_h;
#pragma unroll
        for (int o = 1; o < 64; o <<= 1) { const float t = __shfl_up(acs, o); if (lane >= o) acs += t; }
        const float Atot = __shfl(acs, 63);
        const float wl = __expf(Atot - acs);
        if (w == 0) { v_acs[lane] = acs; v_e[lane] = __expf(acs); }
#pragma unroll
        for (int i = 0; i < 2; ++i) { const int ci = tid + 512 * i, row = ci >> 4, ch = ci & 15; *(LAS u32x4*)(Bs + row * CSTR + ch * 16) = pB[i]; *(LAS u32x4*)(Cs + row * CSTR + ch * 16) = pC[i]; }
        float xraw[8]; unpack8(pX, xraw); const u32x4 zc = pZ;
        { float xd[8], xw[8]; const float dt = __shfl(dtl, erow & 63), wv = __shfl(wl, erow & 63);
#pragma unroll
          for (int k = 0; k < 8; ++k) { xd[k] = xraw[k] * dt; xw[k] = xd[k] * wv; }
          *(LAS u32x4*)(XD + erow * XSTR + ech * 16) = pack8(xd); *(LAS u32x4*)(XDW + erow * XSTR + ech * 16) = pack8(xw); }
        if (c + 1 < nchunks) SSD_LOAD(c + 1);
        __syncthreads();
        if (w < 4) {
            const int lb = w >> 1, sb = w & 1; f32x16 acc;
#pragma unroll
            for (int i = 0; i < 16; ++i) acc[i] = 0.f;
            if (sb <= lb) {
#pragma unroll
                for (int ks = 0; ks < 8; ++ks) { const bf16x8 a = *(const LAS bf16x8*)(Cs + (32 * lb + r) * CSTR + (16 * ks + 8 * hh) * 2), b = *(const LAS bf16x8*)(Bs + (32 * sb + r) * CSTR + (16 * ks + 8 * hh) * 2);
                    acc = mfma32(a, b, acc); } }
            const int s = 32 * sb + r; const float acs_s = v_acs[s];
#pragma unroll
            for (int i = 0; i < 16; ++i) { const int lr = 32 * lb + crow(i, hh); const float v = (s <= lr) ? acc[i] * __expf(v_acs[lr] - acs_s) : 0.f; *(LAS bf16*)(Ms + lr * MSTR + s * 2) = f2bf(v); }
        } else {
            const int nb = w - 4; const float dec = __expf(Atot);
#pragma unroll
            for (int pb = 0; pb < 2; ++pb) {
#pragma unroll
                for (int i = 0; i < 16; ++i) Hacc[pb][i] *= dec;
#pragma unroll
                for (int ks = 0; ks < 4; ++ks) { const bf16x8 a = trfrag(XDW, XSTR, 16 * ks, 32 * pb, lane), b = trfrag(Bs, CSTR, 16 * ks, 32 * nb, lane); Hacc[pb] = mfma32(a, b, Hacc[pb]); }
#pragma unroll
                for (int i = 0; i < 16; ++i) *(LAS bf16*)(Hnxt + (32 * pb + crow(i, hh)) * HSTR + (32 * nb + r) * 2) = f2bf(Hacc[pb][i]);
            }
        }
        __syncthreads();
        if (w < 4) {
            const int lb = w >> 1, pb = w & 1; f32x16 yd, yo;
#pragma unroll
            for (int i = 0; i < 16; ++i) { yd[i] = 0.f; yo[i] = 0.f; }
#pragma unroll
            for (int ks = 0; ks < 4; ++ks) { const bf16x8 a = *(const LAS bf16x8*)(Ms + (32 * lb + r) * MSTR + (16 * ks + 8 * hh) * 2), b = trfrag(XD, XSTR, 16 * ks, 32 * pb, lane); yd = mfma32(a, b, yd); }
#pragma unroll
            for (int ks = 0; ks < 8; ++ks) { const bf16x8 a = *(const LAS bf16x8*)(Cs + (32 * lb + r) * CSTR + (16 * ks + 8 * hh) * 2), b = *(const LAS bf16x8*)(Hcur + (32 * pb + r) * HSTR + (16 * ks + 8 * hh) * 2); yo = mfma32(a, b, yo); }
            const int p = 32 * pb + r;
#pragma unroll
            for (int i = 0; i < 16; ++i) { const int lr = 32 * lb + crow(i, hh); *(LAS float*)(Ys + lr * YSTR + p * 4) = yd[i] + v_e[lr] * yo[i]; }
        }
        __syncthreads();
        {
            float z[8]; unpack8(zc, z);
            const f32x4 y0 = *(const LAS f32x4*)(Ys + erow * YSTR + ech * 32), y1 = *(const LAS f32x4*)(Ys + erow * YSTR + ech * 32 + 16);
            float y[8] = {y0.x, y0.y, y0.z, y0.w, y1.x, y1.y, y1.z, y1.w};
#pragma unroll
            for (int k = 0; k < 8; ++k) { const float yy = y[k] + dsk * xraw[k]; y[k] = yy * z[k] / (1.f + __expf(-z[k])); }
            float* gp = G + (size_t)(rbase + erow) * 1024 + h * 64 + ech * 8;
            ((f32x4*)gp)[0] = (f32x4){y[0], y[1], y[2], y[3]}; ((f32x4*)gp)[1] = (f32x4){y[4], y[5], y[6], y[7]};
        }
    }
#undef SSD_LOAD
    if (w >= 4) { const int nb = w - 4;
#pragma unroll
        for (int pb = 0; pb < 2; ++pb)
#pragma unroll
            for (int i = 0; i < 16; ++i) hout[(32 * pb + crow(i, hh)) * 128 + 32 * nb + r] = Hacc[pb][i]; }
}

DI void gate_norm_phase(const Ctx& C, const Args& A, int l) {
    const int gw = C.bid * NWAVES + C.wave, NGW = C.G * NWAVES; const float* gn = A.in[18] + (size_t)l * 1024;
    for (int m = gw; m < NTOK; m += NGW) { const float* grow = ws_f(C, WS_G) + (size_t)m * 1024; bf16* orow = ws_bf(C, WS_MIX) + (size_t)m * DM + 1024;
#pragma unroll
        for (int g = 0; g < 4; ++g) { const f32x4 v = ((const f32x4*)grow)[g * 64 + C.lane]; const float ss = wave_sum((v.x * v.x + v.y * v.y) + (v.z * v.z + v.w * v.w));
            const float rs = 1.0f / sqrtf(ss * (1.0f / 256.f) + EPS); const f32x4 wv = ((const f32x4*)gn)[g * 64 + C.lane]; const f32x4 o = v * rs * wv;
            u32x2 p; p.x = pk2(o.x, o.y); p.y = pk2(o.z, o.w); ((u32x2*)orow)[g * 64 + C.lane] = p; } }
}
DI void norm_phase(const Ctx& C, const float* w, bf16* outb, float* outf) {
    const int gw = C.bid * NWAVES + C.wave, NGW = C.G * NWAVES;
    for (int m = gw; m < NTOK; m += NGW) { float* xr = ws_f(C, WS_X) + (size_t)m * DM; const bool sp = m >= NTP;
        rms_row(xr, sp ? xr : nullptr, w, outb ? outb + (size_t)m * DM : nullptr, outf ? outf + (size_t)m * DM : nullptr, C.lane, sp ? ws_f(C, WS_G) + (size_t)(m - NTP) * DM : nullptr, (size_t)NTS * DM); }
}

#ifndef MK_ONE_LAUNCH
#define MK_ONE_LAUNCH 1
#endif
#ifndef PHASE_MASK
#define PHASE_MASK 0xFFFF
#endif
#define EN(k) (((PHASE_MASK) >> (k)) & 1)
constexpr int PH_PER_LAYER = 9, NPHASE = 1 + DEPTH * PH_PER_LAYER;
__global__ void __launch_bounds__(NTHR, 2) fwd(Args args) {
    extern __shared__ __attribute__((aligned(16))) unsigned char lds_raw[];
    Ctx C;
    C.lds = (LAS unsigned char*)lds_raw;
    C.tid = threadIdx.x; C.lane = C.tid & 63; C.wave = __builtin_amdgcn_readfirstlane(C.tid >> 6); C.G = gridDim.x; C.bid = blockIdx.x;
    C.ws = args.ws; C.out = args.out; C.ctl = (unsigned*)(args.ws + WS_CTL);
    const Args& A = args;
    for (int u = C.tid; u < (LDS_BYTES - LDSCTL_OFF) / 4; u += NTHR) ((LAS unsigned*)(C.lds + LDSCTL_OFF))[u] = 0u;
    __syncthreads();
    const int lo = args.ph_lo, hi = args.ph_hi;
    const bool multi = (hi - lo) > 1;
    XcdBarrier bar; bar.bar = C.ctl + CW_BAR; bar.x = 0; bar.st = (volatile LAS unsigned*)(C.lds + LDSCTL_OFF);
    if (multi) bar = xcd_barrier_post(C.ctl + CW_BAR, (volatile LAS unsigned*)(C.lds + LDSCTL_OFF));
#define IN(k) (lo <= (k) && (k) < hi)
#define FRESH() do { int t_ = threadIdx.x; asm volatile("" : "+v"(t_)); C.tid = t_; C.lane = t_ & 63; int w_ = __builtin_amdgcn_readfirstlane(t_ >> 6); asm volatile("" : "+s"(w_)); C.wave = w_; } while (0)
#define SEAM(k) do { if (IN((k) + 1)) xcd_barrier(bar); } while (0)

    if (EN(0) && IN(0)) { p0_prologue(C, A);
#if defined(PROBE_P02)
        __syncthreads(); p0_prologue(C, A);
#endif
        SEAM(0); }
#pragma unroll 1
    for (int l = 0; l < DEPTH; ++l) {
        const int pb = 1 + PH_PER_LAYER * l;
        if (EN(1) && IN(pb + 0)) { FRESH();
            pg8::Gemm g{ws_bf(C, WS_H), w_in_t(C, l), NTOK, INP, DM, DM}; pg8::StaticOrder S; S.init(NTOK, INP, C.G, C.bid);
            pg8::EpiBf16<0> E{ws_bf(C, WS_PU), INP};
            pg8::gemm_phase<pg8::EpiBf16<0>, pg8::StaticOrder, true, true>(C.lds, g, S, E);
            SEAM(pb + 0);
        }
        if (EN(2) && IN(pb + 1)) { FRESH(); m0_phase(C, A, l); SEAM(pb + 1); }
        if (IN(pb + 2)) { FRESH();
            unsigned* qh = C.ctl + CW_Q + 64 * (l * 4);
            if (EN(3)) for (;;) { const int u = q_next(C, qh); if (u >= NB * 16) break;
                ssd_unit(C, A, l, (u >> 4) * SEQ, SEQ / 64, u & 15, nullptr, C.out + OFF_P_SSM + ((size_t)(l * NB + (u >> 4)) * 16 + (u & 15)) * 8192); }
            if (EN(4)) for (;;) { const int u = q_next(C, qh + 64); if (u >= 288) break; dsa_unit(C, l, u); }
            if (EN(5)) for (;;) { const int u = q_next(C, qh + 128); if (u >= 288) break; band_unit(C, A, l, u); }
            if (EN(3)) for (;;) { const int u = q_next(C, qh + 192); if (u >= DBAT * 16) break;
                ssd_unit(C, A, l, NTP + (u >> 4) * DSEQ, 1, u & 15, A.in[7] + ((size_t)(l * DBAT + (u >> 4)) * 16 + (u & 15)) * 8192, C.out + OFF_S_SSM + ((size_t)(l * DBAT + (u >> 4)) * 16 + (u & 15)) * 8192); }
#if defined(PROBE_MIXK)
            { unsigned* qh2 = C.ctl + CW_Q + 64 * (16 + l * 4);
            if (PROBE_MIXK & 1) for (;;) { const int u = q_next(C, qh2); if (u >= NB * 16) break;
                ssd_unit(C, A, l, (u >> 4) * SEQ, SEQ / 64, u & 15, nullptr, C.out + OFF_P_SSM + ((size_t)(l * NB + (u >> 4)) * 16 + (u & 15)) * 8192); }
            if (PROBE_MIXK & 2) for (;;) { const int u = q_next(C, qh2 + 64); if (u >= 288) break; dsa_unit(C, l, u); }
            if (PROBE_MIXK & 4) for (;;) { const int u = q_next(C, qh2 + 128); if (u >= 288) break; band_unit(C, A, l, u); }
            if (PROBE_MIXK & 8) for (;;) { const int u = q_next(C, qh2 + 192); if (u >= DBAT * 16) break;
                ssd_unit(C, A, l, NTP + (u >> 4) * DSEQ, 1, u & 15, A.in[7] + ((size_t)(l * DBAT + (u >> 4)) * 16 + (u & 15)) * 8192, C.out + OFF_S_SSM + ((size_t)(l * DBAT + (u >> 4)) * 16 + (u & 15)) * 8192); } }
#endif
            SEAM(pb + 2);
        }
        if (EN(6) && IN(pb + 3)) { FRESH(); gate_norm_phase(C, A, l); SEAM(pb + 3); }
        if (EN(7) && IN(pb + 4)) { FRESH();
            { pg8::Gemm g{ws_bf(C, WS_MIX), w_out_t(C, l), NTP, DM, DM, DM}; pg8::StaticOrder S; S.init(NTP, DM, C.G, C.bid);
              pg8::EpiResF32 E{ws_f(C, WS_X), DM};
              pg8::gemm_phase<pg8::EpiResF32, pg8::StaticOrder, true, true>(C.lds, g, S, E); }
            __syncthreads();
            { pg8::Gemm g{ws_bf(C, WS_MIX), w_out_t(C, l), NTOK, DM, DM / 4, DM}; pg8::SplitOrder S; S.init(NTP / 256, NTS / 256, DM / 256, 4, C.G, C.bid);
              pg8::EpiSplitRes E{ws_f(C, WS_X), DM, ws_f(C, WS_G), (size_t)NTS * DM, NTP};
              pg8::gemm_phase<pg8::EpiSplitRes, pg8::SplitOrder, true, true>(C.lds, g, S, E); }
            SEAM(pb + 4);
        }
        if (EN(8) && IN(pb + 5)) { FRESH(); norm_phase(C, A.in[19] + (size_t)l * DM, ws_bf(C, WS_H), nullptr); SEAM(pb + 5); }
        if (EN(9) && IN(pb + 6)) { FRESH();
            pg8::Gemm g{ws_bf(C, WS_H), w_up_t(C, l), NTOK, DFF, DM, DM}; pg8::StaticOrder S; S.init(NTOK, DFF, C.G, C.bid);
            pg8::EpiBf16<1> E{ws_bf(C, WS_PU), DFF};
            pg8::gemm_phase<pg8::EpiBf16<1>, pg8::StaticOrder, true, true>(C.lds, g, S, E);
#if defined(PROBE_UP2)
            __syncthreads(); pg8::gemm_phase<pg8::EpiBf16<1>, pg8::StaticOrder, true, true>(C.lds, g, S, E);
#endif
            SEAM(pb + 6);
        }
        if (EN(10) && IN(pb + 7)) { FRESH();
            { pg8::Gemm g{ws_bf(C, WS_PU), w_dn_t(C, l), NTP, DM, DFF, DFF}; pg8::StaticOrder S; S.init(NTP, DM, C.G, C.bid);
              pg8::EpiResF32 E{ws_f(C, WS_X), DM};
              pg8::gemm_phase<pg8::EpiResF32, pg8::StaticOrder, true, true>(C.lds, g, S, E); }
            __syncthreads();
            { pg8::Gemm g{ws_bf(C, WS_PU), w_dn_t(C, l), NTOK, DM, DFF / 4, DFF}; pg8::SplitOrder S; S.init(NTP / 256, NTS / 256, DM / 256, 4, C.G, C.bid);
              pg8::EpiSplitRes E{ws_f(C, WS_X), DM, ws_f(C, WS_G), (size_t)NTS * DM, NTP};
              pg8::gemm_phase<pg8::EpiSplitRes, pg8::SplitOrder, true, true>(C.lds, g, S, E); }
            SEAM(pb + 7);
        }
        if (EN(8) && IN(pb + 8)) { FRESH();
            if (l + 1 < DEPTH) norm_phase(C, A.in[9] + (size_t)(l + 1) * DM, ws_bf(C, WS_H), nullptr);
            else norm_phase(C, A.in[22], nullptr, C.out);
            SEAM(pb + 8);
        }
    }
#undef IN
#undef SEAM
}

extern "C" void kernel_launch(void* const* d_in, const int* in_sizes, int n_in, void* d_out, int out_size, void* d_ws, size_t ws_size, hipStream_t stream) {
    static int grid = 0;
    if (grid == 0) {
        if (n_in != 23 || in_sizes[0] != NTP * DM || (size_t)out_size != OUT_TOTAL || ws_size < WS_END) {
            fprintf(stderr, "kernel_launch: unexpected shapes (n_in %d, in0 %d, out %d, ws %zu; need ws >= %zu); nothing launched\n", n_in, n_in > 0 ? in_sizes[0] : -1, out_size, ws_size, (size_t)WS_END); grid = -1; return; }
        int dev = 0, cus = 0, per_cu = 0;
        if (hipGetDevice(&dev) != hipSuccess || hipDeviceGetAttribute(&cus, hipDeviceAttributeMultiprocessorCount, dev) != hipSuccess) { fprintf(stderr, "kernel_launch: device query failed\n"); grid = -1; return; }
        if (hipFuncSetAttribute((const void*)fwd, hipFuncAttributeMaxDynamicSharedMemorySize, LDS_BYTES) != hipSuccess) { fprintf(stderr, "kernel_launch: hipFuncSetAttribute failed\n"); grid = -1; return; }
        if (hipOccupancyMaxActiveBlocksPerMultiprocessor(&per_cu, (const void*)fwd, NTHR, LDS_BYTES) != hipSuccess || per_cu < 1)
            fprintf(stderr, "kernel_launch: note: occupancy query reports %d workgroups per CU\n", per_cu);
        (void)hipGetLastError();
        grid = cus < 256 ? cus : 256;
    }
    if (grid < 0) return;
    if (hipMemsetAsync((char*)d_ws + WS_CTL, 0, CTL_ZERO_BYTES, stream) != hipSuccess) { fprintf(stderr, "kernel_launch: memset failed\n"); return; }
    Args a{};
    for (int i = 0; i < 23; ++i) a.in[i] = (const float*)d_in[i];
    a.out = (float*)d_out; a.ws = (unsigned char*)d_ws;
#if MK_ONE_LAUNCH
    a.ph_lo = 0; a.ph_hi = NPHASE;
    hipLaunchKernelGGL(fwd, dim3(grid), dim3(NTHR), LDS_BYTES, stream, a);
#else
    for (int p = 0; p < NPHASE; ++p) { a.ph_lo = p; a.ph_hi = p + 1; hipLaunchKernelGGL(fwd, dim3(grid), dim3(NTHR), LDS_BYTES, stream, a); }
#endif
    const hipError_t le = hipPeekAtLastError();
    if (le != hipSuccess) fprintf(stderr, "kernel_launch: launch failed: %s\n", hipGetErrorName(le));
}
```

```cpp
#include <hip/hip_runtime.h>
#include <cstdio>
#include <cstdint>
#include <cstddef>
namespace pg8 {
#define PG8_LAS __attribute__((address_space(3)))
typedef unsigned short bf16_t;
typedef short bf16x8 __attribute__((ext_vector_type(8)));
typedef float f32x4 __attribute__((ext_vector_type(4)));
typedef unsigned u32x4 __attribute__((ext_vector_type(4)));
constexpr int BM = 256, BK = 64, HALF = 128, HTB = HALF * BK * 2  , STAGE_BYTES = 8 * HTB, NXCD = 8, WGM = 8;

__host__ __device__ __forceinline__ int lds_byte(int r, int c) { const int st = (r >> 4) * 2 + (c >> 5), rr = r & 15, cc = c & 31, ob = rr * 64 + cc * 2; return st * 1024 + (ob ^ (((ob >> 9) & 1) << 5)); }
__host__ __device__ __forceinline__ void stage_rc(int b, int& R, int& C) { const int st = b / 1024, sb = b % 1024, swz = sb ^ (((sb >> 9) & 1) << 5); R = (st >> 1) * 16 + swz / 64; C = (st & 1) * 32 + (swz % 64) / 2; }
__host__ __device__ __forceinline__ int perm32(int rho) { const int n = rho >> 4, i = rho & 15; return 8 * (i >> 2) + 4 * n + (i & 3); }

struct Unit { int pm, pn, kq; };
struct Gemm { const bf16_t* A; const bf16_t* Bt; int M, N, K, ld; };

struct StaticOrder {
    int nM, nN, nwg, G, c;
    __host__ __device__ void init(int M, int N, int G_, int c_) { nM = M / BM; nN = N / BM; nwg = nM * nN; G = G_; c = c_; }
    __host__ __device__ bool next(int i, Unit& u) const {
        const long L = (long)i * G + c; if (L >= nwg) return false;
        int wgid = (int)L; { const int q = nwg / NXCD, r = nwg % NXCD, xcd = wgid % NXCD, off = wgid / NXCD; wgid = (xcd < r ? xcd * (q + 1) : r * (q + 1) + (xcd - r) * q) + off; }
        const int nig = WGM * nN, gid = wgid / nig, fm = gid * WGM, gsz = (nM - fm) < WGM ? (nM - fm) : WGM;
        u.pm = fm + ((wgid % nig) % gsz); u.pn = (wgid % nig) / gsz; u.kq = 0; return true;
    }
    __device__ __forceinline__ void a_ready(const Unit&) const {}
    __device__ __forceinline__ void done(const Unit&) const {}
};

struct SplitOrder {
    int pm0, npm, nN, nsplit, G, c;
    __host__ __device__ void init(int pm0_, int npm_, int nN_, int nsplit_, int G_, int c_) { pm0 = pm0_; npm = npm_; nN = nN_; nsplit = nsplit_; G = G_; c = c_; }
    __host__ __device__ bool next(int i, Unit& u) const {
        const long L = (long)i * G + c; if (L >= (long)npm * nN * nsplit) return false;
        const int w = (int)L; u.kq = w % nsplit; u.pn = (w / nsplit) % nN; u.pm = pm0 + w / (nsplit * nN); return true;
    }
    __device__ __forceinline__ void a_ready(const Unit&) const {}
    __device__ __forceinline__ void done(const Unit&) const {}
};

typedef float f32x2_t __attribute__((ext_vector_type(2)));
typedef __bf16 bf16x2_t __attribute__((ext_vector_type(2)));
__device__ __forceinline__ unsigned cvt_pk_bf16(float lo, float hi) { f32x2_t v = {lo, hi}; bf16x2_t b = __builtin_convertvector(v, bf16x2_t); return __builtin_bit_cast(unsigned, b); }

template <int ACT  > struct EpiBf16 {
    static constexpr bool PERM = true, AFTER_DRAIN = false;
    bf16_t* O; int ldc;
    __device__ __forceinline__ void operator()(const f32x4 (&acc)[2][2][4][2], const Unit& u, int wr, int wc, int fr, int fq) const {
        const int row0 = u.pm * BM + wr * 64 + fr; const int col0 = u.pn * BM + wc * 32 + 8 * fq;
#pragma unroll
        for (int ai = 0; ai < 2; ++ai)
#pragma unroll
            for (int m = 0; m < 4; ++m) { bf16_t* rowp = O + (size_t)(row0 + ai * HALF + m * 16) * ldc + col0;
#pragma unroll
                for (int bj = 0; bj < 2; ++bj) { f32x4 v0 = acc[ai][bj][m][0], v1 = acc[ai][bj][m][1];
                    if (ACT == 1) {
#pragma unroll
                        for (int j = 0; j < 4; ++j) { const float a = v0[j] > 0.f ? v0[j] : 0.f, b = v1[j] > 0.f ? v1[j] : 0.f; v0[j] = a * a; v1[j] = b * b; } }
                    u32x4 w; w.x = cvt_pk_bf16(v0[0], v0[1]); w.y = cvt_pk_bf16(v0[2], v0[3]); w.z = cvt_pk_bf16(v1[0], v1[1]); w.w = cvt_pk_bf16(v1[2], v1[3]);
                    *(u32x4*)(rowp + bj * HALF) = w; } }
    }
};
struct EpiResF32 {
    static constexpr bool PERM = false, AFTER_DRAIN = false;
    float* X; int ldc;
    __device__ __forceinline__ void operator()(const f32x4 (&acc)[2][2][4][2], const Unit& u, int wr, int wc, int fr, int fq) const {
        const int row0 = u.pm * BM + wr * 64 + fr, col0 = u.pn * BM + wc * 32 + 4 * fq;
#pragma unroll
        for (int ai = 0; ai < 2; ++ai)
#pragma unroll
            for (int m = 0; m < 4; ++m) { float* rowp = X + (size_t)(row0 + ai * HALF + m * 16) * ldc + col0;
                f32x4 b[2][2];
#pragma unroll
                for (int bj = 0; bj < 2; ++bj)
#pragma unroll
                    for (int n = 0; n < 2; ++n) b[bj][n] = *(const f32x4*)(rowp + bj * HALF + n * 16);
#pragma unroll
                for (int bj = 0; bj < 2; ++bj)
#pragma unroll
                    for (int n = 0; n < 2; ++n) *(f32x4*)(rowp + bj * HALF + n * 16) = b[bj][n] + acc[ai][bj][m][n];
                asm volatile("" ::: "memory"); }
    }
};

struct EpiSplitRes {
    static constexpr bool PERM = false, AFTER_DRAIN = false;
    float* X; int ldc; float* P; size_t pstride; int row0;
    __device__ __forceinline__ void operator()(const f32x4 (&acc)[2][2][4][2], const Unit& u, int wr, int wc, int fr, int fq) const {
        const int rowa = u.pm * BM + wr * 64 + fr, col0 = u.pn * BM + wc * 32 + 4 * fq;
        if (u.kq == 0) {
#pragma unroll
            for (int ai = 0; ai < 2; ++ai)
#pragma unroll
                for (int m = 0; m < 4; ++m) { float* rowp = X + (size_t)(rowa + ai * HALF + m * 16) * ldc + col0;
                    f32x4 b[2][2];
#pragma unroll
                    for (int bj = 0; bj < 2; ++bj)
#pragma unroll
                        for (int n = 0; n < 2; ++n) b[bj][n] = *(const f32x4*)(rowp + bj * HALF + n * 16);
#pragma unroll
                    for (int bj = 0; bj < 2; ++bj)
#pragma unroll
                        for (int n = 0; n < 2; ++n) *(f32x4*)(rowp + bj * HALF + n * 16) = b[bj][n] + acc[ai][bj][m][n];
                    asm volatile("" ::: "memory"); }
        } else {
            float* base = P + (size_t)(u.kq - 1) * pstride;
#pragma unroll
            for (int ai = 0; ai < 2; ++ai)
#pragma unroll
                for (int m = 0; m < 4; ++m) { float* rowp = base + (size_t)(rowa - row0 + ai * HALF + m * 16) * ldc + col0;
#pragma unroll
                    for (int bj = 0; bj < 2; ++bj)
#pragma unroll
                        for (int n = 0; n < 2; ++n) *(f32x4*)(rowp + bj * HALF + n * 16) = acc[ai][bj][m][n]; }
        }
    }
};
template <class Epi, class Sched, bool ALIGN_EPI = false, bool SP2 = false>
__device__ __forceinline__ void gemm_phase(PG8_LAS unsigned char* lds, const Gemm g, const Sched& S, const Epi& E) {
    int tid_ = threadIdx.x; asm volatile("" : "+v"(tid_));
    const int tid = tid_, wid = __builtin_amdgcn_readfirstlane(tid >> 6), lane = tid & 63, wr = wid >> 2, wc = wid & 3, fr = lane & 15, fq = lane >> 4;
    const int K = g.K, nt = K / BK, ld = g.ld;
    unsigned voffA[2], voffB[2];
#pragma unroll
    for (int i = 0; i < 2; ++i) { int R, C; stage_rc(tid * 16 + i * 8192, R, C); const int Rb = Epi::PERM ? ((R & ~31) + perm32(R & 31)) : R;
        voffA[i] = (unsigned)(R * ld + C) * 2u; voffB[i] = (unsigned)(Rb * ld + C) * 2u; }
    const size_t kstep = (size_t)(BK * 2);
    const size_t hstep = (size_t)HALF * ld * 2;
    const size_t tstep = 2 * hstep;
    const unsigned ldsw = (unsigned)wid * 1024u;
    const int aoff = lds_byte(wr * 64 + fr, fq * 8), boff = lds_byte(wc * 32 + fr, fq * 8);
#define PG8_SA(b, h) (((b) * 2 + (h)) * HTB)
#define PG8_SB(b, h) ((4 + (b) * 2 + (h)) * HTB)
#define PG8_STAGE(bufoff, gbase, voff) do { _Pragma("unroll") for (int _i = 0; _i < 2; ++_i) \
        __builtin_amdgcn_global_load_lds((const unsigned*)((const char*)(gbase) + (voff)[_i]), (PG8_LAS unsigned*)(lds + (bufoff) + ldsw + _i * 8192), 16, 0, 0); } while (0)
#define PG8_LDA(dst, b, h) do { _Pragma("unroll") for (int m = 0; m < 4; ++m) _Pragma("unroll") for (int k = 0; k < 2; ++k) dst[m][k] = *(const PG8_LAS bf16x8*)(lds + PG8_SA(b, h) + aoff + m * 2048 + k * 1024); } while (0)
#define PG8_LDB(dst, b, h) do { _Pragma("unroll") for (int n = 0; n < 2; ++n) _Pragma("unroll") for (int k = 0; k < 2; ++k) dst[n][k] = *(const PG8_LAS bf16x8*)(lds + PG8_SB(b, h) + boff + n * 2048 + k * 1024); } while (0)
#define PG8_MMA(ai, bj, At, Bt) do { __builtin_amdgcn_s_setprio(1); _Pragma("unroll") for (int m = 0; m < 4; ++m) _Pragma("unroll") for (int n = 0; n < 2; ++n) _Pragma("unroll") for (int k = 0; k < 2; ++k) \
        acc[ai][bj][m][n] = __builtin_amdgcn_mfma_f32_16x16x32_bf16(Bt[n][k], At[m][k], acc[ai][bj][m][n], 0, 0, 0); __builtin_amdgcn_s_setprio(0); } while (0)
#define PG8_WAIT_V(n) asm volatile("s_waitcnt vmcnt(" #n ")" ::: "memory")
#define PG8_WAIT_L(n) asm volatile("s_waitcnt lgkmcnt(" #n ")" ::: "memory")
#define PG8_BAR __builtin_amdgcn_s_barrier()
#define PG8_SCHED __builtin_amdgcn_sched_barrier(0)
    Unit cur, nxt; int ui = 0;
    if (!S.next(0, cur)) return;
    f32x4 acc[2][2][4][2];
#pragma unroll
    for (int a = 0; a < 2; ++a)
#pragma unroll
        for (int b = 0; b < 2; ++b)
#pragma unroll
            for (int m = 0; m < 4; ++m)
#pragma unroll
                for (int n = 0; n < 2; ++n) acc[a][b][m][n] = (f32x4){0.f, 0.f, 0.f, 0.f};
    bf16x8 At[4][2], B0[2][2], B1[2][2];
    const char* cA = (const char*)g.A + (size_t)cur.pm * tstep + (size_t)cur.kq * K * 2; const char* cB = (const char*)g.Bt + (size_t)cur.pn * tstep + (size_t)cur.kq * K * 2;
    S.a_ready(cur);
    if constexpr (SP2) {
        PG8_STAGE(PG8_SB(0, 0), cB, voffB); PG8_STAGE(PG8_SB(0, 1), cB + hstep, voffB); PG8_STAGE(PG8_SA(0, 0), cA, voffA); PG8_STAGE(PG8_SA(0, 1), cA + hstep, voffA);
        if (wr == 1) PG8_BAR;
        PG8_WAIT_V(2); PG8_BAR;
        PG8_STAGE(PG8_SB(1, 0), cB + kstep, voffB); PG8_STAGE(PG8_SA(1, 0), cA + kstep, voffA); PG8_STAGE(PG8_SB(1, 1), cB + hstep + kstep, voffB);
        PG8_WAIT_V(6); PG8_BAR;
    } else {
        PG8_STAGE(PG8_SB(0, 0), cB, voffB); PG8_STAGE(PG8_SA(0, 0), cA, voffA); PG8_STAGE(PG8_SB(0, 1), cB + hstep, voffB); PG8_STAGE(PG8_SA(0, 1), cA + hstep, voffA);
        if (wr == 1) PG8_BAR;
        PG8_WAIT_V(4); PG8_BAR;
        PG8_STAGE(PG8_SB(1, 0), cB + kstep, voffB); PG8_STAGE(PG8_SA(1, 0), cA + kstep, voffA); PG8_STAGE(PG8_SB(1, 1), cB + hstep + kstep, voffB);
        PG8_WAIT_V(6); PG8_BAR;
    }
    for (;;) {
        const bool has_next = S.next(ui + 1, nxt);
        const char* nA = has_next ? (const char*)g.A + (size_t)nxt.pm * tstep + (size_t)nxt.kq * K * 2 : cA; const char* nB = has_next ? (const char*)g.Bt + (size_t)nxt.pn * tstep + (size_t)nxt.kq * K * 2 : cB;
        for (int t = 0; t < nt; t += 2) {
            const bool last = (t == nt - 2);
            const char* a1 = cA + (size_t)(t + 1) * kstep;
            const char* a2 = last ? nA : cA + (size_t)(t + 2) * kstep; const char* b2 = last ? nB : cB + (size_t)(t + 2) * kstep;
            const char* a3 = a2 + kstep; const char* b3 = b2 + kstep;
            if (last && has_next) S.a_ready(nxt);
            if constexpr (SP2) {
            PG8_LDB(B0, 0, 0); PG8_LDB(B1, 0, 1); PG8_SCHED; PG8_LDA(At, 0, 0); PG8_STAGE(PG8_SA(1, 1), a1 + hstep, voffA);
            PG8_WAIT_V(8); PG8_WAIT_L(0); PG8_BAR; PG8_MMA(0, 0, At, B0); PG8_MMA(0, 1, At, B1); PG8_BAR; PG8_SCHED;
            PG8_LDA(At, 0, 1); PG8_STAGE(PG8_SB(0, 0), b2, voffB); PG8_STAGE(PG8_SB(0, 1), b2 + hstep, voffB); PG8_STAGE(PG8_SA(0, 0), a2, voffA);
            PG8_WAIT_V(8); PG8_WAIT_L(0); PG8_BAR; PG8_MMA(1, 0, At, B0); PG8_MMA(1, 1, At, B1); PG8_BAR; PG8_SCHED;
            PG8_LDB(B0, 1, 0); PG8_LDB(B1, 1, 1); PG8_SCHED; PG8_LDA(At, 1, 0); PG8_STAGE(PG8_SA(0, 1), a2 + hstep, voffA);
            PG8_WAIT_V(8); PG8_WAIT_L(0); PG8_BAR; PG8_MMA(0, 0, At, B0); PG8_MMA(0, 1, At, B1); PG8_BAR; PG8_SCHED;
            PG8_LDA(At, 1, 1); PG8_STAGE(PG8_SB(1, 0), b3, voffB); PG8_STAGE(PG8_SB(1, 1), b3 + hstep, voffB); PG8_STAGE(PG8_SA(1, 0), a3, voffA);
            PG8_WAIT_V(8); PG8_WAIT_L(0); PG8_BAR; PG8_MMA(1, 0, At, B0); PG8_MMA(1, 1, At, B1); PG8_BAR; PG8_SCHED;
            } else {
            PG8_LDB(B0, 0, 0); PG8_SCHED; PG8_LDA(At, 0, 0); PG8_STAGE(PG8_SA(1, 1), a1 + hstep, voffA);
            PG8_WAIT_L(8); PG8_BAR; PG8_WAIT_L(0); PG8_MMA(0, 0, At, B0); PG8_BAR; PG8_SCHED;
            PG8_LDB(B1, 0, 1); PG8_STAGE(PG8_SB(0, 0), b2, voffB);
            PG8_BAR; PG8_WAIT_L(0); PG8_MMA(0, 1, At, B1); PG8_BAR;
            PG8_LDA(At, 0, 1); PG8_STAGE(PG8_SA(0, 0), a2, voffA);
            PG8_BAR; PG8_WAIT_L(0); PG8_MMA(1, 0, At, B0); PG8_BAR; PG8_SCHED;
            PG8_STAGE(PG8_SB(0, 1), b2 + hstep, voffB);
            PG8_WAIT_V(6); PG8_BAR; PG8_MMA(1, 1, At, B1); PG8_BAR;
            PG8_LDB(B0, 1, 0); PG8_SCHED; PG8_LDA(At, 1, 0); PG8_STAGE(PG8_SA(0, 1), a2 + hstep, voffA);
            PG8_WAIT_L(8); PG8_BAR; PG8_WAIT_L(0); PG8_MMA(0, 0, At, B0); PG8_BAR; PG8_SCHED;
            PG8_LDB(B1, 1, 1); PG8_STAGE(PG8_SB(1, 0), b3, voffB);
            PG8_BAR; PG8_WAIT_L(0); PG8_MMA(0, 1, At, B1); PG8_BAR;
            PG8_LDA(At, 1, 1); PG8_STAGE(PG8_SA(1, 0), a3, voffA);
            PG8_BAR; PG8_WAIT_L(0); PG8_MMA(1, 0, At, B0); PG8_BAR; PG8_SCHED;
            PG8_STAGE(PG8_SB(1, 1), b3 + hstep, voffB);
            PG8_WAIT_V(6); PG8_BAR; PG8_MMA(1, 1, At, B1); PG8_BAR;
            }
        }
        if constexpr (ALIGN_EPI) { if (wr == 0) PG8_BAR; }
        if constexpr (!Epi::AFTER_DRAIN) { E(acc, cur, wr, wc, fr, fq); S.done(cur); }
        if (!has_next) break;
#pragma unroll
        for (int a = 0; a < 2; ++a)
#pragma unroll
            for (int b = 0; b < 2; ++b)
#pragma unroll
                for (int m = 0; m < 4; ++m)
#pragma unroll
                    for (int n = 0; n < 2; ++n) acc[a][b][m][n] = (f32x4){0.f, 0.f, 0.f, 0.f};
        cur = nxt; cA = nA; cB = nB; ++ui;
        if constexpr (ALIGN_EPI) { if (wr == 1) PG8_BAR; }
    }
    PG8_WAIT_V(0);
    if constexpr (!ALIGN_EPI) { if (wr == 0) PG8_BAR; }
    PG8_BAR;
    if constexpr (Epi::AFTER_DRAIN) { E.fused(acc, cur, wr, wc, fr, fq, lds, wid, lane); S.done(cur); }
#undef PG8_SA
#undef PG8_SB
#undef PG8_STAGE
#undef PG8_LDA
#undef PG8_LDB
#undef PG8_MMA
#undef PG8_WAIT_V
#undef PG8_WAIT_L
#undef PG8_BAR
#undef PG8_SCHED
}
}

#define DI __device__ __forceinline__
#define LAS __attribute__((address_space(3)))
typedef unsigned short bf16;
typedef short bf16x8 __attribute__((ext_vector_type(8)));
typedef short s16x4 __attribute__((ext_vector_type(4)));
typedef short v4i16_t __attribute__((ext_vector_type(4)));
typedef float f32x4 __attribute__((ext_vector_type(4)));
typedef float f32x16 __attribute__((ext_vector_type(16)));
typedef unsigned u32x4 __attribute__((ext_vector_type(4)));
typedef unsigned u32x2 __attribute__((ext_vector_type(2)));
typedef float f32x2_t_ __attribute__((ext_vector_type(2)));

constexpr int DM = 2048, NB = 8, SEQ = 2048, DEPTH = 4, DBAT = 32, DSEQ = 64, PAST = 1024, BWIN = 512;
constexpr int NTP = NB * SEQ, NTS = DBAT * DSEQ, NTOK = NTP + NTS;
constexpr int INC = 7264, INP = 7424, DFF = 8192;
constexpr int C_AQ = 0, C_AK = 512, C_AV = 1024, C_IQ = 1536, C_IK = 2560, C_IW = 2624, C_BQ = 2640, C_BK = 3152, C_BV = 3664, C_CZ = 4176, C_XBC = 5200, C_DT = 7248;
constexpr float EPS = 1e-5f;
constexpr int NWAVES = 8, NTHR = 512;

constexpr size_t SZ_YP = (size_t)NTP * DM, SZ_YS = (size_t)NTS * DM;
constexpr size_t SZ_PAK = (size_t)DEPTH * NB * SEQ * 512, SZ_PKI = (size_t)DEPTH * NB * SEQ * 64, SZ_PBK = (size_t)DEPTH * NB * BWIN * 512;
constexpr size_t SZ_PSSM = (size_t)DEPTH * NB * 16 * 64 * 128, SZ_PCONV = (size_t)DEPTH * NB * 3 * 2048;
constexpr size_t SZ_SAK = (size_t)DEPTH * DBAT * DSEQ * 512, SZ_SKI = (size_t)DEPTH * DBAT * DSEQ * 64, SZ_SBK = SZ_SAK;
constexpr size_t SZ_SSSM = (size_t)DEPTH * DBAT * 16 * 64 * 128, SZ_SCONV = (size_t)DEPTH * DBAT * 3 * 2048;
constexpr size_t OFF_YP = 0, OFF_YS = OFF_YP + SZ_YP, OFF_P_AK = OFF_YS + SZ_YS, OFF_P_AV = OFF_P_AK + SZ_PAK, OFF_P_KI = OFF_P_AV + SZ_PAK,
                 OFF_P_BK = OFF_P_KI + SZ_PKI, OFF_P_BV = OFF_P_BK + SZ_PBK, OFF_P_SSM = OFF_P_BV + SZ_PBK, OFF_P_CONV = OFF_P_SSM + SZ_PSSM,
                 OFF_S_AK = OFF_P_CONV + SZ_PCONV, OFF_S_AV = OFF_S_AK + SZ_SAK, OFF_S_KI = OFF_S_AV + SZ_SAK, OFF_S_BK = OFF_S_KI + SZ_SKI,
                 OFF_S_BV = OFF_S_BK + SZ_SBK, OFF_S_SSM = OFF_S_BV + SZ_SBK, OFF_S_CONV = OFF_S_SSM + SZ_SSSM, OUT_TOTAL = OFF_S_CONV + SZ_SCONV;
static_assert(OUT_TOTAL == 165085184, "output size");

constexpr size_t MiB = 1u << 20;
constexpr size_t WS_CTL = 0, CTL_ZERO_BYTES = 1 * MiB;
constexpr size_t WS_ROPE = 1 * MiB;
constexpr size_t WS_W = 2 * MiB;
constexpr size_t W_IN_B = (size_t)INP * DM * 2, W_OUT_B = (size_t)DM * DM * 2, W_UP_B = (size_t)DFF * DM * 2, W_DN_B = (size_t)DM * DFF * 2, W_LAYER_B = W_IN_B + W_OUT_B + W_UP_B + W_DN_B;
static_assert(W_LAYER_B == 101 * MiB, "weights per layer");
constexpr size_t WS_X = WS_W + DEPTH * W_LAYER_B;
constexpr size_t WS_H = WS_X + (size_t)NTOK * DM * 4;
constexpr size_t WS_MIX = WS_H + (size_t)NTOK * DM * 2;
constexpr size_t WS_PU = WS_MIX + (size_t)NTOK * DM * 2;
constexpr size_t WS_XBC = WS_PU + (size_t)NTOK * DFF * 2;
constexpr size_t WS_G = WS_XBC + (size_t)NTOK * 2048 * 2;
constexpr size_t WS_DTS = WS_G + (size_t)NTOK * 1024 * 4;
constexpr size_t WS_CAK = WS_DTS + 2 * MiB;
constexpr size_t WS_CAV = WS_CAK + (size_t)DBAT * PAST * 512 * 2;
constexpr size_t WS_CBK = WS_CAV + (size_t)DBAT * PAST * 512 * 2;
constexpr size_t WS_CBV = WS_CBK + (size_t)DBAT * BWIN * 512 * 2;
constexpr size_t WS_CKI = WS_CBV + (size_t)DBAT * BWIN * 512 * 2;
constexpr size_t WS_SC = WS_CKI + (size_t)DBAT * PAST * 64 * 2;
constexpr size_t WS_END = WS_SC + (size_t)256 * 64 * 2048 * 4;
static_assert(WS_END == 1356 * MiB, "ws map");
constexpr int CW_BAR = 4096;
constexpr int CW_Q = 16384;

constexpr int RING_BYTES = 131072, LDSCTL_OFF = RING_BYTES, LDS_BYTES = 147456;
constexpr int ATT_SEL = 0;
constexpr int ATT_V = 16384, VSTR = 1088, ATT_END = ATT_V + 2 * 32 * VSTR;
constexpr int CSTR = 272, XSTR = 144, MSTR = 144, HSTR = 272;
constexpr int SSD_CS = 0, SSD_BS = SSD_CS + 64 * CSTR, SSD_XD = SSD_BS + 64 * CSTR, SSD_XDW = SSD_XD + 64 * XSTR, SSD_MS = SSD_XDW + 64 * XSTR,
              SSD_HS = SSD_MS + 64 * MSTR, SSD_VEC = SSD_HS + 2 * 64 * HSTR, SSD_Y = SSD_VEC + 1024, YSTR = 272, SSD_END = SSD_Y + 64 * YSTR;
static_assert(ATT_END <= RING_BYTES && SSD_END <= RING_BYTES, "phase scratch fits the ring region");

DI float bf2f(bf16 v) { return __uint_as_float(((unsigned)v) << 16); }
DI unsigned pk2(float lo, float hi) { return pg8::cvt_pk_bf16(lo, hi); }
DI bf16 f2bf(float f) { return (bf16)(pk2(f, 0.f) & 0xffffu); }
DI float wave_sum(float v) {
#pragma unroll
    for (int o = 1; o < 64; o <<= 1) v += __shfl_xor(v, o);
    return v;
}
DI f32x16 mfma32(bf16x8 a, bf16x8 b, f32x16 c) { return __builtin_amdgcn_mfma_f32_32x32x16_bf16(a, b, c, 0, 0, 0); }
DI int crow(int i, int hh) { return (i & 3) + 8 * (i >> 2) + 4 * hh; }
DI s16x4 tr_read(LAS unsigned char* p) { return __builtin_bit_cast(s16x4, __builtin_amdgcn_ds_read_tr16_b64_v4i16((LAS v4i16_t*)p)); }
DI bf16x8 trfrag(LAS unsigned char* tile, int stride, int k0, int c0, int lane) {
    const int i16 = lane & 15, qq = i16 >> 2, p = i16 & 3, g2 = (lane >> 4) & 1, hh = lane >> 5;
    LAS unsigned char* a = tile + (k0 + 8 * hh + qq) * stride + (c0 + 16 * g2 + 4 * p) * 2;
    const s16x4 lo = tr_read(a), hi = tr_read(a + 4 * stride);
    return __builtin_shufflevector(lo, hi, 0, 1, 2, 3, 4, 5, 6, 7);
}
DI void unpack8(u32x4 v, float (&f)[8]) {
#pragma unroll
    for (int i = 0; i < 4; ++i) { f[2 * i] = __uint_as_float(v[i] << 16); f[2 * i + 1] = __uint_as_float(v[i] & 0xffff0000u); }
}
DI u32x4 pack8(const float (&f)[8]) { u32x4 o; o.x = pk2(f[0], f[1]); o.y = pk2(f[2], f[3]); o.z = pk2(f[4], f[5]); o.w = pk2(f[6], f[7]); return o; }

#define XB_TMO      128
#define XB_XCNT(j)  (256  + 64 * (j))
#define XB_XSUB(j)  (1280 + 64 * (j))
#define XB_XGEN(j)  (2304 + 64 * (j))
#define XB_TOP      3328
#define XB_TOPGEN   3392
#define XCD_BAR_WORDS 3456
#define XB_SPIN_CAP (1u << 20)
DI unsigned xb_ld(unsigned* p)              { return __hip_atomic_load(p, __ATOMIC_RELAXED, __HIP_MEMORY_SCOPE_AGENT); }
DI unsigned xb_add(unsigned* p, unsigned v) { return __hip_atomic_fetch_add(p, v, __ATOMIC_RELAXED, __HIP_MEMORY_SCOPE_AGENT); }
DI unsigned xb_xcc_id() { return (unsigned)__builtin_amdgcn_s_getreg((3 << 11) | 20) & 0xFu; }
#define XB_SPIN(cond, bar) do { unsigned _sp = 0; while (cond) { __builtin_amdgcn_s_sleep(1); \
    if ((++_sp & 255u) == 0u) { if (xb_ld(&(bar)[XB_TMO])) break; if (_sp > XB_SPIN_CAP) { atomicAdd(&(bar)[XB_TMO], 1u); break; } } } } while (0)
struct XcdBarrier { unsigned* bar; unsigned x; volatile LAS unsigned* st; };
DI XcdBarrier xcd_barrier_post(unsigned* bar, volatile LAS unsigned* st) {
    XcdBarrier b; b.bar = bar; b.x = xb_xcc_id(); b.st = st;
    if (threadIdx.x == 0) (void)xb_add(&bar[XB_XCNT(b.x)], 1u);
    return b;
}
DI void xcd_barrier_complete(unsigned* bar, unsigned x, unsigned& nloc, unsigned& nx) {
    const unsigned G = gridDim.x * gridDim.y * gridDim.z;
    unsigned sum, cnt, mine, sp = 0u;
    for (;;) {
        sum = 0u; cnt = 0u; mine = 0u;
#pragma unroll
        for (unsigned j = 0; j < 16; ++j) { const unsigned c = xb_ld(&bar[XB_XCNT(j)]); sum += c; cnt += (c > 0u) ? 1u : 0u; mine = (j == x) ? c : mine; }
        if (sum == G) break;
        __builtin_amdgcn_s_sleep(1);
        if ((++sp & 255u) == 0u) { if (xb_ld(&bar[XB_TMO])) break; if (sp > XB_SPIN_CAP) { atomicAdd(&bar[XB_TMO], 1u); break; } }
    }
    nloc = mine > 0u ? mine : 1u; nx = cnt > 0u ? cnt : 1u;
}
DI void xcd_barrier(const XcdBarrier& b) {
    asm volatile("s_waitcnt vmcnt(0)" ::: "memory");
    __syncthreads();
    if (threadIdx.x == 0) {
        unsigned* bar = b.bar;
        __builtin_amdgcn_s_waitcnt(0);
        unsigned nloc = b.st[0], nx = b.st[1];
        if (nloc == 0u) { xcd_barrier_complete(bar, b.x, nloc, nx); b.st[0] = nloc; b.st[1] = nx; }
        const unsigned old = xb_add(&bar[XB_XSUB(b.x)], 1u);
        const unsigned gen = old / nloc;
        if (old + 1u == (gen + 1u) * nloc) {
            __builtin_amdgcn_fence(__ATOMIC_RELEASE, "agent");
            asm volatile("s_waitcnt vmcnt(0)" ::: "memory");
            const unsigned og = xb_add(&bar[XB_TOP], 1u);
            const unsigned tg = og / nx;
            if (og + 1u == (tg + 1u) * nx) xb_add(&bar[XB_TOPGEN], 1u);
            else XB_SPIN(xb_ld(&bar[XB_TOPGEN]) == tg, bar);
            __builtin_amdgcn_fence(__ATOMIC_ACQUIRE, "agent");
            xb_add(&bar[XB_XGEN(b.x)], 1u);
            asm volatile("s_waitcnt vmcnt(0)" ::: "memory");
        } else {
            XB_SPIN(xb_ld(&bar[XB_XGEN(b.x)]) == gen, bar);
            __builtin_amdgcn_fence(__ATOMIC_ACQUIRE, "agent");
            asm volatile("s_waitcnt vmcnt(0)" ::: "memory");
        }
    }
    __syncthreads();
}

struct Args { const float* in[23]; float* out; unsigned char* ws; int ph_lo, ph_hi; };
static_assert(sizeof(Args) == 23 * 8 + 8 + 8 + 8, "Args has no padding");
struct Ctx {
    LAS unsigned char* lds;
    unsigned* ctl;
    int tid, lane, wave, G, bid;
    float* out;
    unsigned char* ws;
};
DI bf16* ws_bf(const Ctx& C, size_t off) { return (bf16*)(C.ws + off); }
DI float* ws_f(const Ctx& C, size_t off) { return (float*)(C.ws + off); }
DI bf16* w_in_t(const Ctx& C, int l)  { return (bf16*)(C.ws + WS_W + (size_t)l * W_LAYER_B); }
DI bf16* w_out_t(const Ctx& C, int l) { return (bf16*)(C.ws + WS_W + (size_t)l * W_LAYER_B + W_IN_B); }
DI bf16* w_up_t(const Ctx& C, int l)  { return (bf16*)(C.ws + WS_W + (size_t)l * W_LAYER_B + W_IN_B + W_OUT_B); }
DI bf16* w_dn_t(const Ctx& C, int l)  { return (bf16*)(C.ws + WS_W + (size_t)l * W_LAYER_B + W_IN_B + W_OUT_B + W_UP_B); }

DI int q_next(const Ctx& C, unsigned* head) {
    volatile LAS int* slot = (volatile LAS int*)(C.lds + LDSCTL_OFF + 64);
    __syncthreads();
    if (C.tid == 0) *slot = (int)__hip_atomic_fetch_add(head, 1u, __ATOMIC_RELAXED, __HIP_MEMORY_SCOPE_AGENT);
    __syncthreads();
    return *slot;
}

DI void p0_transpose_item(const float* W, int K, int N, bf16* WT, LAS float* scr, int item, int lane) {
    const int nblk = N / 32, kb = item / nblk, nb = item % nblk, k0 = 64 * kb, n0 = 32 * nb;
#pragma unroll 8
    for (int i = 0; i < 32; ++i) { const int kk = 2 * i + (lane >> 5); scr[kk * 33 + (lane & 31)] = W[(size_t)(k0 + kk) * N + n0 + (lane & 31)]; }
    asm volatile("s_waitcnt lgkmcnt(0)" ::: "memory");
    const int c = lane & 7;
#pragma unroll
    for (int j = 0; j < 4; ++j) { const int n = (lane >> 3) + 8 * j; const LAS float* s = scr + (8 * c) * 33 + n;
        u32x4 o; o.x = pk2(s[0 * 33], s[1 * 33]); o.y = pk2(s[2 * 33], s[3 * 33]); o.z = pk2(s[4 * 33], s[5 * 33]); o.w = pk2(s[6 * 33], s[7 * 33]);
        *(u32x4*)(WT + (size_t)(n0 + n) * K + k0 + 8 * c) = o; }
    asm volatile("s_waitcnt lgkmcnt(0)" ::: "memory");
}
DI void rms_row(const float* src, float* xcopy, const float* w, bf16* outb, float* outf, int lane, const float* part = nullptr, size_t pstride = 0) {
    f32x4 v[8]; float ss = 0.f;
#pragma unroll
    for (int j = 0; j < 8; ++j) { v[j] = ((const f32x4*)src)[lane + 64 * j];
        if (part) { v[j] += ((const f32x4*)part)[lane + 64 * j]; v[j] += ((const f32x4*)(part + pstride))[lane + 64 * j]; v[j] += ((const f32x4*)(part + 2 * pstride))[lane + 64 * j]; }
        ss += (v[j].x * v[j].x + v[j].y * v[j].y) + (v[j].z * v[j].z + v[j].w * v[j].w); }
    if (xcopy) {
#pragma unroll
        for (int j = 0; j < 8; ++j) ((f32x4*)xcopy)[lane + 64 * j] = v[j];
    }
    ss = wave_sum(ss);
    const float rs = 1.0f / sqrtf(ss * (1.0f / DM) + EPS);
#pragma unroll
    for (int j = 0; j < 8; ++j) { const f32x4 wv = ((const f32x4*)w)[lane + 64 * j]; const f32x4 o = v[j] * rs * wv;
        if (outb) { u32x2 p; p.x = pk2(o.x, o.y); p.y = pk2(o.z, o.w); ((u32x2*)outb)[lane + 64 * j] = p; }
        if (outf) ((f32x4*)outf)[lane + 64 * j] = o; }
}
DI void sincos_tab(float ang, float& c, float& s) {
    const double a = (double)ang; const double kq = rint(a * 0.63661977236758134308); const double x = a - kq * 1.57079632679489661923; const double x2 = x * x;
    const double sn = x * (1.0 + x2 * (-1.0 / 6 + x2 * (1.0 / 120 + x2 * (-1.0 / 5040 + x2 * (1.0 / 362880 + x2 * (-1.0 / 39916800 + x2 * (1.0 / 6227020800.0)))))));
    const double cn = 1.0 + x2 * (-0.5 + x2 * (1.0 / 24 + x2 * (-1.0 / 720 + x2 * (1.0 / 40320 + x2 * (-1.0 / 3628800 + x2 * (1.0 / 479001600 + x2 * (-1.0 / 87178291200.0)))))));
    const int q = ((int)kq) & 3;
    const double cc = (q == 0) ? cn : (q == 1) ? -sn : (q == 2) ? -cn : sn;
    const double sc = (q == 0) ? sn : (q == 1) ? cn : (q == 2) ? -sn : -cn;
    c = (float)cc; s = (float)sc;
}
DI void p0_prologue(const Ctx& C, const Args& A) {
    LAS float* scr = (LAS float*)(C.lds + C.wave * 16384);
    const int gw = C.bid * NWAVES + C.wave, NGW = C.G * NWAVES;
    constexpr int I_IN = (DM / 64) * (INC / 32), I_OUT = (DM / 64) * (DM / 32), I_UP = (DM / 64) * (DFF / 32), I_DN = (DFF / 64) * (DM / 32), I_L = I_IN + I_OUT + I_UP + I_DN;
    for (int it = gw; it < DEPTH * I_L; it += NGW) {
        const int l = it / I_L; int r = it % I_L;
        if (r < I_IN) { p0_transpose_item(A.in[10] + (size_t)l * DM * INC, DM, INC, w_in_t(C, l), scr, r, C.lane); continue; } r -= I_IN;
        if (r < I_OUT) { p0_transpose_item(A.in[11] + (size_t)l * DM * DM, DM, DM, w_out_t(C, l), scr, r, C.lane); continue; } r -= I_OUT;
        if (r < I_UP) { p0_transpose_item(A.in[20] + (size_t)l * DM * DFF, DM, DFF, w_up_t(C, l), scr, r, C.lane); continue; } r -= I_UP;
        p0_transpose_item(A.in[21] + (size_t)l * DFF * DM, DFF, DM, w_dn_t(C, l), scr, r, C.lane);
    }
    { const int gt = C.bid * NTHR + C.tid, NGT = C.G * NTHR; constexpr int CH_L = (INP - INC) * DM / 8;
      for (int i = gt; i < DEPTH * CH_L; i += NGT) { const int l = i / CH_L, c = i % CH_L; ((u32x4*)(w_in_t(C, l) + (size_t)INC * DM))[c] = (u32x4){0u, 0u, 0u, 0u}; }
      float* ra = ws_f(C, WS_ROPE); float* ri = ra + 2048 * 16 * 2;
      for (int i = gt; i < 2048 * 24; i += NGT) { const int pos = i / 24, k = i % 24; const bool isa = k < 16; const int fi = isa ? k : k - 16;
          const double ex = isa ? (double)fi / 16.0 : (double)fi / 8.0; const float inv = (float)exp2(-ex * 18.931568569324174  );
          const float ang = (float)pos * inv; float c, s; sincos_tab(ang, c, s);
          float* dst = isa ? ra + (pos * 16 + fi) * 2 : ri + (pos * 8 + fi) * 2; dst[0] = c; dst[1] = s; } }
    for (int m = gw; m < NTOK; m += NGW) { const float* src = m < NTP ? A.in[0] + (size_t)m * DM : A.in[1] + (size_t)(m - NTP) * DM;
        rms_row(src, ws_f(C, WS_X) + (size_t)m * DM, A.in[9], ws_bf(C, WS_H) + (size_t)m * DM, nullptr, C.lane); }
}

struct M0Row { unsigned ra1, ra2, ri1, ri2, rk1, rk2; u32x4 cak, cav, cik, cbk, cbv, xb[4]; f32x4 tA, tI; bf16 dt; };
DI void m0_decode(int r, bool& smp, int& b, int& t, int& pos) { smp = r >= NTP; if (!smp) { b = r >> 11; t = r & 2047; pos = t; } else { const int rr = r - NTP; b = rr >> 6; t = rr & 63; pos = PAST + t; } }
DI void m0_load(const Ctx& C, int r, int lane, M0Row& R) {
    const bf16* P = ws_bf(C, WS_PU) + (size_t)r * INP;
    bool smp; int b, t, pos; m0_decode(r, smp, b, t, pos);
    { const int h8 = lane >> 3, j = lane & 7; const bf16* p = P + (h8 < 4 ? C_AQ + h8 * 128 : C_AK + (h8 - 4) * 128) + 2 * j; R.ra1 = *(const unsigned*)p; R.ra2 = *(const unsigned*)(p + 16); }
    { const int h16 = lane >> 2, j = lane & 3; const bf16* p = P + C_IQ + h16 * 64 + 2 * j; R.ri1 = *(const unsigned*)p; R.ri2 = *(const unsigned*)(p + 8); }
    if (lane < 4) { const bf16* p = P + C_IK + 2 * lane; R.rk1 = *(const unsigned*)p; R.rk2 = *(const unsigned*)(p + 8); }
    if (lane < 48) R.cak = *(const u32x4*)(P + C_AK + (lane / 12) * 128 + 32 + (lane % 12) * 8);
    R.cav = *(const u32x4*)(P + C_AV + lane * 8);
    if (lane >= 8 && lane < 14) R.cik = *(const u32x4*)(P + C_IK + 16 + (lane - 8) * 8);
    if (smp || t >= SEQ - BWIN) { R.cbk = *(const u32x4*)(P + C_BK + lane * 8); R.cbv = *(const u32x4*)(P + C_BV + lane * 8); }
    if (lane < 16) R.dt = P[C_DT + lane];
#pragma unroll
    for (int it = 0; it < 4; ++it) R.xb[it] = *(const u32x4*)(P + C_XBC + (lane + 64 * it) * 8);
    R.tA = *(const f32x4*)(ws_f(C, WS_ROPE) + (size_t)pos * 32 + 4 * (lane & 7));
    R.tI = *(const f32x4*)(ws_f(C, WS_ROPE) + 2048 * 32 + (size_t)pos * 16 + 4 * (lane & 3));
}
DI void rope2(unsigned a, unsigned bq, f32x4 t, float (&y1)[2], float (&y2)[2]) {
    const float a0 = __uint_as_float(a << 16), a1 = __uint_as_float(a & 0xffff0000u), b0 = __uint_as_float(bq << 16), b1 = __uint_as_float(bq & 0xffff0000u);
    y1[0] = a0 * t.x - b0 * t.y; y2[0] = b0 * t.x + a0 * t.y; y1[1] = a1 * t.z - b1 * t.w; y2[1] = b1 * t.z + a1 * t.w;
}
DI void st8f(float* dst, u32x4 v) { float f[8]; unpack8(v, f); ((f32x4*)dst)[0] = (f32x4){f[0], f[1], f[2], f[3]}; ((f32x4*)dst)[1] = (f32x4){f[4], f[5], f[6], f[7]}; }
DI void m0_window(const Ctx& C, const Args& A, int l, int r, int lane, u32x4 (&wnd)[3][4]) {
    bool smp; int b, t, pos; m0_decode(r, smp, b, t, pos);
#pragma unroll
    for (int k = 1; k <= 3; ++k) { const int tt = t - k;
#pragma unroll
        for (int it = 0; it < 4; ++it) { const int ch = (lane + 64 * it) * 8; u32x4 v = (u32x4){0u, 0u, 0u, 0u};
            if (tt >= 0) v = *(const u32x4*)(ws_bf(C, WS_PU) + (size_t)(r - k) * INP + C_XBC + ch);
            else if (smp) { const float* sp = A.in[8] + ((size_t)(l * DBAT + b) * 3 + (3 + tt)) * 2048 + ch; const f32x4 s0 = *(const f32x4*)sp, s1 = *(const f32x4*)(sp + 4);
                v.x = pk2(s0.x, s0.y); v.y = pk2(s0.z, s0.w); v.z = pk2(s1.x, s1.y); v.w = pk2(s1.z, s1.w); }
            wnd[3 - k][it] = v; } }
}
DI void m0_process(const Ctx& C, const Args& A, int l, int r, int lane, const M0Row& R, u32x4 (&wnd)[3][4], const LAS float* cwL, const LAS float* cbL) {
    bf16* P = ws_bf(C, WS_PU) + (size_t)r * INP;
    bool smp; int b, t, pos; m0_decode(r, smp, b, t, pos);
    float* out = C.out;
    float* o_ak = smp ? out + OFF_S_AK + ((size_t)(l * DBAT + b) * DSEQ + t) * 512 : out + OFF_P_AK + ((size_t)(l * NB + b) * SEQ + t) * 512;
    float* o_av = smp ? out + OFF_S_AV + ((size_t)(l * DBAT + b) * DSEQ + t) * 512 : out + OFF_P_AV + ((size_t)(l * NB + b) * SEQ + t) * 512;
    float* o_ki = smp ? out + OFF_S_KI + ((size_t)(l * DBAT + b) * DSEQ + t) * 64 : out + OFF_P_KI + ((size_t)(l * NB + b) * SEQ + t) * 64;
    float y1[2], y2[2];
    { const int h8 = lane >> 3, j = lane & 7; rope2(R.ra1, R.ra2, R.tA, y1, y2);
      bf16* p = P + (h8 < 4 ? C_AQ + h8 * 128 : C_AK + (h8 - 4) * 128) + 2 * j; *(unsigned*)p = pk2(y1[0], y1[1]); *(unsigned*)(p + 16) = pk2(y2[0], y2[1]);
      if (h8 >= 4) { float* o = o_ak + (h8 - 4) * 128 + 2 * j; *(f32x2_t_*)o = (f32x2_t_){y1[0], y1[1]}; *(f32x2_t_*)(o + 16) = (f32x2_t_){y2[0], y2[1]}; } }
    { const int h16 = lane >> 2, j = lane & 3; rope2(R.ri1, R.ri2, R.tI, y1, y2);
      bf16* p = P + C_IQ + h16 * 64 + 2 * j; *(unsigned*)p = pk2(y1[0], y1[1]); *(unsigned*)(p + 8) = pk2(y2[0], y2[1]); }
    if (lane < 4) { rope2(R.rk1, R.rk2, R.tI, y1, y2);
      bf16* p = P + C_IK + 2 * lane; *(unsigned*)p = pk2(y1[0], y1[1]); *(unsigned*)(p + 8) = pk2(y2[0], y2[1]);
      float* o = o_ki + 2 * lane; *(f32x2_t_*)o = (f32x2_t_){y1[0], y1[1]}; *(f32x2_t_*)(o + 8) = (f32x2_t_){y2[0], y2[1]}; }
    if (lane < 48) st8f(o_ak + (lane / 12) * 128 + 32 + (lane % 12) * 8, R.cak);
    st8f(o_av + lane * 8, R.cav);
    if (lane >= 8 && lane < 14) st8f(o_ki + 16 + (lane - 8) * 8, R.cik);
    if (smp || t >= SEQ - BWIN) {
        const size_t ro = smp ? ((size_t)(l * DBAT + b) * DSEQ + t) * 512 : ((size_t)(l * NB + b) * BWIN + (t - (SEQ - BWIN))) * 512;
        st8f(out + (smp ? OFF_S_BK : OFF_P_BK) + ro + lane * 8, R.cbk); st8f(out + (smp ? OFF_S_BV : OFF_P_BV) + ro + lane * 8, R.cbv);
    }
    if (lane < 16) { const float x = bf2f(R.dt) + A.in[15][l * 16 + lane]; ws_f(C, WS_DTS)[(size_t)r * 16 + lane] = x > 20.f ? x : log1pf(__expf(x)); }
    const int stt = smp ? DSEQ - 3 : SEQ - 3;
    float* o_conv = (t >= stt) ? (smp ? out + OFF_S_CONV + ((size_t)(l * DBAT + b) * 3 + (t - stt)) * 2048 : out + OFF_P_CONV + ((size_t)(l * NB + b) * 3 + (t - stt)) * 2048) : nullptr;
    bf16* xo = ws_bf(C, WS_XBC) + (size_t)r * 2048;
#pragma unroll
    for (int it = 0; it < 4; ++it) { const int ch = (lane + 64 * it) * 8;
        float acc[8], x[8];
        { const f32x4 b0 = *(const LAS f32x4*)(cbL + ch), b1 = *(const LAS f32x4*)(cbL + ch + 4); acc[0] = b0.x; acc[1] = b0.y; acc[2] = b0.z; acc[3] = b0.w; acc[4] = b1.x; acc[5] = b1.y; acc[6] = b1.z; acc[7] = b1.w; }
#pragma unroll
        for (int j = 0; j < 4; ++j) { unpack8(j < 3 ? wnd[j][it] : R.xb[it], x);
            const f32x4 w0 = *(const LAS f32x4*)(cwL + j * 2048 + ch), w1 = *(const LAS f32x4*)(cwL + j * 2048 + ch + 4);
            acc[0] += x[0] * w0.x; acc[1] += x[1] * w0.y; acc[2] += x[2] * w0.z; acc[3] += x[3] * w0.w; acc[4] += x[4] * w1.x; acc[5] += x[5] * w1.y; acc[6] += x[6] * w1.z; acc[7] += x[7] * w1.w; }
        if (o_conv) { ((f32x4*)(o_conv + ch))[0] = (f32x4){x[0], x[1], x[2], x[3]}; ((f32x4*)(o_conv + ch))[1] = (f32x4){x[4], x[5], x[6], x[7]}; }
#pragma unroll
        for (int k = 0; k < 8; ++k) acc[k] = acc[k] / (1.f + __expf(-acc[k]));
        *(u32x4*)(xo + ch) = pack8(acc);
        wnd[0][it] = wnd[1][it]; wnd[1][it] = wnd[2][it]; wnd[2][it] = R.xb[it];
        asm volatile("" ::: "memory");
    }
}
DI void cvt_f4(const float* src, bf16* dst, size_t n4, size_t gt, size_t ngt) {
    size_t i = gt;
    for (; i + 3 * ngt < n4; i += 4 * ngt) { f32x4 v[4];
#pragma unroll
        for (int k = 0; k < 4; ++k) v[k] = ((const f32x4*)src)[i + k * ngt];
#pragma unroll
        for (int k = 0; k < 4; ++k) { u32x2 o; o.x = pk2(v[k].x, v[k].y); o.y = pk2(v[k].z, v[k].w); ((u32x2*)dst)[i + k * ngt] = o; } }
    for (; i < n4; i += ngt) { const f32x4 v = ((const f32x4*)src)[i]; u32x2 o; o.x = pk2(v.x, v.y); o.y = pk2(v.z, v.w); ((u32x2*)dst)[i] = o; }
}
DI void m0_phase(const Ctx& C, const Args& A, int l) {
    LAS float* cwL = (LAS float*)C.lds; LAS float* cbL = cwL + 4 * 2048;
    { const float* cw = A.in[13] + (size_t)l * 4 * 2048; const float* cb = A.in[14] + (size_t)l * 2048;
      for (int i = C.tid; i < 2048; i += NTHR) ((LAS f32x4*)cwL)[i] = ((const f32x4*)cw)[i];
      for (int i = C.tid; i < 512; i += NTHR) ((LAS f32x4*)cbL)[i] = ((const f32x4*)cb)[i]; }
    __syncthreads();
    const int gw = C.bid * NWAVES + C.wave, NGW = C.G * NWAVES, per = (NTOK + NGW - 1) / NGW;
    const int r0 = gw * per, r1 = (r0 + per < NTOK) ? r0 + per : NTOK;
    if (r0 < r1) {
        u32x4 wnd[3][4]; M0Row cur, nxt;
        m0_load(C, r0, C.lane, cur); m0_window(C, A, l, r0, C.lane, wnd);
#pragma unroll 1
        for (int r = r0; r < r1; ++r) {
            if (r + 1 < r1) m0_load(C, r + 1, C.lane, nxt);
            if (r != r0) { bool smp; int b, t, pos; m0_decode(r, smp, b, t, pos); if (t == 0) m0_window(C, A, l, r, C.lane, wnd); }
            m0_process(C, A, l, r, C.lane, cur, wnd, cwL, cbL);
            cur = nxt;
        }
    }
    const size_t gt = (size_t)C.bid * NTHR + C.tid, ngt = (size_t)C.G * NTHR;
    cvt_f4(A.in[2] + (size_t)l * DBAT * PAST * 512, ws_bf(C, WS_CAK), (size_t)DBAT * PAST * 512 / 4, gt, ngt);
    cvt_f4(A.in[3] + (size_t)l * DBAT * PAST * 512, ws_bf(C, WS_CAV), (size_t)DBAT * PAST * 512 / 4, gt, ngt);
    cvt_f4(A.in[4] + (size_t)l * DBAT * PAST * 64, ws_bf(C, WS_CKI), (size_t)DBAT * PAST * 64 / 4, gt, ngt);
    cvt_f4(A.in[5] + (size_t)l * DBAT * BWIN * 512, ws_bf(C, WS_CBK), (size_t)DBAT * BWIN * 512 / 4, gt, ngt);
    cvt_f4(A.in[6] + (size_t)l * DBAT * BWIN * 512, ws_bf(C, WS_CBV), (size_t)DBAT * BWIN * 512 / 4, gt, ngt);
}

struct KVSrc { const bf16* k0; const bf16* v0; int s0; int n0; const bf16* k1; const bf16* v1; int s1; };
template <int MODE>
DI void attn_unit(const Ctx& C, const bf16* Qp, int qstride, const KVSrc& S, int tile_lo, int tile_hi, bf16* Op, int ostride) {
    int tid = C.tid, lane = C.lane; asm volatile("" : "+v"(tid), "+v"(lane));
    const int w = C.wave, r = lane & 31, hh = lane >> 5;
    const int head = w >> 1, q = (w & 1) * 32 + r;
    LAS unsigned char* Vs = C.lds + ATT_V;
    bf16x8 qf[8];
    { const bf16* qrow = Qp + (size_t)q * qstride + head * 128 + 8 * hh;
#pragma unroll
      for (int ks = 0; ks < 8; ++ks) qf[ks] = *(const bf16x8*)(qrow + 16 * ks); }
    f32x16 o[4];
#pragma unroll
    for (int d = 0; d < 4; ++d)
#pragma unroll
        for (int i = 0; i < 16; ++i) o[d][i] = 0.f;
    float m = -1e30f, lsum = 0.f;
    constexpr float SC2 = 0.08838834764831845f * 1.4426950408889634f;
    constexpr float L2E = 1.4426950408889634f;
    bf16x8 kf[8]; u32x4 vr[4];
#define ATT_KLOAD(tile_) do { const int key_ = (tile_) * 32 + r; const bf16* kp_ = (key_ < S.n0 ? S.k0 + (ptrdiff_t)key_ * S.s0 : S.k1 + (ptrdiff_t)(key_ - S.n0) * S.s1) + head * 128 + 8 * hh; \
        _Pragma("unroll") for (int ks_ = 0; ks_ < 8; ++ks_) kf[ks_] = *(const bf16x8*)(kp_ + 16 * ks_); } while (0)
#define ATT_VLOAD(tile_) do { _Pragma("unroll") for (int i_ = 0; i_ < 4; ++i_) { const int ci_ = tid + 512 * i_, row_ = ci_ >> 6, ch_ = ci_ & 63, key_ = (tile_) * 32 + row_; \
        const bf16* vp_ = key_ < S.n0 ? S.v0 + (ptrdiff_t)key_ * S.s0 : S.v1 + (ptrdiff_t)(key_ - S.n0) * S.s1; vr[i_] = *(const u32x4*)(vp_ + ch_ * 8); } } while (0)
#define ATT_VSTORE(buf_) do { _Pragma("unroll") for (int i_ = 0; i_ < 4; ++i_) { const int ci_ = tid + 512 * i_, row_ = ci_ >> 6, ch_ = ci_ & 63; \
        *(LAS u32x4*)(Vs + (buf_) * (32 * VSTR) + row_ * VSTR + ch_ * 16) = vr[i_]; } } while (0)
    ATT_KLOAD(tile_lo); ATT_VLOAD(tile_lo);
    __syncthreads();
    ATT_VSTORE(0);
    if (tile_lo + 1 < tile_hi) ATT_VLOAD(tile_lo + 1);
    __syncthreads();
    const int i16 = lane & 15;
    LAS unsigned char* vbase = Vs + (4 * hh + (i16 >> 2)) * VSTR + (head * 128 + 16 * ((lane >> 4) & 1) + 4 * (i16 & 3)) * 2;
    const LAS float* btab = (const LAS float*)(C.lds + ATT_SEL) + head * 257;
    const LAS unsigned* sel = (const LAS unsigned*)(C.lds + ATT_SEL) + q * 64;
#pragma unroll 1
    for (int tile = tile_lo; tile < tile_hi; ++tile) {
        const int cur = (tile - tile_lo) & 1;
        f32x16 s;
        if (MODE == 0) {
            const unsigned nwd = ~(sel[tile] >> (4 * hh));
#pragma unroll
            for (int i = 0; i < 16; ++i) { const int mb = ((int)(nwd << (31 - ((i & 3) + 8 * (i >> 2))))) >> 31; s[i] = __int_as_float(mb & (int)0xFF800000); }
        } else {
            if (tile <= 11) { const float bb = btab[256] * (L2E / SC2);
#pragma unroll
                for (int i = 0; i < 16; ++i) s[i] = bb;
            } else {
#pragma unroll
                for (int i = 0; i < 16; ++i) { int rel = BWIN + q - (tile * 32 + crow(i, hh)); rel = rel > 128 ? 128 : rel; s[i] = btab[rel + 128] * (L2E / SC2); }
            }
        }
#pragma unroll
        for (int ks = 0; ks < 8; ++ks) s = mfma32(kf[ks], qf[ks], s);
        if (tile + 1 < tile_hi) ATT_KLOAD(tile + 1);
        float mx = s[0];
#pragma unroll
        for (int i = 1; i < 16; ++i) mx = fmaxf(mx, s[i]);
        mx = fmaxf(mx, __shfl_xor(mx, 32)) * SC2;
        const bool need = mx > m + 8.0f;
        if (__any(need)) {
            const float mn = need ? mx : m, alpha = __builtin_amdgcn_exp2f(m - mn);
            lsum *= alpha; m = mn;
#pragma unroll
            for (int d = 0; d < 4; ++d)
#pragma unroll
                for (int i = 0; i < 16; ++i) o[d][i] *= alpha;
        }
        float rs = 0.f;
#pragma unroll
        for (int i = 0; i < 16; ++i) { s[i] = __builtin_amdgcn_exp2f(__builtin_fmaf(s[i], SC2, -m)); rs += s[i]; }
        rs += __shfl_xor(rs, 32);
        lsum += rs;
        bf16x8 pf[2];
#pragma unroll
        for (int s2 = 0; s2 < 2; ++s2) { u32x4 pk; pk.x = pk2(s[8 * s2], s[8 * s2 + 1]); pk.y = pk2(s[8 * s2 + 2], s[8 * s2 + 3]); pk.z = pk2(s[8 * s2 + 4], s[8 * s2 + 5]); pk.w = pk2(s[8 * s2 + 6], s[8 * s2 + 7]);
            pf[s2] = __builtin_bit_cast(bf16x8, pk); }
        LAS unsigned char* vb = vbase + cur * (32 * VSTR);
#pragma unroll
        for (int d = 0; d < 4; ++d)
#pragma unroll
            for (int s2 = 0; s2 < 2; ++s2) {
                const s16x4 lo = tr_read(vb + (16 * s2) * VSTR + d * 64), hi = tr_read(vb + (16 * s2 + 8) * VSTR + d * 64);
                const bf16x8 vt = __builtin_shufflevector(lo, hi, 0, 1, 2, 3, 4, 5, 6, 7);
                o[d] = mfma32(vt, pf[s2], o[d]);
            }
        if (tile + 1 < tile_hi) { ATT_VSTORE(cur ^ 1); if (tile + 2 < tile_hi) ATT_VLOAD(tile + 2); }
        __syncthreads();
    }
#undef ATT_KLOAD
#undef ATT_VLOAD
#undef ATT_VSTORE
    const float inv = 1.0f / lsum;
    bf16* orow = Op + (size_t)q * ostride + head * 128 + 4 * hh;
#pragma unroll
    for (int d = 0; d < 4; ++d)
#pragma unroll
        for (int g = 0; g < 4; ++g) { u32x2 p; p.x = pk2(o[d][4 * g] * inv, o[d][4 * g + 1] * inv); p.y = pk2(o[d][4 * g + 2] * inv, o[d][4 * g + 3] * inv);
            *(u32x2*)(orow + 32 * d + 8 * g) = p; }
}

DI unsigned fkey(float f) { const unsigned u = __float_as_uint(f); return (u & 0x80000000u) ? ~u : (u | 0x80000000u); }
template <int NR>
DI void topk_pair(const float* SCq  , LAS unsigned* SELa  , int NT, int r, int hh, int lane) {
    unsigned v[NR];
#pragma unroll
    for (int i = 0; i < NR; ++i) { const float f = (i < NT) ? SCq[i * 32 + r] : -INFINITY; v[i] = fkey(f); }
    unsigned T = 0u;
#pragma unroll 1
    for (int bit = 31; bit >= 8; --bit) {
        const unsigned cand = T | (1u << bit); unsigned cnt = 0u;
#pragma unroll
        for (int i = 0; i < NR; ++i) asm("v_cmp_ge_u32 vcc, %1, %2\n\tv_addc_co_u32 %0, vcc, 0, %0, vcc" : "+v"(cnt) : "v"(v[i]), "v"(cand) : "vcc");
        unsigned t0 = 0u, t1 = 0u;
#pragma unroll
        for (int b = 0; b < 7; ++b) { const unsigned long long mk = __ballot((cnt >> b) & 1u); t0 += (unsigned)__popc((unsigned)mk) << b; t1 += (unsigned)__popc((unsigned)(mk >> 32)) << b; }
        if ((hh ? t1 : t0) >= 256u) T = cand;
    }
#pragma unroll
    for (int i = 0; i < NR; ++i) { unsigned long long mk = __ballot(v[i] >= T); if (i >= NT) mk = 0ull;
        if (lane == 0) { SELa[i] = (unsigned)mk; SELa[64 + i] = (unsigned)(mk >> 32); } }
}
DI void dsa_unit(const Ctx& C, int l, int u) {
    int lane = C.lane; asm volatile("" : "+v"(lane));
    const int w = C.wave, r = lane & 31, hh = lane >> 5;
    const bf16* PROJ = ws_bf(C, WS_PU);
    int qrow0, NT, limit; KVSrc S; const bf16* ik0; const bf16* ik1; int iks0, ikn0;
    if (u < 256) { const int c = 31 - (u >> 3), b = u & 7; qrow0 = b * SEQ + c * 64; NT = 2 * (c + 1); limit = 64 * (c + 1);
        const bf16* base = PROJ + (size_t)(b * SEQ) * INP;
        S.k0 = base + C_AK; S.v0 = base + C_AV; S.s0 = INP; S.n0 = limit; S.k1 = S.k0; S.v1 = S.v0; S.s1 = INP;
        ik0 = base + C_IK; iks0 = INP; ikn0 = limit; ik1 = ik0;
    } else { const int b = u - 256; qrow0 = NTP + b * DSEQ; NT = (PAST + DSEQ) / 32; limit = PAST + DSEQ;
        const bf16* nb = PROJ + (size_t)qrow0 * INP;
        S.k0 = ws_bf(C, WS_CAK) + (size_t)b * PAST * 512; S.v0 = ws_bf(C, WS_CAV) + (size_t)b * PAST * 512; S.s0 = 512; S.n0 = PAST; S.k1 = nb + C_AK; S.v1 = nb + C_AV; S.s1 = INP;
        ik0 = ws_bf(C, WS_CKI) + (size_t)b * PAST * 64; iks0 = 64; ikn0 = PAST; ik1 = nb + C_IK;
    }
    float* SC = ws_f(C, WS_SC) + (size_t)C.bid * 64 * 2048;
    LAS unsigned* SEL = (LAS unsigned*)(C.lds + ATT_SEL);
    if (limit > 256) {
#ifndef REP_IDX
#define REP_IDX 1
#endif
#ifndef REP_TOPK
#define REP_TOPK 1
#endif
#ifndef REP_ATT
#define REP_ATT 1
#endif
#pragma unroll 1
    for (int pass = 0; pass < 2 * REP_IDX; ++pass) {
        bf16x8 af[2][4]; float wt[2][16];
#pragma unroll
        for (int np = 0; np < 2; ++np) { const int pp = (pass & 1) * 2 + np;
            const bf16* ap = PROJ + (size_t)(qrow0 + 8 * w + 2 * pp + (r >> 4)) * INP + C_IQ + (r & 15) * 64 + 8 * hh;
#pragma unroll
            for (int ks = 0; ks < 4; ++ks) af[np][ks] = *(const bf16x8*)(ap + 16 * ks);
#pragma unroll
            for (int i = 0; i < 16; ++i) { const int qi = 8 * w + 2 * pp + (i >> 3), hd = (i & 3) + 8 * ((i >> 2) & 1) + 4 * hh;
                wt[np][i] = bf2f(PROJ[(size_t)(qrow0 + qi) * INP + C_IW + hd]) * (0.25f * 0.125f); } }
        bf16x8 bk[4], bn[4];
#define IDX_LOAD(dst_, tile_) do { const int key_ = (tile_) * 32 + r; const bf16* kp_ = (key_ < ikn0 ? ik0 + (size_t)key_ * iks0 : ik1 + (size_t)(key_ - ikn0) * INP) + 8 * hh; \
            _Pragma("unroll") for (int ks_ = 0; ks_ < 4; ++ks_) dst_[ks_] = *(const bf16x8*)(kp_ + 16 * ks_); } while (0)
        IDX_LOAD(bn, 0);
#pragma unroll 1
        for (int tile = 0; tile < NT; ++tile) {
#pragma unroll
            for (int ks = 0; ks < 4; ++ks) bk[ks] = bn[ks];
            if (tile + 1 < NT) IDX_LOAD(bn, tile + 1);
#pragma unroll
            for (int np = 0; np < 2; ++np) {
                f32x16 acc;
#pragma unroll
                for (int i = 0; i < 16; ++i) acc[i] = 0.f;
#pragma unroll
                for (int ks = 0; ks < 4; ++ks) acc = mfma32(af[np][ks], bk[ks], acc);
                float p0 = 0.f, p1 = 0.f;
#pragma unroll
                for (int i = 0; i < 8; ++i) { p0 += fmaxf(acc[i], 0.f) * wt[np][i]; p1 += fmaxf(acc[8 + i], 0.f) * wt[np][8 + i]; }
                const float t0 = p0 + __shfl_xor(p0, 32), t1 = p1 + __shfl_xor(p1, 32);
                const int ql = 8 * w + 2 * ((pass & 1) * 2 + np) + hh;
                SC[(size_t)ql * 2048 + tile * 32 + r] = hh ? t1 : t0;
            }
        }
    }
#undef IDX_LOAD
    asm volatile("s_waitcnt vmcnt(0)" ::: "memory");
    __builtin_amdgcn_fence(__ATOMIC_ACQUIRE, "agent");
    asm volatile("s_waitcnt vmcnt(0)" ::: "memory");
#pragma unroll 1
    for (int pq = 0; pq < 4 * REP_TOPK; ++pq) { const int pp = pq & 3;
        const float* SCq = SC + (size_t)(8 * w + 2 * pp + hh) * 2048; LAS unsigned* SELa = SEL + (8 * w + 2 * pp) * 64;
        if (NT <= 16) topk_pair<16>(SCq, SELa, NT, r, hh, lane);
        else if (NT <= 32) topk_pair<32>(SCq, SELa, NT, r, hh, lane);
        else if (NT <= 48) topk_pair<48>(SCq, SELa, NT, r, hh, lane);
        else topk_pair<64>(SCq, SELa, NT, r, hh, lane);
    }
    } else {
        for (int i = lane; i < 8 * 64; i += 64) SEL[8 * w * 64 + i] = ((i & 63) < NT) ? 0xffffffffu : 0u;
    }
    __syncthreads();
#pragma unroll 1
    for (int rep = 0; rep < REP_ATT; ++rep)
    attn_unit<0>(C, PROJ + (size_t)qrow0 * INP + C_AQ, INP, S, 0, NT, ws_bf(C, WS_MIX) + (size_t)qrow0 * DM, DM);
}

DI void band_unit(const Ctx& C, const Args& A, int l, int u) {
    const bf16* PROJ = ws_bf(C, WS_PU);
    int qrow0, tlo; KVSrc S;
    if (u < 256) { const int c = 31 - (u >> 3), b = u & 7; qrow0 = b * SEQ + c * 64; tlo = c < 8 ? (8 - c) * 2 : 0;
        const bf16* base = PROJ + ((ptrdiff_t)b * SEQ + c * 64 - BWIN) * INP;
        S.k0 = base + C_BK; S.v0 = base + C_BV; S.s0 = INP; S.n0 = BWIN + 64; S.k1 = S.k0; S.v1 = S.v0; S.s1 = INP;
    } else { const int b = u - 256; qrow0 = NTP + b * DSEQ; tlo = 0;
        const bf16* nb = PROJ + (size_t)qrow0 * INP;
        S.k0 = ws_bf(C, WS_CBK) + (size_t)b * BWIN * 512; S.v0 = ws_bf(C, WS_CBV) + (size_t)b * BWIN * 512; S.s0 = 512; S.n0 = BWIN; S.k1 = nb + C_BK; S.v1 = nb + C_BV; S.s1 = INP;
    }
    LAS float* bt = (LAS float*)(C.lds + ATT_SEL);
    const float* brel = A.in[12] + (size_t)l * 4 * 257;
    for (int i = C.tid; i < 4 * 257; i += NTHR) bt[i] = brel[i];
    __syncthreads();
    attn_unit<1>(C, PROJ + (size_t)qrow0 * INP + C_BQ, INP, S, tlo, (BWIN + 64) / 32, ws_bf(C, WS_MIX) + (size_t)qrow0 * DM + 512, DM);
}

DI void ssd_unit(const Ctx& C, const Args& A, int l, int row0, int nchunks, int h, const float* h0, float* hout) {
    int tid = C.tid, lane = C.lane; asm volatile("" : "+v"(tid), "+v"(lane));
    const int w = C.wave, r = lane & 31, hh = lane >> 5, g = h >> 2;
    LAS unsigned char* L = C.lds;
    LAS unsigned char* Cs = L + SSD_CS; LAS unsigned char* Bs = L + SSD_BS; LAS unsigned char* XD = L + SSD_XD; LAS unsigned char* XDW = L + SSD_XDW; LAS unsigned char* Ms = L + SSD_MS; LAS unsigned char* Ys = L + SSD_Y;
    LAS float* v_acs = (LAS float*)(L + SSD_VEC); LAS float* v_e = v_acs + 64;
    const bf16* XBC = ws_bf(C, WS_XBC); const bf16* PROJ = ws_bf(C, WS_PU); const float* DTS = ws_f(C, WS_DTS); float* G = ws_f(C, WS_G);
    const float a_h = -expf(A.in[16][l * 16 + h]); const float dsk = A.in[17][l * 16 + h];
    const int erow = tid >> 3, ech = tid & 7;
    f32x16 Hacc[2];
#pragma unroll
    for (int pb = 0; pb < 2; ++pb)
#pragma unroll
        for (int i = 0; i < 16; ++i) Hacc[pb][i] = 0.f;
    u32x4 pC[2], pB[2], pX, pZ; float pDt;
#define SSD_LOAD(c_) do { const int rb_ = row0 + (c_) * 64; \
        _Pragma("unroll") for (int i_ = 0; i_ < 2; ++i_) { const int ci_ = tid + 512 * i_; const bf16* src_ = XBC + (size_t)(rb_ + (ci_ >> 4)) * 2048 + g * 128 + (ci_ & 15) * 8; pB[i_] = *(const u32x4*)(src_ + 1024); pC[i_] = *(const u32x4*)(src_ + 1536); } \
        pX = *(const u32x4*)(XBC + (size_t)(rb_ + erow) * 2048 + h * 64 + ech * 8); pZ = *(const u32x4*)(PROJ + (size_t)(rb_ + erow) * INP + C_CZ + h * 64 + ech * 8); \
        pDt = DTS[(size_t)(rb_ + lane) * 16 + h]; } while (0)
    SSD_LOAD(0);
    __syncthreads();
    if (w >= 4) { const int nb = w - 4;
#pragma unroll
        for (int pb = 0; pb < 2; ++pb)
#pragma unroll
            for (int i = 0; i < 16; ++i) { const int p = 32 * pb + crow(i, hh), n = 32 * nb + r; const float v = h0 ? h0[p * 128 + n] : 0.f; Hacc[pb][i] = v;
                *(LAS bf16*)(L + SSD_HS + p * HSTR + n * 2) = f2bf(v); } }
#pragma unroll 1
    for (int c = 0; c < nchunks; ++c) {
        const int rbase = row0 + c * 64;
        LAS unsigned char* Hcur = L + SSD_HS + (c & 1) * 64 * HSTR; LAS unsigned char* Hnxt = L + SSD_HS + ((c + 1) & 1) * 64 * HSTR;
        const float dtl = pDt; float acs = dtl * a_h;
#pragma unroll
        for (int o = 1; o < 64; o <<= 1) { const float t = __shfl_up(acs, o); if (lane >= o) acs += t; }
        const float Atot = __shfl(acs, 63);
        const float wl = __expf(Atot - acs);
        if (w == 0) { v_acs[lane] = acs; v_e[lane] = __expf(acs); }
#pragma unroll
        for (int i = 0; i < 2; ++i) { const int ci = tid + 512 * i, row = ci >> 4, ch = ci & 15; *(LAS u32x4*)(Bs + row * CSTR + ch * 16) = pB[i]; *(LAS u32x4*)(Cs + row * CSTR + ch * 16) = pC[i]; }
        float xraw[8]; unpack8(pX, xraw); const u32x4 zc = pZ;
        { float xd[8], xw[8]; const float dt = __shfl(dtl, erow & 63), wv = __shfl(wl, erow & 63);
#pragma unroll
          for (int k = 0; k < 8; ++k) { xd[k] = xraw[k] * dt; xw[k] = xd[k] * wv; }
          *(LAS u32x4*)(XD + erow * XSTR + ech * 16) = pack8(xd); *(LAS u32x4*)(XDW + erow * XSTR + ech * 16) = pack8(xw); }
        if (c + 1 < nchunks) SSD_LOAD(c + 1);
        __syncthreads();
        if (w < 4) {
            const int lb = w >> 1, sb = w & 1; f32x16 acc;
#pragma unroll
            for (int i = 0; i < 16; ++i) acc[i] = 0.f;
            if (sb <= lb) {
#pragma unroll
                for (int ks = 0; ks < 8; ++ks) { const bf16x8 a = *(const LAS bf16x8*)(Cs + (32 * lb + r) * CSTR + (16 * ks + 8 * hh) * 2), b = *(const LAS bf16x8*)(Bs + (32 * sb + r) * CSTR + (16 * ks + 8 * hh) * 2);
                    acc = mfma32(a, b, acc); } }
            const int s = 32 * sb + r; const float acs_s = v_acs[s];
#pragma unroll
            for (int i = 0; i < 16; ++i) { const int lr = 32 * lb + crow(i, hh); const float v = (s <= lr) ? acc[i] * __expf(v_acs[lr] - acs_s) : 0.f; *(LAS bf16*)(Ms + lr * MSTR + s * 2) = f2bf(v); }
        } else {
            const int nb = w - 4; const float dec = __expf(Atot);
#pragma unroll
            for (int pb = 0; pb < 2; ++pb) {
#pragma unroll
                for (int i = 0; i < 16; ++i) Hacc[pb][i] *= dec;
#pragma unroll
                for (int ks = 0; ks < 4; ++ks) { const bf16x8 a = trfrag(XDW, XSTR, 16 * ks, 32 * pb, lane), b = trfrag(Bs, CSTR, 16 * ks, 32 * nb, lane); Hacc[pb] = mfma32(a, b, Hacc[pb]); }
#pragma unroll
                for (int i = 0; i < 16; ++i) *(LAS bf16*)(Hnxt + (32 * pb + crow(i, hh)) * HSTR + (32 * nb + r) * 2) = f2bf(Hacc[pb][i]);
            }
        }
        __syncthreads();
        if (w < 4) {
            const int lb = w >> 1, pb = w & 1; f32x16 yd, yo;
#pragma unroll
            for (int i = 0; i < 16; ++i) { yd[i] = 0.f; yo[i] = 0.f; }
#pragma unroll
            for (int ks = 0; ks < 4; ++ks) { const bf16x8 a = *(const LAS bf16x8*)(Ms + (32 * lb + r) * MSTR + (16 * ks + 8 * hh) * 2), b = trfrag(XD, XSTR, 16 * ks, 32 * pb, lane); yd = mfma32(a, b, yd); }
#pragma unroll
            for (int ks = 0; ks < 8; ++ks) { const bf16x8 a = *(const LAS bf16x8*)(Cs + (32 * lb + r) * CSTR + (16 * ks + 8 * hh) * 2), b = *(const LAS bf16x8*)(Hcur + (32 * pb + r) * HSTR + (16 * ks + 8 * hh) * 2); yo = mfma32(a, b, yo); }
            const int p = 32 * pb + r;
#pragma unroll
            for (int i = 0; i < 16; ++i) { const int lr = 32 * lb + crow(i, hh); *(LAS float*)(Ys + lr * YSTR + p * 4) = yd[i] + v_e[lr] * yo[i]; }
        }
        __syncthreads();
        {
            float z[8]; unpack8(zc, z);
            const f32x4 y0 = *(const LAS f32x4*)(Ys + erow * YSTR + ech * 32), y1 = *(const LAS f32x4*)(Ys + erow * YSTR + ech * 32 + 16);
            float y[8] = {y0.x, y0.y, y0.z, y0.w, y1.x, y1.y, y1.z, y1.w};
#pragma unroll
            for (int k = 0; k < 8; ++k) { const float yy = y[k] + dsk * xraw[k]; y[k] = yy * z[k] / (1.f + __expf(-z[k])); }
            float* gp = G + (size_t)(rbase + erow) * 1024 + h * 64 + ech * 8;
            ((f32x4*)gp)[0] = (f32x4){y[0], y[1], y[2], y[3]}; ((f32x4*)gp)[1] = (f32x4){y[4], y[5], y[6], y[7]};
        }
    }
#undef SSD_LOAD
    if (w >= 4) { const int nb = w - 4;
#pragma unroll
        for (int pb = 0; pb < 2; ++pb)
#pragma unroll
            for (int i = 0; i < 16; ++i) hout[(32 * pb + crow(i, hh)) * 128 + 32 * nb + r] = Hacc[pb][i]; }
}

DI void gate_norm_phase(const Ctx& C, const Args& A, int l) {
    const int gw = C.bid * NWAVES + C.wave, NGW = C.G * NWAVES; const float* gn = A.in[18] + (size_t)l * 1024;
    for (int m = gw; m < NTOK; m += NGW) { const float* grow = ws_f(C, WS_G) + (size_t)m * 1024; bf16* orow = ws_bf(C, WS_MIX) + (size_t)m * DM + 1024;
#pragma unroll
        for (int g = 0; g < 4; ++g) { const f32x4 v = ((const f32x4*)grow)[g * 64 + C.lane]; const float ss = wave_sum((v.x * v.x + v.y * v.y) + (v.z * v.z + v.w * v.w));
            const float rs = 1.0f / sqrtf(ss * (1.0f / 256.f) + EPS); const f32x4 wv = ((const f32x4*)gn)[g * 64 + C.lane]; const f32x4 o = v * rs * wv;
            u32x2 p; p.x = pk2(o.x, o.y); p.y = pk2(o.z, o.w); ((u32x2*)orow)[g * 64 + C.lane] = p; } }
}
DI void norm_phase(const Ctx& C, const float* w, bf16* outb, float* outf) {
    const int gw = C.bid * NWAVES + C.wave, NGW = C.G * NWAVES;
    for (int m = gw; m < NTOK; m += NGW) { float* xr = ws_f(C, WS_X) + (size_t)m * DM; const bool sp = m >= NTP;
        rms_row(xr, sp ? xr : nullptr, w, outb ? outb + (size_t)m * DM : nullptr, outf ? outf + (size_t)m * DM : nullptr, C.lane, sp ? ws_f(C, WS_G) + (size_t)(m - NTP) * DM : nullptr, (size_t)NTS * DM); }
}

#ifndef MK_ONE_LAUNCH
#define MK_ONE_LAUNCH 1
#endif
#ifndef PHASE_MASK
#define PHASE_MASK 0xFFFF
#endif
#define EN(k) (((PHASE_MASK) >> (k)) & 1)
constexpr int PH_PER_LAYER = 9, NPHASE = 1 + DEPTH * PH_PER_LAYER;
__global__ void __launch_bounds__(NTHR, 2) fwd(Args args) {
    extern __shared__ __attribute__((aligned(16))) unsigned char lds_raw[];
    Ctx C;
    C.lds = (LAS unsigned char*)lds_raw;
    C.tid = threadIdx.x; C.lane = C.tid & 63; C.wave = __builtin_amdgcn_readfirstlane(C.tid >> 6); C.G = gridDim.x; C.bid = blockIdx.x;
    C.ws = args.ws; C.out = args.out; C.ctl = (unsigned*)(args.ws + WS_CTL);
    const Args& A = args;
    for (int u = C.tid; u < (LDS_BYTES - LDSCTL_OFF) / 4; u += NTHR) ((LAS unsigned*)(C.lds + LDSCTL_OFF))[u] = 0u;
    __syncthreads();
    const int lo = args.ph_lo, hi = args.ph_hi;
    const bool multi = (hi - lo) > 1;
    XcdBarrier bar; bar.bar = C.ctl + CW_BAR; bar.x = 0; bar.st = (volatile LAS unsigned*)(C.lds + LDSCTL_OFF);
    if (multi) bar = xcd_barrier_post(C.ctl + CW_BAR, (volatile LAS unsigned*)(C.lds + LDSCTL_OFF));
#define IN(k) (lo <= (k) && (k) < hi)
#define FRESH() do { int t_ = threadIdx.x; asm volatile("" : "+v"(t_)); C.tid = t_; C.lane = t_ & 63; int w_ = __builtin_amdgcn_readfirstlane(t_ >> 6); asm volatile("" : "+s"(w_)); C.wave = w_; } while (0)
#define SEAM(k) do { if (IN((k) + 1)) xcd_barrier(bar); } while (0)

    if (EN(0) && IN(0)) { p0_prologue(C, A);
#if defined(PROBE_P02)
        __syncthreads(); p0_prologue(C, A);
#endif
        SEAM(0); }
#pragma unroll 1
    for (int l = 0; l < DEPTH; ++l) {
        const int pb = 1 + PH_PER_LAYER * l;
        if (EN(1) && IN(pb + 0)) { FRESH();
            pg8::Gemm g{ws_bf(C, WS_H), w_in_t(C, l), NTOK, INP, DM, DM}; pg8::StaticOrder S; S.init(NTOK, INP, C.G, C.bid);
            pg8::EpiBf16<0> E{ws_bf(C, WS_PU), INP};
            pg8::gemm_phase<pg8::EpiBf16<0>, pg8::StaticOrder, true, true>(C.lds, g, S, E);
            SEAM(pb + 0);
        }
        if (EN(2) && IN(pb + 1)) { FRESH();
            m0_phase(C, A, l); SEAM(pb + 1); }
        if (IN(pb + 2)) { FRESH();
            unsigned* qh = C.ctl + CW_Q + 64 * (l * 4);
            if (EN(3)) for (;;) { const int u = q_next(C, qh); if (u >= NB * 16) break;
                ssd_unit(C, A, l, (u >> 4) * SEQ, SEQ / 64, u & 15, nullptr, C.out + OFF_P_SSM + ((size_t)(l * NB + (u >> 4)) * 16 + (u & 15)) * 8192); }
            if (EN(4)) for (;;) { const int u = q_next(C, qh + 64); if (u >= 288) break; dsa_unit(C, l, u); }
            if (EN(5)) for (;;) { const int u = q_next(C, qh + 128); if (u >= 288) break; band_unit(C, A, l, u); }
            if (EN(3)) for (;;) { const int u = q_next(C, qh + 192); if (u >= DBAT * 16) break;
                ssd_unit(C, A, l, NTP + (u >> 4) * DSEQ, 1, u & 15, A.in[7] + ((size_t)(l * DBAT + (u >> 4)) * 16 + (u & 15)) * 8192, C.out + OFF_S_SSM + ((size_t)(l * DBAT + (u >> 4)) * 16 + (u & 15)) * 8192); }
#if defined(PROBE_MIXK)
            { unsigned* qh2 = C.ctl + CW_Q + 64 * (16 + l * 4);
            if (PROBE_MIXK & 1) for (;;) { const int u = q_next(C, qh2); if (u >= NB * 16) break;
                ssd_unit(C, A, l, (u >> 4) * SEQ, SEQ / 64, u & 15, nullptr, C.out + OFF_P_SSM + ((size_t)(l * NB + (u >> 4)) * 16 + (u & 15)) * 8192); }
            if (PROBE_MIXK & 2) for (;;) { const int u = q_next(C, qh2 + 64); if (u >= 288) break; dsa_unit(C, l, u); }
            if (PROBE_MIXK & 4) for (;;) { const int u = q_next(C, qh2 + 128); if (u >= 288) break; band_unit(C, A, l, u); }
            if (PROBE_MIXK & 8) for (;;) { const int u = q_next(C, qh2 + 192); if (u >= DBAT * 16) break;
                ssd_unit(C, A, l, NTP + (u >> 4) * DSEQ, 1, u & 15, A.in[7] + ((size_t)(l * DBAT + (u >> 4)) * 16 + (u & 15)) * 8192, C.out + OFF_S_SSM + ((size_t)(l * DBAT + (u >> 4)) * 16 + (u & 15)) * 8192); } }
#endif
            SEAM(pb + 2);
        }
        if (EN(6) && IN(pb + 3)) { FRESH(); gate_norm_phase(C, A, l); SEAM(pb + 3); }
        if (EN(7) && IN(pb + 4)) { FRESH();
            { pg8::Gemm g{ws_bf(C, WS_MIX), w_out_t(C, l), NTP, DM, DM, DM}; pg8::StaticOrder S; S.init(NTP, DM, C.G, C.bid);
              pg8::EpiResF32 E{ws_f(C, WS_X), DM};
              pg8::gemm_phase<pg8::EpiResF32, pg8::StaticOrder, true, true>(C.lds, g, S, E); }
            __syncthreads();
            { pg8::Gemm g{ws_bf(C, WS_MIX), w_out_t(C, l), NTOK, DM, DM / 4, DM}; pg8::SplitOrder S; S.init(NTP / 256, NTS / 256, DM / 256, 4, C.G, C.bid);
              pg8::EpiSplitRes E{ws_f(C, WS_X), DM, ws_f(C, WS_G), (size_t)NTS * DM, NTP};
              pg8::gemm_phase<pg8::EpiSplitRes, pg8::SplitOrder, true, true>(C.lds, g, S, E); }
            SEAM(pb + 4);
        }
        if (EN(8) && IN(pb + 5)) { FRESH(); norm_phase(C, A.in[19] + (size_t)l * DM, ws_bf(C, WS_H), nullptr); SEAM(pb + 5); }
        if (EN(9) && IN(pb + 6)) { FRESH();
            pg8::Gemm g{ws_bf(C, WS_H), w_up_t(C, l), NTOK, DFF, DM, DM}; pg8::StaticOrder S; S.init(NTOK, DFF, C.G, C.bid);
            pg8::EpiBf16<1> E{ws_bf(C, WS_PU), DFF};
            pg8::gemm_phase<pg8::EpiBf16<1>, pg8::StaticOrder, true, true>(C.lds, g, S, E);
#if defined(PROBE_UP2)
            __syncthreads(); pg8::gemm_phase<pg8::EpiBf16<1>, pg8::StaticOrder, true, true>(C.lds, g, S, E);
#endif
            SEAM(pb + 6);
        }
        if (EN(10) && IN(pb + 7)) { FRESH();
            { pg8::Gemm g{ws_bf(C, WS_PU), w_dn_t(C, l), NTP, DM, DFF, DFF}; pg8::StaticOrder S; S.init(NTP, DM, C.G, C.bid);
              pg8::EpiResF32 E{ws_f(C, WS_X), DM};
              pg8::gemm_phase<pg8::EpiResF32, pg8::StaticOrder, true, true>(C.lds, g, S, E); }
            __syncthreads();
            { pg8::Gemm g{ws_bf(C, WS_PU), w_dn_t(C, l), NTOK, DM, DFF / 4, DFF}; pg8::SplitOrder S; S.init(NTP / 256, NTS / 256, DM / 256, 4, C.G, C.bid);
              pg8::EpiSplitRes E{ws_f(C, WS_X), DM, ws_f(C, WS_G), (size_t)NTS * DM, NTP};
              pg8::gemm_phase<pg8::EpiSplitRes, pg8::SplitOrder, true, true>(C.lds, g, S, E); }
            SEAM(pb + 7);
        }
        if (EN(8) && IN(pb + 8)) { FRESH();
            if (l + 1 < DEPTH) norm_phase(C, A.in[9] + (size_t)(l + 1) * DM, ws_bf(C, WS_H), nullptr);
            else norm_phase(C, A.in[22], nullptr, C.out);
            SEAM(pb + 8);
        }
    }
#undef IN
#undef SEAM
}

extern "C" void kernel_launch(void* const* d_in, const int* in_sizes, int n_in, void* d_out, int out_size, void* d_ws, size_t ws_size, hipStream_t stream) {
    static int grid = 0;
    if (grid == 0) {
        if (n_in != 23 || in_sizes[0] != NTP * DM || (size_t)out_size != OUT_TOTAL || ws_size < WS_END) {
            fprintf(stderr, "kernel_launch: unexpected shapes (n_in %d, in0 %d, out %d, ws %zu; need ws >= %zu); nothing launched\n", n_in, n_in > 0 ? in_sizes[0] : -1, out_size, ws_size, (size_t)WS_END); grid = -1; return; }
        int dev = 0, cus = 0, per_cu = 0;
        if (hipGetDevice(&dev) != hipSuccess || hipDeviceGetAttribute(&cus, hipDeviceAttributeMultiprocessorCount, dev) != hipSuccess) { fprintf(stderr, "kernel_launch: device query failed\n"); grid = -1; return; }
        if (hipFuncSetAttribute((const void*)fwd, hipFuncAttributeMaxDynamicSharedMemorySize, LDS_BYTES) != hipSuccess) { fprintf(stderr, "kernel_launch: hipFuncSetAttribute failed\n"); grid = -1; return; }
        if (hipOccupancyMaxActiveBlocksPerMultiprocessor(&per_cu, (const void*)fwd, NTHR, LDS_BYTES) != hipSuccess || per_cu < 1)
            fprintf(stderr, "kernel_launch: note: occupancy query reports %d workgroups per CU\n", per_cu);
        (void)hipGetLastError();
        grid = cus < 256 ? cus : 256;
    }
    if (grid < 0) return;
    if (hipMemsetAsync((char*)d_ws + WS_CTL, 0, CTL_ZERO_BYTES, stream) != hipSuccess) { fprintf(stderr, "kernel_launch: memset failed\n"); return; }
    Args a{};
    for (int i = 0; i < 23; ++i) a.in[i] = (const float*)d_in[i];
    a.out = (float*)d_out; a.ws = (unsigned char*)d_ws;
#if MK_ONE_LAUNCH
    a.ph_lo = 0; a.ph_hi = NPHASE;
    hipLaunchKernelGGL(fwd, dim3(grid), dim3(NTHR), LDS_BYTES, stream, a);
#else
    for (int p = 0; p < NPHASE; ++p) { a.ph_lo = p; a.ph_hi = p + 1; hipLaunchKernelGGL(fwd, dim3(grid), dim3(NTHR), LDS_BYTES, stream, a); }
#endif
    const hipError_t le = hipPeekAtLastError();
    if (le != hipSuccess) fprintf(stderr, "kernel_launch: launch failed: %s\n", hipGetErrorName(le));
}
```

```cpp
#include <hip/hip_runtime.h>
#include <cstdio>
#include <cstdint>
#include <cstddef>
namespace pg8 {
#define PG8_LAS __attribute__((address_space(3)))
typedef unsigned short bf16_t;
typedef short bf16x8 __attribute__((ext_vector_type(8)));
typedef float f32x4 __attribute__((ext_vector_type(4)));
typedef unsigned u32x4 __attribute__((ext_vector_type(4)));
constexpr int BM = 256, BK = 64, HALF = 128, HTB = HALF * BK * 2  , STAGE_BYTES = 8 * HTB, NXCD = 8, WGM = 8;

__host__ __device__ __forceinline__ int lds_byte(int r, int c) { const int st = (r >> 4) * 2 + (c >> 5), rr = r & 15, cc = c & 31, ob = rr * 64 + cc * 2; return st * 1024 + (ob ^ (((ob >> 9) & 1) << 5)); }
__host__ __device__ __forceinline__ void stage_rc(int b, int& R, int& C) { const int st = b / 1024, sb = b % 1024, swz = sb ^ (((sb >> 9) & 1) << 5); R = (st >> 1) * 16 + swz / 64; C = (st & 1) * 32 + (swz % 64) / 2; }
__host__ __device__ __forceinline__ int perm32(int rho) { const int n = rho >> 4, i = rho & 15; return 8 * (i >> 2) + 4 * n + (i & 3); }

struct Unit { int pm, pn, kq; };
struct Gemm { const bf16_t* A; const bf16_t* Bt; int M, N, K, ld; };

struct StaticOrder {
    int nM, nN, nwg, G, c;
    __host__ __device__ void init(int M, int N, int G_, int c_) { nM = M / BM; nN = N / BM; nwg = nM * nN; G = G_; c = c_; }
    __host__ __device__ bool next(int i, Unit& u) const {
        const long L = (long)i * G + c; if (L >= nwg) return false;
        int wgid = (int)L; { const int q = nwg / NXCD, r = nwg % NXCD, xcd = wgid % NXCD, off = wgid / NXCD; wgid = (xcd < r ? xcd * (q + 1) : r * (q + 1) + (xcd - r) * q) + off; }
        const int nig = WGM * nN, gid = wgid / nig, fm = gid * WGM, gsz = (nM - fm) < WGM ? (nM - fm) : WGM;
        u.pm = fm + ((wgid % nig) % gsz); u.pn = (wgid % nig) / gsz; u.kq = 0; return true;
    }
    __device__ __forceinline__ void a_ready(const Unit&) const {}
    __device__ __forceinline__ void done(const Unit&) const {}
};

struct SplitOrder {
    int pm0, npm, nN, nsplit, G, c;
    __host__ __device__ void init(int pm0_, int npm_, int nN_, int nsplit_, int G_, int c_) { pm0 = pm0_; npm = npm_; nN = nN_; nsplit = nsplit_; G = G_; c = c_; }
    __host__ __device__ bool next(int i, Unit& u) const {
        const long L = (long)i * G + c; if (L >= (long)npm * nN * nsplit) return false;
        const int w = (int)L; u.kq = w % nsplit; u.pn = (w / nsplit) % nN; u.pm = pm0 + w / (nsplit * nN); return true;
    }
    __device__ __forceinline__ void a_ready(const Unit&) const {}
    __device__ __forceinline__ void done(const Unit&) const {}
};

typedef float f32x2_t __attribute__((ext_vector_type(2)));
typedef __bf16 bf16x2_t __attribute__((ext_vector_type(2)));
__device__ __forceinline__ unsigned cvt_pk_bf16(float lo, float hi) { f32x2_t v = {lo, hi}; bf16x2_t b = __builtin_convertvector(v, bf16x2_t); return __builtin_bit_cast(unsigned, b); }

template <int ACT  > struct EpiBf16 {
    static constexpr bool PERM = true, AFTER_DRAIN = false;
    bf16_t* O; int ldc;
    __device__ __forceinline__ void operator()(const f32x4 (&acc)[2][2][4][2], const Unit& u, int wr, int wc, int fr, int fq) const {
        const int row0 = u.pm * BM + wr * 64 + fr; const int col0 = u.pn * BM + wc * 32 + 8 * fq;
#pragma unroll
        for (int ai = 0; ai < 2; ++ai)
#pragma unroll
            for (int m = 0; m < 4; ++m) { bf16_t* rowp = O + (size_t)(row0 + ai * HALF + m * 16) * ldc + col0;
#pragma unroll
                for (int bj = 0; bj < 2; ++bj) { f32x4 v0 = acc[ai][bj][m][0], v1 = acc[ai][bj][m][1];
                    if (ACT == 1) {
#pragma unroll
                        for (int j = 0; j < 4; ++j) { const float a = v0[j] > 0.f ? v0[j] : 0.f, b = v1[j] > 0.f ? v1[j] : 0.f; v0[j] = a * a; v1[j] = b * b; } }
                    u32x4 w; w.x = cvt_pk_bf16(v0[0], v0[1]); w.y = cvt_pk_bf16(v0[2], v0[3]); w.z = cvt_pk_bf16(v1[0], v1[1]); w.w = cvt_pk_bf16(v1[2], v1[3]);
                    *(u32x4*)(rowp + bj * HALF) = w; } }
    }
};
struct EpiResF32 {
    static constexpr bool PERM = false, AFTER_DRAIN = false;
    float* X; int ldc;
    __device__ __forceinline__ void operator()(const f32x4 (&acc)[2][2][4][2], const Unit& u, int wr, int wc, int fr, int fq) const {
        const int row0 = u.pm * BM + wr * 64 + fr, col0 = u.pn * BM + wc * 32 + 4 * fq;
#pragma unroll
        for (int ai = 0; ai < 2; ++ai)
#pragma unroll
            for (int m = 0; m < 4; ++m) { float* rowp = X + (size_t)(row0 + ai * HALF + m * 16) * ldc + col0;
                f32x4 b[2][2];
#pragma unroll
                for (int bj = 0; bj < 2; ++bj)
#pragma unroll
                    for (int n = 0; n < 2; ++n) b[bj][n] = *(const f32x4*)(rowp + bj * HALF + n * 16);
#pragma unroll
                for (int bj = 0; bj < 2; ++bj)
#pragma unroll
                    for (int n = 0; n < 2; ++n) *(f32x4*)(rowp + bj * HALF + n * 16) = b[bj][n] + acc[ai][bj][m][n];
                asm volatile("" ::: "memory"); }
    }
};

struct EpiSplitRes {
    static constexpr bool PERM = false, AFTER_DRAIN = false;
    float* X; int ldc; float* P; size_t pstride; int row0;
    __device__ __forceinline__ void operator()(const f32x4 (&acc)[2][2][4][2], const Unit& u, int wr, int wc, int fr, int fq) const {
        const int rowa = u.pm * BM + wr * 64 + fr, col0 = u.pn * BM + wc * 32 + 4 * fq;
        if (u.kq == 0) {
#pragma unroll
            for (int ai = 0; ai < 2; ++ai)
#pragma unroll
                for (int m = 0; m < 4; ++m) { float* rowp = X + (size_t)(rowa + ai * HALF + m * 16) * ldc + col0;
                    f32x4 b[2][2];
#pragma unroll
                    for (int bj = 0; bj < 2; ++bj)
#pragma unroll
                        for (int n = 0; n < 2; ++n) b[bj][n] = *(const f32x4*)(rowp + bj * HALF + n * 16);
#pragma unroll
                    for (int bj = 0; bj < 2; ++bj)
#pragma unroll
                        for (int n = 0; n < 2; ++n) *(f32x4*)(rowp + bj * HALF + n * 16) = b[bj][n] + acc[ai][bj][m][n];
                    asm volatile("" ::: "memory"); }
        } else {
            float* base = P + (size_t)(u.kq - 1) * pstride;
#pragma unroll
            for (int ai = 0; ai < 2; ++ai)
#pragma unroll
                for (int m = 0; m < 4; ++m) { float* rowp = base + (size_t)(rowa - row0 + ai * HALF + m * 16) * ldc + col0;
#pragma unroll
                    for (int bj = 0; bj < 2; ++bj)
#pragma unroll
                        for (int n = 0; n < 2; ++n) *(f32x4*)(rowp + bj * HALF + n * 16) = acc[ai][bj][m][n]; }
        }
    }
};
template <class Epi, class Sched, bool ALIGN_EPI = false, bool SP2 = false>
__device__ __forceinline__ void gemm_phase(PG8_LAS unsigned char* lds, const Gemm g, const Sched& S, const Epi& E) {
    int tid_ = threadIdx.x; asm volatile("" : "+v"(tid_));
    const int tid = tid_, wid = __builtin_amdgcn_readfirstlane(tid >> 6), lane = tid & 63, wr = wid >> 2, wc = wid & 3, fr = lane & 15, fq = lane >> 4;
    const int K = g.K, nt = K / BK, ld = g.ld;
    unsigned voffA[2], voffB[2];
#pragma unroll
    for (int i = 0; i < 2; ++i) { int R, C; stage_rc(tid * 16 + i * 8192, R, C); const int Rb = Epi::PERM ? ((R & ~31) + perm32(R & 31)) : R;
        voffA[i] = (unsigned)(R * ld + C) * 2u; voffB[i] = (unsigned)(Rb * ld + C) * 2u; }
    const size_t kstep = (size_t)(BK * 2);
    const size_t hstep = (size_t)HALF * ld * 2;
    const size_t tstep = 2 * hstep;
    const unsigned ldsw = (unsigned)wid * 1024u;
    const int aoff = lds_byte(wr * 64 + fr, fq * 8), boff = lds_byte(wc * 32 + fr, fq * 8);
#define PG8_SA(b, h) (((b) * 2 + (h)) * HTB)
#define PG8_SB(b, h) ((4 + (b) * 2 + (h)) * HTB)
#define PG8_STAGE(bufoff, gbase, voff) do { _Pragma("unroll") for (int _i = 0; _i < 2; ++_i) \
        __builtin_amdgcn_global_load_lds((const unsigned*)((const char*)(gbase) + (voff)[_i]), (PG8_LAS unsigned*)(lds + (bufoff) + ldsw + _i * 8192), 16, 0, 0); } while (0)
#define PG8_LDA(dst, b, h) do { _Pragma("unroll") for (int m = 0; m < 4; ++m) _Pragma("unroll") for (int k = 0; k < 2; ++k) dst[m][k] = *(const PG8_LAS bf16x8*)(lds + PG8_SA(b, h) + aoff + m * 2048 + k * 1024); } while (0)
#define PG8_LDB(dst, b, h) do { _Pragma("unroll") for (int n = 0; n < 2; ++n) _Pragma("unroll") for (int k = 0; k < 2; ++k) dst[n][k] = *(const PG8_LAS bf16x8*)(lds + PG8_SB(b, h) + boff + n * 2048 + k * 1024); } while (0)
#define PG8_MMA(ai, bj, At, Bt) do { __builtin_amdgcn_s_setprio(1); _Pragma("unroll") for (int m = 0; m < 4; ++m) _Pragma("unroll") for (int n = 0; n < 2; ++n) _Pragma("unroll") for (int k = 0; k < 2; ++k) \
        acc[ai][bj][m][n] = __builtin_amdgcn_mfma_f32_16x16x32_bf16(Bt[n][k], At[m][k], acc[ai][bj][m][n], 0, 0, 0); __builtin_amdgcn_s_setprio(0); } while (0)
#define PG8_WAIT_V(n) asm volatile("s_waitcnt vmcnt(" #n ")" ::: "memory")
#define PG8_WAIT_L(n) asm volatile("s_waitcnt lgkmcnt(" #n ")" ::: "memory")
#define PG8_BAR __builtin_amdgcn_s_barrier()
#define PG8_SCHED __builtin_amdgcn_sched_barrier(0)
    Unit cur, nxt; int ui = 0;
    if (!S.next(0, cur)) return;
    f32x4 acc[2][2][4][2];
#pragma unroll
    for (int a = 0; a < 2; ++a)
#pragma unroll
        for (int b = 0; b < 2; ++b)
#pragma unroll
            for (int m = 0; m < 4; ++m)
#pragma unroll
                for (int n = 0; n < 2; ++n) acc[a][b][m][n] = (f32x4){0.f, 0.f, 0.f, 0.f};
    bf16x8 At[4][2], B0[2][2], B1[2][2];
    const char* cA = (const char*)g.A + (size_t)cur.pm * tstep + (size_t)cur.kq * K * 2; const char* cB = (const char*)g.Bt + (size_t)cur.pn * tstep + (size_t)cur.kq * K * 2;
    S.a_ready(cur);
    if constexpr (SP2) {
        PG8_STAGE(PG8_SB(0, 0), cB, voffB); PG8_STAGE(PG8_SB(0, 1), cB + hstep, voffB); PG8_STAGE(PG8_SA(0, 0), cA, voffA); PG8_STAGE(PG8_SA(0, 1), cA + hstep, voffA);
        if (wr == 1) PG8_BAR;
        PG8_WAIT_V(2); PG8_BAR;
        PG8_STAGE(PG8_SB(1, 0), cB + kstep, voffB); PG8_STAGE(PG8_SA(1, 0), cA + kstep, voffA); PG8_STAGE(PG8_SB(1, 1), cB + hstep + kstep, voffB);
        PG8_WAIT_V(6); PG8_BAR;
    } else {
        PG8_STAGE(PG8_SB(0, 0), cB, voffB); PG8_STAGE(PG8_SA(0, 0), cA, voffA); PG8_STAGE(PG8_SB(0, 1), cB + hstep, voffB); PG8_STAGE(PG8_SA(0, 1), cA + hstep, voffA);
        if (wr == 1) PG8_BAR;
        PG8_WAIT_V(4); PG8_BAR;
        PG8_STAGE(PG8_SB(1, 0), cB + kstep, voffB); PG8_STAGE(PG8_SA(1, 0), cA + kstep, voffA); PG8_STAGE(PG8_SB(1, 1), cB + hstep + kstep, voffB);
        PG8_WAIT_V(6); PG8_BAR;
    }
    for (;;) {
        const bool has_next = S.next(ui + 1, nxt);
        const char* nA = has_next ? (const char*)g.A + (size_t)nxt.pm * tstep + (size_t)nxt.kq * K * 2 : cA; const char* nB = has_next ? (const char*)g.Bt + (size_t)nxt.pn * tstep + (size_t)nxt.kq * K * 2 : cB;
        for (int t = 0; t < nt; t += 2) {
            const bool last = (t == nt - 2);
            const char* a1 = cA + (size_t)(t + 1) * kstep;
            const char* a2 = last ? nA : cA + (size_t)(t + 2) * kstep; const char* b2 = last ? nB : cB + (size_t)(t + 2) * kstep;
            const char* a3 = a2 + kstep; const char* b3 = b2 + kstep;
            if (last && has_next) S.a_ready(nxt);
            if constexpr (SP2) {
            PG8_LDB(B0, 0, 0); PG8_LDB(B1, 0, 1); PG8_SCHED; PG8_LDA(At, 0, 0); PG8_STAGE(PG8_SA(1, 1), a1 + hstep, voffA);
            PG8_WAIT_V(8); PG8_WAIT_L(0); PG8_BAR; PG8_MMA(0, 0, At, B0); PG8_MMA(0, 1, At, B1); PG8_BAR; PG8_SCHED;
            PG8_LDA(At, 0, 1); PG8_STAGE(PG8_SB(0, 0), b2, voffB); PG8_STAGE(PG8_SB(0, 1), b2 + hstep, voffB); PG8_STAGE(PG8_SA(0, 0), a2, voffA);
            PG8_WAIT_V(8); PG8_WAIT_L(0); PG8_BAR; PG8_MMA(1, 0, At, B0); PG8_MMA(1, 1, At, B1); PG8_BAR; PG8_SCHED;
            PG8_LDB(B0, 1, 0); PG8_LDB(B1, 1, 1); PG8_SCHED; PG8_LDA(At, 1, 0); PG8_STAGE(PG8_SA(0, 1), a2 + hstep, voffA);
            PG8_WAIT_V(8); PG8_WAIT_L(0); PG8_BAR; PG8_MMA(0, 0, At, B0); PG8_MMA(0, 1, At, B1); PG8_BAR; PG8_SCHED;
            PG8_LDA(At, 1, 1); PG8_STAGE(PG8_SB(1, 0), b3, voffB); PG8_STAGE(PG8_SB(1, 1), b3 + hstep, voffB); PG8_STAGE(PG8_SA(1, 0), a3, voffA);
            PG8_WAIT_V(8); PG8_WAIT_L(0); PG8_BAR; PG8_MMA(1, 0, At, B0); PG8_MMA(1, 1, At, B1); PG8_BAR; PG8_SCHED;
            } else {
            PG8_LDB(B0, 0, 0); PG8_SCHED; PG8_LDA(At, 0, 0); PG8_STAGE(PG8_SA(1, 1), a1 + hstep, voffA);
            PG8_WAIT_L(8); PG8_BAR; PG8_WAIT_L(0); PG8_MMA(0, 0, At, B0); PG8_BAR; PG8_SCHED;
            PG8_LDB(B1, 0, 1); PG8_STAGE(PG8_SB(0, 0), b2, voffB);
            PG8_BAR; PG8_WAIT_L(0); PG8_MMA(0, 1, At, B1); PG8_BAR;
            PG8_LDA(At, 0, 1); PG8_STAGE(PG8_SA(0, 0), a2, voffA);
            PG8_BAR; PG8_WAIT_L(0); PG8_MMA(1, 0, At, B0); PG8_BAR; PG8_SCHED;
            PG8_STAGE(PG8_SB(0, 1), b2 + hstep, voffB);
            PG8_WAIT_V(6); PG8_BAR; PG8_MMA(1, 1, At, B1); PG8_BAR;
            PG8_LDB(B0, 1, 0); PG8_SCHED; PG8_LDA(At, 1, 0); PG8_STAGE(PG8_SA(0, 1), a2 + hstep, voffA);
            PG8_WAIT_L(8); PG8_BAR; PG8_WAIT_L(0); PG8_MMA(0, 0, At, B0); PG8_BAR; PG8_SCHED;
            PG8_LDB(B1, 1, 1); PG8_STAGE(PG8_SB(1, 0), b3, voffB);
            PG8_BAR; PG8_WAIT_L(0); PG8_MMA(0, 1, At, B1); PG8_BAR;
            PG8_LDA(At, 1, 1); PG8_STAGE(PG8_SA(1, 0), a3, voffA);
            PG8_BAR; PG8_WAIT_L(0); PG8_MMA(1, 0, At, B0); PG8_BAR; PG8_SCHED;
            PG8_STAGE(PG8_SB(1, 1), b3 + hstep, voffB);
            PG8_WAIT_V(6); PG8_BAR; PG8_MMA(1, 1, At, B1); PG8_BAR;
            }
        }
        if constexpr (ALIGN_EPI) { if (wr == 0) PG8_BAR; }
        if constexpr (!Epi::AFTER_DRAIN) { E(acc, cur, wr, wc, fr, fq); S.done(cur); }
        if (!has_next) break;
#pragma unroll
        for (int a = 0; a < 2; ++a)
#pragma unroll
            for (int b = 0; b < 2; ++b)
#pragma unroll
                for (int m = 0; m < 4; ++m)
#pragma unroll
                    for (int n = 0; n < 2; ++n) acc[a][b][m][n] = (f32x4){0.f, 0.f, 0.f, 0.f};
        cur = nxt; cA = nA; cB = nB; ++ui;
        if constexpr (ALIGN_EPI) { if (wr == 1) PG8_BAR; }
    }
    PG8_WAIT_V(0);
    if constexpr (!ALIGN_EPI) { if (wr == 0) PG8_BAR; }
    PG8_BAR;
    if constexpr (Epi::AFTER_DRAIN) { E.fused(acc, cur, wr, wc, fr, fq, lds, wid, lane); S.done(cur); }
#undef PG8_SA
#undef PG8_SB
#undef PG8_STAGE
#undef PG8_LDA
#undef PG8_LDB
#undef PG8_MMA
#undef PG8_WAIT_V
#undef PG8_WAIT_L
#undef PG8_BAR
#undef PG8_SCHED
}
}

#define DI __device__ __forceinline__
#define LAS __attribute__((address_space(3)))
typedef unsigned short bf16;
typedef short bf16x8 __attribute__((ext_vector_type(8)));
typedef short s16x4 __attribute__((ext_vector_type(4)));
typedef short v4i16_t __attribute__((ext_vector_type(4)));
typedef float f32x4 __attribute__((ext_vector_type(4)));
typedef float f32x16 __attribute__((ext_vector_type(16)));
typedef unsigned u32x4 __attribute__((ext_vector_type(4)));
typedef unsigned u32x2 __attribute__((ext_vector_type(2)));
typedef float f32x2_t_ __attribute__((ext_vector_type(2)));

constexpr int DM = 2048, NB = 8, SEQ = 2048, DEPTH = 4, DBAT = 32, DSEQ = 64, PAST = 1024, BWIN = 512;
constexpr int NTP = NB * SEQ, NTS = DBAT * DSEQ, NTOK = NTP + NTS;
constexpr int INC = 7264, INP = 7424, DFF = 8192;
constexpr int C_AQ = 0, C_AK = 512, C_AV = 1024, C_IQ = 1536, C_IK = 2560, C_IW = 2624, C_BQ = 2640, C_BK = 3152, C_BV = 3664, C_CZ = 4176, C_XBC = 5200, C_DT = 7248;
constexpr float EPS = 1e-5f;
constexpr int NWAVES = 8, NTHR = 512;

constexpr size_t SZ_YP = (size_t)NTP * DM, SZ_YS = (size_t)NTS * DM;
constexpr size_t SZ_PAK = (size_t)DEPTH * NB * SEQ * 512, SZ_PKI = (size_t)DEPTH * NB * SEQ * 64, SZ_PBK = (size_t)DEPTH * NB * BWIN * 512;
constexpr size_t SZ_PSSM = (size_t)DEPTH * NB * 16 * 64 * 128, SZ_PCONV = (size_t)DEPTH * NB * 3 * 2048;
constexpr size_t SZ_SAK = (size_t)DEPTH * DBAT * DSEQ * 512, SZ_SKI = (size_t)DEPTH * DBAT * DSEQ * 64, SZ_SBK = SZ_SAK;
constexpr size_t SZ_SSSM = (size_t)DEPTH * DBAT * 16 * 64 * 128, SZ_SCONV = (size_t)DEPTH * DBAT * 3 * 2048;
constexpr size_t OFF_YP = 0, OFF_YS = OFF_YP + SZ_YP, OFF_P_AK = OFF_YS + SZ_YS, OFF_P_AV = OFF_P_AK + SZ_PAK, OFF_P_KI = OFF_P_AV + SZ_PAK,
                 OFF_P_BK = OFF_P_KI + SZ_PKI, OFF_P_BV = OFF_P_BK + SZ_PBK, OFF_P_SSM = OFF_P_BV + SZ_PBK, OFF_P_CONV = OFF_P_SSM + SZ_PSSM,
                 OFF_S_AK = OFF_P_CONV + SZ_PCONV, OFF_S_AV = OFF_S_AK + SZ_SAK, OFF_S_KI = OFF_S_AV + SZ_SAK, OFF_S_BK = OFF_S_KI + SZ_SKI,
                 OFF_S_BV = OFF_S_BK + SZ_SBK, OFF_S_SSM = OFF_S_BV + SZ_SBK, OFF_S_CONV = OFF_S_SSM + SZ_SSSM, OUT_TOTAL = OFF_S_CONV + SZ_SCONV;
static_assert(OUT_TOTAL == 165085184, "output size");

constexpr size_t MiB = 1u << 20;
constexpr size_t WS_CTL = 0, CTL_ZERO_BYTES = 1 * MiB;
constexpr size_t WS_ROPE = 1 * MiB;
constexpr size_t WS_W = 2 * MiB;
constexpr size_t W_IN_B = (size_t)INP * DM * 2, W_OUT_B = (size_t)DM * DM * 2, W_UP_B = (size_t)DFF * DM * 2, W_DN_B = (size_t)DM * DFF * 2, W_LAYER_B = W_IN_B + W_OUT_B + W_UP_B + W_DN_B;
static_assert(W_LAYER_B == 101 * MiB, "weights per layer");
constexpr size_t WS_X = WS_W + DEPTH * W_LAYER_B;
constexpr size_t WS_H = WS_X + (size_t)NTOK * DM * 4;
constexpr size_t WS_MIX = WS_H + (size_t)NTOK * DM * 2;
constexpr size_t WS_PU = WS_MIX + (size_t)NTOK * DM * 2;
constexpr size_t WS_XBC = WS_PU + (size_t)NTOK * DFF * 2;
constexpr size_t WS_G = WS_XBC + (size_t)NTOK * 2048 * 2;
constexpr size_t WS_DTS = WS_G + (size_t)NTOK * 1024 * 4;
constexpr size_t WS_CAK = WS_DTS + 2 * MiB;
constexpr size_t WS_CAV = WS_CAK + (size_t)DBAT * PAST * 512 * 2;
constexpr size_t WS_CBK = WS_CAV + (size_t)DBAT * PAST * 512 * 2;
constexpr size_t WS_CBV = WS_CBK + (size_t)DBAT * BWIN * 512 * 2;
constexpr size_t WS_CKI = WS_CBV + (size_t)DBAT * BWIN * 512 * 2;
constexpr size_t WS_SC = WS_CKI + (size_t)DBAT * PAST * 64 * 2;
constexpr size_t WS_END = WS_SC + (size_t)256 * 64 * 2048 * 4;
static_assert(WS_END == 1356 * MiB, "ws map");
constexpr int CW_BAR = 4096;
constexpr int CW_Q = 16384;

constexpr int RING_BYTES = 155648, LDSCTL_OFF = RING_BYTES, LDS_BYTES = 157696;
constexpr int ATT_SEL = 0;
constexpr int ATT_K = 16384, KSTR = 1040, ATT_V = ATT_K + 2 * 32 * KSTR, VSTR = 1088, ATT_END = ATT_V + 2 * 32 * VSTR;
constexpr int CSTR = 272, XSTR = 144, MSTR = 144, HSTR = 272;
constexpr int SSD_CS = 0, SSD_BS = SSD_CS + 64 * CSTR, SSD_XD = SSD_BS + 64 * CSTR, SSD_XDW = SSD_XD + 64 * XSTR, SSD_MS = SSD_XDW + 64 * XSTR,
              SSD_HS = SSD_MS + 64 * MSTR, SSD_VEC = SSD_HS + 2 * 64 * HSTR, SSD_Y = SSD_VEC + 1024, YSTR = 272, SSD_END = SSD_Y + 64 * YSTR;
static_assert(ATT_END <= RING_BYTES && SSD_END <= RING_BYTES, "phase scratch fits the ring region");

DI float bf2f(bf16 v) { return __uint_as_float(((unsigned)v) << 16); }
DI unsigned pk2(float lo, float hi) { return pg8::cvt_pk_bf16(lo, hi); }
DI bf16 f2bf(float f) { return (bf16)(pk2(f, 0.f) & 0xffffu); }
DI float wave_sum(float v) {
#pragma unroll
    for (int o = 1; o < 64; o <<= 1) v += __shfl_xor(v, o);
    return v;
}
DI f32x16 mfma32(bf16x8 a, bf16x8 b, f32x16 c) { return __builtin_amdgcn_mfma_f32_32x32x16_bf16(a, b, c, 0, 0, 0); }
DI int crow(int i, int hh) { return (i & 3) + 8 * (i >> 2) + 4 * hh; }
DI s16x4 tr_read(LAS unsigned char* p) { return __builtin_bit_cast(s16x4, __builtin_amdgcn_ds_read_tr16_b64_v4i16((LAS v4i16_t*)p)); }
DI bf16x8 trfrag(LAS unsigned char* tile, int stride, int k0, int c0, int lane) {
    const int i16 = lane & 15, qq = i16 >> 2, p = i16 & 3, g2 = (lane >> 4) & 1, hh = lane >> 5;
    LAS unsigned char* a = tile + (k0 + 8 * hh + qq) * stride + (c0 + 16 * g2 + 4 * p) * 2;
    const s16x4 lo = tr_read(a), hi = tr_read(a + 4 * stride);
    return __builtin_shufflevector(lo, hi, 0, 1, 2, 3, 4, 5, 6, 7);
}
DI void unpack8(u32x4 v, float (&f)[8]) {
#pragma unroll
    for (int i = 0; i < 4; ++i) { f[2 * i] = __uint_as_float(v[i] << 16); f[2 * i + 1] = __uint_as_float(v[i] & 0xffff0000u); }
}
DI u32x4 pack8(const float (&f)[8]) { u32x4 o; o.x = pk2(f[0], f[1]); o.y = pk2(f[2], f[3]); o.z = pk2(f[4], f[5]); o.w = pk2(f[6], f[7]); return o; }

#define XB_TMO      128
#define XB_XCNT(j)  (256  + 64 * (j))
#define XB_XSUB(j)  (1280 + 64 * (j))
#define XB_XGEN(j)  (2304 + 64 * (j))
#define XB_TOP      3328
#define XB_TOPGEN   3392
#define XCD_BAR_WORDS 3456
#define XB_SPIN_CAP (1u << 20)
DI unsigned xb_ld(unsigned* p)              { return __hip_atomic_load(p, __ATOMIC_RELAXED, __HIP_MEMORY_SCOPE_AGENT); }
DI unsigned xb_add(unsigned* p, unsigned v) { return __hip_atomic_fetch_add(p, v, __ATOMIC_RELAXED, __HIP_MEMORY_SCOPE_AGENT); }
DI unsigned xb_xcc_id() { return (unsigned)__builtin_amdgcn_s_getreg((3 << 11) | 20) & 0xFu; }
#define XB_SPIN(cond, bar) do { unsigned _sp = 0; while (cond) { __builtin_amdgcn_s_sleep(1); \
    if ((++_sp & 255u) == 0u) { if (xb_ld(&(bar)[XB_TMO])) break; if (_sp > XB_SPIN_CAP) { atomicAdd(&(bar)[XB_TMO], 1u); break; } } } } while (0)
struct XcdBarrier { unsigned* bar; unsigned x; volatile LAS unsigned* st; };
DI XcdBarrier xcd_barrier_post(unsigned* bar, volatile LAS unsigned* st) {
    XcdBarrier b; b.bar = bar; b.x = xb_xcc_id(); b.st = st;
    if (threadIdx.x == 0) (void)xb_add(&bar[XB_XCNT(b.x)], 1u);
    return b;
}
DI void xcd_barrier_complete(unsigned* bar, unsigned x, unsigned& nloc, unsigned& nx) {
    const unsigned G = gridDim.x * gridDim.y * gridDim.z;
    unsigned sum, cnt, mine, sp = 0u;
    for (;;) {
        sum = 0u; cnt = 0u; mine = 0u;
#pragma unroll
        for (unsigned j = 0; j < 16; ++j) { const unsigned c = xb_ld(&bar[XB_XCNT(j)]); sum += c; cnt += (c > 0u) ? 1u : 0u; mine = (j == x) ? c : mine; }
        if (sum == G) break;
        __builtin_amdgcn_s_sleep(1);
        if ((++sp & 255u) == 0u) { if (xb_ld(&bar[XB_TMO])) break; if (sp > XB_SPIN_CAP) { atomicAdd(&bar[XB_TMO], 1u); break; } }
    }
    nloc = mine > 0u ? mine : 1u; nx = cnt > 0u ? cnt : 1u;
}
DI void xcd_barrier(const XcdBarrier& b) {
    asm volatile("s_waitcnt vmcnt(0)" ::: "memory");
    __syncthreads();
    if (threadIdx.x == 0) {
        unsigned* bar = b.bar;
        __builtin_amdgcn_s_waitcnt(0);
        unsigned nloc = b.st[0], nx = b.st[1];
        if (nloc == 0u) { xcd_barrier_complete(bar, b.x, nloc, nx); b.st[0] = nloc; b.st[1] = nx; }
        const unsigned old = xb_add(&bar[XB_XSUB(b.x)], 1u);
        const unsigned gen = old / nloc;
        if (old + 1u == (gen + 1u) * nloc) {
            __builtin_amdgcn_fence(__ATOMIC_RELEASE, "agent");
            asm volatile("s_waitcnt vmcnt(0)" ::: "memory");
            const unsigned og = xb_add(&bar[XB_TOP], 1u);
            const unsigned tg = og / nx;
            if (og + 1u == (tg + 1u) * nx) xb_add(&bar[XB_TOPGEN], 1u);
            else XB_SPIN(xb_ld(&bar[XB_TOPGEN]) == tg, bar);
            __builtin_amdgcn_fence(__ATOMIC_ACQUIRE, "agent");
            xb_add(&bar[XB_XGEN(b.x)], 1u);
            asm volatile("s_waitcnt vmcnt(0)" ::: "memory");
        } else {
            XB_SPIN(xb_ld(&bar[XB_XGEN(b.x)]) == gen, bar);
            __builtin_amdgcn_fence(__ATOMIC_ACQUIRE, "agent");
            asm volatile("s_waitcnt vmcnt(0)" ::: "memory");
        }
    }
    __syncthreads();
}

struct Args { const float* in[23]; float* out; unsigned char* ws; int ph_lo, ph_hi; };
static_assert(sizeof(Args) == 23 * 8 + 8 + 8 + 8, "Args has no padding");
struct Ctx {
    LAS unsigned char* lds;
    unsigned* ctl;
    int tid, lane, wave, G, bid;
    float* out;
    unsigned char* ws;
};
DI bf16* ws_bf(const Ctx& C, size_t off) { return (bf16*)(C.ws + off); }
DI float* ws_f(const Ctx& C, size_t off) { return (float*)(C.ws + off); }
DI bf16* w_in_t(const Ctx& C, int l)  { return (bf16*)(C.ws + WS_W + (size_t)l * W_LAYER_B); }
DI bf16* w_out_t(const Ctx& C, int l) { return (bf16*)(C.ws + WS_W + (size_t)l * W_LAYER_B + W_IN_B); }
DI bf16* w_up_t(const Ctx& C, int l)  { return (bf16*)(C.ws + WS_W + (size_t)l * W_LAYER_B + W_IN_B + W_OUT_B); }
DI bf16* w_dn_t(const Ctx& C, int l)  { return (bf16*)(C.ws + WS_W + (size_t)l * W_LAYER_B + W_IN_B + W_OUT_B + W_UP_B); }

DI int q_next(const Ctx& C, unsigned* head) {
    volatile LAS int* slot = (volatile LAS int*)(C.lds + LDSCTL_OFF + 64);
    __syncthreads();
    if (C.tid == 0) *slot = (int)__hip_atomic_fetch_add(head, 1u, __ATOMIC_RELAXED, __HIP_MEMORY_SCOPE_AGENT);
    __syncthreads();
    return *slot;
}

DI void p0_transpose_item(const float* W, int K, int N, bf16* WT, LAS float* scr, int item, int lane) {
    const int nblk = N / 32, kb = item / nblk, nb = item % nblk, k0 = 64 * kb, n0 = 32 * nb;
#pragma unroll 8
    for (int i = 0; i < 32; ++i) { const int kk = 2 * i + (lane >> 5); scr[kk * 33 + (lane & 31)] = W[(size_t)(k0 + kk) * N + n0 + (lane & 31)]; }
    asm volatile("s_waitcnt lgkmcnt(0)" ::: "memory");
    const int c = lane & 7;
#pragma unroll
    for (int j = 0; j < 4; ++j) { const int n = (lane >> 3) + 8 * j; const LAS float* s = scr + (8 * c) * 33 + n;
        u32x4 o; o.x = pk2(s[0 * 33], s[1 * 33]); o.y = pk2(s[2 * 33], s[3 * 33]); o.z = pk2(s[4 * 33], s[5 * 33]); o.w = pk2(s[6 * 33], s[7 * 33]);
        *(u32x4*)(WT + (size_t)(n0 + n) * K + k0 + 8 * c) = o; }
    asm volatile("s_waitcnt lgkmcnt(0)" ::: "memory");
}
DI void rms_row(const float* src, float* xcopy, const float* w, bf16* outb, float* outf, int lane, const float* part = nullptr, size_t pstride = 0) {
    f32x4 v[8]; float ss = 0.f;
#pragma unroll
    for (int j = 0; j < 8; ++j) { v[j] = ((const f32x4*)src)[lane + 64 * j];
        if (part) { v[j] += ((const f32x4*)part)[lane + 64 * j]; v[j] += ((const f32x4*)(part + pstride))[lane + 64 * j]; v[j] += ((const f32x4*)(part + 2 * pstride))[lane + 64 * j]; }
        ss += (v[j].x * v[j].x + v[j].y * v[j].y) + (v[j].z * v[j].z + v[j].w * v[j].w); }
    if (xcopy) {
#pragma unroll
        for (int j = 0; j < 8; ++j) ((f32x4*)xcopy)[lane + 64 * j] = v[j];
    }
    ss = wave_sum(ss);
    const float rs = 1.0f / sqrtf(ss * (1.0f / DM) + EPS);
#pragma unroll
    for (int j = 0; j < 8; ++j) { const f32x4 wv = ((const f32x4*)w)[lane + 64 * j]; const f32x4 o = v[j] * rs * wv;
        if (outb) { u32x2 p; p.x = pk2(o.x, o.y); p.y = pk2(o.z, o.w); ((u32x2*)outb)[lane + 64 * j] = p; }
        if (outf) ((f32x4*)outf)[lane + 64 * j] = o; }
}
DI void sincos_tab(float ang, float& c, float& s) {
    const double a = (double)ang; const double kq = rint(a * 0.63661977236758134308); const double x = a - kq * 1.57079632679489661923; const double x2 = x * x;
    const double sn = x * (1.0 + x2 * (-1.0 / 6 + x2 * (1.0 / 120 + x2 * (-1.0 / 5040 + x2 * (1.0 / 362880 + x2 * (-1.0 / 39916800 + x2 * (1.0 / 6227020800.0)))))));
    const double cn = 1.0 + x2 * (-0.5 + x2 * (1.0 / 24 + x2 * (-1.0 / 720 + x2 * (1.0 / 40320 + x2 * (-1.0 / 3628800 + x2 * (1.0 / 479001600 + x2 * (-1.0 / 87178291200.0)))))));
    const int q = ((int)kq) & 3;
    const double cc = (q == 0) ? cn : (q == 1) ? -sn : (q == 2) ? -cn : sn;
    const double sc = (q == 0) ? sn : (q == 1) ? cn : (q == 2) ? -sn : -cn;
    c = (float)cc; s = (float)sc;
}
DI void p0_prologue(const Ctx& C, const Args& A) {
    LAS float* scr = (LAS float*)(C.lds + C.wave * 16384);
    const int gw = C.bid * NWAVES + C.wave, NGW = C.G * NWAVES;
    constexpr int I_IN = (DM / 64) * (INC / 32), I_OUT = (DM / 64) * (DM / 32), I_UP = (DM / 64) * (DFF / 32), I_DN = (DFF / 64) * (DM / 32), I_L = I_IN + I_OUT + I_UP + I_DN;
    for (int it = gw; it < DEPTH * I_L; it += NGW) {
        const int l = it / I_L; int r = it % I_L;
        if (r < I_IN) { p0_transpose_item(A.in[10] + (size_t)l * DM * INC, DM, INC, w_in_t(C, l), scr, r, C.lane); continue; } r -= I_IN;
        if (r < I_OUT) { p0_transpose_item(A.in[11] + (size_t)l * DM * DM, DM, DM, w_out_t(C, l), scr, r, C.lane); continue; } r -= I_OUT;
        if (r < I_UP) { p0_transpose_item(A.in[20] + (size_t)l * DM * DFF, DM, DFF, w_up_t(C, l), scr, r, C.lane); continue; } r -= I_UP;
        p0_transpose_item(A.in[21] + (size_t)l * DFF * DM, DFF, DM, w_dn_t(C, l), scr, r, C.lane);
    }
    { const int gt = C.bid * NTHR + C.tid, NGT = C.G * NTHR; constexpr int CH_L = (INP - INC) * DM / 8;
      for (int i = gt; i < DEPTH * CH_L; i += NGT) { const int l = i / CH_L, c = i % CH_L; ((u32x4*)(w_in_t(C, l) + (size_t)INC * DM))[c] = (u32x4){0u, 0u, 0u, 0u}; }
      float* ra = ws_f(C, WS_ROPE); float* ri = ra + 2048 * 16 * 2;
      for (int i = gt; i < 2048 * 24; i += NGT) { const int pos = i / 24, k = i % 24; const bool isa = k < 16; const int fi = isa ? k : k - 16;
          const double ex = isa ? (double)fi / 16.0 : (double)fi / 8.0; const float inv = (float)exp2(-ex * 18.931568569324174  );
          const float ang = (float)pos * inv; float c, s; sincos_tab(ang, c, s);
          float* dst = isa ? ra + (pos * 16 + fi) * 2 : ri + (pos * 8 + fi) * 2; dst[0] = c; dst[1] = s; } }
    for (int m = gw; m < NTOK; m += NGW) { const float* src = m < NTP ? A.in[0] + (size_t)m * DM : A.in[1] + (size_t)(m - NTP) * DM;
        rms_row(src, ws_f(C, WS_X) + (size_t)m * DM, A.in[9], ws_bf(C, WS_H) + (size_t)m * DM, nullptr, C.lane); }
}

struct M0Row { unsigned ra1, ra2, ri1, ri2, rk1, rk2; u32x4 cak, cav, cik, cbk, cbv, xb[4]; f32x4 tA, tI; bf16 dt; };
DI void m0_decode(int r, bool& smp, int& b, int& t, int& pos) { smp = r >= NTP; if (!smp) { b = r >> 11; t = r & 2047; pos = t; } else { const int rr = r - NTP; b = rr >> 6; t = rr & 63; pos = PAST + t; } }
DI void m0_load(const Ctx& C, int r, int lane, M0Row& R) {
    const bf16* P = ws_bf(C, WS_PU) + (size_t)r * INP;
    bool smp; int b, t, pos; m0_decode(r, smp, b, t, pos);
    { const int h8 = lane >> 3, j = lane & 7; const bf16* p = P + (h8 < 4 ? C_AQ + h8 * 128 : C_AK + (h8 - 4) * 128) + 2 * j; R.ra1 = *(const unsigned*)p; R.ra2 = *(const unsigned*)(p + 16); }
    { const int h16 = lane >> 2, j = lane & 3; const bf16* p = P + C_IQ + h16 * 64 + 2 * j; R.ri1 = *(const unsigned*)p; R.ri2 = *(const unsigned*)(p + 8); }
    if (lane < 4) { const bf16* p = P + C_IK + 2 * lane; R.rk1 = *(const unsigned*)p; R.rk2 = *(const unsigned*)(p + 8); }
    if (lane < 48) R.cak = *(const u32x4*)(P + C_AK + (lane / 12) * 128 + 32 + (lane % 12) * 8);
    R.cav = *(const u32x4*)(P + C_AV + lane * 8);
    if (lane >= 8 && lane < 14) R.cik = *(const u32x4*)(P + C_IK + 16 + (lane - 8) * 8);
    if (smp || t >= SEQ - BWIN) { R.cbk = *(const u32x4*)(P + C_BK + lane * 8); R.cbv = *(const u32x4*)(P + C_BV + lane * 8); }
    if (lane < 16) R.dt = P[C_DT + lane];
#pragma unroll
    for (int it = 0; it < 4; ++it) R.xb[it] = *(const u32x4*)(P + C_XBC + (lane + 64 * it) * 8);
    R.tA = *(const f32x4*)(ws_f(C, WS_ROPE) + (size_t)pos * 32 + 4 * (lane & 7));
    R.tI = *(const f32x4*)(ws_f(C, WS_ROPE) + 2048 * 32 + (size_t)pos * 16 + 4 * (lane & 3));
}
DI void rope2(unsigned a, unsigned bq, f32x4 t, float (&y1)[2], float (&y2)[2]) {
    const float a0 = __uint_as_float(a << 16), a1 = __uint_as_float(a & 0xffff0000u), b0 = __uint_as_float(bq << 16), b1 = __uint_as_float(bq & 0xffff0000u);
    y1[0] = a0 * t.x - b0 * t.y; y2[0] = b0 * t.x + a0 * t.y; y1[1] = a1 * t.z - b1 * t.w; y2[1] = b1 * t.z + a1 * t.w;
}
DI void st8f(float* dst, u32x4 v) { float f[8]; unpack8(v, f); ((f32x4*)dst)[0] = (f32x4){f[0], f[1], f[2], f[3]}; ((f32x4*)dst)[1] = (f32x4){f[4], f[5], f[6], f[7]}; }
DI void m0_window(const Ctx& C, const Args& A, int l, int r, int lane, u32x4 (&wnd)[3][4]) {
    bool smp; int b, t, pos; m0_decode(r, smp, b, t, pos);
#pragma unroll
    for (int k = 1; k <= 3; ++k) { const int tt = t - k;
#pragma unroll
        for (int it = 0; it < 4; ++it) { const int ch = (lane + 64 * it) * 8; u32x4 v = (u32x4){0u, 0u, 0u, 0u};
            if (tt >= 0) v = *(const u32x4*)(ws_bf(C, WS_PU) + (size_t)(r - k) * INP + C_XBC + ch);
            else if (smp) { const float* sp = A.in[8] + ((size_t)(l * DBAT + b) * 3 + (3 + tt)) * 2048 + ch; const f32x4 s0 = *(const f32x4*)sp, s1 = *(const f32x4*)(sp + 4);
                v.x = pk2(s0.x, s0.y); v.y = pk2(s0.z, s0.w); v.z = pk2(s1.x, s1.y); v.w = pk2(s1.z, s1.w); }
            wnd[3 - k][it] = v; } }
}
DI void m0_process(const Ctx& C, const Args& A, int l, int r, int lane, const M0Row& R, u32x4 (&wnd)[3][4], const LAS float* cwL, const LAS float* cbL) {
    bf16* P = ws_bf(C, WS_PU) + (size_t)r * INP;
    bool smp; int b, t, pos; m0_decode(r, smp, b, t, pos);
    float* out = C.out;
    float* o_ak = smp ? out + OFF_S_AK + ((size_t)(l * DBAT + b) * DSEQ + t) * 512 : out + OFF_P_AK + ((size_t)(l * NB + b) * SEQ + t) * 512;
    float* o_av = smp ? out + OFF_S_AV + ((size_t)(l * DBAT + b) * DSEQ + t) * 512 : out + OFF_P_AV + ((size_t)(l * NB + b) * SEQ + t) * 512;
    float* o_ki = smp ? out + OFF_S_KI + ((size_t)(l * DBAT + b) * DSEQ + t) * 64 : out + OFF_P_KI + ((size_t)(l * NB + b) * SEQ + t) * 64;
    float y1[2], y2[2];
    { const int h8 = lane >> 3, j = lane & 7; rope2(R.ra1, R.ra2, R.tA, y1, y2);
      bf16* p = P + (h8 < 4 ? C_AQ + h8 * 128 : C_AK + (h8 - 4) * 128) + 2 * j; *(unsigned*)p = pk2(y1[0], y1[1]); *(unsigned*)(p + 16) = pk2(y2[0], y2[1]);
      if (h8 >= 4) { float* o = o_ak + (h8 - 4) * 128 + 2 * j; *(f32x2_t_*)o = (f32x2_t_){y1[0], y1[1]}; *(f32x2_t_*)(o + 16) = (f32x2_t_){y2[0], y2[1]}; } }
    { const int h16 = lane >> 2, j = lane & 3; rope2(R.ri1, R.ri2, R.tI, y1, y2);
      bf16* p = P + C_IQ + h16 * 64 + 2 * j; *(unsigned*)p = pk2(y1[0], y1[1]); *(unsigned*)(p + 8) = pk2(y2[0], y2[1]); }
    if (lane < 4) { rope2(R.rk1, R.rk2, R.tI, y1, y2);
      bf16* p = P + C_IK + 2 * lane; *(unsigned*)p = pk2(y1[0], y1[1]); *(unsigned*)(p + 8) = pk2(y2[0], y2[1]);
      float* o = o_ki + 2 * lane; *(f32x2_t_*)o = (f32x2_t_){y1[0], y1[1]}; *(f32x2_t_*)(o + 8) = (f32x2_t_){y2[0], y2[1]}; }
    if (lane < 48) st8f(o_ak + (lane / 12) * 128 + 32 + (lane % 12) * 8, R.cak);
    st8f(o_av + lane * 8, R.cav);
    if (lane >= 8 && lane < 14) st8f(o_ki + 16 + (lane - 8) * 8, R.cik);
    if (smp || t >= SEQ - BWIN) {
        const size_t ro = smp ? ((size_t)(l * DBAT + b) * DSEQ + t) * 512 : ((size_t)(l * NB + b) * BWIN + (t - (SEQ - BWIN))) * 512;
        st8f(out + (smp ? OFF_S_BK : OFF_P_BK) + ro + lane * 8, R.cbk); st8f(out + (smp ? OFF_S_BV : OFF_P_BV) + ro + lane * 8, R.cbv);
    }
    if (lane < 16) { const float x = bf2f(R.dt) + A.in[15][l * 16 + lane]; ws_f(C, WS_DTS)[(size_t)r * 16 + lane] = x > 20.f ? x : log1pf(__expf(x)); }
    const int stt = smp ? DSEQ - 3 : SEQ - 3;
    float* o_conv = (t >= stt) ? (smp ? out + OFF_S_CONV + ((size_t)(l * DBAT + b) * 3 + (t - stt)) * 2048 : out + OFF_P_CONV + ((size_t)(l * NB + b) * 3 + (t - stt)) * 2048) : nullptr;
    bf16* xo = ws_bf(C, WS_XBC) + (size_t)r * 2048;
#pragma unroll
    for (int it = 0; it < 4; ++it) { const int ch = (lane + 64 * it) * 8;
        float acc[8], x[8];
        { const f32x4 b0 = *(const LAS f32x4*)(cbL + ch), b1 = *(const LAS f32x4*)(cbL + ch + 4); acc[0] = b0.x; acc[1] = b0.y; acc[2] = b0.z; acc[3] = b0.w; acc[4] = b1.x; acc[5] = b1.y; acc[6] = b1.z; acc[7] = b1.w; }
#pragma unroll
        for (int j = 0; j < 4; ++j) { unpack8(j < 3 ? wnd[j][it] : R.xb[it], x);
            const f32x4 w0 = *(const LAS f32x4*)(cwL + j * 2048 + ch), w1 = *(const LAS f32x4*)(cwL + j * 2048 + ch + 4);
            acc[0] += x[0] * w0.x; acc[1] += x[1] * w0.y; acc[2] += x[2] * w0.z; acc[3] += x[3] * w0.w; acc[4] += x[4] * w1.x; acc[5] += x[5] * w1.y; acc[6] += x[6] * w1.z; acc[7] += x[7] * w1.w; }
        if (o_conv) { ((f32x4*)(o_conv + ch))[0] = (f32x4){x[0], x[1], x[2], x[3]}; ((f32x4*)(o_conv + ch))[1] = (f32x4){x[4], x[5], x[6], x[7]}; }
#pragma unroll
        for (int k = 0; k < 8; ++k) acc[k] = acc[k] / (1.f + __expf(-acc[k]));
        *(u32x4*)(xo + ch) = pack8(acc);
        wnd[0][it] = wnd[1][it]; wnd[1][it] = wnd[2][it]; wnd[2][it] = R.xb[it];
        asm volatile("" ::: "memory");
    }
}
DI void cvt_f4(const float* src, bf16* dst, size_t n4, size_t gt, size_t ngt) {
    size_t i = gt;
    for (; i + 3 * ngt < n4; i += 4 * ngt) { f32x4 v[4];
#pragma unroll
        for (int k = 0; k < 4; ++k) v[k] = ((const f32x4*)src)[i + k * ngt];
#pragma unroll
        for (int k = 0; k < 4; ++k) { u32x2 o; o.x = pk2(v[k].x, v[k].y); o.y = pk2(v[k].z, v[k].w); ((u32x2*)dst)[i + k * ngt] = o; } }
    for (; i < n4; i += ngt) { const f32x4 v = ((const f32x4*)src)[i]; u32x2 o; o.x = pk2(v.x, v.y); o.y = pk2(v.z, v.w); ((u32x2*)dst)[i] = o; }
}
DI void m0_phase(const Ctx& C, const Args& A, int l) {
    LAS float* cwL = (LAS float*)C.lds; LAS float* cbL = cwL + 4 * 2048;
    { const float* cw = A.in[13] + (size_t)l * 4 * 2048; const float* cb = A.in[14] + (size_t)l * 2048;
      for (int i = C.tid; i < 2048; i += NTHR) ((LAS f32x4*)cwL)[i] = ((const f32x4*)cw)[i];
      for (int i = C.tid; i < 512; i += NTHR) ((LAS f32x4*)cbL)[i] = ((const f32x4*)cb)[i]; }
    __syncthreads();
    const int gw = C.bid * NWAVES + C.wave, NGW = C.G * NWAVES, per = (NTOK + NGW - 1) / NGW;
    const int r0 = gw * per, r1 = (r0 + per < NTOK) ? r0 + per : NTOK;
    if (r0 < r1) {
        u32x4 wnd[3][4]; M0Row cur, nxt;
        m0_load(C, r0, C.lane, cur); m0_window(C, A, l, r0, C.lane, wnd);
#pragma unroll 1
        for (int r = r0; r < r1; ++r) {
            if (r + 1 < r1) m0_load(C, r + 1, C.lane, nxt);
            if (r != r0) { bool smp; int b, t, pos; m0_decode(r, smp, b, t, pos); if (t == 0) m0_window(C, A, l, r, C.lane, wnd); }
            m0_process(C, A, l, r, C.lane, cur, wnd, cwL, cbL);
            cur = nxt;
        }
    }
    const size_t gt = (size_t)C.bid * NTHR + C.tid, ngt = (size_t)C.G * NTHR;
    cvt_f4(A.in[2] + (size_t)l * DBAT * PAST * 512, ws_bf(C, WS_CAK), (size_t)DBAT * PAST * 512 / 4, gt, ngt);
    cvt_f4(A.in[3] + (size_t)l * DBAT * PAST * 512, ws_bf(C, WS_CAV), (size_t)DBAT * PAST * 512 / 4, gt, ngt);
    cvt_f4(A.in[4] + (size_t)l * DBAT * PAST * 64, ws_bf(C, WS_CKI), (size_t)DBAT * PAST * 64 / 4, gt, ngt);
    cvt_f4(A.in[5] + (size_t)l * DBAT * BWIN * 512, ws_bf(C, WS_CBK), (size_t)DBAT * BWIN * 512 / 4, gt, ngt);
    cvt_f4(A.in[6] + (size_t)l * DBAT * BWIN * 512, ws_bf(C, WS_CBV), (size_t)DBAT * BWIN * 512 / 4, gt, ngt);
}

struct KVSrc { const bf16* k0; const bf16* v0; int s0; int n0; const bf16* k1; const bf16* v1; int s1; };
template <int MODE>
DI void attn_unit(const Ctx& C, const bf16* Qp, int qstride, const KVSrc& S, int tile_lo, int tile_hi, bf16* Op, int ostride) {
    int tid = C.tid, lane = C.lane; asm volatile("" : "+v"(tid), "+v"(lane));
    const int w = C.wave, r = lane & 31, hh = lane >> 5;
    const int head = w >> 1, q = (w & 1) * 32 + r;
    LAS unsigned char* Ks = C.lds + ATT_K; LAS unsigned char* Vs = C.lds + ATT_V;
    bf16x8 qf[8];
    { const bf16* qrow = Qp + (size_t)q * qstride + head * 128 + 8 * hh;
#pragma unroll
      for (int ks = 0; ks < 8; ++ks) qf[ks] = *(const bf16x8*)(qrow + 16 * ks); }
    f32x16 o[4];
#pragma unroll
    for (int d = 0; d < 4; ++d)
#pragma unroll
        for (int i = 0; i < 16; ++i) o[d][i] = 0.f;
    float m = -1e30f, lsum = 0.f;
    constexpr float SC2 = 0.08838834764831845f * 1.4426950408889634f;
    constexpr float L2E = 1.4426950408889634f;
    u32x4 kr[4], vr[4];
#define ATT_LOAD(tile_) do { _Pragma("unroll") for (int i_ = 0; i_ < 4; ++i_) { const int ci_ = tid + 512 * i_, row_ = ci_ >> 6, ch_ = ci_ & 63, key_ = (tile_) * 32 + row_; \
        const ptrdiff_t off_ = key_ < S.n0 ? (ptrdiff_t)key_ * S.s0 : (ptrdiff_t)(key_ - S.n0) * S.s1; \
        kr[i_] = *(const u32x4*)((key_ < S.n0 ? S.k0 : S.k1) + off_ + ch_ * 8); vr[i_] = *(const u32x4*)((key_ < S.n0 ? S.v0 : S.v1) + off_ + ch_ * 8); } } while (0)
#define ATT_STORE(buf_) do { _Pragma("unroll") for (int i_ = 0; i_ < 4; ++i_) { const int ci_ = tid + 512 * i_, row_ = ci_ >> 6, ch_ = ci_ & 63; \
        *(LAS u32x4*)(Ks + (buf_) * (32 * KSTR) + row_ * KSTR + ch_ * 16) = kr[i_]; *(LAS u32x4*)(Vs + (buf_) * (32 * VSTR) + row_ * VSTR + ch_ * 16) = vr[i_]; } } while (0)
    ATT_LOAD(tile_lo);
    __syncthreads();
    ATT_STORE(0);
    if (tile_lo + 1 < tile_hi) ATT_LOAD(tile_lo + 1);
    __syncthreads();
    const int i16 = lane & 15;
    LAS unsigned char* vbase = Vs + (4 * hh + (i16 >> 2)) * VSTR + (head * 128 + 16 * ((lane >> 4) & 1) + 4 * (i16 & 3)) * 2;
    LAS unsigned char* kbase = Ks + r * KSTR + head * 256 + hh * 16;
    const LAS float* btab = (const LAS float*)(C.lds + ATT_SEL) + head * 257;
    const LAS unsigned* sel = (const LAS unsigned*)(C.lds + ATT_SEL) + q * 64;
#pragma unroll 1
    for (int tile = tile_lo; tile < tile_hi; ++tile) {
        const int cur = (tile - tile_lo) & 1;
        if (tile + 1 < tile_hi) { ATT_STORE(cur ^ 1); if (tile + 2 < tile_hi) ATT_LOAD(tile + 2); }
        f32x16 s;
        if (MODE == 0) {
            const unsigned nwd = ~(sel[tile] >> (4 * hh));
#pragma unroll
            for (int i = 0; i < 16; ++i) { const int mb = ((int)(nwd << (31 - ((i & 3) + 8 * (i >> 2))))) >> 31; s[i] = __int_as_float(mb & (int)0xFF800000); }
        } else {
            if (tile <= 11) { const float bb = btab[256] * (L2E / SC2);
#pragma unroll
                for (int i = 0; i < 16; ++i) s[i] = bb;
            } else {
#pragma unroll
                for (int i = 0; i < 16; ++i) { int rel = BWIN + q - (tile * 32 + crow(i, hh)); rel = rel > 128 ? 128 : rel; s[i] = btab[rel + 128] * (L2E / SC2); }
            }
        }
        { bf16x8 kf[8]; LAS unsigned char* kb = kbase + cur * (32 * KSTR);
#pragma unroll
          for (int ks = 0; ks < 8; ++ks) kf[ks] = *(const LAS bf16x8*)(kb + ks * 32);
#pragma unroll
          for (int ks = 0; ks < 8; ++ks) s = mfma32(kf[ks], qf[ks], s); }
        float mx = s[0];
#pragma unroll
        for (int i = 1; i < 16; ++i) mx = fmaxf(mx, s[i]);
        mx *= SC2;
        if (__any(mx > m + 8.0f)) {
            const auto rr = __builtin_amdgcn_permlane32_swap(__float_as_uint(mx), __float_as_uint(mx), false, false);
            const float mxs = fmaxf(__uint_as_float(rr[0]), __uint_as_float(rr[1]));
            const float mn = (mxs > m + 8.0f) ? mxs : m, alpha = __builtin_amdgcn_exp2f(m - mn);
            lsum *= alpha; m = mn;
#pragma unroll
            for (int d = 0; d < 4; ++d)
#pragma unroll
                for (int i = 0; i < 16; ++i) o[d][i] *= alpha;
        }
#pragma unroll
        for (int i = 0; i < 16; ++i) { s[i] = __builtin_amdgcn_exp2f(__builtin_fmaf(s[i], SC2, -m)); lsum += s[i]; }
        bf16x8 pf[2];
#pragma unroll
        for (int s2 = 0; s2 < 2; ++s2) { u32x4 pk; pk.x = pk2(s[8 * s2], s[8 * s2 + 1]); pk.y = pk2(s[8 * s2 + 2], s[8 * s2 + 3]); pk.z = pk2(s[8 * s2 + 4], s[8 * s2 + 5]); pk.w = pk2(s[8 * s2 + 6], s[8 * s2 + 7]);
            pf[s2] = __builtin_bit_cast(bf16x8, pk); }
        LAS unsigned char* vb = vbase + cur * (32 * VSTR);
#pragma unroll
        for (int dh = 0; dh < 2; ++dh) {
            s16x4 lo[2][2], hi[2][2];
#pragma unroll
            for (int d2 = 0; d2 < 2; ++d2)
#pragma unroll
                for (int s2 = 0; s2 < 2; ++s2) { lo[d2][s2] = tr_read(vb + (16 * s2) * VSTR + (2 * dh + d2) * 64); hi[d2][s2] = tr_read(vb + (16 * s2 + 8) * VSTR + (2 * dh + d2) * 64); }
#pragma unroll
            for (int d2 = 0; d2 < 2; ++d2)
#pragma unroll
                for (int s2 = 0; s2 < 2; ++s2) { const bf16x8 vt = __builtin_shufflevector(lo[d2][s2], hi[d2][s2], 0, 1, 2, 3, 4, 5, 6, 7); o[2 * dh + d2] = mfma32(vt, pf[s2], o[2 * dh + d2]); }
        }
        __syncthreads();
    }
#undef ATT_LOAD
#undef ATT_STORE
    { const auto rr = __builtin_amdgcn_permlane32_swap(__float_as_uint(lsum), __float_as_uint(lsum), false, false); lsum = __uint_as_float(rr[0]) + __uint_as_float(rr[1]); }
    const float inv = 1.0f / lsum;
    bf16* orow = Op + (size_t)q * ostride + head * 128 + 4 * hh;
#pragma unroll
    for (int d = 0; d < 4; ++d)
#pragma unroll
        for (int g = 0; g < 4; ++g) { u32x2 p; p.x = pk2(o[d][4 * g] * inv, o[d][4 * g + 1] * inv); p.y = pk2(o[d][4 * g + 2] * inv, o[d][4 * g + 3] * inv);
            *(u32x2*)(orow + 32 * d + 8 * g) = p; }
}

DI unsigned fkey(float f) { const unsigned u = __float_as_uint(f); return (u & 0x80000000u) ? ~u : (u | 0x80000000u); }
template <int NR>
DI void topk_pair(const float* SCq  , LAS unsigned* SELa  , int NT, int r, int hh, int lane) {
    unsigned v[NR];
#pragma unroll
    for (int i = 0; i < NR; ++i) { const float f = (i < NT) ? SCq[i * 32 + r] : -INFINITY; v[i] = fkey(f); }
    unsigned T = 0u;
#pragma unroll 1
    for (int bit = 31; bit >= 8; --bit) {
        const unsigned cand = T | (1u << bit); unsigned cnt = 0u;
#pragma unroll
        for (int i = 0; i < NR; ++i) asm("v_cmp_ge_u32 vcc, %1, %2\n\tv_addc_co_u32 %0, vcc, 0, %0, vcc" : "+v"(cnt) : "v"(v[i]), "v"(cand) : "vcc");
        unsigned t0 = 0u, t1 = 0u;
#pragma unroll
        for (int b = 0; b < 7; ++b) { const unsigned long long mk = __ballot((cnt >> b) & 1u); t0 += (unsigned)__popc((unsigned)mk) << b; t1 += (unsigned)__popc((unsigned)(mk >> 32)) << b; }
        if ((hh ? t1 : t0) >= 256u) T = cand;
    }
#pragma unroll
    for (int i = 0; i < NR; ++i) { unsigned long long mk = __ballot(v[i] >= T); if (i >= NT) mk = 0ull;
        if (lane == 0) { SELa[i] = (unsigned)mk; SELa[64 + i] = (unsigned)(mk >> 32); } }
}
DI void dsa_unit(const Ctx& C, int l, int u) {
    int lane = C.lane; asm volatile("" : "+v"(lane));
    const int w = C.wave, r = lane & 31, hh = lane >> 5;
    const bf16* PROJ = ws_bf(C, WS_PU);
    int qrow0, NT, limit; KVSrc S; const bf16* ik0; const bf16* ik1; int iks0, ikn0;
    if (u < 256) { const int c = 31 - (u >> 3), b = u & 7; qrow0 = b * SEQ + c * 64; NT = 2 * (c + 1); limit = 64 * (c + 1);
        const bf16* base = PROJ + (size_t)(b * SEQ) * INP;
        S.k0 = base + C_AK; S.v0 = base + C_AV; S.s0 = INP; S.n0 = limit; S.k1 = S.k0; S.v1 = S.v0; S.s1 = INP;
        ik0 = base + C_IK; iks0 = INP; ikn0 = limit; ik1 = ik0;
    } else { const int b = u - 256; qrow0 = NTP + b * DSEQ; NT = (PAST + DSEQ) / 32; limit = PAST + DSEQ;
        const bf16* nb = PROJ + (size_t)qrow0 * INP;
        S.k0 = ws_bf(C, WS_CAK) + (size_t)b * PAST * 512; S.v0 = ws_bf(C, WS_CAV) + (size_t)b * PAST * 512; S.s0 = 512; S.n0 = PAST; S.k1 = nb + C_AK; S.v1 = nb + C_AV; S.s1 = INP;
        ik0 = ws_bf(C, WS_CKI) + (size_t)b * PAST * 64; iks0 = 64; ikn0 = PAST; ik1 = nb + C_IK;
    }
    float* SC = ws_f(C, WS_SC) + (size_t)C.bid * 64 * 2048;
    LAS unsigned* SEL = (LAS unsigned*)(C.lds + ATT_SEL);
    if (limit > 256) {
#ifndef REP_IDX
#define REP_IDX 1
#endif
#ifndef REP_TOPK
#define REP_TOPK 1
#endif
#ifndef REP_ATT
#define REP_ATT 1
#endif
#pragma unroll 1
    for (int pass = 0; pass < 2 * REP_IDX; ++pass) {
        bf16x8 af[2][4]; float wt[2][16];
#pragma unroll
        for (int np = 0; np < 2; ++np) { const int pp = (pass & 1) * 2 + np;
            const bf16* ap = PROJ + (size_t)(qrow0 + 8 * w + 2 * pp + (r >> 4)) * INP + C_IQ + (r & 15) * 64 + 8 * hh;
#pragma unroll
            for (int ks = 0; ks < 4; ++ks) af[np][ks] = *(const bf16x8*)(ap + 16 * ks);
#pragma unroll
            for (int i = 0; i < 16; ++i) { const int qi = 8 * w + 2 * pp + (i >> 3), hd = (i & 3) + 8 * ((i >> 2) & 1) + 4 * hh;
                wt[np][i] = bf2f(PROJ[(size_t)(qrow0 + qi) * INP + C_IW + hd]) * (0.25f * 0.125f); } }
        bf16x8 bk[4], bn[4];
#define IDX_LOAD(dst_, tile_) do { const int key_ = (tile_) * 32 + r; const bf16* kp_ = (key_ < ikn0 ? ik0 + (size_t)key_ * iks0 : ik1 + (size_t)(key_ - ikn0) * INP) + 8 * hh; \
            _Pragma("unroll") for (int ks_ = 0; ks_ < 4; ++ks_) dst_[ks_] = *(const bf16x8*)(kp_ + 16 * ks_); } while (0)
        IDX_LOAD(bn, 0);
#pragma unroll 1
        for (int tile = 0; tile < NT; ++tile) {
#pragma unroll
            for (int ks = 0; ks < 4; ++ks) bk[ks] = bn[ks];
            if (tile + 1 < NT) IDX_LOAD(bn, tile + 1);
#pragma unroll
            for (int np = 0; np < 2; ++np) {
                f32x16 acc;
#pragma unroll
                for (int i = 0; i < 16; ++i) acc[i] = 0.f;
#pragma unroll
                for (int ks = 0; ks < 4; ++ks) acc = mfma32(af[np][ks], bk[ks], acc);
                float p0 = 0.f, p1 = 0.f;
#pragma unroll
                for (int i = 0; i < 8; ++i) { p0 += fmaxf(acc[i], 0.f) * wt[np][i]; p1 += fmaxf(acc[8 + i], 0.f) * wt[np][8 + i]; }
                const float t0 = p0 + __shfl_xor(p0, 32), t1 = p1 + __shfl_xor(p1, 32);
                const int ql = 8 * w + 2 * ((pass & 1) * 2 + np) + hh;
                SC[(size_t)ql * 2048 + tile * 32 + r] = hh ? t1 : t0;
            }
        }
    }
#undef IDX_LOAD
    asm volatile("s_waitcnt vmcnt(0)" ::: "memory");
    __builtin_amdgcn_fence(__ATOMIC_ACQUIRE, "agent");
    asm volatile("s_waitcnt vmcnt(0)" ::: "memory");
#pragma unroll 1
    for (int pq = 0; pq < 4 * REP_TOPK; ++pq) { const int pp = pq & 3;
        const float* SCq = SC + (size_t)(8 * w + 2 * pp + hh) * 2048; LAS unsigned* SELa = SEL + (8 * w + 2 * pp) * 64;
        if (NT <= 16) topk_pair<16>(SCq, SELa, NT, r, hh, lane);
        else if (NT <= 32) topk_pair<32>(SCq, SELa, NT, r, hh, lane);
        else if (NT <= 48) topk_pair<48>(SCq, SELa, NT, r, hh, lane);
        else topk_pair<64>(SCq, SELa, NT, r, hh, lane);
    }
    } else {
        for (int i = lane; i < 8 * 64; i += 64) SEL[8 * w * 64 + i] = ((i & 63) < NT) ? 0xffffffffu : 0u;
    }
    __syncthreads();
#pragma unroll 1
    for (int rep = 0; rep < REP_ATT; ++rep)
    attn_unit<0>(C, PROJ + (size_t)qrow0 * INP + C_AQ, INP, S, 0, NT, ws_bf(C, WS_MIX) + (size_t)qrow0 * DM, DM);
}

DI void band_unit(const Ctx& C, const Args& A, int l, int u) {
    const bf16* PROJ = ws_bf(C, WS_PU);
    int qrow0, tlo; KVSrc S;
    if (u < 256) { const int c = 31 - (u >> 3), b = u & 7; qrow0 = b * SEQ + c * 64; tlo = c < 8 ? (8 - c) * 2 : 0;
        const bf16* base = PROJ + ((ptrdiff_t)b * SEQ + c * 64 - BWIN) * INP;
        S.k0 = base + C_BK; S.v0 = base + C_BV; S.s0 = INP; S.n0 = BWIN + 64; S.k1 = S.k0; S.v1 = S.v0; S.s1 = INP;
    } else { const int b = u - 256; qrow0 = NTP + b * DSEQ; tlo = 0;
        const bf16* nb = PROJ + (size_t)qrow0 * INP;
        S.k0 = ws_bf(C, WS_CBK) + (size_t)b * BWIN * 512; S.v0 = ws_bf(C, WS_CBV) + (size_t)b * BWIN * 512; S.s0 = 512; S.n0 = BWIN; S.k1 = nb + C_BK; S.v1 = nb + C_BV; S.s1 = INP;
    }
    LAS float* bt = (LAS float*)(C.lds + ATT_SEL);
    const float* brel = A.in[12] + (size_t)l * 4 * 257;
    for (int i = C.tid; i < 4 * 257; i += NTHR) bt[i] = brel[i];
    __syncthreads();
    attn_unit<1>(C, PROJ + (size_t)qrow0 * INP + C_BQ, INP, S, tlo, (BWIN + 64) / 32, ws_bf(C, WS_MIX) + (size_t)qrow0 * DM + 512, DM);
}

DI void ssd_unit(const Ctx& C, const Args& A, int l, int row0, int nchunks, int h, const float* h0, float* hout) {
    int tid = C.tid, lane = C.lane; asm volatile("" : "+v"(tid), "+v"(lane));
    const int w = C.wave, r = lane & 31, hh = lane >> 5, g = h >> 2;
    LAS unsigned char* L = C.lds;
    LAS unsigned char* Cs = L + SSD_CS; LAS unsigned char* Bs = L + SSD_BS; LAS unsigned char* XD = L + SSD_XD; LAS unsigned char* XDW = L + SSD_XDW; LAS unsigned char* Ms = L + SSD_MS; LAS unsigned char* Ys = L + SSD_Y;
    LAS float* v_acs = (LAS float*)(L + SSD_VEC); LAS float* v_e = v_acs + 64;
    const bf16* XBC = ws_bf(C, WS_XBC); const bf16* PROJ = ws_bf(C, WS_PU); const float* DTS = ws_f(C, WS_DTS); float* G = ws_f(C, WS_G);
    const float a_h = -expf(A.in[16][l * 16 + h]); const float dsk = A.in[17][l * 16 + h];
    const int erow = tid >> 3, ech = tid & 7;
    f32x16 Hacc[2];
#pragma unroll
    for (int pb = 0; pb < 2; ++pb)
#pragma unroll
        for (int i = 0; i < 16; ++i) Hacc[pb][i] = 0.f;
    u32x4 pC[2], pB[2], pX, pZ; float pDt;
#define SSD_LOAD(c_) do { const int rb_ = row0 + (c_) * 64; \
        _Pragma("unroll") for (int i_ = 0; i_ < 2; ++i_) { const int ci_ = tid + 512 * i_; const bf16* src_ = XBC + (size_t)(rb_ + (ci_ >> 4)) * 2048 + g * 128 + (ci_ & 15) * 8; pB[i_] = *(const u32x4*)(src_ + 1024); pC[i_] = *(const u32x4*)(src_ + 1536); } \
        pX = *(const u32x4*)(XBC + (size_t)(rb_ + erow) * 2048 + h * 64 + ech * 8); pZ = *(const u32x4*)(PROJ + (size_t)(rb_ + erow) * INP + C_CZ + h * 64 + ech * 8); \
        pDt = DTS[(size_t)(rb_ + lane) * 16 + h]; } while (0)
    SSD_LOAD(0);
    __syncthreads();
    if (w >= 4) { const int nb = w - 4;
#pragma unroll
        for (int pb = 0; pb < 2; ++pb)
#pragma unroll
            for (int i = 0; i < 16; ++i) { const int p = 32 * pb + crow(i, hh), n = 32 * nb + r; const float v = h0 ? h0[p * 128 + n] : 0.f; Hacc[pb][i] = v;
                *(LAS bf16*)(L + SSD_HS + p * HSTR + n * 2) = f2bf(v); } }
#pragma unroll 1
    for (int c = 0; c < nchunks; ++c) {
        const int rbase = row0 + c * 64;
        LAS unsigned char* Hcur = L + SSD_HS + (c & 1) * 64 * HSTR; LAS unsigned char* Hnxt = L + SSD_HS + ((c + 1) & 1) * 64 * HSTR;
        const float dtl = pDt; float acs = dtl * a_h;
#pragma unroll
        for (int o = 1; o < 64; o <<= 1) { const float t = __shfl_up(acs, o); if (lane >= o) acs += t; }
        const float Atot = __shfl(acs, 63);
        const float wl = __expf(Atot - acs);
        if (w == 0) { v_acs[lane] = acs; v_e[lane] = __expf(acs); }
#pragma unroll
        for (int i = 0; i < 2; ++i) { const int ci = tid + 512 * i, row = ci >> 4, ch = ci & 15; *(LAS u32x4*)(Bs + row * CSTR + ch * 16) = pB[i]; *(LAS u32x4*)(Cs + row * CSTR + ch * 16) = pC[i]; }
        float xraw[8]; unpack8(pX, xraw); const u32x4 zc = pZ;
        { float xd[8], xw[8]; const float dt = __shfl(dtl, erow & 63), wv = __shfl(wl, erow & 63);
#pragma unroll
          for (int k = 0; k < 8; ++k) { xd[k] = xraw[k] * dt; xw[k] = xd[k] * wv; }
          *(LAS u32x4*)(XD + erow * XSTR + ech * 16) = pack8(xd); *(LAS u32x4*)(XDW + erow * XSTR + ech * 16) = pack8(xw); }
        if (c + 1 < nchunks) SSD_LOAD(c + 1);
        __syncthreads();
        if (w < 4) {
            const int lb = w >> 1, sb = w & 1; f32x16 acc;
#pragma unroll
            for (int i = 0; i < 16; ++i) acc[i] = 0.f;
            if (sb <= lb) {
#pragma unroll
                for (int ks = 0; ks < 8; ++ks) { const bf16x8 a = *(const LAS bf16x8*)(Cs + (32 * lb + r) * CSTR + (16 * ks + 8 * hh) * 2), b = *(const LAS bf16x8*)(Bs + (32 * sb + r) * CSTR + (16 * ks + 8 * hh) * 2);
                    acc = mfma32(a, b, acc); } }
            const int s = 32 * sb + r; const float acs_s = v_acs[s];
#pragma unroll
            for (int i = 0; i < 16; ++i) { const int lr = 32 * lb + crow(i, hh); const float v = (s <= lr) ? acc[i] * __expf(v_acs[lr] - acs_s) : 0.f; *(LAS bf16*)(Ms + lr * MSTR + s * 2) = f2bf(v); }
        } else {
            const int nb = w - 4; const float dec = __expf(Atot);
#pragma unroll
            for (int pb = 0; pb < 2; ++pb) {
#pragma unroll
                for (int i = 0; i < 16; ++i) Hacc[pb][i] *= dec;
#pragma unroll
                for (int ks = 0; ks < 4; ++ks) { const bf16x8 a = trfrag(XDW, XSTR, 16 * ks, 32 * pb, lane), b = trfrag(Bs, CSTR, 16 * ks, 32 * nb, lane); Hacc[pb] = mfma32(a, b, Hacc[pb]); }
#pragma unroll
                for (int i = 0; i < 16; ++i) *(LAS bf16*)(Hnxt + (32 * pb + crow(i, hh)) * HSTR + (32 * nb + r) * 2) = f2bf(Hacc[pb][i]);
            }
        }
        __syncthreads();
        if (w < 4) {
            const int lb = w >> 1, pb = w & 1; f32x16 yd, yo;
#pragma unroll
            for (int i = 0; i < 16; ++i) { yd[i] = 0.f; yo[i] = 0.f; }
#pragma unroll
            for (int ks = 0; ks < 4; ++ks) { const bf16x8 a = *(const LAS bf16x8*)(Ms + (32 * lb + r) * MSTR + (16 * ks + 8 * hh) * 2), b = trfrag(XD, XSTR, 16 * ks, 32 * pb, lane); yd = mfma32(a, b, yd); }
#pragma unroll
            for (int ks = 0; ks < 8; ++ks) { const bf16x8 a = *(const LAS bf16x8*)(Cs + (32 * lb + r) * CSTR + (16 * ks + 8 * hh) * 2), b = *(const LAS bf16x8*)(Hcur + (32 * pb + r) * HSTR + (16 * ks + 8 * hh) * 2); yo = mfma32(a, b, yo); }
            const int p = 32 * pb + r;
#pragma unroll
            for (int i = 0; i < 16; ++i) { const int lr = 32 * lb + crow(i, hh); *(LAS float*)(Ys + lr * YSTR + p * 4) = yd[i] + v_e[lr] * yo[i]; }
        }
        __syncthreads();
        {
            float z[8]; unpack8(zc, z);
            const f32x4 y0 = *(const LAS f32x4*)(Ys + erow * YSTR + ech * 32), y1 = *(const LAS f32x4*)(Ys + erow * YSTR + ech * 32 + 16);
            float y[8] = {y0.x, y0.y, y0.z, y0.w, y1.x, y1.y, y1.z, y1.w};
#pragma unroll
            for (int k = 0; k < 8; ++k) { const float yy = y[k] + dsk * xraw[k]; y[k] = yy * z[k] / (1.f + __expf(-z[k])); }
            float* gp = G + (size_t)(rbase + erow) * 1024 + h * 64 + ech * 8;
            ((f32x4*)gp)[0] = (f32x4){y[0], y[1], y[2], y[3]}; ((f32x4*)gp)[1] = (f32x4){y[4], y[5], y[6], y[7]};
        }
    }
#undef SSD_LOAD
    if (w >= 4) { const int nb = w - 4;
#pragma unroll
        for (int pb = 0; pb < 2; ++pb)
#pragma unroll
            for (int i = 0; i < 16; ++i) hout[(32 * pb + crow(i, hh)) * 128 + 32 * nb + r] = Hacc[pb][i]; }
}

DI void gate_norm_phase(const Ctx& C, const Args& A, int l) {
    const int gw = C.bid * NWAVES + C.wave, NGW = C.G * NWAVES; const float* gn = A.in[18] + (size_t)l * 1024;
    for (int m = gw; m < NTOK; m += NGW) { const float* grow = ws_f(C, WS_G) + (size_t)m * 1024; bf16* orow = ws_bf(C, WS_MIX) + (size_t)m * DM + 1024;
#pragma unroll
        for (int g = 0; g < 4; ++g) { const f32x4 v = ((const f32x4*)grow)[g * 64 + C.lane]; const float ss = wave_sum((v.x * v.x + v.y * v.y) + (v.z * v.z + v.w * v.w));
            const float rs = 1.0f / sqrtf(ss * (1.0f / 256.f) + EPS); const f32x4 wv = ((const f32x4*)gn)[g * 64 + C.lane]; const f32x4 o = v * rs * wv;
            u32x2 p; p.x = pk2(o.x, o.y); p.y = pk2(o.z, o.w); ((u32x2*)orow)[g * 64 + C.lane] = p; } }
}
DI void norm_phase(const Ctx& C, const float* w, bf16* outb, float* outf) {
    const int gw = C.bid * NWAVES + C.wave, NGW = C.G * NWAVES;
    for (int m = gw; m < NTOK; m += NGW) { float* xr = ws_f(C, WS_X) + (size_t)m * DM; const bool sp = m >= NTP;
        rms_row(xr, sp ? xr : nullptr, w, outb ? outb + (size_t)m * DM : nullptr, outf ? outf + (size_t)m * DM : nullptr, C.lane, sp ? ws_f(C, WS_G) + (size_t)(m - NTP) * DM : nullptr, (size_t)NTS * DM); }
}

#ifndef MK_ONE_LAUNCH
#define MK_ONE_LAUNCH 1
#endif
#ifndef PHASE_MASK
#define PHASE_MASK 0xFFFF
#endif
#define EN(k) (((PHASE_MASK) >> (k)) & 1)
constexpr int PH_PER_LAYER = 9, NPHASE = 1 + DEPTH * PH_PER_LAYER;
__global__ void __launch_bounds__(NTHR, 2) fwd(Args args) {
    extern __shared__ __attribute__((aligned(16))) unsigned char lds_raw[];
    Ctx C;
    C.lds = (LAS unsigned char*)lds_raw;
    C.tid = threadIdx.x; C.lane = C.tid & 63; C.wave = __builtin_amdgcn_readfirstlane(C.tid >> 6); C.G = gridDim.x; C.bid = blockIdx.x;
    C.ws = args.ws; C.out = args.out; C.ctl = (unsigned*)(args.ws + WS_CTL);
    const Args& A = args;
    for (int u = C.tid; u < (LDS_BYTES - LDSCTL_OFF) / 4; u += NTHR) ((LAS unsigned*)(C.lds + LDSCTL_OFF))[u] = 0u;
    __syncthreads();
    const int lo = args.ph_lo, hi = args.ph_hi;
    const bool multi = (hi - lo) > 1;
    XcdBarrier bar; bar.bar = C.ctl + CW_BAR; bar.x = 0; bar.st = (volatile LAS unsigned*)(C.lds + LDSCTL_OFF);
    if (multi) bar = xcd_barrier_post(C.ctl + CW_BAR, (volatile LAS unsigned*)(C.lds + LDSCTL_OFF));
#define IN(k) (lo <= (k) && (k) < hi)
#define FRESH() do { int t_ = threadIdx.x; asm volatile("" : "+v"(t_)); C.tid = t_; C.lane = t_ & 63; int w_ = __builtin_amdgcn_readfirstlane(t_ >> 6); asm volatile("" : "+s"(w_)); C.wave = w_; } while (0)
#define SEAM(k) do { if (IN((k) + 1)) xcd_barrier(bar); } while (0)

    if (EN(0) && IN(0)) { p0_prologue(C, A);
#if defined(PROBE_P02)
        __syncthreads(); p0_prologue(C, A);
#endif
        SEAM(0); }
#pragma unroll 1
    for (int l = 0; l < DEPTH; ++l) {
        const int pb = 1 + PH_PER_LAYER * l;
        if (EN(1) && IN(pb + 0)) { FRESH();
            pg8::Gemm g{ws_bf(C, WS_H), w_in_t(C, l), NTOK, INP, DM, DM}; pg8::StaticOrder S; S.init(NTOK, INP, C.G, C.bid);
            pg8::EpiBf16<0> E{ws_bf(C, WS_PU), INP};
            pg8::gemm_phase<pg8::EpiBf16<0>, pg8::StaticOrder, true, true>(C.lds, g, S, E);
            SEAM(pb + 0);
        }
        if (EN(2) && IN(pb + 1)) { FRESH();
            m0_phase(C, A, l); SEAM(pb + 1); }
        if (IN(pb + 2)) { FRESH();
            unsigned* qh = C.ctl + CW_Q + 64 * (l * 4);
            if (EN(3)) for (;;) { const int u = q_next(C, qh); if (u >= NB * 16) break;
                ssd_unit(C, A, l, (u >> 4) * SEQ, SEQ / 64, u & 15, nullptr, C.out + OFF_P_SSM + ((size_t)(l * NB + (u >> 4)) * 16 + (u & 15)) * 8192); }
            if (EN(4)) for (;;) { const int u = q_next(C, qh + 64); if (u >= 288) break; dsa_unit(C, l, u); }
            if (EN(5)) for (;;) { const int u = q_next(C, qh + 128); if (u >= 288) break; band_unit(C, A, l, u); }
            if (EN(3)) for (;;) { const int u = q_next(C, qh + 192); if (u >= DBAT * 16) break;
                ssd_unit(C, A, l, NTP + (u >> 4) * DSEQ, 1, u & 15, A.in[7] + ((size_t)(l * DBAT + (u >> 4)) * 16 + (u & 15)) * 8192, C.out + OFF_S_SSM + ((size_t)(l * DBAT + (u >> 4)) * 16 + (u & 15)) * 8192); }
#if defined(PROBE_MIXK)
            { unsigned* qh2 = C.ctl + CW_Q + 64 * (16 + l * 4);
            if (PROBE_MIXK & 1) for (;;) { const int u = q_next(C, qh2); if (u >= NB * 16) break;
                ssd_unit(C, A, l, (u >> 4) * SEQ, SEQ / 64, u & 15, nullptr, C.out + OFF_P_SSM + ((size_t)(l * NB + (u >> 4)) * 16 + (u & 15)) * 8192); }
            if (PROBE_MIXK & 2) for (;;) { const int u = q_next(C, qh2 + 64); if (u >= 288) break; dsa_unit(C, l, u); }
            if (PROBE_MIXK & 4) for (;;) { const int u = q_next(C, qh2 + 128); if (u >= 288) break; band_unit(C, A, l, u); }
            if (PROBE_MIXK & 8) for (;;) { const int u = q_next(C, qh2 + 192); if (u >= DBAT * 16) break;
                ssd_unit(C, A, l, NTP + (u >> 4) * DSEQ, 1, u & 15, A.in[7] + ((size_t)(l * DBAT + (u >> 4)) * 16 + (u & 15)) * 8192, C.out + OFF_S_SSM + ((size_t)(l * DBAT + (u >> 4)) * 16 + (u & 15)) * 8192); } }
#endif
            SEAM(pb + 2);
        }
        if (EN(6) && IN(pb + 3)) { FRESH(); gate_norm_phase(C, A, l); SEAM(pb + 3); }
        if (EN(7) && IN(pb + 4)) { FRESH();
            { pg8::Gemm g{ws_bf(C, WS_MIX), w_out_t(C, l), NTP, DM, DM, DM}; pg8::StaticOrder S; S.init(NTP, DM, C.G, C.bid);
              pg8::EpiResF32 E{ws_f(C, WS_X), DM};
              pg8::gemm_phase<pg8::EpiResF32, pg8::StaticOrder, true, true>(C.lds, g, S, E); }
            __syncthreads();
            { pg8::Gemm g{ws_bf(C, WS_MIX), w_out_t(C, l), NTOK, DM, DM / 4, DM}; pg8::SplitOrder S; S.init(NTP / 256, NTS / 256, DM / 256, 4, C.G, C.bid);
              pg8::EpiSplitRes E{ws_f(C, WS_X), DM, ws_f(C, WS_G), (size_t)NTS * DM, NTP};
              pg8::gemm_phase<pg8::EpiSplitRes, pg8::SplitOrder, true, true>(C.lds, g, S, E); }
            SEAM(pb + 4);
        }
        if (EN(8) && IN(pb + 5)) { FRESH(); norm_phase(C, A.in[19] + (size_t)l * DM, ws_bf(C, WS_H), nullptr); SEAM(pb + 5); }
        if (EN(9) && IN(pb + 6)) { FRESH();
            pg8::Gemm g{ws_bf(C, WS_H), w_up_t(C, l), NTOK, DFF, DM, DM}; pg8::StaticOrder S; S.init(NTOK, DFF, C.G, C.bid);
            pg8::EpiBf16<1> E{ws_bf(C, WS_PU), DFF};
            pg8::gemm_phase<pg8::EpiBf16<1>, pg8::StaticOrder, true, true>(C.lds, g, S, E);
#if defined(PROBE_UP2)
            __syncthreads(); pg8::gemm_phase<pg8::EpiBf16<1>, pg8::StaticOrder, true, true>(C.lds, g, S, E);
#endif
            SEAM(pb + 6);
        }
        if (EN(10) && IN(pb + 7)) { FRESH();
            { pg8::Gemm g{ws_bf(C, WS_PU), w_dn_t(C, l), NTP, DM, DFF, DFF}; pg8::StaticOrder S; S.init(NTP, DM, C.G, C.bid);
              pg8::EpiResF32 E{ws_f(C, WS_X), DM};
              pg8::gemm_phase<pg8::EpiResF32, pg8::StaticOrder, true, true>(C.lds, g, S, E); }
            __syncthreads();
            { pg8::Gemm g{ws_bf(C, WS_PU), w_dn_t(C, l), NTOK, DM, DFF / 4, DFF}; pg8::SplitOrder S; S.init(NTP / 256, NTS / 256, DM / 256, 4, C.G, C.bid);
              pg8::EpiSplitRes E{ws_f(C, WS_X), DM, ws_f(C, WS_G), (size_t)NTS * DM, NTP};
              pg8::gemm_phase<pg8::EpiSplitRes, pg8::SplitOrder, true, true>(C.lds, g, S, E); }
            SEAM(pb + 7);
        }
        if (EN(8) && IN(pb + 8)) { FRESH();
            if (l + 1 < DEPTH) norm_phase(C, A.in[9] + (size_t)(l + 1) * DM, ws_bf(C, WS_H), nullptr);
            else norm_phase(C, A.in[22], nullptr, C.out);
            SEAM(pb + 8);
        }
    }
#undef IN
#undef SEAM
}

extern "C" void kernel_launch(void* const* d_in, const int* in_sizes, int n_in, void* d_out, int out_size, void* d_ws, size_t ws_size, hipStream_t stream) {
    static int grid = 0;
    if (grid == 0) {
        if (n_in != 23 || in_sizes[0] != NTP * DM || (size_t)out_size != OUT_TOTAL || ws_size < WS_END) {
            fprintf(stderr, "kernel_launch: unexpected shapes (n_in %d, in0 %d, out %d, ws %zu; need ws >= %zu); nothing launched\n", n_in, n_in > 0 ? in_sizes[0] : -1, out_size, ws_size, (size_t)WS_END); grid = -1; return; }
        int dev = 0, cus = 0, per_cu = 0;
        if (hipGetDevice(&dev) != hipSuccess || hipDeviceGetAttribute(&cus, hipDeviceAttributeMultiprocessorCount, dev) != hipSuccess) { fprintf(stderr, "kernel_launch: device query failed\n"); grid = -1; return; }
        if (hipFuncSetAttribute((const void*)fwd, hipFuncAttributeMaxDynamicSharedMemorySize, LDS_BYTES) != hipSuccess) { fprintf(stderr, "kernel_launch: hipFuncSetAttribute failed\n"); grid = -1; return; }
        if (hipOccupancyMaxActiveBlocksPerMultiprocessor(&per_cu, (const void*)fwd, NTHR, LDS_BYTES) != hipSuccess || per_cu < 1)
            fprintf(stderr, "kernel_launch: note: occupancy query reports %d workgroups per CU\n", per_cu);
        (void)hipGetLastError();
        grid = cus < 256 ? cus : 256;
    }
    if (grid < 0) return;
    if (hipMemsetAsync((char*)d_ws + WS_CTL, 0, CTL_ZERO_BYTES, stream) != hipSuccess) { fprintf(stderr, "kernel_launch: memset failed\n"); return; }
    Args a{};
    for (int i = 0; i < 23; ++i) a.in[i] = (const float*)d_in[i];
    a.out = (float*)d_out; a.ws = (unsigned char*)d_ws;
#if MK_ONE_LAUNCH
    a.ph_lo = 0; a.ph_hi = NPHASE;
    hipLaunchKernelGGL(fwd, dim3(grid), dim3(NTHR), LDS_BYTES, stream, a);
#else
    for (int p = 0; p < NPHASE; ++p) { a.ph_lo = p; a.ph_hi = p + 1; hipLaunchKernelGGL(fwd, dim3(grid), dim3(NTHR), LDS_BYTES, stream, a); }
#endif
    const hipError_t le = hipPeekAtLastError();
    if (le != hipSuccess) fprintf(stderr, "kernel_launch: launch failed: %s\n", hipGetErrorName(le));
}
```

```cpp
#include <hip/hip_runtime.h>
#include <cstdio>
#include <cstdint>
#include <cstddef>
namespace pg8 {
#define PG8_LAS __attribute__((address_space(3)))
typedef unsigned short bf16_t;
typedef short bf16x8 __attribute__((ext_vector_type(8)));
typedef float f32x4 __attribute__((ext_vector_type(4)));
typedef unsigned u32x4 __attribute__((ext_vector_type(4)));
constexpr int BM = 256, BK = 64, HALF = 128, HTB = HALF * BK * 2  , STAGE_BYTES = 8 * HTB, NXCD = 8, WGM = 8;

__host__ __device__ __forceinline__ int lds_byte(int r, int c) { const int st = (r >> 4) * 2 + (c >> 5), rr = r & 15, cc = c & 31, ob = rr * 64 + cc * 2; return st * 1024 + (ob ^ (((ob >> 9) & 1) << 5)); }
__host__ __device__ __forceinline__ void stage_rc(int b, int& R, int& C) { const int st = b / 1024, sb = b % 1024, swz = sb ^ (((sb >> 9) & 1) << 5); R = (st >> 1) * 16 + swz / 64; C = (st & 1) * 32 + (swz % 64) / 2; }
__host__ __device__ __forceinline__ int perm32(int rho) { const int n = rho >> 4, i = rho & 15; return 8 * (i >> 2) + 4 * n + (i & 3); }

struct Unit { int pm, pn, kq; };
struct Gemm { const bf16_t* A; const bf16_t* Bt; int M, N, K, ld; };

struct StaticOrder {
    int nM, nN, nwg, G, c;
    __host__ __device__ void init(int M, int N, int G_, int c_) { nM = M / BM; nN = N / BM; nwg = nM * nN; G = G_; c = c_; }
    __host__ __device__ bool next(int i, Unit& u) const {
        const long L = (long)i * G + c; if (L >= nwg) return false;
        int wgid = (int)L; { const int q = nwg / NXCD, r = nwg % NXCD, xcd = wgid % NXCD, off = wgid / NXCD; wgid = (xcd < r ? xcd * (q + 1) : r * (q + 1) + (xcd - r) * q) + off; }
        const int nig = WGM * nN, gid = wgid / nig, fm = gid * WGM, gsz = (nM - fm) < WGM ? (nM - fm) : WGM;
        u.pm = fm + ((wgid % nig) % gsz); u.pn = (wgid % nig) / gsz; u.kq = 0; return true;
    }
    __device__ __forceinline__ void a_ready(const Unit&) const {}
    __device__ __forceinline__ void done(const Unit&) const {}
};

struct SplitOrder {
    int pm0, npm, nN, nsplit, G, c;
    __host__ __device__ void init(int pm0_, int npm_, int nN_, int nsplit_, int G_, int c_) { pm0 = pm0_; npm = npm_; nN = nN_; nsplit = nsplit_; G = G_; c = c_; }
    __host__ __device__ bool next(int i, Unit& u) const {
        const long L = (long)i * G + c; if (L >= (long)npm * nN * nsplit) return false;
        const int w = (int)L; u.kq = w % nsplit; u.pn = (w / nsplit) % nN; u.pm = pm0 + w / (nsplit * nN); return true;
    }
    __device__ __forceinline__ void a_ready(const Unit&) const {}
    __device__ __forceinline__ void done(const Unit&) const {}
};

typedef float f32x2_t __attribute__((ext_vector_type(2)));
typedef __bf16 bf16x2_t __attribute__((ext_vector_type(2)));
__device__ __forceinline__ unsigned cvt_pk_bf16(float lo, float hi) { f32x2_t v = {lo, hi}; bf16x2_t b = __builtin_convertvector(v, bf16x2_t); return __builtin_bit_cast(unsigned, b); }

template <int ACT  > struct EpiBf16 {
    static constexpr bool PERM = true, AFTER_DRAIN = false;
    bf16_t* O; int ldc; const float* SSQ; float invk, eps; PG8_LAS float* tab;
    __device__ __forceinline__ void operator()(const f32x4 (&acc)[2][2][4][2], const Unit& u, int wr, int wc, int fr, int fq) const {
        const int row0 = u.pm * BM + wr * 64 + fr; const int col0 = u.pn * BM + wc * 32 + 8 * fq;
        { const int t = threadIdx.x;
          if (t < 256) { const f32x4* p = (const f32x4*)(SSQ + (size_t)(u.pm * BM + t) * 32); f32x4 a = p[0];
#pragma unroll
              for (int j = 1; j < 8; ++j) a += p[j];
              tab[t] = 1.0f / sqrtf(((a.x + a.y) + (a.z + a.w)) * invk + eps); }
          asm volatile("s_waitcnt lgkmcnt(0)" ::: "memory"); __builtin_amdgcn_s_barrier(); asm volatile("" ::: "memory"); }
        float rs[2][4];
#pragma unroll
        for (int ai = 0; ai < 2; ++ai)
#pragma unroll
            for (int m = 0; m < 4; ++m) rs[ai][m] = tab[wr * 64 + fr + ai * HALF + m * 16];
#pragma unroll
        for (int ai = 0; ai < 2; ++ai)
#pragma unroll
            for (int m = 0; m < 4; ++m) { bf16_t* rowp = O + (size_t)(row0 + ai * HALF + m * 16) * ldc + col0;
#pragma unroll
                for (int bj = 0; bj < 2; ++bj) { f32x4 v0 = acc[ai][bj][m][0] * rs[ai][m], v1 = acc[ai][bj][m][1] * rs[ai][m];
                    if (ACT == 1) {
#pragma unroll
                        for (int j = 0; j < 4; ++j) { const float a = v0[j] > 0.f ? v0[j] : 0.f, b = v1[j] > 0.f ? v1[j] : 0.f; v0[j] = a * a; v1[j] = b * b; } }
                    u32x4 w; w.x = cvt_pk_bf16(v0[0], v0[1]); w.y = cvt_pk_bf16(v0[2], v0[3]); w.z = cvt_pk_bf16(v1[0], v1[1]); w.w = cvt_pk_bf16(v1[2], v1[3]);
                    *(u32x4*)(rowp + bj * HALF) = w; } }
    }
};
struct EpiResF32 {
    static constexpr bool PERM = false, AFTER_DRAIN = false;
    float* X; int ldc;
    __device__ __forceinline__ void operator()(const f32x4 (&acc)[2][2][4][2], const Unit& u, int wr, int wc, int fr, int fq) const {
        const int row0 = u.pm * BM + wr * 64 + fr, col0 = u.pn * BM + wc * 32 + 4 * fq;
#pragma unroll
        for (int ai = 0; ai < 2; ++ai)
#pragma unroll
            for (int m = 0; m < 4; ++m) { float* rowp = X + (size_t)(row0 + ai * HALF + m * 16) * ldc + col0;
                f32x4 b[2][2];
#pragma unroll
                for (int bj = 0; bj < 2; ++bj)
#pragma unroll
                    for (int n = 0; n < 2; ++n) b[bj][n] = *(const f32x4*)(rowp + bj * HALF + n * 16);
#pragma unroll
                for (int bj = 0; bj < 2; ++bj)
#pragma unroll
                    for (int n = 0; n < 2; ++n) *(f32x4*)(rowp + bj * HALF + n * 16) = b[bj][n] + acc[ai][bj][m][n];
                asm volatile("" ::: "memory"); }
    }
};

struct EpiSplitRes {
    static constexpr bool PERM = false, AFTER_DRAIN = false;
    float* X; int ldc; float* P; size_t pstride; int row0;
    __device__ __forceinline__ void operator()(const f32x4 (&acc)[2][2][4][2], const Unit& u, int wr, int wc, int fr, int fq) const {
        const int rowa = u.pm * BM + wr * 64 + fr, col0 = u.pn * BM + wc * 32 + 4 * fq;
        if (u.kq == 0) {
#pragma unroll
            for (int ai = 0; ai < 2; ++ai)
#pragma unroll
                for (int m = 0; m < 4; ++m) { float* rowp = X + (size_t)(rowa + ai * HALF + m * 16) * ldc + col0;
                    f32x4 b[2][2];
#pragma unroll
                    for (int bj = 0; bj < 2; ++bj)
#pragma unroll
                        for (int n = 0; n < 2; ++n) b[bj][n] = *(const f32x4*)(rowp + bj * HALF + n * 16);
#pragma unroll
                    for (int bj = 0; bj < 2; ++bj)
#pragma unroll
                        for (int n = 0; n < 2; ++n) *(f32x4*)(rowp + bj * HALF + n * 16) = b[bj][n] + acc[ai][bj][m][n];
                    asm volatile("" ::: "memory"); }
        } else {
            float* base = P + (size_t)(u.kq - 1) * pstride;
#pragma unroll
            for (int ai = 0; ai < 2; ++ai)
#pragma unroll
                for (int m = 0; m < 4; ++m) { float* rowp = base + (size_t)(rowa - row0 + ai * HALF + m * 16) * ldc + col0;
#pragma unroll
                    for (int bj = 0; bj < 2; ++bj)
#pragma unroll
                        for (int n = 0; n < 2; ++n) *(f32x4*)(rowp + bj * HALF + n * 16) = acc[ai][bj][m][n]; }
        }
    }
};

struct EpiResBf16 {
    static constexpr bool PERM = true, AFTER_DRAIN = false;
    bf16_t* X; int ldc; float* SSQ; int emit;
    __device__ __forceinline__ void operator()(const f32x4 (&acc)[2][2][4][2], const Unit& u, int wr, int wc, int fr, int fq) const {
        const int row0 = u.pm * BM + wr * 64 + fr, col0 = u.pn * BM + wc * 32 + 8 * fq;
#pragma unroll
        for (int ai = 0; ai < 2; ++ai)
#pragma unroll
            for (int m = 0; m < 4; ++m) { const int row = row0 + ai * HALF + m * 16; bf16_t* rowp = X + (size_t)row * ldc + col0;
                u32x4 b[2]; float ss = 0.f;
#pragma unroll
                for (int bj = 0; bj < 2; ++bj) b[bj] = *(const u32x4*)(rowp + bj * HALF);
#pragma unroll
                for (int bj = 0; bj < 2; ++bj) { float v[8];
#pragma unroll
                    for (int j = 0; j < 4; ++j) { v[2 * j] = __uint_as_float(b[bj][j] << 16); v[2 * j + 1] = __uint_as_float(b[bj][j] & 0xffff0000u); }
#pragma unroll
                    for (int j = 0; j < 4; ++j) { v[j] += acc[ai][bj][m][0][j]; v[4 + j] += acc[ai][bj][m][1][j]; }
#pragma unroll
                    for (int j = 0; j < 8; ++j) ss += v[j] * v[j];
                    u32x4 w; w.x = cvt_pk_bf16(v[0], v[1]); w.y = cvt_pk_bf16(v[2], v[3]); w.z = cvt_pk_bf16(v[4], v[5]); w.w = cvt_pk_bf16(v[6], v[7]);
                    *(u32x4*)(rowp + bj * HALF) = w; }
                if (emit) { ss += __shfl_xor(ss, 16); ss += __shfl_xor(ss, 32); if (fq == 0) SSQ[(size_t)row * 32 + u.pn * 4 + wc] = ss; }
                asm volatile("" ::: "memory"); }
    }
};
struct EpiSplitPart {
    static constexpr bool PERM = false, AFTER_DRAIN = false;
    float* P; int ldc; size_t pstride; int row0;
    __device__ __forceinline__ void operator()(const f32x4 (&acc)[2][2][4][2], const Unit& u, int wr, int wc, int fr, int fq) const {
        const int rowa = u.pm * BM + wr * 64 + fr, col0 = u.pn * BM + wc * 32 + 4 * fq;
        float* base = P + (size_t)u.kq * pstride;
#pragma unroll
        for (int ai = 0; ai < 2; ++ai)
#pragma unroll
            for (int m = 0; m < 4; ++m) { float* rowp = base + (size_t)(rowa - row0 + ai * HALF + m * 16) * ldc + col0;
#pragma unroll
                for (int bj = 0; bj < 2; ++bj)
#pragma unroll
                    for (int n = 0; n < 2; ++n) *(f32x4*)(rowp + bj * HALF + n * 16) = acc[ai][bj][m][n]; }
    }
};
template <class Epi, class Sched, bool ALIGN_EPI = false, bool SP2 = false>
__device__ __forceinline__ void gemm_phase(PG8_LAS unsigned char* lds, const Gemm g, const Sched& S, const Epi& E) {
    int tid_ = threadIdx.x; asm volatile("" : "+v"(tid_));
    const int tid = tid_, wid = __builtin_amdgcn_readfirstlane(tid >> 6), lane = tid & 63, wr = wid >> 2, wc = wid & 3, fr = lane & 15, fq = lane >> 4;
    const int K = g.K, nt = K / BK, ld = g.ld;
    unsigned voffA[2], voffB[2];
#pragma unroll
    for (int i = 0; i < 2; ++i) { int R, C; stage_rc(tid * 16 + i * 8192, R, C); const int Rb = Epi::PERM ? ((R & ~31) + perm32(R & 31)) : R;
        voffA[i] = (unsigned)(R * ld + C) * 2u; voffB[i] = (unsigned)(Rb * ld + C) * 2u; }
    const size_t kstep = (size_t)(BK * 2);
    const size_t hstep = (size_t)HALF * ld * 2;
    const size_t tstep = 2 * hstep;
    const unsigned ldsw = (unsigned)wid * 1024u;
    const int aoff = lds_byte(wr * 64 + fr, fq * 8), boff = lds_byte(wc * 32 + fr, fq * 8);
#define PG8_SA(b, h) (((b) * 2 + (h)) * HTB)
#define PG8_SB(b, h) ((4 + (b) * 2 + (h)) * HTB)
#define PG8_STAGE(bufoff, gbase, voff) do { _Pragma("unroll") for (int _i = 0; _i < 2; ++_i) \
        __builtin_amdgcn_global_load_lds((const unsigned*)((const char*)(gbase) + (voff)[_i]), (PG8_LAS unsigned*)(lds + (bufoff) + ldsw + _i * 8192), 16, 0, 0); } while (0)
#define PG8_LDA(dst, b, h) do { _Pragma("unroll") for (int m = 0; m < 4; ++m) _Pragma("unroll") for (int k = 0; k < 2; ++k) dst[m][k] = *(const PG8_LAS bf16x8*)(lds + PG8_SA(b, h) + aoff + m * 2048 + k * 1024); } while (0)
#define PG8_LDB(dst, b, h) do { _Pragma("unroll") for (int n = 0; n < 2; ++n) _Pragma("unroll") for (int k = 0; k < 2; ++k) dst[n][k] = *(const PG8_LAS bf16x8*)(lds + PG8_SB(b, h) + boff + n * 2048 + k * 1024); } while (0)
#define PG8_MMA(ai, bj, At, Bt) do { __builtin_amdgcn_s_setprio(1); _Pragma("unroll") for (int m = 0; m < 4; ++m) _Pragma("unroll") for (int n = 0; n < 2; ++n) _Pragma("unroll") for (int k = 0; k < 2; ++k) \
        acc[ai][bj][m][n] = __builtin_amdgcn_mfma_f32_16x16x32_bf16(Bt[n][k], At[m][k], acc[ai][bj][m][n], 0, 0, 0); __builtin_amdgcn_s_setprio(0); } while (0)
#define PG8_WAIT_V(n) asm volatile("s_waitcnt vmcnt(" #n ")" ::: "memory")
#define PG8_WAIT_L(n) asm volatile("s_waitcnt lgkmcnt(" #n ")" ::: "memory")
#define PG8_BAR __builtin_amdgcn_s_barrier()
#define PG8_SCHED __builtin_amdgcn_sched_barrier(0)
    Unit cur, nxt; int ui = 0;
    if (!S.next(0, cur)) return;
    f32x4 acc[2][2][4][2];
#pragma unroll
    for (int a = 0; a < 2; ++a)
#pragma unroll
        for (int b = 0; b < 2; ++b)
#pragma unroll
            for (int m = 0; m < 4; ++m)
#pragma unroll
                for (int n = 0; n < 2; ++n) acc[a][b][m][n] = (f32x4){0.f, 0.f, 0.f, 0.f};
    bf16x8 At[4][2], B0[2][2], B1[2][2];
    const char* cA = (const char*)g.A + (size_t)cur.pm * tstep + (size_t)cur.kq * K * 2; const char* cB = (const char*)g.Bt + (size_t)cur.pn * tstep + (size_t)cur.kq * K * 2;
    S.a_ready(cur);
    if constexpr (SP2) {
        PG8_STAGE(PG8_SB(0, 0), cB, voffB); PG8_STAGE(PG8_SB(0, 1), cB + hstep, voffB); PG8_STAGE(PG8_SA(0, 0), cA, voffA); PG8_STAGE(PG8_SA(0, 1), cA + hstep, voffA);
        if (wr == 1) PG8_BAR;
        PG8_WAIT_V(2); PG8_BAR;
        PG8_STAGE(PG8_SB(1, 0), cB + kstep, voffB); PG8_STAGE(PG8_SA(1, 0), cA + kstep, voffA); PG8_STAGE(PG8_SB(1, 1), cB + hstep + kstep, voffB);
        PG8_WAIT_V(6); PG8_BAR;
    } else {
        PG8_STAGE(PG8_SB(0, 0), cB, voffB); PG8_STAGE(PG8_SA(0, 0), cA, voffA); PG8_STAGE(PG8_SB(0, 1), cB + hstep, voffB); PG8_STAGE(PG8_SA(0, 1), cA + hstep, voffA);
        if (wr == 1) PG8_BAR;
        PG8_WAIT_V(4); PG8_BAR;
        PG8_STAGE(PG8_SB(1, 0), cB + kstep, voffB); PG8_STAGE(PG8_SA(1, 0), cA + kstep, voffA); PG8_STAGE(PG8_SB(1, 1), cB + hstep + kstep, voffB);
        PG8_WAIT_V(6); PG8_BAR;
    }
    for (;;) {
        const bool has_next = S.next(ui + 1, nxt);
        const char* nA = has_next ? (const char*)g.A + (size_t)nxt.pm * tstep + (size_t)nxt.kq * K * 2 : cA; const char* nB = has_next ? (const char*)g.Bt + (size_t)nxt.pn * tstep + (size_t)nxt.kq * K * 2 : cB;
        for (int t = 0; t < nt; t += 2) {
            const bool last = (t == nt - 2);
            const char* a1 = cA + (size_t)(t + 1) * kstep;
            const char* a2 = last ? nA : cA + (size_t)(t + 2) * kstep; const char* b2 = last ? nB : cB + (size_t)(t + 2) * kstep;
            const char* a3 = a2 + kstep; const char* b3 = b2 + kstep;
            if (last && has_next) S.a_ready(nxt);
            if constexpr (SP2) {
            PG8_LDB(B0, 0, 0); PG8_LDB(B1, 0, 1); PG8_SCHED; PG8_LDA(At, 0, 0); PG8_STAGE(PG8_SA(1, 1), a1 + hstep, voffA);
            PG8_WAIT_V(8); PG8_WAIT_L(0); PG8_BAR; PG8_MMA(0, 0, At, B0); PG8_MMA(0, 1, At, B1); PG8_BAR; PG8_SCHED;
            PG8_LDA(At, 0, 1); PG8_STAGE(PG8_SB(0, 0), b2, voffB); PG8_STAGE(PG8_SB(0, 1), b2 + hstep, voffB); PG8_STAGE(PG8_SA(0, 0), a2, voffA);
            PG8_WAIT_V(8); PG8_WAIT_L(0); PG8_BAR; PG8_MMA(1, 0, At, B0); PG8_MMA(1, 1, At, B1); PG8_BAR; PG8_SCHED;
            PG8_LDB(B0, 1, 0); PG8_LDB(B1, 1, 1); PG8_SCHED; PG8_LDA(At, 1, 0); PG8_STAGE(PG8_SA(0, 1), a2 + hstep, voffA);
            PG8_WAIT_V(8); PG8_WAIT_L(0); PG8_BAR; PG8_MMA(0, 0, At, B0); PG8_MMA(0, 1, At, B1); PG8_BAR; PG8_SCHED;
            PG8_LDA(At, 1, 1); PG8_STAGE(PG8_SB(1, 0), b3, voffB); PG8_STAGE(PG8_SB(1, 1), b3 + hstep, voffB); PG8_STAGE(PG8_SA(1, 0), a3, voffA);
            PG8_WAIT_V(8); PG8_WAIT_L(0); PG8_BAR; PG8_MMA(1, 0, At, B0); PG8_MMA(1, 1, At, B1); PG8_BAR; PG8_SCHED;
            } else {
            PG8_LDB(B0, 0, 0); PG8_SCHED; PG8_LDA(At, 0, 0); PG8_STAGE(PG8_SA(1, 1), a1 + hstep, voffA);
            PG8_WAIT_L(8); PG8_BAR; PG8_WAIT_L(0); PG8_MMA(0, 0, At, B0); PG8_BAR; PG8_SCHED;
            PG8_LDB(B1, 0, 1); PG8_STAGE(PG8_SB(0, 0), b2, voffB);
            PG8_BAR; PG8_WAIT_L(0); PG8_MMA(0, 1, At, B1); PG8_BAR;
            PG8_LDA(At, 0, 1); PG8_STAGE(PG8_SA(0, 0), a2, voffA);
            PG8_BAR; PG8_WAIT_L(0); PG8_MMA(1, 0, At, B0); PG8_BAR; PG8_SCHED;
            PG8_STAGE(PG8_SB(0, 1), b2 + hstep, voffB);
            PG8_WAIT_V(6); PG8_BAR; PG8_MMA(1, 1, At, B1); PG8_BAR;
            PG8_LDB(B0, 1, 0); PG8_SCHED; PG8_LDA(At, 1, 0); PG8_STAGE(PG8_SA(0, 1), a2 + hstep, voffA);
            PG8_WAIT_L(8); PG8_BAR; PG8_WAIT_L(0); PG8_MMA(0, 0, At, B0); PG8_BAR; PG8_SCHED;
            PG8_LDB(B1, 1, 1); PG8_STAGE(PG8_SB(1, 0), b3, voffB);
            PG8_BAR; PG8_WAIT_L(0); PG8_MMA(0, 1, At, B1); PG8_BAR;
            PG8_LDA(At, 1, 1); PG8_STAGE(PG8_SA(1, 0), a3, voffA);
            PG8_BAR; PG8_WAIT_L(0); PG8_MMA(1, 0, At, B0); PG8_BAR; PG8_SCHED;
            PG8_STAGE(PG8_SB(1, 1), b3 + hstep, voffB);
            PG8_WAIT_V(6); PG8_BAR; PG8_MMA(1, 1, At, B1); PG8_BAR;
            }
        }
        if constexpr (ALIGN_EPI) { if (wr == 0) PG8_BAR; }
        if constexpr (!Epi::AFTER_DRAIN) { E(acc, cur, wr, wc, fr, fq); S.done(cur); }
        if (!has_next) break;
#pragma unroll
        for (int a = 0; a < 2; ++a)
#pragma unroll
            for (int b = 0; b < 2; ++b)
#pragma unroll
                for (int m = 0; m < 4; ++m)
#pragma unroll
                    for (int n = 0; n < 2; ++n) acc[a][b][m][n] = (f32x4){0.f, 0.f, 0.f, 0.f};
        cur = nxt; cA = nA; cB = nB; ++ui;
        if constexpr (ALIGN_EPI) { if (wr == 1) PG8_BAR; }
    }
    PG8_WAIT_V(0);
    if constexpr (!ALIGN_EPI) { if (wr == 0) PG8_BAR; }
    PG8_BAR;
    if constexpr (Epi::AFTER_DRAIN) { E.fused(acc, cur, wr, wc, fr, fq, lds, wid, lane); S.done(cur); }
#undef PG8_SA
#undef PG8_SB
#undef PG8_STAGE
#undef PG8_LDA
#undef PG8_LDB
#undef PG8_MMA
#undef PG8_WAIT_V
#undef PG8_WAIT_L
#undef PG8_BAR
#undef PG8_SCHED
}
}

#define DI __device__ __forceinline__
#define LAS __attribute__((address_space(3)))
typedef unsigned short bf16;
typedef short bf16x8 __attribute__((ext_vector_type(8)));
typedef short s16x4 __attribute__((ext_vector_type(4)));
typedef short v4i16_t __attribute__((ext_vector_type(4)));
typedef float f32x4 __attribute__((ext_vector_type(4)));
typedef float f32x16 __attribute__((ext_vector_type(16)));
typedef unsigned u32x4 __attribute__((ext_vector_type(4)));
typedef unsigned u32x2 __attribute__((ext_vector_type(2)));
typedef float f32x2_t_ __attribute__((ext_vector_type(2)));

constexpr int DM = 2048, NB = 8, SEQ = 2048, DEPTH = 4, DBAT = 32, DSEQ = 64, PAST = 1024, BWIN = 512;
constexpr int NTP = NB * SEQ, NTS = DBAT * DSEQ, NTOK = NTP + NTS;
constexpr int INC = 7264, INP = 7424, DFF = 8192;
constexpr int C_AQ = 0, C_AK = 512, C_AV = 1024, C_IQ = 1536, C_IK = 2560, C_IW = 2624, C_BQ = 2640, C_BK = 3152, C_BV = 3664, C_CZ = 4176, C_XBC = 5200, C_DT = 7248;
constexpr float EPS = 1e-5f;
constexpr int NWAVES = 8, NTHR = 512;

constexpr size_t SZ_YP = (size_t)NTP * DM, SZ_YS = (size_t)NTS * DM;
constexpr size_t SZ_PAK = (size_t)DEPTH * NB * SEQ * 512, SZ_PKI = (size_t)DEPTH * NB * SEQ * 64, SZ_PBK = (size_t)DEPTH * NB * BWIN * 512;
constexpr size_t SZ_PSSM = (size_t)DEPTH * NB * 16 * 64 * 128, SZ_PCONV = (size_t)DEPTH * NB * 3 * 2048;
constexpr size_t SZ_SAK = (size_t)DEPTH * DBAT * DSEQ * 512, SZ_SKI = (size_t)DEPTH * DBAT * DSEQ * 64, SZ_SBK = SZ_SAK;
constexpr size_t SZ_SSSM = (size_t)DEPTH * DBAT * 16 * 64 * 128, SZ_SCONV = (size_t)DEPTH * DBAT * 3 * 2048;
constexpr size_t OFF_YP = 0, OFF_YS = OFF_YP + SZ_YP, OFF_P_AK = OFF_YS + SZ_YS, OFF_P_AV = OFF_P_AK + SZ_PAK, OFF_P_KI = OFF_P_AV + SZ_PAK,
                 OFF_P_BK = OFF_P_KI + SZ_PKI, OFF_P_BV = OFF_P_BK + SZ_PBK, OFF_P_SSM = OFF_P_BV + SZ_PBK, OFF_P_CONV = OFF_P_SSM + SZ_PSSM,
                 OFF_S_AK = OFF_P_CONV + SZ_PCONV, OFF_S_AV = OFF_S_AK + SZ_SAK, OFF_S_KI = OFF_S_AV + SZ_SAK, OFF_S_BK = OFF_S_KI + SZ_SKI,
                 OFF_S_BV = OFF_S_BK + SZ_SBK, OFF_S_SSM = OFF_S_BV + SZ_SBK, OFF_S_CONV = OFF_S_SSM + SZ_SSSM, OUT_TOTAL = OFF_S_CONV + SZ_SCONV;
static_assert(OUT_TOTAL == 165085184, "output size");

constexpr size_t MiB = 1u << 20;
constexpr size_t WS_CTL = 0, CTL_ZERO_BYTES = 1 * MiB;
constexpr size_t WS_ROPE = 1 * MiB;
constexpr size_t WS_W = 2 * MiB;
constexpr size_t W_IN_B = (size_t)INP * DM * 2, W_OUT_B = (size_t)DM * DM * 2, W_UP_B = (size_t)DFF * DM * 2, W_DN_B = (size_t)DM * DFF * 2, W_LAYER_B = W_IN_B + W_OUT_B + W_UP_B + W_DN_B;
static_assert(W_LAYER_B == 101 * MiB, "weights per layer");
constexpr size_t WS_X = WS_W + DEPTH * W_LAYER_B;
constexpr size_t WS_H = WS_X + (size_t)NTOK * DM * 4;
constexpr size_t WS_MIX = WS_H + (size_t)NTOK * DM * 2;
constexpr size_t WS_PU = WS_MIX + (size_t)NTOK * DM * 2;
constexpr size_t WS_XBC = WS_PU + (size_t)NTOK * DFF * 2;
constexpr size_t WS_G = WS_XBC + (size_t)NTOK * 2048 * 2;
constexpr size_t WS_DTS = WS_G + (size_t)NTOK * 1024 * 4;
constexpr size_t WS_CAK = WS_DTS + 2 * MiB;
constexpr size_t WS_CAV = WS_CAK + (size_t)DBAT * PAST * 512 * 2;
constexpr size_t WS_CBK = WS_CAV + (size_t)DBAT * PAST * 512 * 2;
constexpr size_t WS_CBV = WS_CBK + (size_t)DBAT * BWIN * 512 * 2;
constexpr size_t WS_CKI = WS_CBV + (size_t)DBAT * BWIN * 512 * 2;
constexpr size_t WS_SC = WS_CKI + (size_t)DBAT * PAST * 64 * 2;
constexpr size_t WS_SSQ1 = WS_SC + (size_t)256 * 64 * 2048 * 4, WS_SSQ2 = WS_SSQ1 + 3 * MiB;
constexpr size_t WS_END = WS_SSQ2 + 3 * MiB;
static_assert(WS_END == 1362 * MiB, "ws map");
constexpr int CW_BAR = 4096;
constexpr int CW_Q = 16384;

constexpr int RING_BYTES = 155648, LDSCTL_OFF = RING_BYTES, LDS_RSTD = LDSCTL_OFF + 1024, LDS_BYTES = 157696;
constexpr int ATT_SEL = 0;
constexpr int ATT_K = 16384, KSTR = 1040, ATT_V = ATT_K + 2 * 32 * KSTR, VSTR = 1088, ATT_END = ATT_V + 2 * 32 * VSTR;
constexpr int CSTR = 272, XSTR = 144, MSTR = 144, HSTR = 272;
constexpr int SSD_CS = 0, SSD_BS = SSD_CS + 64 * CSTR, SSD_XD = SSD_BS + 64 * CSTR, SSD_XDW = SSD_XD + 64 * XSTR, SSD_MS = SSD_XDW + 64 * XSTR,
              SSD_HS = SSD_MS + 64 * MSTR, SSD_VEC = SSD_HS + 2 * 64 * HSTR, SSD_Y = SSD_VEC + 1024, YSTR = 272, SSD_END = SSD_Y + 64 * YSTR;
static_assert(ATT_END <= RING_BYTES && SSD_END <= RING_BYTES, "phase scratch fits the ring region");

DI float bf2f(bf16 v) { return __uint_as_float(((unsigned)v) << 16); }
DI unsigned pk2(float lo, float hi) { return pg8::cvt_pk_bf16(lo, hi); }
DI bf16 f2bf(float f) { return (bf16)(pk2(f, 0.f) & 0xffffu); }
DI float wave_sum(float v) {
#pragma unroll
    for (int o = 1; o < 64; o <<= 1) v += __shfl_xor(v, o);
    return v;
}
DI f32x16 mfma32(bf16x8 a, bf16x8 b, f32x16 c) { return __builtin_amdgcn_mfma_f32_32x32x16_bf16(a, b, c, 0, 0, 0); }
DI int crow(int i, int hh) { return (i & 3) + 8 * (i >> 2) + 4 * hh; }
DI s16x4 tr_read(LAS unsigned char* p) { return __builtin_bit_cast(s16x4, __builtin_amdgcn_ds_read_tr16_b64_v4i16((LAS v4i16_t*)p)); }
DI bf16x8 trfrag(LAS unsigned char* tile, int stride, int k0, int c0, int lane) {
    const int i16 = lane & 15, qq = i16 >> 2, p = i16 & 3, g2 = (lane >> 4) & 1, hh = lane >> 5;
    LAS unsigned char* a = tile + (k0 + 8 * hh + qq) * stride + (c0 + 16 * g2 + 4 * p) * 2;
    const s16x4 lo = tr_read(a), hi = tr_read(a + 4 * stride);
    return __builtin_shufflevector(lo, hi, 0, 1, 2, 3, 4, 5, 6, 7);
}
DI void unpack8(u32x4 v, float (&f)[8]) {
#pragma unroll
    for (int i = 0; i < 4; ++i) { f[2 * i] = __uint_as_float(v[i] << 16); f[2 * i + 1] = __uint_as_float(v[i] & 0xffff0000u); }
}
DI u32x4 pack8(const float (&f)[8]) { u32x4 o; o.x = pk2(f[0], f[1]); o.y = pk2(f[2], f[3]); o.z = pk2(f[4], f[5]); o.w = pk2(f[6], f[7]); return o; }

#define XB_TMO      128
#define XB_XCNT(j)  (256  + 64 * (j))
#define XB_XSUB(j)  (1280 + 64 * (j))
#define XB_XGEN(j)  (2304 + 64 * (j))
#define XB_TOP      3328
#define XB_TOPGEN   3392
#define XCD_BAR_WORDS 3456
#define XB_SPIN_CAP (1u << 20)
DI unsigned xb_ld(unsigned* p)              { return __hip_atomic_load(p, __ATOMIC_RELAXED, __HIP_MEMORY_SCOPE_AGENT); }
DI unsigned xb_add(unsigned* p, unsigned v) { return __hip_atomic_fetch_add(p, v, __ATOMIC_RELAXED, __HIP_MEMORY_SCOPE_AGENT); }
DI unsigned xb_xcc_id() { return (unsigned)__builtin_amdgcn_s_getreg((3 << 11) | 20) & 0xFu; }
#define XB_SPIN(cond, bar) do { unsigned _sp = 0; while (cond) { __builtin_amdgcn_s_sleep(1); \
    if ((++_sp & 255u) == 0u) { if (xb_ld(&(bar)[XB_TMO])) break; if (_sp > XB_SPIN_CAP) { atomicAdd(&(bar)[XB_TMO], 1u); break; } } } } while (0)
struct XcdBarrier { unsigned* bar; unsigned x; volatile LAS unsigned* st; };
DI XcdBarrier xcd_barrier_post(unsigned* bar, volatile LAS unsigned* st) {
    XcdBarrier b; b.bar = bar; b.x = xb_xcc_id(); b.st = st;
    if (threadIdx.x == 0) (void)xb_add(&bar[XB_XCNT(b.x)], 1u);
    return b;
}
DI void xcd_barrier_complete(unsigned* bar, unsigned x, unsigned& nloc, unsigned& nx) {
    const unsigned G = gridDim.x * gridDim.y * gridDim.z;
    unsigned sum, cnt, mine, sp = 0u;
    for (;;) {
        sum = 0u; cnt = 0u; mine = 0u;
#pragma unroll
        for (unsigned j = 0; j < 16; ++j) { const unsigned c = xb_ld(&bar[XB_XCNT(j)]); sum += c; cnt += (c > 0u) ? 1u : 0u; mine = (j == x) ? c : mine; }
        if (sum == G) break;
        __builtin_amdgcn_s_sleep(1);
        if ((++sp & 255u) == 0u) { if (xb_ld(&bar[XB_TMO])) break; if (sp > XB_SPIN_CAP) { atomicAdd(&bar[XB_TMO], 1u); break; } }
    }
    nloc = mine > 0u ? mine : 1u; nx = cnt > 0u ? cnt : 1u;
}
DI void xcd_barrier(const XcdBarrier& b) {
    asm volatile("s_waitcnt vmcnt(0)" ::: "memory");
    __syncthreads();
    if (threadIdx.x == 0) {
        unsigned* bar = b.bar;
        __builtin_amdgcn_s_waitcnt(0);
        unsigned nloc = b.st[0], nx = b.st[1];
        if (nloc == 0u) { xcd_barrier_complete(bar, b.x, nloc, nx); b.st[0] = nloc; b.st[1] = nx; }
        const unsigned old = xb_add(&bar[XB_XSUB(b.x)], 1u);
        const unsigned gen = old / nloc;
        if (old + 1u == (gen + 1u) * nloc) {
            __builtin_amdgcn_fence(__ATOMIC_RELEASE, "agent");
            asm volatile("s_waitcnt vmcnt(0)" ::: "memory");
            const unsigned og = xb_add(&bar[XB_TOP], 1u);
            const unsigned tg = og / nx;
            if (og + 1u == (tg + 1u) * nx) xb_add(&bar[XB_TOPGEN], 1u);
            else XB_SPIN(xb_ld(&bar[XB_TOPGEN]) == tg, bar);
            __builtin_amdgcn_fence(__ATOMIC_ACQUIRE, "agent");
            xb_add(&bar[XB_XGEN(b.x)], 1u);
            asm volatile("s_waitcnt vmcnt(0)" ::: "memory");
        } else {
            XB_SPIN(xb_ld(&bar[XB_XGEN(b.x)]) == gen, bar);
            __builtin_amdgcn_fence(__ATOMIC_ACQUIRE, "agent");
            asm volatile("s_waitcnt vmcnt(0)" ::: "memory");
        }
    }
    __syncthreads();
}

struct Args { const float* in[23]; float* out; unsigned char* ws; int ph_lo, ph_hi; };
static_assert(sizeof(Args) == 23 * 8 + 8 + 8 + 8, "Args has no padding");
struct Ctx {
    LAS unsigned char* lds;
    unsigned* ctl;
    int tid, lane, wave, G, bid;
    float* out;
    unsigned char* ws;
};
DI bf16* ws_bf(const Ctx& C, size_t off) { return (bf16*)(C.ws + off); }
DI float* ws_f(const Ctx& C, size_t off) { return (float*)(C.ws + off); }
DI bf16* w_in_t(const Ctx& C, int l)  { return (bf16*)(C.ws + WS_W + (size_t)l * W_LAYER_B); }
DI bf16* w_out_t(const Ctx& C, int l) { return (bf16*)(C.ws + WS_W + (size_t)l * W_LAYER_B + W_IN_B); }
DI bf16* w_up_t(const Ctx& C, int l)  { return (bf16*)(C.ws + WS_W + (size_t)l * W_LAYER_B + W_IN_B + W_OUT_B); }
DI bf16* w_dn_t(const Ctx& C, int l)  { return (bf16*)(C.ws + WS_W + (size_t)l * W_LAYER_B + W_IN_B + W_OUT_B + W_UP_B); }

DI int q_next(const Ctx& C, unsigned* head) {
    volatile LAS int* slot = (volatile LAS int*)(C.lds + LDSCTL_OFF + 64);
    __syncthreads();
    if (C.tid == 0) *slot = (int)__hip_atomic_fetch_add(head, 1u, __ATOMIC_RELAXED, __HIP_MEMORY_SCOPE_AGENT);
    __syncthreads();
    return *slot;
}

DI void p0_transpose_item(const float* W, int K, int N, bf16* WT, LAS float* scr, int item, int lane, const float* kscale = nullptr) {
    const int nblk = N / 32, kb = item / nblk, nb = item % nblk, k0 = 64 * kb, n0 = 32 * nb;
#pragma unroll 8
    for (int i = 0; i < 32; ++i) { const int kk = 2 * i + (lane >> 5); const float sc = kscale ? kscale[k0 + kk] : 1.0f; scr[kk * 33 + (lane & 31)] = W[(size_t)(k0 + kk) * N + n0 + (lane & 31)] * sc; }
    asm volatile("s_waitcnt lgkmcnt(0)" ::: "memory");
    const int c = lane & 7;
#pragma unroll
    for (int j = 0; j < 4; ++j) { const int n = (lane >> 3) + 8 * j; const LAS float* s = scr + (8 * c) * 33 + n;
        u32x4 o; o.x = pk2(s[0 * 33], s[1 * 33]); o.y = pk2(s[2 * 33], s[3 * 33]); o.z = pk2(s[4 * 33], s[5 * 33]); o.w = pk2(s[6 * 33], s[7 * 33]);
        *(u32x4*)(WT + (size_t)(n0 + n) * K + k0 + 8 * c) = o; }
    asm volatile("s_waitcnt lgkmcnt(0)" ::: "memory");
}
DI void row_ssq_slots(float ss, float* slots, int lane) { if (lane < 32) slots[lane] = lane == 0 ? ss : 0.f; }
DI void p0_row(const float* src, bf16* xrow, float* slots, int lane) {
    float ss = 0.f;
#pragma unroll
    for (int j = 0; j < 4; ++j) { const f32x4 a = ((const f32x4*)src)[2 * (lane + 64 * j)], b = ((const f32x4*)src)[2 * (lane + 64 * j) + 1];
        ss += (a.x * a.x + a.y * a.y) + (a.z * a.z + a.w * a.w) + (b.x * b.x + b.y * b.y) + (b.z * b.z + b.w * b.w);
        u32x4 o; o.x = pk2(a.x, a.y); o.y = pk2(a.z, a.w); o.z = pk2(b.x, b.y); o.w = pk2(b.z, b.w); ((u32x4*)xrow)[lane + 64 * j] = o; }
    row_ssq_slots(wave_sum(ss), slots, lane);
}
DI void res_row(bf16* xrow, const float* part, size_t pstride, int mode, float* slots, const float* w, float* outf, int lane) {
    float v[4][8]; float ss = 0.f;
#pragma unroll
    for (int j = 0; j < 4; ++j) { unpack8(((const u32x4*)xrow)[lane + 64 * j], v[j]);
        if (part) {
#pragma unroll
            for (int k = 0; k < 4; ++k) { const float* pp = part + k * pstride + 8 * (lane + 64 * j); const f32x4 a = *(const f32x4*)pp, b = *(const f32x4*)(pp + 4);
                v[j][0] += a.x; v[j][1] += a.y; v[j][2] += a.z; v[j][3] += a.w; v[j][4] += b.x; v[j][5] += b.y; v[j][6] += b.z; v[j][7] += b.w; } }
#pragma unroll
        for (int k = 0; k < 8; ++k) ss += v[j][k] * v[j][k]; }
    ss = wave_sum(ss);
    if (mode == 0) {
#pragma unroll
        for (int j = 0; j < 4; ++j) ((u32x4*)xrow)[lane + 64 * j] = pack8(v[j]);
        row_ssq_slots(ss, slots, lane);
    } else {
        const float rs = 1.0f / sqrtf(ss * (1.0f / DM) + EPS);
#pragma unroll
        for (int j = 0; j < 4; ++j) { const float* wp = w + 8 * (lane + 64 * j); const f32x4 w0 = *(const f32x4*)wp, w1 = *(const f32x4*)(wp + 4); float* op = outf + 8 * (lane + 64 * j);
            *(f32x4*)op = (f32x4){v[j][0] * rs * w0.x, v[j][1] * rs * w0.y, v[j][2] * rs * w0.z, v[j][3] * rs * w0.w};
            *(f32x4*)(op + 4) = (f32x4){v[j][4] * rs * w1.x, v[j][5] * rs * w1.y, v[j][6] * rs * w1.z, v[j][7] * rs * w1.w}; }
    }
}
DI void sincos_tab(float ang, float& c, float& s) {
    const double a = (double)ang; const double kq = rint(a * 0.63661977236758134308); const double x = a - kq * 1.57079632679489661923; const double x2 = x * x;
    const double sn = x * (1.0 + x2 * (-1.0 / 6 + x2 * (1.0 / 120 + x2 * (-1.0 / 5040 + x2 * (1.0 / 362880 + x2 * (-1.0 / 39916800 + x2 * (1.0 / 6227020800.0)))))));
    const double cn = 1.0 + x2 * (-0.5 + x2 * (1.0 / 24 + x2 * (-1.0 / 720 + x2 * (1.0 / 40320 + x2 * (-1.0 / 3628800 + x2 * (1.0 / 479001600 + x2 * (-1.0 / 87178291200.0)))))));
    const int q = ((int)kq) & 3;
    const double cc = (q == 0) ? cn : (q == 1) ? -sn : (q == 2) ? -cn : sn;
    const double sc = (q == 0) ? sn : (q == 1) ? cn : (q == 2) ? -sn : -cn;
    c = (float)cc; s = (float)sc;
}
DI void p0_prologue(const Ctx& C, const Args& A) {
    LAS float* scr = (LAS float*)(C.lds + C.wave * 16384);
    const int gw = C.bid * NWAVES + C.wave, NGW = C.G * NWAVES;
    constexpr int I_IN = (DM / 64) * (INC / 32), I_OUT = (DM / 64) * (DM / 32), I_UP = (DM / 64) * (DFF / 32), I_DN = (DFF / 64) * (DM / 32), I_L = I_IN + I_OUT + I_UP + I_DN;
    for (int it = gw; it < DEPTH * I_L; it += NGW) {
        const int l = it / I_L; int r = it % I_L;
        if (r < I_IN) { p0_transpose_item(A.in[10] + (size_t)l * DM * INC, DM, INC, w_in_t(C, l), scr, r, C.lane, A.in[9] + (size_t)l * DM); continue; } r -= I_IN;
        if (r < I_OUT) { p0_transpose_item(A.in[11] + (size_t)l * DM * DM, DM, DM, w_out_t(C, l), scr, r, C.lane); continue; } r -= I_OUT;
        if (r < I_UP) { p0_transpose_item(A.in[20] + (size_t)l * DM * DFF, DM, DFF, w_up_t(C, l), scr, r, C.lane, A.in[19] + (size_t)l * DM); continue; } r -= I_UP;
        p0_transpose_item(A.in[21] + (size_t)l * DFF * DM, DFF, DM, w_dn_t(C, l), scr, r, C.lane);
    }
    { const int gt = C.bid * NTHR + C.tid, NGT = C.G * NTHR; constexpr int CH_L = (INP - INC) * DM / 8;
      for (int i = gt; i < DEPTH * CH_L; i += NGT) { const int l = i / CH_L, c = i % CH_L; ((u32x4*)(w_in_t(C, l) + (size_t)INC * DM))[c] = (u32x4){0u, 0u, 0u, 0u}; }
      float* ra = ws_f(C, WS_ROPE); float* ri = ra + 2048 * 16 * 2;
      for (int i = gt; i < 2048 * 24; i += NGT) { const int pos = i / 24, k = i % 24; const bool isa = k < 16; const int fi = isa ? k : k - 16;
          const double ex = isa ? (double)fi / 16.0 : (double)fi / 8.0; const float inv = (float)exp2(-ex * 18.931568569324174  );
          const float ang = (float)pos * inv; float c, s; sincos_tab(ang, c, s);
          float* dst = isa ? ra + (pos * 16 + fi) * 2 : ri + (pos * 8 + fi) * 2; dst[0] = c; dst[1] = s; } }
    for (int m = gw; m < NTOK; m += NGW) { const float* src = m < NTP ? A.in[0] + (size_t)m * DM : A.in[1] + (size_t)(m - NTP) * DM;
        p0_row(src, ws_bf(C, WS_X) + (size_t)m * DM, ws_f(C, WS_SSQ1) + (size_t)m * 32, C.lane); }
}

struct M0Row { unsigned ra1, ra2, ri1, ri2, rk1, rk2; u32x4 cak, cav, cik, cbk, cbv, xb[4]; f32x4 tA, tI; bf16 dt; };
DI void m0_decode(int r, bool& smp, int& b, int& t, int& pos) { smp = r >= NTP; if (!smp) { b = r >> 11; t = r & 2047; pos = t; } else { const int rr = r - NTP; b = rr >> 6; t = rr & 63; pos = PAST + t; } }
DI void m0_load(const Ctx& C, int r, int lane, M0Row& R) {
    const bf16* P = ws_bf(C, WS_PU) + (size_t)r * INP;
    bool smp; int b, t, pos; m0_decode(r, smp, b, t, pos);
    { const int h8 = lane >> 3, j = lane & 7; const bf16* p = P + (h8 < 4 ? C_AQ + h8 * 128 : C_AK + (h8 - 4) * 128) + 2 * j; R.ra1 = *(const unsigned*)p; R.ra2 = *(const unsigned*)(p + 16); }
    { const int h16 = lane >> 2, j = lane & 3; const bf16* p = P + C_IQ + h16 * 64 + 2 * j; R.ri1 = *(const unsigned*)p; R.ri2 = *(const unsigned*)(p + 8); }
    if (lane < 4) { const bf16* p = P + C_IK + 2 * lane; R.rk1 = *(const unsigned*)p; R.rk2 = *(const unsigned*)(p + 8); }
    if (lane < 48) R.cak = *(const u32x4*)(P + C_AK + (lane / 12) * 128 + 32 + (lane % 12) * 8);
    R.cav = *(const u32x4*)(P + C_AV + lane * 8);
    if (lane >= 8 && lane < 14) R.cik = *(const u32x4*)(P + C_IK + 16 + (lane - 8) * 8);
    if (smp || t >= SEQ - BWIN) { R.cbk = *(const u32x4*)(P + C_BK + lane * 8); R.cbv = *(const u32x4*)(P + C_BV + lane * 8); }
    if (lane < 16) R.dt = P[C_DT + lane];
#pragma unroll
    for (int it = 0; it < 4; ++it) R.xb[it] = *(const u32x4*)(P + C_XBC + (lane + 64 * it) * 8);
    R.tA = *(const f32x4*)(ws_f(C, WS_ROPE) + (size_t)pos * 32 + 4 * (lane & 7));
    R.tI = *(const f32x4*)(ws_f(C, WS_ROPE) + 2048 * 32 + (size_t)pos * 16 + 4 * (lane & 3));
}
DI void rope2(unsigned a, unsigned bq, f32x4 t, float (&y1)[2], float (&y2)[2]) {
    const float a0 = __uint_as_float(a << 16), a1 = __uint_as_float(a & 0xffff0000u), b0 = __uint_as_float(bq << 16), b1 = __uint_as_float(bq & 0xffff0000u);
    y1[0] = a0 * t.x - b0 * t.y; y2[0] = b0 * t.x + a0 * t.y; y1[1] = a1 * t.z - b1 * t.w; y2[1] = b1 * t.z + a1 * t.w;
}
DI void st8f(float* dst, u32x4 v) { float f[8]; unpack8(v, f); ((f32x4*)dst)[0] = (f32x4){f[0], f[1], f[2], f[3]}; ((f32x4*)dst)[1] = (f32x4){f[4], f[5], f[6], f[7]}; }
DI void m0_window(const Ctx& C, const Args& A, int l, int r, int lane, u32x4 (&wnd)[3][4]) {
    bool smp; int b, t, pos; m0_decode(r, smp, b, t, pos);
#pragma unroll
    for (int k = 1; k <= 3; ++k) { const int tt = t - k;
#pragma unroll
        for (int it = 0; it < 4; ++it) { const int ch = (lane + 64 * it) * 8; u32x4 v = (u32x4){0u, 0u, 0u, 0u};
            if (tt >= 0) v = *(const u32x4*)(ws_bf(C, WS_PU) + (size_t)(r - k) * INP + C_XBC + ch);
            else if (smp) { const float* sp = A.in[8] + ((size_t)(l * DBAT + b) * 3 + (3 + tt)) * 2048 + ch; const f32x4 s0 = *(const f32x4*)sp, s1 = *(const f32x4*)(sp + 4);
                v.x = pk2(s0.x, s0.y); v.y = pk2(s0.z, s0.w); v.z = pk2(s1.x, s1.y); v.w = pk2(s1.z, s1.w); }
            wnd[3 - k][it] = v; } }
}
DI void m0_process(const Ctx& C, const Args& A, int l, int r, int lane, const M0Row& R, u32x4 (&wnd)[3][4], const LAS float* cwL, const LAS float* cbL) {
    bf16* P = ws_bf(C, WS_PU) + (size_t)r * INP;
    bool smp; int b, t, pos; m0_decode(r, smp, b, t, pos);
    float* out = C.out;
    float* o_ak = smp ? out + OFF_S_AK + ((size_t)(l * DBAT + b) * DSEQ + t) * 512 : out + OFF_P_AK + ((size_t)(l * NB + b) * SEQ + t) * 512;
    float* o_av = smp ? out + OFF_S_AV + ((size_t)(l * DBAT + b) * DSEQ + t) * 512 : out + OFF_P_AV + ((size_t)(l * NB + b) * SEQ + t) * 512;
    float* o_ki = smp ? out + OFF_S_KI + ((size_t)(l * DBAT + b) * DSEQ + t) * 64 : out + OFF_P_KI + ((size_t)(l * NB + b) * SEQ + t) * 64;
    float y1[2], y2[2];
    { const int h8 = lane >> 3, j = lane & 7; rope2(R.ra1, R.ra2, R.tA, y1, y2);
      bf16* p = P + (h8 < 4 ? C_AQ + h8 * 128 : C_AK + (h8 - 4) * 128) + 2 * j; *(unsigned*)p = pk2(y1[0], y1[1]); *(unsigned*)(p + 16) = pk2(y2[0], y2[1]);
      if (h8 >= 4) { float* o = o_ak + (h8 - 4) * 128 + 2 * j; *(f32x2_t_*)o = (f32x2_t_){y1[0], y1[1]}; *(f32x2_t_*)(o + 16) = (f32x2_t_){y2[0], y2[1]}; } }
    { const int h16 = lane >> 2, j = lane & 3; rope2(R.ri1, R.ri2, R.tI, y1, y2);
      bf16* p = P + C_IQ + h16 * 64 + 2 * j; *(unsigned*)p = pk2(y1[0], y1[1]); *(unsigned*)(p + 8) = pk2(y2[0], y2[1]); }
    if (lane < 4) { rope2(R.rk1, R.rk2, R.tI, y1, y2);
      bf16* p = P + C_IK + 2 * lane; *(unsigned*)p = pk2(y1[0], y1[1]); *(unsigned*)(p + 8) = pk2(y2[0], y2[1]);
      float* o = o_ki + 2 * lane; *(f32x2_t_*)o = (f32x2_t_){y1[0], y1[1]}; *(f32x2_t_*)(o + 8) = (f32x2_t_){y2[0], y2[1]}; }
    if (lane < 48) st8f(o_ak + (lane / 12) * 128 + 32 + (lane % 12) * 8, R.cak);
    st8f(o_av + lane * 8, R.cav);
    if (lane >= 8 && lane < 14) st8f(o_ki + 16 + (lane - 8) * 8, R.cik);
    if (smp || t >= SEQ - BWIN) {
        const size_t ro = smp ? ((size_t)(l * DBAT + b) * DSEQ + t) * 512 : ((size_t)(l * NB + b) * BWIN + (t - (SEQ - BWIN))) * 512;
        st8f(out + (smp ? OFF_S_BK : OFF_P_BK) + ro + lane * 8, R.cbk); st8f(out + (smp ? OFF_S_BV : OFF_P_BV) + ro + lane * 8, R.cbv);
    }
    if (lane < 16) { const float x = bf2f(R.dt) + A.in[15][l * 16 + lane]; ws_f(C, WS_DTS)[(size_t)r * 16 + lane] = x > 20.f ? x : log1pf(__expf(x)); }
    const int stt = smp ? DSEQ - 3 : SEQ - 3;
    float* o_conv = (t >= stt) ? (smp ? out + OFF_S_CONV + ((size_t)(l * DBAT + b) * 3 + (t - stt)) * 2048 : out + OFF_P_CONV + ((size_t)(l * NB + b) * 3 + (t - stt)) * 2048) : nullptr;
    bf16* xo = ws_bf(C, WS_XBC) + (size_t)r * 2048;
#pragma unroll
    for (int it = 0; it < 4; ++it) { const int ch = (lane + 64 * it) * 8;
        float acc[8], x[8];
        { const f32x4 b0 = *(const LAS f32x4*)(cbL + ch), b1 = *(const LAS f32x4*)(cbL + ch + 4); acc[0] = b0.x; acc[1] = b0.y; acc[2] = b0.z; acc[3] = b0.w; acc[4] = b1.x; acc[5] = b1.y; acc[6] = b1.z; acc[7] = b1.w; }
#pragma unroll
        for (int j = 0; j < 4; ++j) { unpack8(j < 3 ? wnd[j][it] : R.xb[it], x);
            const f32x4 w0 = *(const LAS f32x4*)(cwL + j * 2048 + ch), w1 = *(const LAS f32x4*)(cwL + j * 2048 + ch + 4);
            acc[0] += x[0] * w0.x; acc[1] += x[1] * w0.y; acc[2] += x[2] * w0.z; acc[3] += x[3] * w0.w; acc[4] += x[4] * w1.x; acc[5] += x[5] * w1.y; acc[6] += x[6] * w1.z; acc[7] += x[7] * w1.w; }
        if (o_conv) { ((f32x4*)(o_conv + ch))[0] = (f32x4){x[0], x[1], x[2], x[3]}; ((f32x4*)(o_conv + ch))[1] = (f32x4){x[4], x[5], x[6], x[7]}; }
#pragma unroll
        for (int k = 0; k < 8; ++k) acc[k] = acc[k] / (1.f + __expf(-acc[k]));
        *(u32x4*)(xo + ch) = pack8(acc);
        wnd[0][it] = wnd[1][it]; wnd[1][it] = wnd[2][it]; wnd[2][it] = R.xb[it];
        asm volatile("" ::: "memory");
    }
}
DI void cvt_f4(const float* src, bf16* dst, size_t n4, size_t gt, size_t ngt) {
    size_t i = gt;
    for (; i + 3 * ngt < n4; i += 4 * ngt) { f32x4 v[4];
#pragma unroll
        for (int k = 0; k < 4; ++k) v[k] = ((const f32x4*)src)[i + k * ngt];
#pragma unroll
        for (int k = 0; k < 4; ++k) { u32x2 o; o.x = pk2(v[k].x, v[k].y); o.y = pk2(v[k].z, v[k].w); ((u32x2*)dst)[i + k * ngt] = o; } }
    for (; i < n4; i += ngt) { const f32x4 v = ((const f32x4*)src)[i]; u32x2 o; o.x = pk2(v.x, v.y); o.y = pk2(v.z, v.w); ((u32x2*)dst)[i] = o; }
}
DI void m0_phase(const Ctx& C, const Args& A, int l) {
    LAS float* cwL = (LAS float*)C.lds; LAS float* cbL = cwL + 4 * 2048;
    { const float* cw = A.in[13] + (size_t)l * 4 * 2048; const float* cb = A.in[14] + (size_t)l * 2048;
      for (int i = C.tid; i < 2048; i += NTHR) ((LAS f32x4*)cwL)[i] = ((const f32x4*)cw)[i];
      for (int i = C.tid; i < 512; i += NTHR) ((LAS f32x4*)cbL)[i] = ((const f32x4*)cb)[i]; }
    __syncthreads();
    const int gw = C.bid * NWAVES + C.wave, NGW = C.G * NWAVES, per = (NTOK + NGW - 1) / NGW;
    const int r0 = gw * per, r1 = (r0 + per < NTOK) ? r0 + per : NTOK;
    if (r0 < r1) {
        u32x4 wnd[3][4]; M0Row cur, nxt;
        m0_load(C, r0, C.lane, cur); m0_window(C, A, l, r0, C.lane, wnd);
#pragma unroll 1
        for (int r = r0; r < r1; ++r) {
            if (r + 1 < r1) m0_load(C, r + 1, C.lane, nxt);
            if (r != r0) { bool smp; int b, t, pos; m0_decode(r, smp, b, t, pos); if (t == 0) m0_window(C, A, l, r, C.lane, wnd); }
            m0_process(C, A, l, r, C.lane, cur, wnd, cwL, cbL);
            cur = nxt;
        }
    }
    const size_t gt = (size_t)C.bid * NTHR + C.tid, ngt = (size_t)C.G * NTHR;
    cvt_f4(A.in[2] + (size_t)l * DBAT * PAST * 512, ws_bf(C, WS_CAK), (size_t)DBAT * PAST * 512 / 4, gt, ngt);
    cvt_f4(A.in[3] + (size_t)l * DBAT * PAST * 512, ws_bf(C, WS_CAV), (size_t)DBAT * PAST * 512 / 4, gt, ngt);
    cvt_f4(A.in[4] + (size_t)l * DBAT * PAST * 64, ws_bf(C, WS_CKI), (size_t)DBAT * PAST * 64 / 4, gt, ngt);
    cvt_f4(A.in[5] + (size_t)l * DBAT * BWIN * 512, ws_bf(C, WS_CBK), (size_t)DBAT * BWIN * 512 / 4, gt, ngt);
    cvt_f4(A.in[6] + (size_t)l * DBAT * BWIN * 512, ws_bf(C, WS_CBV), (size_t)DBAT * BWIN * 512 / 4, gt, ngt);
}

struct KVSrc { const bf16* k0; const bf16* v0; int s0; int n0; const bf16* k1; const bf16* v1; int s1; };
template <int MODE>
DI void attn_unit(const Ctx& C, const bf16* Qp, int qstride, const KVSrc& S, int tile_lo, int tile_hi, bf16* Op, int ostride) {
    int tid = C.tid, lane = C.lane; asm volatile("" : "+v"(tid), "+v"(lane));
    const int w = C.wave, r = lane & 31, hh = lane >> 5;
    const int head = w >> 1, q = (w & 1) * 32 + r;
    LAS unsigned char* Ks = C.lds + ATT_K; LAS unsigned char* Vs = C.lds + ATT_V;
    bf16x8 qf[8];
    { const bf16* qrow = Qp + (size_t)q * qstride + head * 128 + 8 * hh;
#pragma unroll
      for (int ks = 0; ks < 8; ++ks) qf[ks] = *(const bf16x8*)(qrow + 16 * ks); }
    f32x16 o[4];
#pragma unroll
    for (int d = 0; d < 4; ++d)
#pragma unroll
        for (int i = 0; i < 16; ++i) o[d][i] = 0.f;
    float m = -1e30f, lsum = 0.f;
    constexpr float SC2 = 0.08838834764831845f * 1.4426950408889634f;
    constexpr float L2E = 1.4426950408889634f;
    u32x4 kr[4], vr[4];
#define ATT_LOAD(tile_) do { _Pragma("unroll") for (int i_ = 0; i_ < 4; ++i_) { const int ci_ = tid + 512 * i_, row_ = ci_ >> 6, ch_ = ci_ & 63, key_ = (tile_) * 32 + row_; \
        const ptrdiff_t off_ = key_ < S.n0 ? (ptrdiff_t)key_ * S.s0 : (ptrdiff_t)(key_ - S.n0) * S.s1; \
        kr[i_] = *(const u32x4*)((key_ < S.n0 ? S.k0 : S.k1) + off_ + ch_ * 8); vr[i_] = *(const u32x4*)((key_ < S.n0 ? S.v0 : S.v1) + off_ + ch_ * 8); } } while (0)
#define ATT_STORE(buf_) do { _Pragma("unroll") for (int i_ = 0; i_ < 4; ++i_) { const int ci_ = tid + 512 * i_, row_ = ci_ >> 6, ch_ = ci_ & 63; \
        *(LAS u32x4*)(Ks + (buf_) * (32 * KSTR) + row_ * KSTR + ch_ * 16) = kr[i_]; *(LAS u32x4*)(Vs + (buf_) * (32 * VSTR) + row_ * VSTR + ch_ * 16) = vr[i_]; } } while (0)
    ATT_LOAD(tile_lo);
    __syncthreads();
    ATT_STORE(0);
    if (tile_lo + 1 < tile_hi) ATT_LOAD(tile_lo + 1);
    __syncthreads();
    const int i16 = lane & 15;
    LAS unsigned char* vbase = Vs + (4 * hh + (i16 >> 2)) * VSTR + (head * 128 + 16 * ((lane >> 4) & 1) + 4 * (i16 & 3)) * 2;
    LAS unsigned char* kbase = Ks + r * KSTR + head * 256 + hh * 16;
    const LAS float* btab = (const LAS float*)(C.lds + ATT_SEL) + head * 257;
    const LAS unsigned* sel = (const LAS unsigned*)(C.lds + ATT_SEL) + q * 64;
#pragma unroll 1
    for (int tile = tile_lo; tile < tile_hi; ++tile) {
        const int cur = (tile - tile_lo) & 1;
        if (tile + 1 < tile_hi) { ATT_STORE(cur ^ 1); if (tile + 2 < tile_hi) ATT_LOAD(tile + 2); }
        f32x16 s;
        if (MODE == 0) {
            const unsigned nwd = ~(sel[tile] >> (4 * hh));
#pragma unroll
            for (int i = 0; i < 16; ++i) { const int mb = ((int)(nwd << (31 - ((i & 3) + 8 * (i >> 2))))) >> 31; s[i] = __int_as_float(mb & (int)0xFF800000); }
        } else {
            if (tile <= 11) { const float bb = btab[256] * (L2E / SC2);
#pragma unroll
                for (int i = 0; i < 16; ++i) s[i] = bb;
            } else {
#pragma unroll
                for (int i = 0; i < 16; ++i) { int rel = BWIN + q - (tile * 32 + crow(i, hh)); rel = rel > 128 ? 128 : rel; s[i] = btab[rel + 128] * (L2E / SC2); }
            }
        }
        { bf16x8 kf[8]; LAS unsigned char* kb = kbase + cur * (32 * KSTR);
#pragma unroll
          for (int ks = 0; ks < 8; ++ks) kf[ks] = *(const LAS bf16x8*)(kb + ks * 32);
#pragma unroll
          for (int ks = 0; ks < 8; ++ks) s = mfma32(kf[ks], qf[ks], s); }
        float mx = s[0];
#pragma unroll
        for (int i = 1; i < 16; ++i) mx = fmaxf(mx, s[i]);
        mx *= SC2;
        if (__any(mx > m + 8.0f)) {
            const auto rr = __builtin_amdgcn_permlane32_swap(__float_as_uint(mx), __float_as_uint(mx), false, false);
            const float mxs = fmaxf(__uint_as_float(rr[0]), __uint_as_float(rr[1]));
            const float mn = (mxs > m + 8.0f) ? mxs : m, alpha = __builtin_amdgcn_exp2f(m - mn);
            lsum *= alpha; m = mn;
#pragma unroll
            for (int d = 0; d < 4; ++d)
#pragma unroll
                for (int i = 0; i < 16; ++i) o[d][i] *= alpha;
        }
#pragma unroll
        for (int i = 0; i < 16; ++i) { s[i] = __builtin_amdgcn_exp2f(__builtin_fmaf(s[i], SC2, -m)); lsum += s[i]; }
        bf16x8 pf[2];
#pragma unroll
        for (int s2 = 0; s2 < 2; ++s2) { u32x4 pk; pk.x = pk2(s[8 * s2], s[8 * s2 + 1]); pk.y = pk2(s[8 * s2 + 2], s[8 * s2 + 3]); pk.z = pk2(s[8 * s2 + 4], s[8 * s2 + 5]); pk.w = pk2(s[8 * s2 + 6], s[8 * s2 + 7]);
            pf[s2] = __builtin_bit_cast(bf16x8, pk); }
        LAS unsigned char* vb = vbase + cur * (32 * VSTR);
#pragma unroll
        for (int dh = 0; dh < 2; ++dh) {
            s16x4 lo[2][2], hi[2][2];
#pragma unroll
            for (int d2 = 0; d2 < 2; ++d2)
#pragma unroll
                for (int s2 = 0; s2 < 2; ++s2) { lo[d2][s2] = tr_read(vb + (16 * s2) * VSTR + (2 * dh + d2) * 64); hi[d2][s2] = tr_read(vb + (16 * s2 + 8) * VSTR + (2 * dh + d2) * 64); }
#pragma unroll
            for (int d2 = 0; d2 < 2; ++d2)
#pragma unroll
                for (int s2 = 0; s2 < 2; ++s2) { const bf16x8 vt = __builtin_shufflevector(lo[d2][s2], hi[d2][s2], 0, 1, 2, 3, 4, 5, 6, 7); o[2 * dh + d2] = mfma32(vt, pf[s2], o[2 * dh + d2]); }
        }
        __syncthreads();
    }
#undef ATT_LOAD
#undef ATT_STORE
    { const auto rr = __builtin_amdgcn_permlane32_swap(__float_as_uint(lsum), __float_as_uint(lsum), false, false); lsum = __uint_as_float(rr[0]) + __uint_as_float(rr[1]); }
    const float inv = 1.0f / lsum;
    bf16* orow = Op + (size_t)q * ostride + head * 128 + 4 * hh;
#pragma unroll
    for (int d = 0; d < 4; ++d)
#pragma unroll
        for (int g = 0; g < 4; ++g) { u32x2 p; p.x = pk2(o[d][4 * g] * inv, o[d][4 * g + 1] * inv); p.y = pk2(o[d][4 * g + 2] * inv, o[d][4 * g + 3] * inv);
            *(u32x2*)(orow + 32 * d + 8 * g) = p; }
}

DI unsigned fkey(float f) { const unsigned u = __float_as_uint(f); return (u & 0x80000000u) ? ~u : (u | 0x80000000u); }
template <int NR>
DI void topk_pair(const float* SCq  , LAS unsigned* SELa  , int NT, int r, int hh, int lane) {
    unsigned v[NR];
#pragma unroll
    for (int i = 0; i < NR; ++i) { const float f = (i < NT) ? SCq[i * 32 + r] : -INFINITY; v[i] = fkey(f); }
    unsigned T = 0u;
#pragma unroll 1
    for (int bit = 31; bit >= 8; --bit) {
        const unsigned cand = T | (1u << bit); unsigned cnt = 0u;
#pragma unroll
        for (int i = 0; i < NR; ++i) asm("v_cmp_ge_u32 vcc, %1, %2\n\tv_addc_co_u32 %0, vcc, 0, %0, vcc" : "+v"(cnt) : "v"(v[i]), "v"(cand) : "vcc");
        unsigned t0 = 0u, t1 = 0u;
#pragma unroll
        for (int b = 0; b < 7; ++b) { const unsigned long long mk = __ballot((cnt >> b) & 1u); t0 += (unsigned)__popc((unsigned)mk) << b; t1 += (unsigned)__popc((unsigned)(mk >> 32)) << b; }
        if ((hh ? t1 : t0) >= 256u) T = cand;
    }
#pragma unroll
    for (int i = 0; i < NR; ++i) { unsigned long long mk = __ballot(v[i] >= T); if (i >= NT) mk = 0ull;
        if (lane == 0) { SELa[i] = (unsigned)mk; SELa[64 + i] = (unsigned)(mk >> 32); } }
}
DI void dsa_unit(const Ctx& C, int l, int u) {
    int lane = C.lane; asm volatile("" : "+v"(lane));
    const int w = C.wave, r = lane & 31, hh = lane >> 5;
    const bf16* PROJ = ws_bf(C, WS_PU);
    int qrow0, NT, limit; KVSrc S; const bf16* ik0; const bf16* ik1; int iks0, ikn0;
    if (u < 256) { const int c = 31 - (u >> 3), b = u & 7; qrow0 = b * SEQ + c * 64; NT = 2 * (c + 1); limit = 64 * (c + 1);
        const bf16* base = PROJ + (size_t)(b * SEQ) * INP;
        S.k0 = base + C_AK; S.v0 = base + C_AV; S.s0 = INP; S.n0 = limit; S.k1 = S.k0; S.v1 = S.v0; S.s1 = INP;
        ik0 = base + C_IK; iks0 = INP; ikn0 = limit; ik1 = ik0;
    } else { const int b = u - 256; qrow0 = NTP + b * DSEQ; NT = (PAST + DSEQ) / 32; limit = PAST + DSEQ;
        const bf16* nb = PROJ + (size_t)qrow0 * INP;
        S.k0 = ws_bf(C, WS_CAK) + (size_t)b * PAST * 512; S.v0 = ws_bf(C, WS_CAV) + (size_t)b * PAST * 512; S.s0 = 512; S.n0 = PAST; S.k1 = nb + C_AK; S.v1 = nb + C_AV; S.s1 = INP;
        ik0 = ws_bf(C, WS_CKI) + (size_t)b * PAST * 64; iks0 = 64; ikn0 = PAST; ik1 = nb + C_IK;
    }
    float* SC = ws_f(C, WS_SC) + (size_t)C.bid * 64 * 2048;
    LAS unsigned* SEL = (LAS unsigned*)(C.lds + ATT_SEL);
    if (limit > 256) {
#ifndef REP_IDX
#define REP_IDX 1
#endif
#ifndef REP_TOPK
#define REP_TOPK 1
#endif
#ifndef REP_ATT
#define REP_ATT 1
#endif
#pragma unroll 1
    for (int pass = 0; pass < 2 * REP_IDX; ++pass) {
        bf16x8 af[2][4]; float wt[2][16];
#pragma unroll
        for (int np = 0; np < 2; ++np) { const int pp = (pass & 1) * 2 + np;
            const bf16* ap = PROJ + (size_t)(qrow0 + 8 * w + 2 * pp + (r >> 4)) * INP + C_IQ + (r & 15) * 64 + 8 * hh;
#pragma unroll
            for (int ks = 0; ks < 4; ++ks) af[np][ks] = *(const bf16x8*)(ap + 16 * ks);
#pragma unroll
            for (int i = 0; i < 16; ++i) { const int qi = 8 * w + 2 * pp + (i >> 3), hd = (i & 3) + 8 * ((i >> 2) & 1) + 4 * hh;
                wt[np][i] = bf2f(PROJ[(size_t)(qrow0 + qi) * INP + C_IW + hd]) * (0.25f * 0.125f); } }
        bf16x8 bk[4], bn[4];
#define IDX_LOAD(dst_, tile_) do { const int key_ = (tile_) * 32 + r; const bf16* kp_ = (key_ < ikn0 ? ik0 + (size_t)key_ * iks0 : ik1 + (size_t)(key_ - ikn0) * INP) + 8 * hh; \
            _Pragma("unroll") for (int ks_ = 0; ks_ < 4; ++ks_) dst_[ks_] = *(const bf16x8*)(kp_ + 16 * ks_); } while (0)
        IDX_LOAD(bn, 0);
#pragma unroll 1
        for (int tile = 0; tile < NT; ++tile) {
#pragma unroll
            for (int ks = 0; ks < 4; ++ks) bk[ks] = bn[ks];
            if (tile + 1 < NT) IDX_LOAD(bn, tile + 1);
#pragma unroll
            for (int np = 0; np < 2; ++np) {
                f32x16 acc;
#pragma unroll
                for (int i = 0; i < 16; ++i) acc[i] = 0.f;
#pragma unroll
                for (int ks = 0; ks < 4; ++ks) acc = mfma32(af[np][ks], bk[ks], acc);
                float p0 = 0.f, p1 = 0.f;
#pragma unroll
                for (int i = 0; i < 8; ++i) { p0 += fmaxf(acc[i], 0.f) * wt[np][i]; p1 += fmaxf(acc[8 + i], 0.f) * wt[np][8 + i]; }
                const float t0 = p0 + __shfl_xor(p0, 32), t1 = p1 + __shfl_xor(p1, 32);
                const int ql = 8 * w + 2 * ((pass & 1) * 2 + np) + hh;
                SC[(size_t)ql * 2048 + tile * 32 + r] = hh ? t1 : t0;
            }
        }
    }
#undef IDX_LOAD
    asm volatile("s_waitcnt vmcnt(0)" ::: "memory");
    __builtin_amdgcn_fence(__ATOMIC_ACQUIRE, "agent");
    asm volatile("s_waitcnt vmcnt(0)" ::: "memory");
#pragma unroll 1
    for (int pq = 0; pq < 4 * REP_TOPK; ++pq) { const int pp = pq & 3;
        const float* SCq = SC + (size_t)(8 * w + 2 * pp + hh) * 2048; LAS unsigned* SELa = SEL + (8 * w + 2 * pp) * 64;
        if (NT <= 16) topk_pair<16>(SCq, SELa, NT, r, hh, lane);
        else if (NT <= 32) topk_pair<32>(SCq, SELa, NT, r, hh, lane);
        else if (NT <= 48) topk_pair<48>(SCq, SELa, NT, r, hh, lane);
        else topk_pair<64>(SCq, SELa, NT, r, hh, lane);
    }
    } else {
        for (int i = lane; i < 8 * 64; i += 64) SEL[8 * w * 64 + i] = ((i & 63) < NT) ? 0xffffffffu : 0u;
    }
    __syncthreads();
#pragma unroll 1
    for (int rep = 0; rep < REP_ATT; ++rep)
    attn_unit<0>(C, PROJ + (size_t)qrow0 * INP + C_AQ, INP, S, 0, NT, ws_bf(C, WS_MIX) + (size_t)qrow0 * DM, DM);
}

DI void band_unit(const Ctx& C, const Args& A, int l, int u) {
    const bf16* PROJ = ws_bf(C, WS_PU);
    int qrow0, tlo; KVSrc S;
    if (u < 256) { const int c = 31 - (u >> 3), b = u & 7; qrow0 = b * SEQ + c * 64; tlo = c < 8 ? (8 - c) * 2 : 0;
        const bf16* base = PROJ + ((ptrdiff_t)b * SEQ + c * 64 - BWIN) * INP;
        S.k0 = base + C_BK; S.v0 = base + C_BV; S.s0 = INP; S.n0 = BWIN + 64; S.k1 = S.k0; S.v1 = S.v0; S.s1 = INP;
    } else { const int b = u - 256; qrow0 = NTP + b * DSEQ; tlo = 0;
        const bf16* nb = PROJ + (size_t)qrow0 * INP;
        S.k0 = ws_bf(C, WS_CBK) + (size_t)b * BWIN * 512; S.v0 = ws_bf(C, WS_CBV) + (size_t)b * BWIN * 512; S.s0 = 512; S.n0 = BWIN; S.k1 = nb + C_BK; S.v1 = nb + C_BV; S.s1 = INP;
    }
    LAS float* bt = (LAS float*)(C.lds + ATT_SEL);
    const float* brel = A.in[12] + (size_t)l * 4 * 257;
    for (int i = C.tid; i < 4 * 257; i += NTHR) bt[i] = brel[i];
    __syncthreads();
    attn_unit<1>(C, PROJ + (size_t)qrow0 * INP + C_BQ, INP, S, tlo, (BWIN + 64) / 32, ws_bf(C, WS_MIX) + (size_t)qrow0 * DM + 512, DM);
}

DI void ssd_unit(const Ctx& C, const Args& A, int l, int row0, int nchunks, int h, const float* h0, float* hout) {
    int tid = C.tid, lane = C.lane; asm volatile("" : "+v"(tid), "+v"(lane));
    const int w = C.wave, r = lane & 31, hh = lane >> 5, g = h >> 2;
    LAS unsigned char* L = C.lds;
    LAS unsigned char* Cs = L + SSD_CS; LAS unsigned char* Bs = L + SSD_BS; LAS unsigned char* XD = L + SSD_XD; LAS unsigned char* XDW = L + SSD_XDW; LAS unsigned char* Ms = L + SSD_MS; LAS unsigned char* Ys = L + SSD_Y;
    LAS float* v_acs = (LAS float*)(L + SSD_VEC); LAS float* v_e = v_acs + 64;
    const bf16* XBC = ws_bf(C, WS_XBC); const bf16* PROJ = ws_bf(C, WS_PU); const float* DTS = ws_f(C, WS_DTS); float* G = ws_f(C, WS_G);
    const float a_h = -expf(A.in[16][l * 16 + h]); const float dsk = A.in[17][l * 16 + h];
    const int erow = tid >> 3, ech = tid & 7;
    f32x16 Hacc[2];
#pragma unroll
    for (int pb = 0; pb < 2; ++pb)
#pragma unroll
        for (int i = 0; i < 16; ++i) Hacc[pb][i] = 0.f;
    u32x4 pC[2], pB[2], pX, pZ; float pDt;
#define SSD_LOAD(c_) do { const int rb_ = row0 + (c_) * 64; \
        _Pragma("unroll") for (int i_ = 0; i_ < 2; ++i_) { const int ci_ = tid + 512 * i_; const bf16* src_ = XBC + (size_t)(rb_ + (ci_ >> 4)) * 2048 + g * 128 + (ci_ & 15) * 8; pB[i_] = *(const u32x4*)(src_ + 1024); pC[i_] = *(const u32x4*)(src_ + 1536); } \
        pX = *(const u32x4*)(XBC + (size_t)(rb_ + erow) * 2048 + h * 64 + ech * 8); pZ = *(const u32x4*)(PROJ + (size_t)(rb_ + erow) * INP + C_CZ + h * 64 + ech * 8); \
        pDt = DTS[(size_t)(rb_ + lane) * 16 + h]; } while (0)
    SSD_LOAD(0);
    __syncthreads();
    if (w >= 4) { const int nb = w - 4;
#pragma unroll
        for (int pb = 0; pb < 2; ++pb)
#pragma unroll
            for (int i = 0; i < 16; ++i) { const int p = 32 * pb + crow(i, hh), n = 32 * nb + r; const float v = h0 ? h0[p * 128 + n] : 0.f; Hacc[pb][i] = v;
                *(LAS bf16*)(L + SSD_HS + p * HSTR + n * 2) = f2bf(v); } }
#pragma unroll 1
    for (int c = 0; c < nchunks; ++c) {
        const int rbase = row0 + c * 64;
        LAS unsigned char* Hcur = L + SSD_HS + (c & 1) * 64 * HSTR; LAS unsigned char* Hnxt = L + SSD_HS + ((c + 1) & 1) * 64 * HSTR;
        const float dtl = pDt; float acs = dtl * a_h;
#pragma unroll
        for (int o = 1; o < 64; o <<= 1) { const float t = __shfl_up(acs, o); if (lane >= o) acs += t; }
        const float Atot = __shfl(acs, 63);
        const float wl = __expf(Atot - acs);
        if (w == 0) { v_acs[lane] = acs; v_e[lane] = __expf(acs); }
#pragma unroll
        for (int i = 0; i < 2; ++i) { const int ci = tid + 512 * i, row = ci >> 4, ch = ci & 15; *(LAS u32x4*)(Bs + row * CSTR + ch * 16) = pB[i]; *(LAS u32x4*)(Cs + row * CSTR + ch * 16) = pC[i]; }
        float xraw[8]; unpack8(pX, xraw); const u32x4 zc = pZ;
        { float xd[8], xw[8]; const float dt = __shfl(dtl, erow & 63), wv = __shfl(wl, erow & 63);
#pragma unroll
          for (int k = 0; k < 8; ++k) { xd[k] = xraw[k] * dt; xw[k] = xd[k] * wv; }
          *(LAS u32x4*)(XD + erow * XSTR + ech * 16) = pack8(xd); *(LAS u32x4*)(XDW + erow * XSTR + ech * 16) = pack8(xw); }
        if (c + 1 < nchunks) SSD_LOAD(c + 1);
        __syncthreads();
        if (w < 4) {
            const int lb = w >> 1, sb = w & 1; f32x16 acc;
#pragma unroll
            for (int i = 0; i < 16; ++i) acc[i] = 0.f;
            if (sb <= lb) {
#pragma unroll
                for (int ks = 0; ks < 8; ++ks) { const bf16x8 a = *(const LAS bf16x8*)(Cs + (32 * lb + r) * CSTR + (16 * ks + 8 * hh) * 2), b = *(const LAS bf16x8*)(Bs + (32 * sb + r) * CSTR + (16 * ks + 8 * hh) * 2);
                    acc = mfma32(a, b, acc); } }
            const int s = 32 * sb + r; const float acs_s = v_acs[s];
#pragma unroll
            for (int i = 0; i < 16; ++i) { const int lr = 32 * lb + crow(i, hh); const float v = (s <= lr) ? acc[i] * __expf(v_acs[lr] - acs_s) : 0.f; *(LAS bf16*)(Ms + lr * MSTR + s * 2) = f2bf(v); }
        } else {
            const int nb = w - 4; const float dec = __expf(Atot);
#pragma unroll
            for (int pb = 0; pb < 2; ++pb) {
#pragma unroll
                for (int i = 0; i < 16; ++i) Hacc[pb][i] *= dec;
#pragma unroll
                for (int ks = 0; ks < 4; ++ks) { const bf16x8 a = trfrag(XDW, XSTR, 16 * ks, 32 * pb, lane), b = trfrag(Bs, CSTR, 16 * ks, 32 * nb, lane); Hacc[pb] = mfma32(a, b, Hacc[pb]); }
#pragma unroll
                for (int i = 0; i < 16; ++i) *(LAS bf16*)(Hnxt + (32 * pb + crow(i, hh)) * HSTR + (32 * nb + r) * 2) = f2bf(Hacc[pb][i]);
            }
        }
        __syncthreads();
        if (w < 4) {
            const int lb = w >> 1, pb = w & 1; f32x16 yd, yo;
#pragma unroll
            for (int i = 0; i < 16; ++i) { yd[i] = 0.f; yo[i] = 0.f; }
#pragma unroll
            for (int ks = 0; ks < 4; ++ks) { const bf16x8 a = *(const LAS bf16x8*)(Ms + (32 * lb + r) * MSTR + (16 * ks + 8 * hh) * 2), b = trfrag(XD, XSTR, 16 * ks, 32 * pb, lane); yd = mfma32(a, b, yd); }
#pragma unroll
            for (int ks = 0; ks < 8; ++ks) { const bf16x8 a = *(const LAS bf16x8*)(Cs + (32 * lb + r) * CSTR + (16 * ks + 8 * hh) * 2), b = *(const LAS bf16x8*)(Hcur + (32 * pb + r) * HSTR + (16 * ks + 8 * hh) * 2); yo = mfma32(a, b, yo); }
            const int p = 32 * pb + r;
#pragma unroll
            for (int i = 0; i < 16; ++i) { const int lr = 32 * lb + crow(i, hh); *(LAS float*)(Ys + lr * YSTR + p * 4) = yd[i] + v_e[lr] * yo[i]; }
        }
        __syncthreads();
        {
            float z[8]; unpack8(zc, z);
            const f32x4 y0 = *(const LAS f32x4*)(Ys + erow * YSTR + ech * 32), y1 = *(const LAS f32x4*)(Ys + erow * YSTR + ech * 32 + 16);
            float y[8] = {y0.x, y0.y, y0.z, y0.w, y1.x, y1.y, y1.z, y1.w};
#pragma unroll
            for (int k = 0; k < 8; ++k) { const float yy = y[k] + dsk * xraw[k]; y[k] = yy * z[k] / (1.f + __expf(-z[k])); }
            float* gp = G + (size_t)(rbase + erow) * 1024 + h * 64 + ech * 8;
            ((f32x4*)gp)[0] = (f32x4){y[0], y[1], y[2], y[3]}; ((f32x4*)gp)[1] = (f32x4){y[4], y[5], y[6], y[7]};
        }
    }
#undef SSD_LOAD
    if (w >= 4) { const int nb = w - 4;
#pragma unroll
        for (int pb = 0; pb < 2; ++pb)
#pragma unroll
            for (int i = 0; i < 16; ++i) hout[(32 * pb + crow(i, hh)) * 128 + 32 * nb + r] = Hacc[pb][i]; }
}

DI void gate_norm_phase(const Ctx& C, const Args& A, int l) {
    const int gw = C.bid * NWAVES + C.wave, NGW = C.G * NWAVES; const float* gn = A.in[18] + (size_t)l * 1024;
    for (int m = gw; m < NTOK; m += NGW) { const float* grow = ws_f(C, WS_G) + (size_t)m * 1024; bf16* orow = ws_bf(C, WS_MIX) + (size_t)m * DM + 1024;
#pragma unroll
        for (int g = 0; g < 4; ++g) { const f32x4 v = ((const f32x4*)grow)[g * 64 + C.lane]; const float ss = wave_sum((v.x * v.x + v.y * v.y) + (v.z * v.z + v.w * v.w));
            const float rs = 1.0f / sqrtf(ss * (1.0f / 256.f) + EPS); const f32x4 wv = ((const f32x4*)gn)[g * 64 + C.lane]; const f32x4 o = v * rs * wv;
            u32x2 p; p.x = pk2(o.x, o.y); p.y = pk2(o.z, o.w); ((u32x2*)orow)[g * 64 + C.lane] = p; } }
}
DI void norm_phase(const Ctx& C, int rlo, int mode, const float* w) {
    const int gw = C.bid * NWAVES + C.wave, NGW = C.G * NWAVES;
    for (int m = rlo + gw; m < NTOK; m += NGW)
        res_row(ws_bf(C, WS_X) + (size_t)m * DM, m >= NTP ? ws_f(C, WS_G) + (size_t)(m - NTP) * DM : nullptr, (size_t)NTS * DM, mode, ws_f(C, WS_SSQ1) + (size_t)m * 32, w, C.out + (size_t)m * DM, C.lane);
}
DI void zero_f32(const Ctx& C, float* p, int n) { for (int i = C.bid * NTHR + C.tid; i < n; i += C.G * NTHR) p[i] = 0.f; }

#ifndef MK_ONE_LAUNCH
#define MK_ONE_LAUNCH 1
#endif
#ifndef PHASE_MASK
#define PHASE_MASK 0xFFFF
#endif
#define EN(k) (((PHASE_MASK) >> (k)) & 1)
constexpr int PH_PER_LAYER = 8, NPHASE = 1 + DEPTH * PH_PER_LAYER;
__global__ void __launch_bounds__(NTHR, 2) fwd(Args args) {
    extern __shared__ __attribute__((aligned(16))) unsigned char lds_raw[];
    Ctx C;
    C.lds = (LAS unsigned char*)lds_raw;
    C.tid = threadIdx.x; C.lane = C.tid & 63; C.wave = __builtin_amdgcn_readfirstlane(C.tid >> 6); C.G = gridDim.x; C.bid = blockIdx.x;
    C.ws = args.ws; C.out = args.out; C.ctl = (unsigned*)(args.ws + WS_CTL);
    const Args& A = args;
    for (int u = C.tid; u < (LDS_BYTES - LDSCTL_OFF) / 4; u += NTHR) ((LAS unsigned*)(C.lds + LDSCTL_OFF))[u] = 0u;
    __syncthreads();
    const int lo = args.ph_lo, hi = args.ph_hi;
    const bool multi = (hi - lo) > 1;
    XcdBarrier bar; bar.bar = C.ctl + CW_BAR; bar.x = 0; bar.st = (volatile LAS unsigned*)(C.lds + LDSCTL_OFF);
    if (multi) bar = xcd_barrier_post(C.ctl + CW_BAR, (volatile LAS unsigned*)(C.lds + LDSCTL_OFF));
#define IN(k) (lo <= (k) && (k) < hi)
#define FRESH() do { int t_ = threadIdx.x; asm volatile("" : "+v"(t_)); C.tid = t_; C.lane = t_ & 63; int w_ = __builtin_amdgcn_readfirstlane(t_ >> 6); asm volatile("" : "+s"(w_)); C.wave = w_; } while (0)
#define SEAM(k) do { if (IN((k) + 1)) xcd_barrier(bar); } while (0)

    if (EN(0) && IN(0)) { p0_prologue(C, A);
#if defined(PROBE_P02)
        __syncthreads(); p0_prologue(C, A);
#endif
        SEAM(0); }
#pragma unroll 1
    for (int l = 0; l < DEPTH; ++l) {
        const int pb = 1 + PH_PER_LAYER * l;
        if (EN(1) && IN(pb + 0)) { FRESH();
            pg8::Gemm g{ws_bf(C, WS_X), w_in_t(C, l), NTOK, INP, DM, DM}; pg8::StaticOrder S; S.init(NTOK, INP, C.G, C.bid);
            pg8::EpiBf16<0> E{ws_bf(C, WS_PU), INP, ws_f(C, WS_SSQ1), 1.0f / DM, EPS, (LAS float*)(C.lds + LDS_RSTD)};
            pg8::gemm_phase<pg8::EpiBf16<0>, pg8::StaticOrder, true, true>(C.lds, g, S, E);
            SEAM(pb + 0);
        }
        if (EN(2) && IN(pb + 1)) { FRESH(); m0_phase(C, A, l); SEAM(pb + 1); }
        if (IN(pb + 2)) { FRESH();
            unsigned* qh = C.ctl + CW_Q + 64 * (l * 4);
            if (EN(3)) for (;;) { const int u = q_next(C, qh); if (u >= NB * 16) break;
                ssd_unit(C, A, l, (u >> 4) * SEQ, SEQ / 64, u & 15, nullptr, C.out + OFF_P_SSM + ((size_t)(l * NB + (u >> 4)) * 16 + (u & 15)) * 8192); }
            if (EN(4)) for (;;) { const int u = q_next(C, qh + 64); if (u >= 288) break; dsa_unit(C, l, u); }
            if (EN(5)) for (;;) { const int u = q_next(C, qh + 128); if (u >= 288) break; band_unit(C, A, l, u); }
            if (EN(3)) for (;;) { const int u = q_next(C, qh + 192); if (u >= DBAT * 16) break;
                ssd_unit(C, A, l, NTP + (u >> 4) * DSEQ, 1, u & 15, A.in[7] + ((size_t)(l * DBAT + (u >> 4)) * 16 + (u & 15)) * 8192, C.out + OFF_S_SSM + ((size_t)(l * DBAT + (u >> 4)) * 16 + (u & 15)) * 8192); }
            SEAM(pb + 2);
        }
        if (EN(6) && IN(pb + 3)) { FRESH(); gate_norm_phase(C, A, l); SEAM(pb + 3); }
        if (EN(7) && IN(pb + 4)) { FRESH();
            pg8::Gemm g{ws_bf(C, WS_MIX), w_out_t(C, l), NTOK, DM, DM, DM}; pg8::StaticOrder S; S.init(NTOK, DM, C.G, C.bid);
            pg8::EpiResBf16 E{ws_bf(C, WS_X), DM, ws_f(C, WS_SSQ2), 1};
            pg8::gemm_phase<pg8::EpiResBf16, pg8::StaticOrder, true, true>(C.lds, g, S, E);
            SEAM(pb + 4);
        }
        if (EN(9) && IN(pb + 5)) { FRESH();
            pg8::Gemm g{ws_bf(C, WS_X), w_up_t(C, l), NTOK, DFF, DM, DM}; pg8::StaticOrder S; S.init(NTOK, DFF, C.G, C.bid);
            pg8::EpiBf16<1> E{ws_bf(C, WS_PU), DFF, ws_f(C, WS_SSQ2), 1.0f / DM, EPS, (LAS float*)(C.lds + LDS_RSTD)};
            pg8::gemm_phase<pg8::EpiBf16<1>, pg8::StaticOrder, true, true>(C.lds, g, S, E);
            SEAM(pb + 5);
        }
        if (EN(10) && IN(pb + 6)) { FRESH();
            { pg8::Gemm g{ws_bf(C, WS_PU), w_dn_t(C, l), NTP, DM, DFF, DFF}; pg8::StaticOrder S; S.init(NTP, DM, C.G, C.bid);
              pg8::EpiResBf16 E{ws_bf(C, WS_X), DM, ws_f(C, WS_SSQ1), l + 1 < DEPTH ? 1 : 0};
              pg8::gemm_phase<pg8::EpiResBf16, pg8::StaticOrder, true, true>(C.lds, g, S, E); }
            __syncthreads();
            { pg8::Gemm g{ws_bf(C, WS_PU), w_dn_t(C, l), NTOK, DM, DFF / 4, DFF}; pg8::SplitOrder S; S.init(NTP / 256, NTS / 256, DM / 256, 4, C.G, C.bid);
              pg8::EpiSplitPart E{ws_f(C, WS_G), DM, (size_t)NTS * DM, NTP};
              pg8::gemm_phase<pg8::EpiSplitPart, pg8::SplitOrder, true, true>(C.lds, g, S, E); }
            SEAM(pb + 6);
        }
        if (EN(8) && IN(pb + 7)) { FRESH();
            if (l + 1 < DEPTH) norm_phase(C, NTP, 0, nullptr);
            else norm_phase(C, 0, 1, A.in[22]);
            SEAM(pb + 7);
        }
    }
#undef IN
#undef SEAM
}

extern "C" void kernel_launch(void* const* d_in, const int* in_sizes, int n_in, void* d_out, int out_size, void* d_ws, size_t ws_size, hipStream_t stream) {
    static int grid = 0;
    if (grid == 0) {
        if (n_in != 23 || in_sizes[0] != NTP * DM || (size_t)out_size != OUT_TOTAL || ws_size < WS_END) {
            fprintf(stderr, "kernel_launch: unexpected shapes (n_in %d, in0 %d, out %d, ws %zu; need ws >= %zu); nothing launched\n", n_in, n_in > 0 ? in_sizes[0] : -1, out_size, ws_size, (size_t)WS_END); grid = -1; return; }
        int dev = 0, cus = 0, per_cu = 0;
        if (hipGetDevice(&dev) != hipSuccess || hipDeviceGetAttribute(&cus, hipDeviceAttributeMultiprocessorCount, dev) != hipSuccess) { fprintf(stderr, "kernel_launch: device query failed\n"); grid = -1; return; }
        if (hipFuncSetAttribute((const void*)fwd, hipFuncAttributeMaxDynamicSharedMemorySize, LDS_BYTES) != hipSuccess) { fprintf(stderr, "kernel_launch: hipFuncSetAttribute failed\n"); grid = -1; return; }
        if (hipOccupancyMaxActiveBlocksPerMultiprocessor(&per_cu, (const void*)fwd, NTHR, LDS_BYTES) != hipSuccess || per_cu < 1)
            fprintf(stderr, "kernel_launch: note: occupancy query reports %d workgroups per CU\n", per_cu);
        (void)hipGetLastError();
        grid = cus < 256 ? cus : 256;
    }
    if (grid < 0) return;
    if (hipMemsetAsync((char*)d_ws + WS_CTL, 0, CTL_ZERO_BYTES, stream) != hipSuccess) { fprintf(stderr, "kernel_launch: memset failed\n"); return; }
    Args a{};
    for (int i = 0; i < 23; ++i) a.in[i] = (const float*)d_in[i];
    a.out = (float*)d_out; a.ws = (unsigned char*)d_ws;
#if MK_ONE_LAUNCH
    a.ph_lo = 0; a.ph_hi = NPHASE;
    hipLaunchKernelGGL(fwd, dim3(grid), dim3(NTHR), LDS_BYTES, stream, a);
#else
    for (int p = 0; p < NPHASE; ++p) { a.ph_lo = p; a.ph_hi = p + 1; hipLaunchKernelGGL(fwd, dim3(grid), dim3(NTHR), LDS_BYTES, stream, a); }
#endif
    const hipError_t le = hipPeekAtLastError();
    if (le != hipSuccess) fprintf(stderr, "kernel_launch: launch failed: %s\n", hipGetErrorName(le));
}
```

```cpp
#include <hip/hip_runtime.h>
#include <cstdio>
#include <cstdint>
#include <cstddef>
namespace pg8 {
#define PG8_LAS __attribute__((address_space(3)))
typedef unsigned short bf16_t;
typedef short bf16x8 __attribute__((ext_vector_type(8)));
typedef float f32x4 __attribute__((ext_vector_type(4)));
typedef unsigned u32x4 __attribute__((ext_vector_type(4)));
constexpr int BM = 256, BK = 64, HALF = 128, HTB = HALF * BK * 2  , STAGE_BYTES = 8 * HTB, NXCD = 8, WGM = 8;

__host__ __device__ __forceinline__ int lds_byte(int r, int c) { const int st = (r >> 4) * 2 + (c >> 5), rr = r & 15, cc = c & 31, ob = rr * 64 + cc * 2; return st * 1024 + (ob ^ (((ob >> 9) & 1) << 5)); }
__host__ __device__ __forceinline__ void stage_rc(int b, int& R, int& C) { const int st = b / 1024, sb = b % 1024, swz = sb ^ (((sb >> 9) & 1) << 5); R = (st >> 1) * 16 + swz / 64; C = (st & 1) * 32 + (swz % 64) / 2; }
__host__ __device__ __forceinline__ int perm32(int rho) { const int n = rho >> 4, i = rho & 15; return 8 * (i >> 2) + 4 * n + (i & 3); }

struct Unit { int pm, pn, kq, ord; };
struct Gemm { const bf16_t* A; const bf16_t* Bt; int M, N, K, ld; };

struct StaticOrder {
    int nM, nN, nwg, G, c;
    __host__ __device__ void init(int M, int N, int G_, int c_) { nM = M / BM; nN = N / BM; nwg = nM * nN; G = G_; c = c_; }
    __host__ __device__ bool next(int i, Unit& u) const {
        const long L = (long)i * G + c; if (L >= nwg) return false;
        int wgid = (int)L; { const int q = nwg / NXCD, r = nwg % NXCD, xcd = wgid % NXCD, off = wgid / NXCD; wgid = (xcd < r ? xcd * (q + 1) : r * (q + 1) + (xcd - r) * q) + off; }
        const int nig = WGM * nN, gid = wgid / nig, fm = gid * WGM, gsz = (nM - fm) < WGM ? (nM - fm) : WGM;
        u.pm = fm + ((wgid % nig) % gsz); u.pn = (wgid % nig) / gsz; u.kq = 0; u.ord = i; return true;
    }
    __device__ __forceinline__ void a_ready(const Unit&) const {}
    __device__ __forceinline__ void done(const Unit&) const {}
};

struct WinOrder {
    int G, c, c2, n1;
    template <int nM, int nN> static __host__ __device__ __forceinline__ void tile(int L, int& pm, int& pn) {
        constexpr int nwg = nM * nN, q = nwg / NXCD, r = nwg % NXCD, nig = WGM * nN;
        const int xcd = L % NXCD, off = L / NXCD; const int wgid = (xcd < r ? xcd * (q + 1) : r * (q + 1) + (xcd - r) * q) + off;
        const int gid = wgid / nig, fm = gid * WGM, gsz = (nM - fm) < WGM ? (nM - fm) : WGM;
        pm = fm + ((wgid % nig) % gsz); pn = (wgid % nig) / gsz;
    }
    __host__ __device__ __forceinline__ void init(int G_, int c_) { G = G_; c = c_; c2 = (c_ + G_ - (146 % G_)) % G_; n1 = c_ < 1682 ? (1681 - c_) / G_ + 1 : 0; }
    __host__ __device__ __forceinline__ bool next(int i, Unit& u) const {
        if (i < n1) { tile<58, 29>(i * G + c, u.pm, u.pn); }
        else { const int L = (i - n1) * G + c2; if (L >= 364) return false; int pm, pn; tile<14, 26>(L, pm, pn); u.pm = pm + 58; u.pn = pn < 17 ? pn : pn + 3; }
        u.kq = 0; u.ord = i; return true;
    }
    __device__ __forceinline__ void a_ready(const Unit&) const {}
    __device__ __forceinline__ void done(const Unit&) const {}
};
struct ListOrder {
    const PG8_LAS int* list; int n;
    __device__ __forceinline__ bool next(int i, Unit& u) const { if (i >= n) return false; const int v = __builtin_amdgcn_readfirstlane(list[i]); u.pm = v >> 8; u.pn = v & 255; u.kq = 0; u.ord = i; return true; }
    __device__ __forceinline__ void a_ready(const Unit&) const {}
    __device__ __forceinline__ void done(const Unit&) const {}
};
struct OneUnit {
    int pm, pn;
    __host__ __device__ bool next(int i, Unit& u) const { if (i != 0) return false; u.pm = pm; u.pn = pn; u.kq = 0; u.ord = 0; return true; }
    __device__ __forceinline__ void a_ready(const Unit&) const {}
    __device__ __forceinline__ void done(const Unit&) const {}
};

struct SplitOrder {
    int pm0, npm, nN, nsplit, G, c;
    __host__ __device__ void init(int pm0_, int npm_, int nN_, int nsplit_, int G_, int c_) { pm0 = pm0_; npm = npm_; nN = nN_; nsplit = nsplit_; G = G_; c = c_; }
    __host__ __device__ bool next(int i, Unit& u) const {
        const long L = (long)i * G + c; if (L >= (long)npm * nN * nsplit) return false;
        const int w = (int)L; u.kq = w % nsplit; u.pn = (w / nsplit) % nN; u.pm = pm0 + w / (nsplit * nN); u.ord = i; return true;
    }
    __device__ __forceinline__ void a_ready(const Unit&) const {}
    __device__ __forceinline__ void done(const Unit&) const {}
};

struct HotOrder {
    int n, c;
    __host__ __device__ bool next(int i, Unit& u) const { if (i >= n) return false; u.pm = c & 7; u.pn = (c >> 3) & 3; u.kq = 0; u.ord = i; return true; }
    __device__ __forceinline__ void a_ready(const Unit&) const {}
    __device__ __forceinline__ void done(const Unit&) const {}
};

typedef float f32x2_t __attribute__((ext_vector_type(2)));
typedef __bf16 bf16x2_t __attribute__((ext_vector_type(2)));
__device__ __forceinline__ unsigned cvt_pk_bf16(float lo, float hi) { f32x2_t v = {lo, hi}; bf16x2_t b = __builtin_convertvector(v, bf16x2_t); return __builtin_bit_cast(unsigned, b); }

template <int ACT  , int PMODE = 0  > struct EpiBf16 {
    static constexpr bool PERM = true, AFTER_DRAIN = false;
    bf16_t* O; int ldc; const PG8_LAS float* tab;
    __device__ __forceinline__ void operator()(const f32x4 (&acc)[2][2][4][2], const Unit& u, int wr, int wc, int fr, int fq) const {
        const int row0 = u.pm * BM + wr * 64 + fr; const int col0 = u.pn * BM + wc * 32 + 8 * fq;
        float rs[2][4];
#pragma unroll
        for (int ai = 0; ai < 2; ++ai)
#pragma unroll
            for (int m = 0; m < 4; ++m) rs[ai][m] = PMODE == 1 ? 1.0f : tab[u.ord * BM + wr * 64 + fr + ai * HALF + m * 16];
#pragma unroll
        for (int ai = 0; ai < 2; ++ai)
#pragma unroll
            for (int m = 0; m < 4; ++m) { bf16_t* rowp = O + (size_t)(row0 + ai * HALF + m * 16) * ldc + col0;
#pragma unroll
                for (int bj = 0; bj < 2; ++bj) { f32x4 v0 = acc[ai][bj][m][0] * rs[ai][m], v1 = acc[ai][bj][m][1] * rs[ai][m];
                    if (ACT == 1) {
#pragma unroll
                        for (int j = 0; j < 4; ++j) { const float a = v0[j] > 0.f ? v0[j] : 0.f, b = v1[j] > 0.f ? v1[j] : 0.f; v0[j] = a * a; v1[j] = b * b; } }
                    u32x4 w; w.x = cvt_pk_bf16(v0[0], v0[1]); w.y = cvt_pk_bf16(v0[2], v0[3]); w.z = cvt_pk_bf16(v1[0], v1[1]); w.w = cvt_pk_bf16(v1[2], v1[3]);
                    if (PMODE == 2) asm volatile("" :: "v"(w)); else *(u32x4*)(rowp + bj * HALF) = w; } }
    }
};
struct EpiResF32 {
    static constexpr bool PERM = false, AFTER_DRAIN = false;
    float* X; int ldc;
    __device__ __forceinline__ void operator()(const f32x4 (&acc)[2][2][4][2], const Unit& u, int wr, int wc, int fr, int fq) const {
        const int row0 = u.pm * BM + wr * 64 + fr, col0 = u.pn * BM + wc * 32 + 4 * fq;
#pragma unroll
        for (int ai = 0; ai < 2; ++ai)
#pragma unroll
            for (int m = 0; m < 4; ++m) { float* rowp = X + (size_t)(row0 + ai * HALF + m * 16) * ldc + col0;
                f32x4 b[2][2];
#pragma unroll
                for (int bj = 0; bj < 2; ++bj)
#pragma unroll
                    for (int n = 0; n < 2; ++n) b[bj][n] = *(const f32x4*)(rowp + bj * HALF + n * 16);
#pragma unroll
                for (int bj = 0; bj < 2; ++bj)
#pragma unroll
                    for (int n = 0; n < 2; ++n) *(f32x4*)(rowp + bj * HALF + n * 16) = b[bj][n] + acc[ai][bj][m][n];
                asm volatile("" ::: "memory"); }
    }
};

struct EpiSplitRes {
    static constexpr bool PERM = false, AFTER_DRAIN = false;
    float* X; int ldc; float* P; size_t pstride; int row0;
    __device__ __forceinline__ void operator()(const f32x4 (&acc)[2][2][4][2], const Unit& u, int wr, int wc, int fr, int fq) const {
        const int rowa = u.pm * BM + wr * 64 + fr, col0 = u.pn * BM + wc * 32 + 4 * fq;
        if (u.kq == 0) {
#pragma unroll
            for (int ai = 0; ai < 2; ++ai)
#pragma unroll
                for (int m = 0; m < 4; ++m) { float* rowp = X + (size_t)(rowa + ai * HALF + m * 16) * ldc + col0;
                    f32x4 b[2][2];
#pragma unroll
                    for (int bj = 0; bj < 2; ++bj)
#pragma unroll
                        for (int n = 0; n < 2; ++n) b[bj][n] = *(const f32x4*)(rowp + bj * HALF + n * 16);
#pragma unroll
                    for (int bj = 0; bj < 2; ++bj)
#pragma unroll
                        for (int n = 0; n < 2; ++n) *(f32x4*)(rowp + bj * HALF + n * 16) = b[bj][n] + acc[ai][bj][m][n];
                    asm volatile("" ::: "memory"); }
        } else {
            float* base = P + (size_t)(u.kq - 1) * pstride;
#pragma unroll
            for (int ai = 0; ai < 2; ++ai)
#pragma unroll
                for (int m = 0; m < 4; ++m) { float* rowp = base + (size_t)(rowa - row0 + ai * HALF + m * 16) * ldc + col0;
#pragma unroll
                    for (int bj = 0; bj < 2; ++bj)
#pragma unroll
                        for (int n = 0; n < 2; ++n) *(f32x4*)(rowp + bj * HALF + n * 16) = acc[ai][bj][m][n]; }
        }
    }
};

struct EpiResBf16 {
    static constexpr bool PERM = true, AFTER_DRAIN = false;
    bf16_t* X; int ldc; float* SSQ; int emit;
    __device__ __forceinline__ void operator()(const f32x4 (&acc)[2][2][4][2], const Unit& u, int wr, int wc, int fr, int fq) const {
        const int row0 = u.pm * BM + wr * 64 + fr, col0 = u.pn * BM + wc * 32 + 8 * fq;
        u32x4 b[2][4][2];
#pragma unroll
        for (int ai = 0; ai < 2; ++ai)
#pragma unroll
            for (int m = 0; m < 4; ++m)
#pragma unroll
                for (int bj = 0; bj < 2; ++bj) b[ai][m][bj] = *(const u32x4*)(X + (size_t)(row0 + ai * HALF + m * 16) * ldc + col0 + bj * HALF);
#pragma unroll
        for (int ai = 0; ai < 2; ++ai)
#pragma unroll
            for (int m = 0; m < 4; ++m) { const int row = row0 + ai * HALF + m * 16; bf16_t* rowp = X + (size_t)row * ldc + col0; float ss = 0.f;
#pragma unroll
                for (int bj = 0; bj < 2; ++bj) { float v[8];
#pragma unroll
                    for (int j = 0; j < 4; ++j) { v[2 * j] = __uint_as_float(b[ai][m][bj][j] << 16); v[2 * j + 1] = __uint_as_float(b[ai][m][bj][j] & 0xffff0000u); }
#pragma unroll
                    for (int j = 0; j < 4; ++j) { v[j] += acc[ai][bj][m][0][j]; v[4 + j] += acc[ai][bj][m][1][j]; }
#pragma unroll
                    for (int j = 0; j < 8; ++j) ss += v[j] * v[j];
                    u32x4 w; w.x = cvt_pk_bf16(v[0], v[1]); w.y = cvt_pk_bf16(v[2], v[3]); w.z = cvt_pk_bf16(v[4], v[5]); w.w = cvt_pk_bf16(v[6], v[7]);
                    *(u32x4*)(rowp + bj * HALF) = w; }
                if (emit) { ss += __shfl_xor(ss, 16); ss += __shfl_xor(ss, 32); if (fq == 0) SSQ[(size_t)row * 32 + u.pn * 4 + wc] = ss; } }
    }
};
struct EpiSplitPart {
    static constexpr bool PERM = false, AFTER_DRAIN = false;
    float* P; int ldc; size_t pstride; int row0;
    __device__ __forceinline__ void operator()(const f32x4 (&acc)[2][2][4][2], const Unit& u, int wr, int wc, int fr, int fq) const {
        const int rowa = u.pm * BM + wr * 64 + fr, col0 = u.pn * BM + wc * 32 + 4 * fq;
        float* base = P + (size_t)u.kq * pstride;
#pragma unroll
        for (int ai = 0; ai < 2; ++ai)
#pragma unroll
            for (int m = 0; m < 4; ++m) { float* rowp = base + (size_t)(rowa - row0 + ai * HALF + m * 16) * ldc + col0;
#pragma unroll
                for (int bj = 0; bj < 2; ++bj)
#pragma unroll
                    for (int n = 0; n < 2; ++n) *(f32x4*)(rowp + bj * HALF + n * 16) = acc[ai][bj][m][n]; }
    }
};

struct EpiNull {
    static constexpr bool PERM = false, AFTER_DRAIN = false;
    __device__ __forceinline__ void operator()(const f32x4 (&acc)[2][2][4][2], const Unit&, int, int, int, int) const {
#pragma unroll
        for (int ai = 0; ai < 2; ++ai)
#pragma unroll
            for (int bj = 0; bj < 2; ++bj)
#pragma unroll
                for (int m = 0; m < 4; ++m)
#pragma unroll
                    for (int n = 0; n < 2; ++n) asm volatile("" :: "v"(acc[ai][bj][m][n]));
    }
};
template <class Epi, class Sched, bool ALIGN_EPI = false, bool SP2 = false>
__device__ __forceinline__ void gemm_phase(PG8_LAS unsigned char* lds, const Gemm g, const Sched& S, const Epi& E) {
    int tid_ = threadIdx.x; asm volatile("" : "+v"(tid_));
    const int tid = tid_, wid = __builtin_amdgcn_readfirstlane(tid >> 6), lane = tid & 63, wr = wid >> 2, wc = wid & 3, fr = lane & 15, fq = lane >> 4;
    const int K = g.K, nt = K / BK, ld = g.ld;
    unsigned voffA[2], voffB[2];
#pragma unroll
    for (int i = 0; i < 2; ++i) { int R, C; stage_rc(tid * 16 + i * 8192, R, C); const int Rb = Epi::PERM ? ((R & ~31) + perm32(R & 31)) : R;
        voffA[i] = (unsigned)(R * ld + C) * 2u; voffB[i] = (unsigned)(Rb * ld + C) * 2u; }
    const size_t kstep = (size_t)(BK * 2);
    const size_t hstep = (size_t)HALF * ld * 2;
    const size_t tstep = 2 * hstep;
    const unsigned ldsw = (unsigned)wid * 1024u;
    const int aoff = lds_byte(wr * 64 + fr, fq * 8), boff = lds_byte(wc * 32 + fr, fq * 8);
#define PG8_SA(b, h) (((b) * 2 + (h)) * HTB)
#define PG8_SB(b, h) ((4 + (b) * 2 + (h)) * HTB)
#define PG8_STAGE(bufoff, gbase, voff) do { _Pragma("unroll") for (int _i = 0; _i < 2; ++_i) \
        __builtin_amdgcn_global_load_lds((const unsigned*)((const char*)(gbase) + (voff)[_i]), (PG8_LAS unsigned*)(lds + (bufoff) + ldsw + _i * 8192), 16, 0, 0); } while (0)
#define PG8_LDA(dst, b, h) do { _Pragma("unroll") for (int m = 0; m < 4; ++m) _Pragma("unroll") for (int k = 0; k < 2; ++k) dst[m][k] = *(const PG8_LAS bf16x8*)(lds + PG8_SA(b, h) + aoff + m * 2048 + k * 1024); } while (0)
#define PG8_LDB(dst, b, h) do { _Pragma("unroll") for (int n = 0; n < 2; ++n) _Pragma("unroll") for (int k = 0; k < 2; ++k) dst[n][k] = *(const PG8_LAS bf16x8*)(lds + PG8_SB(b, h) + boff + n * 2048 + k * 1024); } while (0)
#define PG8_MMA(ai, bj, At, Bt) do { __builtin_amdgcn_s_setprio(1); _Pragma("unroll") for (int m = 0; m < 4; ++m) _Pragma("unroll") for (int n = 0; n < 2; ++n) _Pragma("unroll") for (int k = 0; k < 2; ++k) \
        acc[ai][bj][m][n] = __builtin_amdgcn_mfma_f32_16x16x32_bf16(Bt[n][k], At[m][k], acc[ai][bj][m][n], 0, 0, 0); __builtin_amdgcn_s_setprio(0); } while (0)
#define PG8_WAIT_V(n) asm volatile("s_waitcnt vmcnt(" #n ")" ::: "memory")
#define PG8_WAIT_L(n) asm volatile("s_waitcnt lgkmcnt(" #n ")" ::: "memory")
#define PG8_BAR __builtin_amdgcn_s_barrier()
#define PG8_SCHED __builtin_amdgcn_sched_barrier(0)
    Unit cur, nxt; int ui = 0;
    if (!S.next(0, cur)) return;
    f32x4 acc[2][2][4][2];
#pragma unroll
    for (int a = 0; a < 2; ++a)
#pragma unroll
        for (int b = 0; b < 2; ++b)
#pragma unroll
            for (int m = 0; m < 4; ++m)
#pragma unroll
                for (int n = 0; n < 2; ++n) acc[a][b][m][n] = (f32x4){0.f, 0.f, 0.f, 0.f};
    bf16x8 At[4][2], B0[2][2], B1[2][2];
    const char* cA = (const char*)g.A + (size_t)cur.pm * tstep + (size_t)cur.kq * K * 2; const char* cB = (const char*)g.Bt + (size_t)cur.pn * tstep + (size_t)cur.kq * K * 2;
    S.a_ready(cur);
    if constexpr (SP2) {
        PG8_STAGE(PG8_SB(0, 0), cB, voffB); PG8_STAGE(PG8_SB(0, 1), cB + hstep, voffB); PG8_STAGE(PG8_SA(0, 0), cA, voffA); PG8_STAGE(PG8_SA(0, 1), cA + hstep, voffA);
        if (wr == 1) PG8_BAR;
        PG8_WAIT_V(2); PG8_BAR;
        PG8_STAGE(PG8_SB(1, 0), cB + kstep, voffB); PG8_STAGE(PG8_SA(1, 0), cA + kstep, voffA); PG8_STAGE(PG8_SB(1, 1), cB + hstep + kstep, voffB);
        PG8_WAIT_V(6); PG8_BAR;
    } else {
        PG8_STAGE(PG8_SB(0, 0), cB, voffB); PG8_STAGE(PG8_SA(0, 0), cA, voffA); PG8_STAGE(PG8_SB(0, 1), cB + hstep, voffB); PG8_STAGE(PG8_SA(0, 1), cA + hstep, voffA);
        if (wr == 1) PG8_BAR;
        PG8_WAIT_V(4); PG8_BAR;
        PG8_STAGE(PG8_SB(1, 0), cB + kstep, voffB); PG8_STAGE(PG8_SA(1, 0), cA + kstep, voffA); PG8_STAGE(PG8_SB(1, 1), cB + hstep + kstep, voffB);
        PG8_WAIT_V(6); PG8_BAR;
    }
    for (;;) {
        const bool has_next = S.next(ui + 1, nxt);
        const char* nA = has_next ? (const char*)g.A + (size_t)nxt.pm * tstep + (size_t)nxt.kq * K * 2 : cA; const char* nB = has_next ? (const char*)g.Bt + (size_t)nxt.pn * tstep + (size_t)nxt.kq * K * 2 : cB;
        for (int t = 0; t < nt; t += 2) {
            const bool last = (t == nt - 2);
            const char* a1 = cA + (size_t)(t + 1) * kstep;
            const char* a2 = last ? nA : cA + (size_t)(t + 2) * kstep; const char* b2 = last ? nB : cB + (size_t)(t + 2) * kstep;
            const char* a3 = a2 + kstep; const char* b3 = b2 + kstep;
            if (last && has_next) S.a_ready(nxt);
            if constexpr (SP2) {
            PG8_LDB(B0, 0, 0); PG8_LDB(B1, 0, 1); PG8_SCHED; PG8_LDA(At, 0, 0); PG8_STAGE(PG8_SA(1, 1), a1 + hstep, voffA);
            PG8_WAIT_V(8); PG8_WAIT_L(0); PG8_BAR; PG8_MMA(0, 0, At, B0); PG8_MMA(0, 1, At, B1); PG8_BAR; PG8_SCHED;
            PG8_LDA(At, 0, 1); PG8_STAGE(PG8_SB(0, 0), b2, voffB); PG8_STAGE(PG8_SB(0, 1), b2 + hstep, voffB); PG8_STAGE(PG8_SA(0, 0), a2, voffA);
            PG8_WAIT_V(8); PG8_WAIT_L(0); PG8_BAR; PG8_MMA(1, 0, At, B0); PG8_MMA(1, 1, At, B1); PG8_BAR; PG8_SCHED;
            PG8_LDB(B0, 1, 0); PG8_LDB(B1, 1, 1); PG8_SCHED; PG8_LDA(At, 1, 0); PG8_STAGE(PG8_SA(0, 1), a2 + hstep, voffA);
            PG8_WAIT_V(8); PG8_WAIT_L(0); PG8_BAR; PG8_MMA(0, 0, At, B0); PG8_MMA(0, 1, At, B1); PG8_BAR; PG8_SCHED;
            PG8_LDA(At, 1, 1); PG8_STAGE(PG8_SB(1, 0), b3, voffB); PG8_STAGE(PG8_SB(1, 1), b3 + hstep, voffB); PG8_STAGE(PG8_SA(1, 0), a3, voffA);
            PG8_WAIT_V(8); PG8_WAIT_L(0); PG8_BAR; PG8_MMA(1, 0, At, B0); PG8_MMA(1, 1, At, B1); PG8_BAR; PG8_SCHED;
            } else {
            PG8_LDB(B0, 0, 0); PG8_SCHED; PG8_LDA(At, 0, 0); PG8_STAGE(PG8_SA(1, 1), a1 + hstep, voffA);
            PG8_WAIT_L(8); PG8_BAR; PG8_WAIT_L(0); PG8_MMA(0, 0, At, B0); PG8_BAR; PG8_SCHED;
            PG8_LDB(B1, 0, 1); PG8_STAGE(PG8_SB(0, 0), b2, voffB);
            PG8_BAR; PG8_WAIT_L(0); PG8_MMA(0, 1, At, B1); PG8_BAR;
            PG8_LDA(At, 0, 1); PG8_STAGE(PG8_SA(0, 0), a2, voffA);
            PG8_BAR; PG8_WAIT_L(0); PG8_MMA(1, 0, At, B0); PG8_BAR; PG8_SCHED;
            PG8_STAGE(PG8_SB(0, 1), b2 + hstep, voffB);
            PG8_WAIT_V(6); PG8_BAR; PG8_MMA(1, 1, At, B1); PG8_BAR;
            PG8_LDB(B0, 1, 0); PG8_SCHED; PG8_LDA(At, 1, 0); PG8_STAGE(PG8_SA(0, 1), a2 + hstep, voffA);
            PG8_WAIT_L(8); PG8_BAR; PG8_WAIT_L(0); PG8_MMA(0, 0, At, B0); PG8_BAR; PG8_SCHED;
            PG8_LDB(B1, 1, 1); PG8_STAGE(PG8_SB(1, 0), b3, voffB);
            PG8_BAR; PG8_WAIT_L(0); PG8_MMA(0, 1, At, B1); PG8_BAR;
            PG8_LDA(At, 1, 1); PG8_STAGE(PG8_SA(1, 0), a3, voffA);
            PG8_BAR; PG8_WAIT_L(0); PG8_MMA(1, 0, At, B0); PG8_BAR; PG8_SCHED;
            PG8_STAGE(PG8_SB(1, 1), b3 + hstep, voffB);
            PG8_WAIT_V(6); PG8_BAR; PG8_MMA(1, 1, At, B1); PG8_BAR;
            }
        }
        if constexpr (ALIGN_EPI) { if (wr == 0) PG8_BAR; }
        if constexpr (!Epi::AFTER_DRAIN) { E(acc, cur, wr, wc, fr, fq); S.done(cur); }
        if (!has_next) break;
#pragma unroll
        for (int a = 0; a < 2; ++a)
#pragma unroll
            for (int b = 0; b < 2; ++b)
#pragma unroll
                for (int m = 0; m < 4; ++m)
#pragma unroll
                    for (int n = 0; n < 2; ++n) acc[a][b][m][n] = (f32x4){0.f, 0.f, 0.f, 0.f};
        cur = nxt; cA = nA; cB = nB; ++ui;
        if constexpr (ALIGN_EPI) { if (wr == 1) PG8_BAR; }
    }
    PG8_WAIT_V(0);
    if constexpr (!ALIGN_EPI) { if (wr == 0) PG8_BAR; }
    PG8_BAR;
    if constexpr (Epi::AFTER_DRAIN) { E.fused(acc, cur, wr, wc, fr, fq, lds, wid, lane); S.done(cur); }
#undef PG8_SA
#undef PG8_SB
#undef PG8_STAGE
#undef PG8_LDA
#undef PG8_LDB
#undef PG8_MMA
#undef PG8_WAIT_V
#undef PG8_WAIT_L
#undef PG8_BAR
#undef PG8_SCHED
}
}

#define DI __device__ __forceinline__
#define LAS __attribute__((address_space(3)))
typedef unsigned short bf16;
typedef short bf16x8 __attribute__((ext_vector_type(8)));
typedef short s16x4 __attribute__((ext_vector_type(4)));
typedef short v4i16_t __attribute__((ext_vector_type(4)));
typedef float f32x4 __attribute__((ext_vector_type(4)));
typedef float f32x16 __attribute__((ext_vector_type(16)));
typedef unsigned u32x4 __attribute__((ext_vector_type(4)));
typedef unsigned u32x2 __attribute__((ext_vector_type(2)));
typedef float f32x2_t_ __attribute__((ext_vector_type(2)));

constexpr int DM = 2048, NB = 8, SEQ = 2048, DEPTH = 4, DBAT = 32, DSEQ = 64, PAST = 1024, BWIN = 512;
constexpr int NTP = NB * SEQ, NTS = DBAT * DSEQ, NTOK = NTP + NTS;
constexpr int INC = 7264, INP = 7424, DFF = 8192;
constexpr int C_AQ = 0, C_AK = 512, C_AV = 1024, C_IQ = 1536, C_IK = 2560, C_IW = 2624, C_BQ = 2640, C_BK = 3152, C_BV = 3664, C_CZ = 4176, C_XBC = 5200, C_DT = 7248;
constexpr float EPS = 1e-5f;
constexpr int NWAVES = 8, NTHR = 512;

constexpr size_t SZ_YP = (size_t)NTP * DM, SZ_YS = (size_t)NTS * DM;
constexpr size_t SZ_PAK = (size_t)DEPTH * NB * SEQ * 512, SZ_PKI = (size_t)DEPTH * NB * SEQ * 64, SZ_PBK = (size_t)DEPTH * NB * BWIN * 512;
constexpr size_t SZ_PSSM = (size_t)DEPTH * NB * 16 * 64 * 128, SZ_PCONV = (size_t)DEPTH * NB * 3 * 2048;
constexpr size_t SZ_SAK = (size_t)DEPTH * DBAT * DSEQ * 512, SZ_SKI = (size_t)DEPTH * DBAT * DSEQ * 64, SZ_SBK = SZ_SAK;
constexpr size_t SZ_SSSM = (size_t)DEPTH * DBAT * 16 * 64 * 128, SZ_SCONV = (size_t)DEPTH * DBAT * 3 * 2048;
constexpr size_t OFF_YP = 0, OFF_YS = OFF_YP + SZ_YP, OFF_P_AK = OFF_YS + SZ_YS, OFF_P_AV = OFF_P_AK + SZ_PAK, OFF_P_KI = OFF_P_AV + SZ_PAK,
                 OFF_P_BK = OFF_P_KI + SZ_PKI, OFF_P_BV = OFF_P_BK + SZ_PBK, OFF_P_SSM = OFF_P_BV + SZ_PBK, OFF_P_CONV = OFF_P_SSM + SZ_PSSM,
                 OFF_S_AK = OFF_P_CONV + SZ_PCONV, OFF_S_AV = OFF_S_AK + SZ_SAK, OFF_S_KI = OFF_S_AV + SZ_SAK, OFF_S_BK = OFF_S_KI + SZ_SKI,
                 OFF_S_BV = OFF_S_BK + SZ_SBK, OFF_S_SSM = OFF_S_BV + SZ_SBK, OFF_S_CONV = OFF_S_SSM + SZ_SSSM, OUT_TOTAL = OFF_S_CONV + SZ_SCONV;
static_assert(OUT_TOTAL == 165085184, "output size");

constexpr size_t MiB = 1u << 20;
constexpr size_t WS_CTL = 0, CTL_ZERO_BYTES = 1 * MiB;
constexpr size_t WS_ROPE = 1 * MiB;
constexpr size_t WS_W = 2 * MiB;
constexpr size_t W_IN_B = (size_t)INP * DM * 2, W_OUT_B = (size_t)DM * DM * 2, W_UP_B = (size_t)DFF * DM * 2, W_DN_B = (size_t)DM * DFF * 2, W_LAYER_B = W_IN_B + W_OUT_B + W_UP_B + W_DN_B;
static_assert(W_LAYER_B == 101 * MiB, "weights per layer");
constexpr size_t WS_X = WS_W + DEPTH * W_LAYER_B;
constexpr size_t WS_H = WS_X + (size_t)NTOK * DM * 4;
constexpr size_t WS_MIX = WS_H + (size_t)NTOK * DM * 2;
constexpr size_t WS_PU = WS_MIX + (size_t)NTOK * DM * 2;
constexpr size_t WS_XBC = WS_PU + (size_t)NTOK * DFF * 2;
constexpr size_t WS_G = WS_XBC + (size_t)NTOK * 2048 * 2;
constexpr size_t WS_DTS = WS_G + (size_t)NTOK * 1024 * 4;
constexpr size_t WS_CAK = WS_DTS + 2 * MiB;
constexpr size_t WS_CAV = WS_CAK + (size_t)DBAT * PAST * 512 * 2;
constexpr size_t WS_CBK = WS_CAV + (size_t)DBAT * PAST * 512 * 2;
constexpr size_t WS_CBV = WS_CBK + (size_t)DBAT * BWIN * 512 * 2;
constexpr size_t WS_CKI = WS_CBV + (size_t)DBAT * BWIN * 512 * 2;
constexpr size_t WS_SC = WS_CKI + (size_t)DBAT * PAST * 64 * 2;
constexpr size_t WS_SSQ1 = WS_SC + (size_t)256 * 64 * 2048 * 4, WS_SSQ2 = WS_SSQ1 + 3 * MiB;
constexpr size_t WS_END = WS_SSQ2 + 3 * MiB;
static_assert(WS_END == 1362 * MiB, "ws map");
constexpr int CW_BAR = 4096;
constexpr int LDS_ULIST = 147456;
constexpr int CW_H = 16384 + 64 * 64;
constexpr int CW_Q = 16384;

constexpr int RING_BYTES = 155648, LDSCTL_OFF = RING_BYTES, LDS_RSTD = 131072, LDS_BYTES = 157696;
constexpr int ATT_SEL = 0;
constexpr int ATT_K = 16384, KSTR = 1040, ATT_V = ATT_K + 2 * 32 * KSTR, VSTR = 1088, ATT_END = ATT_V + 2 * 32 * VSTR;
constexpr int CSTR = 272, XSTR = 144, MSTR = 144, HSTR = 272;
constexpr int SSD_CS = 0, SSD_BS = SSD_CS + 64 * CSTR, SSD_XD = SSD_BS + 64 * CSTR, SSD_XDW = SSD_XD + 64 * XSTR, SSD_MS = SSD_XDW + 64 * XSTR,
              SSD_HS = SSD_MS + 64 * MSTR, SSD_VEC = SSD_HS + 2 * 64 * HSTR, SSD_Y = SSD_VEC + 1024, YSTR = 272, SSD_Y2 = SSD_Y + 64 * YSTR, SSD_END = SSD_Y2 + 64 * YSTR;
static_assert(ATT_END <= RING_BYTES && SSD_END <= RING_BYTES, "phase scratch fits the ring region");

DI float bf2f(bf16 v) { return __uint_as_float(((unsigned)v) << 16); }
DI unsigned pk2(float lo, float hi) { return pg8::cvt_pk_bf16(lo, hi); }
DI bf16 f2bf(float f) { return (bf16)(pk2(f, 0.f) & 0xffffu); }
DI float wave_sum(float v) {
#pragma unroll
    for (int o = 1; o < 64; o <<= 1) v += __shfl_xor(v, o);
    return v;
}
DI f32x16 mfma32(bf16x8 a, bf16x8 b, f32x16 c) { return __builtin_amdgcn_mfma_f32_32x32x16_bf16(a, b, c, 0, 0, 0); }
DI int crow(int i, int hh) { return (i & 3) + 8 * (i >> 2) + 4 * hh; }
DI s16x4 tr_read(LAS unsigned char* p) { return __builtin_bit_cast(s16x4, __builtin_amdgcn_ds_read_tr16_b64_v4i16((LAS v4i16_t*)p)); }
DI bf16x8 trfrag(LAS unsigned char* tile, int stride, int k0, int c0, int lane) {
    const int i16 = lane & 15, qq = i16 >> 2, p = i16 & 3, g2 = (lane >> 4) & 1, hh = lane >> 5;
    LAS unsigned char* a = tile + (k0 + 8 * hh + qq) * stride + (c0 + 16 * g2 + 4 * p) * 2;
    const s16x4 lo = tr_read(a), hi = tr_read(a + 4 * stride);
    return __builtin_shufflevector(lo, hi, 0, 1, 2, 3, 4, 5, 6, 7);
}
DI void unpack8(u32x4 v, float (&f)[8]) {
#pragma unroll
    for (int i = 0; i < 4; ++i) { f[2 * i] = __uint_as_float(v[i] << 16); f[2 * i + 1] = __uint_as_float(v[i] & 0xffff0000u); }
}
DI u32x4 pack8(const float (&f)[8]) { u32x4 o; o.x = pk2(f[0], f[1]); o.y = pk2(f[2], f[3]); o.z = pk2(f[4], f[5]); o.w = pk2(f[6], f[7]); return o; }

#define XB_TMO      128
#define XB_XCNT(j)  (256  + 64 * (j))
#define XB_XSUB(j)  (1280 + 64 * (j))
#define XB_XGEN(j)  (2304 + 64 * (j))
#define XB_TOP      3328
#define XB_TOPGEN   3392
#define XCD_BAR_WORDS 3456
#define XB_SPIN_CAP (1u << 20)
DI unsigned xb_ld(unsigned* p)              { return __hip_atomic_load(p, __ATOMIC_RELAXED, __HIP_MEMORY_SCOPE_AGENT); }
DI unsigned xb_add(unsigned* p, unsigned v) { return __hip_atomic_fetch_add(p, v, __ATOMIC_RELAXED, __HIP_MEMORY_SCOPE_AGENT); }
DI unsigned xb_xcc_id() { return (unsigned)__builtin_amdgcn_s_getreg((3 << 11) | 20) & 0xFu; }
#define XB_SPIN(cond, bar) do { unsigned _sp = 0; while (cond) { __builtin_amdgcn_s_sleep(1); \
    if ((++_sp & 255u) == 0u) { if (xb_ld(&(bar)[XB_TMO])) break; if (_sp > XB_SPIN_CAP) { atomicAdd(&(bar)[XB_TMO], 1u); break; } } } } while (0)
struct XcdBarrier { unsigned* bar; unsigned x; volatile LAS unsigned* st; };
DI XcdBarrier xcd_barrier_post(unsigned* bar, volatile LAS unsigned* st) {
    XcdBarrier b; b.bar = bar; b.x = xb_xcc_id(); b.st = st;
    if (threadIdx.x == 0) (void)xb_add(&bar[XB_XCNT(b.x)], 1u);
    return b;
}
DI void xcd_barrier_complete(unsigned* bar, unsigned x, unsigned& nloc, unsigned& nx) {
    const unsigned G = gridDim.x * gridDim.y * gridDim.z;
    unsigned sum, cnt, mine, sp = 0u;
    for (;;) {
        sum = 0u; cnt = 0u; mine = 0u;
#pragma unroll
        for (unsigned j = 0; j < 16; ++j) { const unsigned c = xb_ld(&bar[XB_XCNT(j)]); sum += c; cnt += (c > 0u) ? 1u : 0u; mine = (j == x) ? c : mine; }
        if (sum == G) break;
        __builtin_amdgcn_s_sleep(1);
        if ((++sp & 255u) == 0u) { if (xb_ld(&bar[XB_TMO])) break; if (sp > XB_SPIN_CAP) { atomicAdd(&bar[XB_TMO], 1u); break; } }
    }
    nloc = mine > 0u ? mine : 1u; nx = cnt > 0u ? cnt : 1u;
}
DI void xcd_barrier(const XcdBarrier& b) {
    asm volatile("s_waitcnt vmcnt(0)" ::: "memory");
    __syncthreads();
    if (threadIdx.x == 0) {
        unsigned* bar = b.bar;
        __builtin_amdgcn_s_waitcnt(0);
        unsigned nloc = b.st[0], nx = b.st[1];
        if (nloc == 0u) { xcd_barrier_complete(bar, b.x, nloc, nx); b.st[0] = nloc; b.st[1] = nx; }
        const unsigned old = xb_add(&bar[XB_XSUB(b.x)], 1u);
        const unsigned gen = old / nloc;
        if (old + 1u == (gen + 1u) * nloc) {
            __builtin_amdgcn_fence(__ATOMIC_RELEASE, "agent");
            asm volatile("s_waitcnt vmcnt(0)" ::: "memory");
            const unsigned og = xb_add(&bar[XB_TOP], 1u);
            const unsigned tg = og / nx;
            if (og + 1u == (tg + 1u) * nx) xb_add(&bar[XB_TOPGEN], 1u);
            else XB_SPIN(xb_ld(&bar[XB_TOPGEN]) == tg, bar);
            __builtin_amdgcn_fence(__ATOMIC_ACQUIRE, "agent");
            xb_add(&bar[XB_XGEN(b.x)], 1u);
            asm volatile("s_waitcnt vmcnt(0)" ::: "memory");
        } else {
            XB_SPIN(xb_ld(&bar[XB_XGEN(b.x)]) == gen, bar);
            __builtin_amdgcn_fence(__ATOMIC_ACQUIRE, "agent");
            asm volatile("s_waitcnt vmcnt(0)" ::: "memory");
        }
    }
    __syncthreads();
}

struct Args { const float* in[23]; float* out; unsigned char* ws; int ph_lo, ph_hi; };
static_assert(sizeof(Args) == 23 * 8 + 8 + 8 + 8, "Args has no padding");
struct Ctx {
    LAS unsigned char* lds;
    unsigned* ctl;
    int tid, lane, wave, G, bid;
    float* out;
    unsigned char* ws;
};
DI bf16* ws_bf(const Ctx& C, size_t off) { return (bf16*)(C.ws + off); }
DI float* ws_f(const Ctx& C, size_t off) { return (float*)(C.ws + off); }
DI bf16* w_in_t(const Ctx& C, int l)  { return (bf16*)(C.ws + WS_W + (size_t)l * W_LAYER_B); }
DI bf16* w_out_t(const Ctx& C, int l) { return (bf16*)(C.ws + WS_W + (size_t)l * W_LAYER_B + W_IN_B); }
DI bf16* w_up_t(const Ctx& C, int l)  { return (bf16*)(C.ws + WS_W + (size_t)l * W_LAYER_B + W_IN_B + W_OUT_B); }
DI bf16* w_dn_t(const Ctx& C, int l)  { return (bf16*)(C.ws + WS_W + (size_t)l * W_LAYER_B + W_IN_B + W_OUT_B + W_UP_B); }

DI int q_prefetch(const Ctx& C, unsigned* head) { int v = 0; if (C.tid == 0) v = (int)__hip_atomic_fetch_add(head, 1u, __ATOMIC_RELAXED, __HIP_MEMORY_SCOPE_AGENT); return v; }
DI int q_publish(const Ctx& C, int v) {
    volatile LAS int* slot = (volatile LAS int*)(C.lds + LDSCTL_OFF + 64);
    __syncthreads();
    if (C.tid == 0) *slot = v;
    __syncthreads();
    return *slot;
}
DI int q_next(const Ctx& C, unsigned* head) {
    volatile LAS int* slot = (volatile LAS int*)(C.lds + LDSCTL_OFF + 64);
    __syncthreads();
    if (C.tid == 0) *slot = (int)__hip_atomic_fetch_add(head, 1u, __ATOMIC_RELAXED, __HIP_MEMORY_SCOPE_AGENT);
    __syncthreads();
    return *slot;
}

DI void wait_flags(const Ctx& C, unsigned* flg, int p0, int n) {
    if (C.tid == 0) { for (int p = p0; p < p0 + n; ++p) XB_SPIN(xb_ld(&flg[64 * p]) < 3u, C.ctl + CW_BAR); __builtin_amdgcn_fence(__ATOMIC_ACQUIRE, "agent"); }
    __syncthreads();
}
DI void p0_transpose_item(const float* W, int K, int N, bf16* WT, LAS float* scr, int item, int lane, const float* kscale = nullptr) {
    const int nblk = N / 32, kb = item / nblk, nb = item % nblk, k0 = 64 * kb, n0 = 32 * nb;
    float tv[32];
#pragma unroll
    for (int i = 0; i < 32; ++i) { const int kk = 2 * i + (lane >> 5); tv[i] = W[(size_t)(k0 + kk) * N + n0 + (lane & 31)]; }
#pragma unroll
    for (int i = 0; i < 32; ++i) { const int kk = 2 * i + (lane >> 5); const float sc = kscale ? kscale[k0 + kk] : 1.0f; scr[kk * 33 + (lane & 31)] = tv[i] * sc; }
    asm volatile("s_waitcnt lgkmcnt(0)" ::: "memory");
    const int c = lane & 7;
#pragma unroll
    for (int j = 0; j < 4; ++j) { const int n = (lane >> 3) + 8 * j; const LAS float* s = scr + (8 * c) * 33 + n;
        u32x4 o; o.x = pk2(s[0 * 33], s[1 * 33]); o.y = pk2(s[2 * 33], s[3 * 33]); o.z = pk2(s[4 * 33], s[5 * 33]); o.w = pk2(s[6 * 33], s[7 * 33]);
        *(u32x4*)(WT + (size_t)(n0 + n) * K + k0 + 8 * c) = o; }
    asm volatile("s_waitcnt lgkmcnt(0)" ::: "memory");
}
DI void row_ssq_slots(float ss, float* slots, int lane) { if (lane < 32) slots[lane] = lane == 0 ? ss : 0.f; }
DI void p0_row(const float* src, bf16* xrow, float* slots, int lane) {
    float ss = 0.f;
#pragma unroll
    for (int j = 0; j < 4; ++j) { const f32x4 a = ((const f32x4*)src)[2 * (lane + 64 * j)], b = ((const f32x4*)src)[2 * (lane + 64 * j) + 1];
        ss += (a.x * a.x + a.y * a.y) + (a.z * a.z + a.w * a.w) + (b.x * b.x + b.y * b.y) + (b.z * b.z + b.w * b.w);
        u32x4 o; o.x = pk2(a.x, a.y); o.y = pk2(a.z, a.w); o.z = pk2(b.x, b.y); o.w = pk2(b.z, b.w); ((u32x4*)xrow)[lane + 64 * j] = o; }
    row_ssq_slots(wave_sum(ss), slots, lane);
}
DI void res_row(bf16* xrow, const float* part, size_t pstride, int mode, float* slots, const float* w, float* outf, int lane) {
    float v[4][8]; float ss = 0.f;
#pragma unroll
    for (int j = 0; j < 4; ++j) { unpack8(((const u32x4*)xrow)[lane + 64 * j], v[j]);
        if (part) {
#pragma unroll
            for (int k = 0; k < 4; ++k) { const float* pp = part + k * pstride + 8 * (lane + 64 * j); const f32x4 a = *(const f32x4*)pp, b = *(const f32x4*)(pp + 4);
                v[j][0] += a.x; v[j][1] += a.y; v[j][2] += a.z; v[j][3] += a.w; v[j][4] += b.x; v[j][5] += b.y; v[j][6] += b.z; v[j][7] += b.w; } }
#pragma unroll
        for (int k = 0; k < 8; ++k) ss += v[j][k] * v[j][k]; }
    ss = wave_sum(ss);
    if (mode == 0) {
#pragma unroll
        for (int j = 0; j < 4; ++j) ((u32x4*)xrow)[lane + 64 * j] = pack8(v[j]);
        row_ssq_slots(ss, slots, lane);
    } else {
        const float rs = 1.0f / sqrtf(ss * (1.0f / DM) + EPS);
#pragma unroll
        for (int j = 0; j < 4; ++j) { const float* wp = w + 8 * (lane + 64 * j); const f32x4 w0 = *(const f32x4*)wp, w1 = *(const f32x4*)(wp + 4); float* op = outf + 8 * (lane + 64 * j);
            *(f32x4*)op = (f32x4){v[j][0] * rs * w0.x, v[j][1] * rs * w0.y, v[j][2] * rs * w0.z, v[j][3] * rs * w0.w};
            *(f32x4*)(op + 4) = (f32x4){v[j][4] * rs * w1.x, v[j][5] * rs * w1.y, v[j][6] * rs * w1.z, v[j][7] * rs * w1.w}; }
    }
}
DI void sincos_tab(float ang, float& c, float& s) {
    const double a = (double)ang; const double kq = rint(a * 0.63661977236758134308); const double x = a - kq * 1.57079632679489661923; const double x2 = x * x;
    const double sn = x * (1.0 + x2 * (-1.0 / 6 + x2 * (1.0 / 120 + x2 * (-1.0 / 5040 + x2 * (1.0 / 362880 + x2 * (-1.0 / 39916800 + x2 * (1.0 / 6227020800.0)))))));
    const double cn = 1.0 + x2 * (-0.5 + x2 * (1.0 / 24 + x2 * (-1.0 / 720 + x2 * (1.0 / 40320 + x2 * (-1.0 / 3628800 + x2 * (1.0 / 479001600 + x2 * (-1.0 / 87178291200.0)))))));
    const int q = ((int)kq) & 3;
    const double cc = (q == 0) ? cn : (q == 1) ? -sn : (q == 2) ? -cn : sn;
    const double sc = (q == 0) ? sn : (q == 1) ? cn : (q == 2) ? -sn : -cn;
    c = (float)cc; s = (float)sc;
}
constexpr int I_IN = (DM / 64) * (INC / 32), I_OUT = (DM / 64) * (DM / 32), I_UP = (DM / 64) * (DFF / 32), I_DN = (DFF / 64) * (DM / 32), I_L = I_IN + I_OUT + I_UP + I_DN;
static_assert(I_L % 8 == 0, "items per layer in groups of 8 waves");
DI void wconv_item(const Ctx& C, const Args& A, int l, int r, LAS float* scr) {
    if (r < I_IN) { p0_transpose_item(A.in[10] + (size_t)l * DM * INC, DM, INC, w_in_t(C, l), scr, r, C.lane, A.in[9] + (size_t)l * DM); return; } r -= I_IN;
    if (r < I_OUT) { p0_transpose_item(A.in[11] + (size_t)l * DM * DM, DM, DM, w_out_t(C, l), scr, r, C.lane); return; } r -= I_OUT;
    if (r < I_UP) { p0_transpose_item(A.in[20] + (size_t)l * DM * DFF, DM, DFF, w_up_t(C, l), scr, r, C.lane, A.in[19] + (size_t)l * DM); return; } r -= I_UP;
    p0_transpose_item(A.in[21] + (size_t)l * DFF * DM, DFF, DM, w_dn_t(C, l), scr, r, C.lane);
}
DI void wconv_some(const Ctx& C, const Args& A, int l, int max_entries) {
    unsigned* head = C.ctl + CW_Q + 64 * (40 + l);
    LAS float* scr = (LAS float*)(C.lds + C.wave * 16384);
    for (int n = 0; n < max_entries; ++n) { const int e = q_next(C, head); if (e >= I_L / 8) break; wconv_item(C, A, l, e * 8 + C.wave, scr); }
}
DI void p0_prologue(const Ctx& C, const Args& A) {
    LAS float* scr = (LAS float*)(C.lds + C.wave * 16384);
    const int gw = C.bid * NWAVES + C.wave, NGW = C.G * NWAVES;
    for (int it = gw; it < DEPTH * I_L; it += NGW) wconv_item(C, A, it / I_L, it % I_L, scr);
    { const int gt = C.bid * NTHR + C.tid, NGT = C.G * NTHR; constexpr int CH_L = (INP - INC) * DM / 8;
      for (int i = gt; i < DEPTH * CH_L; i += NGT) { const int l = i / CH_L, c = i % CH_L; ((u32x4*)(w_in_t(C, l) + (size_t)INC * DM))[c] = (u32x4){0u, 0u, 0u, 0u}; }
      float* ra = ws_f(C, WS_ROPE); float* ri = ra + 2048 * 16 * 2;
      for (int i = gt; i < 2048 * 24; i += NGT) { const int pos = i / 24, k = i % 24; const bool isa = k < 16; const int fi = isa ? k : k - 16;
          const double ex = isa ? (double)fi / 16.0 : (double)fi / 8.0; const float inv = (float)exp2(-ex * 18.931568569324174  );
          const float ang = (float)pos * inv; float c, s; sincos_tab(ang, c, s);
          float* dst = isa ? ra + (pos * 16 + fi) * 2 : ri + (pos * 8 + fi) * 2; dst[0] = c; dst[1] = s; } }
    for (int m = gw; m < NTOK; m += NGW) { const float* src = m < NTP ? A.in[0] + (size_t)m * DM : A.in[1] + (size_t)(m - NTP) * DM;
        p0_row(src, ws_bf(C, WS_X) + (size_t)m * DM, ws_f(C, WS_SSQ1) + (size_t)m * 32, C.lane); }
}

struct M0Row { unsigned ra1, ra2, ri1, ri2, rk1, rk2; u32x4 cak, cav, cik, cbk, cbv, xb[4]; f32x4 tA, tI; bf16 dt; };
DI void m0_decode(int r, bool& smp, int& b, int& t, int& pos) { smp = r >= NTP; if (!smp) { b = r >> 11; t = r & 2047; pos = t; } else { const int rr = r - NTP; b = rr >> 6; t = rr & 63; pos = PAST + t; } }
DI void m0_load(const Ctx& C, int r, int lane, M0Row& R) {
    const bf16* P = ws_bf(C, WS_PU) + (size_t)r * INP;
    bool smp; int b, t, pos; m0_decode(r, smp, b, t, pos);
    { const int h8 = lane >> 3, j = lane & 7; const bf16* p = P + (h8 < 4 ? C_AQ + h8 * 128 : C_AK + (h8 - 4) * 128) + 2 * j; R.ra1 = *(const unsigned*)p; R.ra2 = *(const unsigned*)(p + 16); }
    { const int h16 = lane >> 2, j = lane & 3; const bf16* p = P + C_IQ + h16 * 64 + 2 * j; R.ri1 = *(const unsigned*)p; R.ri2 = *(const unsigned*)(p + 8); }
    if (lane < 4) { const bf16* p = P + C_IK + 2 * lane; R.rk1 = *(const unsigned*)p; R.rk2 = *(const unsigned*)(p + 8); }
    if (lane < 48) R.cak = *(const u32x4*)(P + C_AK + (lane / 12) * 128 + 32 + (lane % 12) * 8);
    R.cav = *(const u32x4*)(P + C_AV + lane * 8);
    if (lane >= 8 && lane < 14) R.cik = *(const u32x4*)(P + C_IK + 16 + (lane - 8) * 8);
    if (smp || t >= SEQ - BWIN) { R.cbk = *(const u32x4*)(P + C_BK + lane * 8); R.cbv = *(const u32x4*)(P + C_BV + lane * 8); }
    if (lane < 16) R.dt = P[C_DT + lane];
#pragma unroll
    for (int it = 0; it < 4; ++it) R.xb[it] = *(const u32x4*)(P + C_XBC + (lane + 64 * it) * 8);
    R.tA = *(const f32x4*)(ws_f(C, WS_ROPE) + (size_t)pos * 32 + 4 * (lane & 7));
    R.tI = *(const f32x4*)(ws_f(C, WS_ROPE) + 2048 * 32 + (size_t)pos * 16 + 4 * (lane & 3));
}
DI void rope2(unsigned a, unsigned bq, f32x4 t, float (&y1)[2], float (&y2)[2]) {
    const float a0 = __uint_as_float(a << 16), a1 = __uint_as_float(a & 0xffff0000u), b0 = __uint_as_float(bq << 16), b1 = __uint_as_float(bq & 0xffff0000u);
    y1[0] = a0 * t.x - b0 * t.y; y2[0] = b0 * t.x + a0 * t.y; y1[1] = a1 * t.z - b1 * t.w; y2[1] = b1 * t.z + a1 * t.w;
}
DI void st8f(float* dst, u32x4 v) { float f[8]; unpack8(v, f); __builtin_nontemporal_store((f32x4){f[0], f[1], f[2], f[3]}, (f32x4*)dst); __builtin_nontemporal_store((f32x4){f[4], f[5], f[6], f[7]}, (f32x4*)dst + 1); }
DI void m0_window(const Ctx& C, const Args& A, int l, int r, int lane, u32x4 (&wnd)[3][4]) {
    bool smp; int b, t, pos; m0_decode(r, smp, b, t, pos);
#pragma unroll
    for (int k = 1; k <= 3; ++k) { const int tt = t - k;
#pragma unroll
        for (int it = 0; it < 4; ++it) { const int ch = (lane + 64 * it) * 8; u32x4 v = (u32x4){0u, 0u, 0u, 0u};
            if (tt >= 0) v = *(const u32x4*)(ws_bf(C, WS_PU) + (size_t)(r - k) * INP + C_XBC + ch);
            else if (smp) { const float* sp = A.in[8] + ((size_t)(l * DBAT + b) * 3 + (3 + tt)) * 2048 + ch; const f32x4 s0 = *(const f32x4*)sp, s1 = *(const f32x4*)(sp + 4);
                v.x = pk2(s0.x, s0.y); v.y = pk2(s0.z, s0.w); v.z = pk2(s1.x, s1.y); v.w = pk2(s1.z, s1.w); }
            wnd[3 - k][it] = v; } }
}
DI void m0_process(const Ctx& C, const Args& A, int l, int r, int lane, const M0Row& R, u32x4 (&wnd)[3][4], const LAS float* cwL, const LAS float* cbL) {
    bf16* P = ws_bf(C, WS_PU) + (size_t)r * INP;
    bool smp; int b, t, pos; m0_decode(r, smp, b, t, pos);
    float* out = C.out;
    float* o_ak = smp ? out + OFF_S_AK + ((size_t)(l * DBAT + b) * DSEQ + t) * 512 : out + OFF_P_AK + ((size_t)(l * NB + b) * SEQ + t) * 512;
    float* o_av = smp ? out + OFF_S_AV + ((size_t)(l * DBAT + b) * DSEQ + t) * 512 : out + OFF_P_AV + ((size_t)(l * NB + b) * SEQ + t) * 512;
    float* o_ki = smp ? out + OFF_S_KI + ((size_t)(l * DBAT + b) * DSEQ + t) * 64 : out + OFF_P_KI + ((size_t)(l * NB + b) * SEQ + t) * 64;
    float y1[2], y2[2];
    { const int h8 = lane >> 3, j = lane & 7; rope2(R.ra1, R.ra2, R.tA, y1, y2);
      bf16* p = P + (h8 < 4 ? C_AQ + h8 * 128 : C_AK + (h8 - 4) * 128) + 2 * j; *(unsigned*)p = pk2(y1[0], y1[1]); *(unsigned*)(p + 16) = pk2(y2[0], y2[1]);
      if (h8 >= 4) { float* o = o_ak + (h8 - 4) * 128 + 2 * j; *(f32x2_t_*)o = (f32x2_t_){y1[0], y1[1]}; *(f32x2_t_*)(o + 16) = (f32x2_t_){y2[0], y2[1]}; } }
    { const int h16 = lane >> 2, j = lane & 3; rope2(R.ri1, R.ri2, R.tI, y1, y2);
      bf16* p = P + C_IQ + h16 * 64 + 2 * j; *(unsigned*)p = pk2(y1[0], y1[1]); *(unsigned*)(p + 8) = pk2(y2[0], y2[1]); }
    if (lane < 4) { rope2(R.rk1, R.rk2, R.tI, y1, y2);
      bf16* p = P + C_IK + 2 * lane; *(unsigned*)p = pk2(y1[0], y1[1]); *(unsigned*)(p + 8) = pk2(y2[0], y2[1]);
      float* o = o_ki + 2 * lane; *(f32x2_t_*)o = (f32x2_t_){y1[0], y1[1]}; *(f32x2_t_*)(o + 8) = (f32x2_t_){y2[0], y2[1]}; }
    if (lane < 48) st8f(o_ak + (lane / 12) * 128 + 32 + (lane % 12) * 8, R.cak);
    st8f(o_av + lane * 8, R.cav);
    if (lane >= 8 && lane < 14) st8f(o_ki + 16 + (lane - 8) * 8, R.cik);
    if (smp || t >= SEQ - BWIN) {
        const size_t ro = smp ? ((size_t)(l * DBAT + b) * DSEQ + t) * 512 : ((size_t)(l * NB + b) * BWIN + (t - (SEQ - BWIN))) * 512;
        st8f(out + (smp ? OFF_S_BK : OFF_P_BK) + ro + lane * 8, R.cbk); st8f(out + (smp ? OFF_S_BV : OFF_P_BV) + ro + lane * 8, R.cbv);
    }
    if (lane < 16) { const float x = bf2f(R.dt) + A.in[15][l * 16 + lane]; ws_f(C, WS_DTS)[(size_t)r * 16 + lane] = x > 20.f ? x : log1pf(__expf(x)); }
    const int stt = smp ? DSEQ - 3 : SEQ - 3;
    float* o_conv = (t >= stt) ? (smp ? out + OFF_S_CONV + ((size_t)(l * DBAT + b) * 3 + (t - stt)) * 2048 : out + OFF_P_CONV + ((size_t)(l * NB + b) * 3 + (t - stt)) * 2048) : nullptr;
    bf16* xo = ws_bf(C, WS_XBC) + (size_t)r * 2048;
#pragma unroll
    for (int it = 0; it < 4; ++it) { const int ch = (lane + 64 * it) * 8;
        float acc[8], x[8];
        { const f32x4 b0 = *(const LAS f32x4*)(cbL + ch), b1 = *(const LAS f32x4*)(cbL + ch + 4); acc[0] = b0.x; acc[1] = b0.y; acc[2] = b0.z; acc[3] = b0.w; acc[4] = b1.x; acc[5] = b1.y; acc[6] = b1.z; acc[7] = b1.w; }
#pragma unroll
        for (int j = 0; j < 4; ++j) { unpack8(j < 3 ? wnd[j][it] : R.xb[it], x);
            const f32x4 w0 = *(const LAS f32x4*)(cwL + j * 2048 + ch), w1 = *(const LAS f32x4*)(cwL + j * 2048 + ch + 4);
            acc[0] += x[0] * w0.x; acc[1] += x[1] * w0.y; acc[2] += x[2] * w0.z; acc[3] += x[3] * w0.w; acc[4] += x[4] * w1.x; acc[5] += x[5] * w1.y; acc[6] += x[6] * w1.z; acc[7] += x[7] * w1.w; }
        if (o_conv) { ((f32x4*)(o_conv + ch))[0] = (f32x4){x[0], x[1], x[2], x[3]}; ((f32x4*)(o_conv + ch))[1] = (f32x4){x[4], x[5], x[6], x[7]}; }
#pragma unroll
        for (int k = 0; k < 8; ++k) acc[k] = acc[k] / (1.f + __expf(-acc[k]));
        *(u32x4*)(xo + ch) = pack8(acc);
        wnd[0][it] = wnd[1][it]; wnd[1][it] = wnd[2][it]; wnd[2][it] = R.xb[it];
        asm volatile("" ::: "memory");
    }
}
DI void cvt_f4(const float* src, bf16* dst, size_t n4, size_t gt, size_t ngt) {
    size_t i = gt;
    for (; i + 3 * ngt < n4; i += 4 * ngt) { f32x4 v[4];
#pragma unroll
        for (int k = 0; k < 4; ++k) v[k] = ((const f32x4*)src)[i + k * ngt];
#pragma unroll
        for (int k = 0; k < 4; ++k) { u32x2 o; o.x = pk2(v[k].x, v[k].y); o.y = pk2(v[k].z, v[k].w); ((u32x2*)dst)[i + k * ngt] = o; } }
    for (; i < n4; i += ngt) { const f32x4 v = ((const f32x4*)src)[i]; u32x2 o; o.x = pk2(v.x, v.y); o.y = pk2(v.z, v.w); ((u32x2*)dst)[i] = o; }
}
constexpr int CV_CH = 4096;
constexpr int CV_N0 = DBAT * PAST * 512 / 4 / CV_CH, CV_N2 = DBAT * PAST * 64 / 4 / CV_CH, CV_N3 = DBAT * BWIN * 512 / 4 / CV_CH, CV_TOTAL = 2 * CV_N0 + CV_N2 + 2 * CV_N3;
DI void cvt_chunk(const float* src, bf16* dst, int chunk, int tid) {
    const size_t base = (size_t)chunk * CV_CH; f32x4 v[8];
#pragma unroll
    for (int k = 0; k < 8; ++k) v[k] = ((const f32x4*)src)[base + tid + 512 * k];
#pragma unroll
    for (int k = 0; k < 8; ++k) { u32x2 o; o.x = pk2(v[k].x, v[k].y); o.y = pk2(v[k].z, v[k].w); ((u32x2*)dst)[base + tid + 512 * k] = o; }
}
DI void cache_convert(const Ctx& C, const Args& A, int l) {
    unsigned* head = C.ctl + CW_Q + 64 * (32 + l);
    int cq = q_next(C, head);
    while (cq < CV_TOTAL) { const int nx = q_prefetch(C, head); int c = cq;
        if (c < CV_N0) cvt_chunk(A.in[2] + (size_t)l * DBAT * PAST * 512, ws_bf(C, WS_CAK), c, C.tid);
        else { c -= CV_N0;
            if (c < CV_N0) cvt_chunk(A.in[3] + (size_t)l * DBAT * PAST * 512, ws_bf(C, WS_CAV), c, C.tid);
            else { c -= CV_N0;
                if (c < CV_N2) cvt_chunk(A.in[4] + (size_t)l * DBAT * PAST * 64, ws_bf(C, WS_CKI), c, C.tid);
                else { c -= CV_N2;
                    if (c < CV_N3) cvt_chunk(A.in[5] + (size_t)l * DBAT * BWIN * 512, ws_bf(C, WS_CBK), c, C.tid);
                    else cvt_chunk(A.in[6] + (size_t)l * DBAT * BWIN * 512, ws_bf(C, WS_CBV), c - CV_N3, C.tid); } } }
        cq = q_publish(C, nx); }
}
DI void m0_phase(const Ctx& C, const Args& A, int l) {
    LAS float* cwL = (LAS float*)C.lds; LAS float* cbL = cwL + 4 * 2048;
    { const float* cw = A.in[13] + (size_t)l * 4 * 2048; const float* cb = A.in[14] + (size_t)l * 2048;
      for (int i = C.tid; i < 2048; i += NTHR) ((LAS f32x4*)cwL)[i] = ((const f32x4*)cw)[i];
      for (int i = C.tid; i < 512; i += NTHR) ((LAS f32x4*)cbL)[i] = ((const f32x4*)cb)[i]; }
    __syncthreads();
    const int gw = C.bid * NWAVES + C.wave, NGW = C.G * NWAVES, per = (NTOK + NGW - 1) / NGW;
    const int r0 = gw * per, r1 = (r0 + per < NTOK) ? r0 + per : NTOK;
    if (r0 < r1) {
        u32x4 wnd[3][4]; M0Row cur, nxt;
        m0_load(C, r0, C.lane, cur); m0_window(C, A, l, r0, C.lane, wnd);
#pragma unroll 1
        for (int r = r0; r < r1; ++r) {
            if (r + 1 < r1) m0_load(C, r + 1, C.lane, nxt);
            if (r != r0) { bool smp; int b, t, pos; m0_decode(r, smp, b, t, pos); if (t == 0) m0_window(C, A, l, r, C.lane, wnd); }
            m0_process(C, A, l, r, C.lane, cur, wnd, cwL, cbL);
            cur = nxt;
        }
    }
}

struct KVSrc { const bf16* k0; const bf16* v0; int s0; int n0; const bf16* k1; const bf16* v1; int s1; };
template <int MODE>
DI void attn_unit(const Ctx& C, const bf16* Qp, int qstride, const KVSrc& S, int tile_lo, int tile_hi, bf16* Op, int ostride) {
    int tid = C.tid, lane = C.lane; asm volatile("" : "+v"(tid), "+v"(lane));
    const int w = C.wave, r = lane & 31, hh = lane >> 5;
    const int head = w >> 1, q = (w & 1) * 32 + r;
    LAS unsigned char* Ks = C.lds + ATT_K; LAS unsigned char* Vs = C.lds + ATT_V;
    bf16x8 qf[8];
    { const bf16* qrow = Qp + (size_t)q * qstride + head * 128 + 8 * hh;
#pragma unroll
      for (int ks = 0; ks < 8; ++ks) qf[ks] = *(const bf16x8*)(qrow + 16 * ks); }
    f32x16 o[4];
#pragma unroll
    for (int d = 0; d < 4; ++d)
#pragma unroll
        for (int i = 0; i < 16; ++i) o[d][i] = 0.f;
    float m = -1e30f, lsum = 0.f;
    constexpr float SC2 = 0.08838834764831845f * 1.4426950408889634f;
    constexpr float L2E = 1.4426950408889634f;
    u32x4 kr[4], vr[4];
#define ATT_LOAD(tile_) do { const int k0_ = (tile_) * 32; const bool first_ = k0_ < S.n0; const int st_ = first_ ? S.s0 : S.s1; \
        const bf16* kb_ = (first_ ? S.k0 + (ptrdiff_t)k0_ * S.s0 : S.k1 + (ptrdiff_t)(k0_ - S.n0) * S.s1) + (ptrdiff_t)(tid >> 6) * st_ + (tid & 63) * 8; \
        const bf16* vb_ = (first_ ? S.v0 + (ptrdiff_t)k0_ * S.s0 : S.v1 + (ptrdiff_t)(k0_ - S.n0) * S.s1) + (ptrdiff_t)(tid >> 6) * st_ + (tid & 63) * 8; \
        _Pragma("unroll") for (int i_ = 0; i_ < 4; ++i_) { kr[i_] = *(const u32x4*)(kb_ + (ptrdiff_t)(8 * i_) * st_); vr[i_] = *(const u32x4*)(vb_ + (ptrdiff_t)(8 * i_) * st_); } } while (0)
#define ATT_STORE(buf_) do { _Pragma("unroll") for (int i_ = 0; i_ < 4; ++i_) { const int ci_ = tid + 512 * i_, row_ = ci_ >> 6, ch_ = ci_ & 63; \
        *(LAS u32x4*)(Ks + (buf_) * (32 * KSTR) + row_ * KSTR + ch_ * 16) = kr[i_]; *(LAS u32x4*)(Vs + (buf_) * (32 * VSTR) + row_ * VSTR + ch_ * 16) = vr[i_]; } } while (0)
    ATT_LOAD(tile_lo);
    __syncthreads();
    ATT_STORE(0);
    if (tile_lo + 1 < tile_hi) ATT_LOAD(tile_lo + 1);
    __syncthreads();
    const int i16 = lane & 15;
    LAS unsigned char* vbase = Vs + (4 * hh + (i16 >> 2)) * VSTR + (head * 128 + 16 * ((lane >> 4) & 1) + 4 * (i16 & 3)) * 2;
    LAS unsigned char* kbase = Ks + r * KSTR + head * 256 + hh * 16;
    const LAS float* btab = (const LAS float*)(C.lds + ATT_SEL) + head * 257;
    const LAS unsigned* sel = (const LAS unsigned*)(C.lds + ATT_SEL) + q * 64;
#pragma unroll 1
    for (int tile = tile_lo; tile < tile_hi; ++tile) {
        const int cur = (tile - tile_lo) & 1;
        if (tile + 1 < tile_hi) { ATT_STORE(cur ^ 1); if (tile + 2 < tile_hi) ATT_LOAD(tile + 2); }
        f32x16 s;
        if (MODE == 0) {
            const unsigned nwd = ~(sel[tile] >> (4 * hh));
#pragma unroll
            for (int i = 0; i < 16; ++i) { int mb; asm("v_bfe_i32 %0, %1, %2, 1" : "=v"(mb) : "v"(nwd), "n"((i & 3) + 8 * (i >> 2))); s[i] = __int_as_float(mb & (int)0xFF800000); }
        } else {
            if (tile <= 11) { const float bb = btab[256] * (L2E / SC2);
#pragma unroll
                for (int i = 0; i < 16; ++i) s[i] = bb;
            } else {
#pragma unroll
                for (int i = 0; i < 16; ++i) { int rel = BWIN + q - (tile * 32 + crow(i, hh)); rel = rel > 128 ? 128 : rel; s[i] = btab[rel + 128] * (L2E / SC2); }
            }
        }
        { bf16x8 kf[8]; LAS unsigned char* kb = kbase + cur * (32 * KSTR);
#pragma unroll
          for (int ks = 0; ks < 8; ++ks) kf[ks] = *(const LAS bf16x8*)(kb + ks * 32);
#pragma unroll
          for (int ks = 0; ks < 8; ++ks) s = mfma32(kf[ks], qf[ks], s); }
        float mx = s[0];
#pragma unroll
        for (int i = 1; i < 16; ++i) mx = fmaxf(mx, s[i]);
        mx *= SC2;
        if (__any(mx > m + 8.0f)) {
            const auto rr = __builtin_amdgcn_permlane32_swap(__float_as_uint(mx), __float_as_uint(mx), false, false);
            const float mxs = fmaxf(__uint_as_float(rr[0]), __uint_as_float(rr[1]));
            const float mn = (mxs > m + 8.0f) ? mxs : m, alpha = __builtin_amdgcn_exp2f(m - mn);
            lsum *= alpha; m = mn;
#pragma unroll
            for (int d = 0; d < 4; ++d)
#pragma unroll
                for (int i = 0; i < 16; ++i) o[d][i] *= alpha;
        }
#pragma unroll
        for (int i = 0; i < 16; ++i) { s[i] = __builtin_amdgcn_exp2f(__builtin_fmaf(s[i], SC2, -m)); lsum += s[i]; }
        bf16x8 pf[2];
#pragma unroll
        for (int s2 = 0; s2 < 2; ++s2) { u32x4 pk; pk.x = pk2(s[8 * s2], s[8 * s2 + 1]); pk.y = pk2(s[8 * s2 + 2], s[8 * s2 + 3]); pk.z = pk2(s[8 * s2 + 4], s[8 * s2 + 5]); pk.w = pk2(s[8 * s2 + 6], s[8 * s2 + 7]);
            pf[s2] = __builtin_bit_cast(bf16x8, pk); }
        LAS unsigned char* vb = vbase + cur * (32 * VSTR);
#pragma unroll
        for (int dh = 0; dh < 2; ++dh) {
            s16x4 lo[2][2], hi[2][2];
#pragma unroll
            for (int d2 = 0; d2 < 2; ++d2)
#pragma unroll
                for (int s2 = 0; s2 < 2; ++s2) { lo[d2][s2] = tr_read(vb + (16 * s2) * VSTR + (2 * dh + d2) * 64); hi[d2][s2] = tr_read(vb + (16 * s2 + 8) * VSTR + (2 * dh + d2) * 64); }
#pragma unroll
            for (int d2 = 0; d2 < 2; ++d2)
#pragma unroll
                for (int s2 = 0; s2 < 2; ++s2) { const bf16x8 vt = __builtin_shufflevector(lo[d2][s2], hi[d2][s2], 0, 1, 2, 3, 4, 5, 6, 7); o[2 * dh + d2] = mfma32(vt, pf[s2], o[2 * dh + d2]); }
        }
        __syncthreads();
    }
#undef ATT_LOAD
#undef ATT_STORE
    { const auto rr = __builtin_amdgcn_permlane32_swap(__float_as_uint(lsum), __float_as_uint(lsum), false, false); lsum = __uint_as_float(rr[0]) + __uint_as_float(rr[1]); }
    const float inv = 1.0f / lsum;
    bf16* orow = Op + (size_t)q * ostride + head * 128 + 4 * hh;
#pragma unroll
    for (int d = 0; d < 4; ++d)
#pragma unroll
        for (int g = 0; g < 4; ++g) { u32x2 p; p.x = pk2(o[d][4 * g] * inv, o[d][4 * g + 1] * inv); p.y = pk2(o[d][4 * g + 2] * inv, o[d][4 * g + 3] * inv);
            *(u32x2*)(orow + 32 * d + 8 * g) = p; }
}

DI float relu_i(float x) { const int v = __float_as_int(x); return __int_as_float(v > 0 ? v : 0); }
DI unsigned fkey(float f) { const int u = __float_as_int(f); return (unsigned)(u ^ ((u >> 31) | (int)0x80000000)); }
DI void bt32(unsigned (&a)[32]) {
#pragma unroll
    for (int s = 0; s < 5; ++s) { const int j = 16 >> s;
        const unsigned m = s == 0 ? 0x0000FFFFu : s == 1 ? 0x00FF00FFu : s == 2 ? 0x0F0F0F0Fu : s == 3 ? 0x33333333u : 0x55555555u;
#pragma unroll
        for (int k = 0; k < 32; ++k) if ((k & j) == 0) {
            const unsigned x = a[k], y = a[k + j];
            a[k] = (x & m) | ((y << j) & ~m);
            a[k + j] = ((x >> j) & m) | (y & ~m); } }
}
template <int NR>
DI void topk_pair(const float* SCq  , LAS unsigned* SELa  , int NT, int r, int hh, int lane) {
    constexpr int NBLK = NR / 32;
    unsigned P[NBLK][32];
#pragma unroll
    for (int b = 0; b < NBLK; ++b)
#pragma unroll
        for (int i = 0; i < 32; ++i) { const int idx = b * 32 + i; const float f = SCq[idx * 32 + r]; P[b][i] = (idx < NT) ? fkey(f) : 0u; }
#pragma unroll
    for (int b = 0; b < NBLK; ++b) bt32(P[b]);
    unsigned L[NBLK], G[NBLK], cg = 0u; bool done = false;
#pragma unroll
    for (int b = 0; b < NBLK; ++b) { L[b] = 0xffffffffu; G[b] = 0u; }
#pragma unroll
    for (int bit = 31; bit >= 8; --bit) {
        if (__all(done)) break;
        unsigned X[NBLK], c = cg;
#pragma unroll
        for (int b = 0; b < NBLK; ++b) { X[b] = L[b] & P[b][bit]; c += __popc(X[b]); }
        int x = (int)c;
        x += __builtin_amdgcn_update_dpp(0, x, 0x111, 0xf, 0xf, true);
        x += __builtin_amdgcn_update_dpp(0, x, 0x112, 0xf, 0xf, true);
        x += __builtin_amdgcn_update_dpp(0, x, 0x114, 0xf, 0xf, true);
        x += __builtin_amdgcn_update_dpp(0, x, 0x118, 0xf, 0xf, true);
        x += __builtin_amdgcn_update_dpp(0, x, 0x142, 0xa, 0xf, true);
        const unsigned t0 = (unsigned)__builtin_amdgcn_readlane(x, 31), t1 = (unsigned)__builtin_amdgcn_readlane(x, 63);
        const unsigned tot = hh ? t1 : t0;
        const bool ge = tot >= 256u;
        if (!done) {
#pragma unroll
            for (int b = 0; b < NBLK; ++b) { const unsigned l0 = L[b], g0 = G[b]; L[b] = ge ? X[b] : (l0 ^ X[b]); G[b] = ge ? g0 : (g0 | X[b]); }
            cg = ge ? cg : c; }
        if (tot == 256u) done = true;
    }
#pragma unroll
    for (int i = 0; i < NR; ++i) { const unsigned S = G[i >> 5] | L[i >> 5]; unsigned long long mk = __ballot((S >> (i & 31)) & 1u); if (i >= NT) mk = 0ull;
        if (lane == 0) { SELa[i] = (unsigned)mk; SELa[64 + i] = (unsigned)(mk >> 32); } }
}
DI void dsa_unit(const Ctx& C, int l, int u) {
    int lane = C.lane; asm volatile("" : "+v"(lane));
    const int w = C.wave, r = lane & 31, hh = lane >> 5;
    const bf16* PROJ = ws_bf(C, WS_PU);
    int qrow0, NT, limit; KVSrc S; const bf16* ik0; const bf16* ik1; int iks0, ikn0;
    const bool smp = (u >= 120 && u < 152); const int up = u < 120 ? u : u - 32;
    if (!smp) { const int c = 31 - (up >> 3), b = up & 7; qrow0 = b * SEQ + c * 64; NT = 2 * (c + 1); limit = 64 * (c + 1);
        const bf16* base = PROJ + (size_t)(b * SEQ) * INP;
        S.k0 = base + C_AK; S.v0 = base + C_AV; S.s0 = INP; S.n0 = limit; S.k1 = S.k0; S.v1 = S.v0; S.s1 = INP;
        ik0 = base + C_IK; iks0 = INP; ikn0 = limit; ik1 = ik0;
    } else { const int b = u - 120; qrow0 = NTP + b * DSEQ; NT = (PAST + DSEQ) / 32; limit = PAST + DSEQ;
        const bf16* nb = PROJ + (size_t)qrow0 * INP;
        S.k0 = ws_bf(C, WS_CAK) + (size_t)b * PAST * 512; S.v0 = ws_bf(C, WS_CAV) + (size_t)b * PAST * 512; S.s0 = 512; S.n0 = PAST; S.k1 = nb + C_AK; S.v1 = nb + C_AV; S.s1 = INP;
        ik0 = ws_bf(C, WS_CKI) + (size_t)b * PAST * 64; iks0 = 64; ikn0 = PAST; ik1 = nb + C_IK;
    }
    float* SC = ws_f(C, WS_SC) + (size_t)C.bid * 64 * 2048;
    LAS unsigned* SEL = (LAS unsigned*)(C.lds + ATT_SEL);
    LAS unsigned char* IKS = C.lds + ATT_K; constexpr int IDX_CH = 256, IDX_STR = 144;
    int tidx = C.tid; asm volatile("" : "+v"(tidx));
    if (limit > 256) {
#ifndef REP_IDX
#define REP_IDX 1
#endif
#ifndef REP_TOPK
#define REP_TOPK 1
#endif
#ifndef REP_ATT
#define REP_ATT 1
#endif
#pragma unroll 1
    for (int pass = 0; pass < 2 * REP_IDX; ++pass) {
        bf16x8 af[2][4]; f32x2_t_ wt2[2][8];
#pragma unroll
        for (int np = 0; np < 2; ++np) { const int pp = (pass & 1) * 2 + np;
            const bf16* ap = PROJ + (size_t)(qrow0 + 8 * w + 2 * pp + (r >> 4)) * INP + C_IQ + (r & 15) * 64 + 8 * hh;
#pragma unroll
            for (int ks = 0; ks < 4; ++ks) af[np][ks] = *(const bf16x8*)(ap + 16 * ks);
#pragma unroll
            for (int i = 0; i < 16; ++i) { const int qi = 8 * w + 2 * pp + (i >> 3), hd = (i & 3) + 8 * ((i >> 2) & 1) + 4 * hh;
                wt2[np][i >> 1][i & 1] = bf2f(PROJ[(size_t)(qrow0 + qi) * INP + C_IW + hd]) * (0.25f * 0.125f); } }
        u32x4 sg[4];
#define IDX_GLOAD(ch_) do { _Pragma("unroll") for (int i_ = 0; i_ < 4; ++i_) { int key_ = (ch_) * IDX_CH + ((tidx + 512 * i_) >> 3); key_ = key_ < limit ? key_ : limit - 1; \
            const bf16* kp_ = (key_ < ikn0 ? ik0 + (size_t)key_ * iks0 : ik1 + (size_t)(key_ - ikn0) * INP) + (tidx & 7) * 8; sg[i_] = *(const u32x4*)kp_; } } while (0)
#define IDX_LSTORE(buf_) do { _Pragma("unroll") for (int i_ = 0; i_ < 4; ++i_) *(LAS u32x4*)(IKS + (buf_) * (IDX_CH * IDX_STR) + ((tidx + 512 * i_) >> 3) * IDX_STR + (tidx & 7) * 16) = sg[i_]; } while (0)
#define IDX_FRAG(dst_, kb_, tl_) do { _Pragma("unroll") for (int ks_ = 0; ks_ < 4; ++ks_) dst_[ks_] = *(const LAS bf16x8*)((kb_) + (tl_) * (32 * IDX_STR) + ks_ * 32); } while (0)
        IDX_GLOAD(0);
        IDX_LSTORE(0);
        __syncthreads();
        const int nch = (NT + 7) >> 3;
#pragma unroll 1
        for (int ch = 0; ch < nch; ++ch) {
            if (ch + 1 < nch) IDX_GLOAD(ch + 1);
            const LAS unsigned char* kb = IKS + (ch & 1) * (IDX_CH * IDX_STR) + r * IDX_STR + hh * 16;
            const int t0 = ch * 8, tn = (NT - t0) < 8 ? (NT - t0) : 8;
            bf16x8 bk[4], bk1[4], bn[4], b2[4];
            IDX_FRAG(bn, kb, 0); IDX_FRAG(b2, kb, 1);
#define IDX_TRIP(tl_) do { const int tile_ = t0 + (tl_); \
                _Pragma("unroll") for (int ks = 0; ks < 4; ++ks) { bk[ks] = bn[ks]; bk1[ks] = b2[ks]; } \
                if ((tl_) + 2 < tn) { IDX_FRAG(bn, kb, (tl_) + 2); IDX_FRAG(b2, kb, (tl_) + 3); } \
                f32x16 acc[2][2]; \
                _Pragma("unroll") for (int tt = 0; tt < 2; ++tt) _Pragma("unroll") for (int np = 0; np < 2; ++np) _Pragma("unroll") for (int i = 0; i < 16; ++i) acc[tt][np][i] = 0.f; \
                _Pragma("unroll") for (int ks = 0; ks < 4; ++ks) _Pragma("unroll") for (int np = 0; np < 2; ++np) { acc[0][np] = mfma32(af[np][ks], bk[ks], acc[0][np]); acc[1][np] = mfma32(af[np][ks], bk1[ks], acc[1][np]); } \
                _Pragma("unroll") for (int tt = 0; tt < 2; ++tt) _Pragma("unroll") for (int np = 0; np < 2; ++np) { \
                    f32x2_t_ s0, s1; \
                    _Pragma("unroll") for (int j = 0; j < 4; ++j) { \
                        const f32x2_t_ x0 = {relu_i(acc[tt][np][2 * j]), relu_i(acc[tt][np][2 * j + 1])}, x1 = {relu_i(acc[tt][np][8 + 2 * j]), relu_i(acc[tt][np][9 + 2 * j])}; \
                        if (j == 0) { asm("v_pk_mul_f32 %0, %1, %2" : "=v"(s0) : "v"(x0), "v"(wt2[np][0])); asm("v_pk_mul_f32 %0, %1, %2" : "=v"(s1) : "v"(x1), "v"(wt2[np][4])); } \
                        else { asm("v_pk_fma_f32 %0, %1, %2, %0" : "+v"(s0) : "v"(x0), "v"(wt2[np][j])); \
                               asm("v_pk_fma_f32 %0, %1, %2, %0" : "+v"(s1) : "v"(x1), "v"(wt2[np][4 + j])); } } \
                    const float p0 = s0.x + s0.y, p1 = s1.x + s1.y; \
                    const auto rr = __builtin_amdgcn_permlane32_swap(__float_as_uint(p0), __float_as_uint(p1), false, false);      \
                    const int ql = 8 * w + 2 * ((pass & 1) * 2 + np) + hh; \
                    SC[(size_t)ql * 2048 + (tile_ + tt) * 32 + r] = __uint_as_float(rr[0]) + __uint_as_float(rr[1]); } } while (0)
            IDX_TRIP(0);
            if (ch + 1 < nch) IDX_LSTORE((ch + 1) & 1);
#pragma unroll 1
            for (int tl = 2; tl < tn; tl += 2) IDX_TRIP(tl);
#undef IDX_TRIP
            __syncthreads();
        }
    }
#undef IDX_GLOAD
#undef IDX_LSTORE
#undef IDX_FRAG
    asm volatile("s_waitcnt vmcnt(0)" ::: "memory");
    __builtin_amdgcn_fence(__ATOMIC_ACQUIRE, "agent");
    asm volatile("s_waitcnt vmcnt(0)" ::: "memory");
#pragma unroll 1
    for (int pq = 0; pq < 4 * REP_TOPK; ++pq) { const int pp = pq & 3;
        const float* SCq = SC + (size_t)(8 * w + 2 * pp + hh) * 2048; LAS unsigned* SELa = SEL + (8 * w + 2 * pp) * 64;
        if (NT <= 32) topk_pair<32>(SCq, SELa, NT, r, hh, lane);
        else topk_pair<64>(SCq, SELa, NT, r, hh, lane);
    }
    } else {
        for (int i = lane; i < 8 * 64; i += 64) SEL[8 * w * 64 + i] = ((i & 63) < NT) ? 0xffffffffu : 0u;
    }
    __syncthreads();
#pragma unroll 1
    for (int rep = 0; rep < REP_ATT; ++rep)
    attn_unit<0>(C, PROJ + (size_t)qrow0 * INP + C_AQ, INP, S, 0, NT, ws_bf(C, WS_MIX) + (size_t)qrow0 * DM, DM);
}

DI void band_unit(const Ctx& C, const Args& A, int l, int u) {
    const bf16* PROJ = ws_bf(C, WS_PU);
    int qrow0, tlo; KVSrc S;
    if (u < 256) { const int c = 31 - (u >> 3), b = u & 7; qrow0 = b * SEQ + c * 64; tlo = c < 8 ? (8 - c) * 2 : 0;
        const bf16* base = PROJ + ((ptrdiff_t)b * SEQ + c * 64 - BWIN) * INP;
        S.k0 = base + C_BK; S.v0 = base + C_BV; S.s0 = INP; S.n0 = BWIN + 64; S.k1 = S.k0; S.v1 = S.v0; S.s1 = INP;
    } else { const int b = u - 256; qrow0 = NTP + b * DSEQ; tlo = 0;
        const bf16* nb = PROJ + (size_t)qrow0 * INP;
        S.k0 = ws_bf(C, WS_CBK) + (size_t)b * BWIN * 512; S.v0 = ws_bf(C, WS_CBV) + (size_t)b * BWIN * 512; S.s0 = 512; S.n0 = BWIN; S.k1 = nb + C_BK; S.v1 = nb + C_BV; S.s1 = INP;
    }
    LAS float* bt = (LAS float*)(C.lds + ATT_SEL);
    const float* brel = A.in[12] + (size_t)l * 4 * 257;
    for (int i = C.tid; i < 4 * 257; i += NTHR) bt[i] = brel[i];
    __syncthreads();
    attn_unit<1>(C, PROJ + (size_t)qrow0 * INP + C_BQ, INP, S, tlo, (BWIN + 64) / 32, ws_bf(C, WS_MIX) + (size_t)qrow0 * DM + 512, DM);
}

DI void ssd_unit(const Ctx& C, const Args& A, int l, int row0, int nchunks, int h, const float* h0, float* hout) {
    int tid = C.tid, lane = C.lane; asm volatile("" : "+v"(tid), "+v"(lane));
    const int w = C.wave, r = lane & 31, hh = lane >> 5, g = h >> 2;
    LAS unsigned char* L = C.lds;
    LAS unsigned char* Cs = L + SSD_CS; LAS unsigned char* Bs = L + SSD_BS; LAS unsigned char* XD = L + SSD_XD; LAS unsigned char* XDW = L + SSD_XDW; LAS unsigned char* Ms = L + SSD_MS; LAS unsigned char* Ys = L + SSD_Y; LAS unsigned char* Ys2 = L + SSD_Y2;
    LAS float* v_acs = (LAS float*)(L + SSD_VEC); LAS float* v_e = v_acs + 64;
    const bf16* XBC = ws_bf(C, WS_XBC); const bf16* PROJ = ws_bf(C, WS_PU); const float* DTS = ws_f(C, WS_DTS); float* G = ws_f(C, WS_G);
    const float a_h = -expf(A.in[16][l * 16 + h]); const float dsk = A.in[17][l * 16 + h];
    const int erow = tid >> 3, ech = tid & 7;
    f32x16 Hacc[2];
#pragma unroll
    for (int pb = 0; pb < 2; ++pb)
#pragma unroll
        for (int i = 0; i < 16; ++i) Hacc[pb][i] = 0.f;
    u32x4 pC[2], pB[2], pX, pZ; float pDt;
#define SSD_LOAD(c_) do { const int rb_ = row0 + (c_) * 64; \
        _Pragma("unroll") for (int i_ = 0; i_ < 2; ++i_) { const int ci_ = tid + 512 * i_; const bf16* src_ = XBC + (size_t)(rb_ + (ci_ >> 4)) * 2048 + g * 128 + (ci_ & 15) * 8; pB[i_] = *(const u32x4*)(src_ + 1024); pC[i_] = *(const u32x4*)(src_ + 1536); } \
        pX = *(const u32x4*)(XBC + (size_t)(rb_ + erow) * 2048 + h * 64 + ech * 8); pZ = *(const u32x4*)(PROJ + (size_t)(rb_ + erow) * INP + C_CZ + h * 64 + ech * 8); \
        pDt = DTS[(size_t)(rb_ + lane) * 16 + h]; } while (0)
    SSD_LOAD(0);
    if (w >= 4 && h0) { const int nb = w - 4;
#pragma unroll
        for (int pb = 0; pb < 2; ++pb)
#pragma unroll
            for (int i = 0; i < 16; ++i) Hacc[pb][i] = h0[(32 * pb + crow(i, hh)) * 128 + 32 * nb + r]; }
    __syncthreads();
    if (w >= 4) { const int nb = w - 4;
#pragma unroll
        for (int pb = 0; pb < 2; ++pb)
#pragma unroll
            for (int i = 0; i < 16; ++i) { const int p = 32 * pb + crow(i, hh), n = 32 * nb + r; *(LAS bf16*)(L + SSD_HS + p * HSTR + n * 2) = f2bf(Hacc[pb][i]); } }
#pragma unroll 1
    for (int c = 0; c < nchunks; ++c) {
        const int rbase = row0 + c * 64;
        LAS unsigned char* Hcur = L + SSD_HS + (c & 1) * 64 * HSTR; LAS unsigned char* Hnxt = L + SSD_HS + ((c + 1) & 1) * 64 * HSTR;
        const float dtl = pDt; float acs = dtl * a_h;
#pragma unroll
        for (int o = 1; o < 64; o <<= 1) { const float t = __shfl_up(acs, o); if (lane >= o) acs += t; }
        const float Atot = __shfl(acs, 63);
        const float wl = __expf(Atot - acs);
        if (w == 0) { v_acs[lane] = acs; v_e[lane] = __expf(acs); }
#pragma unroll
        for (int i = 0; i < 2; ++i) { const int ci = tid + 512 * i, row = ci >> 4, ch = ci & 15; *(LAS u32x4*)(Bs + row * CSTR + ch * 16) = pB[i]; *(LAS u32x4*)(Cs + row * CSTR + ch * 16) = pC[i]; }
        float xraw[8]; unpack8(pX, xraw); const u32x4 zc = pZ;
        { float xd[8], xw[8]; const float dt = __shfl(dtl, erow & 63), wv = __shfl(wl, erow & 63);
#pragma unroll
          for (int k = 0; k < 8; ++k) { xd[k] = xraw[k] * dt; xw[k] = xd[k] * wv; }
          *(LAS u32x4*)(XD + erow * XSTR + ech * 16) = pack8(xd); *(LAS u32x4*)(XDW + erow * XSTR + ech * 16) = pack8(xw); }
        if (c + 1 < nchunks) SSD_LOAD(c + 1);
        __syncthreads();
        if (w < 4) {
            const int lb = w >> 1, sb = w & 1; f32x16 acc;
#pragma unroll
            for (int i = 0; i < 16; ++i) acc[i] = 0.f;
            if (sb <= lb) {
#pragma unroll
                for (int ks = 0; ks < 8; ++ks) { const bf16x8 a = *(const LAS bf16x8*)(Cs + (32 * lb + r) * CSTR + (16 * ks + 8 * hh) * 2), b = *(const LAS bf16x8*)(Bs + (32 * sb + r) * CSTR + (16 * ks + 8 * hh) * 2);
                    acc = mfma32(a, b, acc); } }
            const int s = 32 * sb + r; const float acs_s = v_acs[s];
#pragma unroll
            for (int i = 0; i < 16; ++i) { const int lr = 32 * lb + crow(i, hh); const float v = (s <= lr) ? acc[i] * __expf(v_acs[lr] - acs_s) : 0.f; *(LAS bf16*)(Ms + lr * MSTR + s * 2) = f2bf(v); }
        } else {
            const int nb = w - 4; const float dec = __expf(Atot);
#pragma unroll
            for (int pb = 0; pb < 2; ++pb) {
#pragma unroll
                for (int i = 0; i < 16; ++i) Hacc[pb][i] *= dec;
#pragma unroll
                for (int ks = 0; ks < 4; ++ks) { const bf16x8 a = trfrag(XDW, XSTR, 16 * ks, 32 * pb, lane), b = trfrag(Bs, CSTR, 16 * ks, 32 * nb, lane); Hacc[pb] = mfma32(a, b, Hacc[pb]); }
#pragma unroll
                for (int i = 0; i < 16; ++i) *(LAS bf16*)(Hnxt + (32 * pb + crow(i, hh)) * HSTR + (32 * nb + r) * 2) = f2bf(Hacc[pb][i]);
            }
        }
        __syncthreads();
        {
            const int lb = (w >> 1) & 1, pb = w & 1, p = 32 * pb + r; f32x16 yv;
#pragma unroll
            for (int i = 0; i < 16; ++i) yv[i] = 0.f;
            if (w < 4) {
#pragma unroll
                for (int ks = 0; ks < 4; ++ks) { const bf16x8 a = *(const LAS bf16x8*)(Ms + (32 * lb + r) * MSTR + (16 * ks + 8 * hh) * 2), b = trfrag(XD, XSTR, 16 * ks, 32 * pb, lane); yv = mfma32(a, b, yv); }
#pragma unroll
                for (int i = 0; i < 16; ++i) *(LAS float*)(Ys + (32 * lb + crow(i, hh)) * YSTR + p * 4) = yv[i];
            } else {
#pragma unroll
                for (int ks = 0; ks < 8; ++ks) { const bf16x8 a = *(const LAS bf16x8*)(Cs + (32 * lb + r) * CSTR + (16 * ks + 8 * hh) * 2), b = *(const LAS bf16x8*)(Hcur + (32 * pb + r) * HSTR + (16 * ks + 8 * hh) * 2); yv = mfma32(a, b, yv); }
#pragma unroll
                for (int i = 0; i < 16; ++i) { const int lr = 32 * lb + crow(i, hh); *(LAS float*)(Ys2 + lr * YSTR + p * 4) = v_e[lr] * yv[i]; }
            }
        }
        __syncthreads();
        {
            float z[8]; unpack8(zc, z);
            const f32x4 y0 = *(const LAS f32x4*)(Ys + erow * YSTR + ech * 32) + *(const LAS f32x4*)(Ys2 + erow * YSTR + ech * 32), y1 = *(const LAS f32x4*)(Ys + erow * YSTR + ech * 32 + 16) + *(const LAS f32x4*)(Ys2 + erow * YSTR + ech * 32 + 16);
            float y[8] = {y0.x, y0.y, y0.z, y0.w, y1.x, y1.y, y1.z, y1.w};
#pragma unroll
            for (int k = 0; k < 8; ++k) { const float yy = y[k] + dsk * xraw[k]; y[k] = yy * z[k] / (1.f + __expf(-z[k])); }
            float* gp = G + (size_t)(rbase + erow) * 1024 + h * 64 + ech * 8;
            ((f32x4*)gp)[0] = (f32x4){y[0], y[1], y[2], y[3]}; ((f32x4*)gp)[1] = (f32x4){y[4], y[5], y[6], y[7]};
        }
    }
#undef SSD_LOAD
    if (w >= 4) { const int nb = w - 4;
#pragma unroll
        for (int pb = 0; pb < 2; ++pb)
#pragma unroll
            for (int i = 0; i < 16; ++i) hout[(32 * pb + crow(i, hh)) * 128 + 32 * nb + r] = Hacc[pb][i]; }
}

DI void gate_norm_phase(const Ctx& C, const Args& A, int l) {
    const int gw = C.bid * NWAVES + C.wave, NGW = C.G * NWAVES; const float* gn = A.in[18] + (size_t)l * 1024;
    constexpr int GNB = 9;
    for (int m0 = gw; m0 < NTOK; m0 += GNB * NGW) {
        f32x4 v[GNB][4];
#pragma unroll
        for (int k = 0; k < GNB; ++k) { const int m = m0 + k * NGW; const float* grow = ws_f(C, WS_G) + (size_t)(m < NTOK ? m : m0) * 1024;
#pragma unroll
            for (int g = 0; g < 4; ++g) v[k][g] = ((const f32x4*)grow)[g * 64 + C.lane]; }
#pragma unroll
        for (int k = 0; k < GNB; ++k) { const int m = m0 + k * NGW; if (m < NTOK) { bf16* orow = ws_bf(C, WS_MIX) + (size_t)m * DM + 1024;
#pragma unroll
            for (int g = 0; g < 4; ++g) { const f32x4 x = v[k][g]; const float ss = wave_sum((x.x * x.x + x.y * x.y) + (x.z * x.z + x.w * x.w));
                const float rs = 1.0f / sqrtf(ss * (1.0f / 256.f) + EPS); const f32x4 wv = ((const f32x4*)gn)[g * 64 + C.lane]; const f32x4 o = x * rs * wv;
                u32x2 p; p.x = pk2(o.x, o.y); p.y = pk2(o.z, o.w); ((u32x2*)orow)[g * 64 + C.lane] = p; } } }
    }
}
DI void norm_phase(const Ctx& C, int rlo, int mode, const float* w) {
    const int gw = C.bid * NWAVES + C.wave, NGW = C.G * NWAVES;
    for (int m = rlo + gw; m < NTOK; m += NGW)
        res_row(ws_bf(C, WS_X) + (size_t)m * DM, m >= NTP ? ws_f(C, WS_G) + (size_t)(m - NTP) * DM : nullptr, (size_t)NTS * DM, mode, ws_f(C, WS_SSQ1) + (size_t)m * 32, w, C.out + (size_t)m * DM, C.lane);
}
DI void final_norm_phase(const Ctx& C, const float* w) {
    const int gw = C.bid * NWAVES + C.wave, NGW = C.G * NWAVES, lane = C.lane; const bf16* X = ws_bf(C, WS_X);
    u32x4 nx[4]; int m = gw;
    if (m < NTOK) {
#pragma unroll
        for (int j = 0; j < 4; ++j) nx[j] = ((const u32x4*)(X + (size_t)m * DM))[lane + 64 * j]; }
    for (; m < NTOK; m += NGW) {
        float v[4][8]; float ss = 0.f;
#pragma unroll
        for (int j = 0; j < 4; ++j) unpack8(nx[j], v[j]);
        const int mn = m + NGW;
        if (mn < NTOK) {
#pragma unroll
            for (int j = 0; j < 4; ++j) nx[j] = ((const u32x4*)(X + (size_t)mn * DM))[lane + 64 * j]; }
        const float* part = m >= NTP ? ws_f(C, WS_G) + (size_t)(m - NTP) * DM : nullptr;
#pragma unroll
        for (int j = 0; j < 4; ++j) {
            if (part) {
#pragma unroll
                for (int k = 0; k < 4; ++k) { const float* pp = part + k * ((size_t)NTS * DM) + 8 * (lane + 64 * j); const f32x4 a = *(const f32x4*)pp, b = *(const f32x4*)(pp + 4);
                    v[j][0] += a.x; v[j][1] += a.y; v[j][2] += a.z; v[j][3] += a.w; v[j][4] += b.x; v[j][5] += b.y; v[j][6] += b.z; v[j][7] += b.w; } }
#pragma unroll
            for (int k = 0; k < 8; ++k) ss += v[j][k] * v[j][k]; }
        ss = wave_sum(ss);
        const float rs = 1.0f / sqrtf(ss * (1.0f / DM) + EPS); float* outf = C.out + (size_t)m * DM;
#pragma unroll
        for (int j = 0; j < 4; ++j) { const float* wp = w + 8 * (lane + 64 * j); const f32x4 w0 = *(const f32x4*)wp, w1 = *(const f32x4*)(wp + 4); float* op = outf + 8 * (lane + 64 * j);
            *(f32x4*)op = (f32x4){v[j][0] * rs * w0.x, v[j][1] * rs * w0.y, v[j][2] * rs * w0.z, v[j][3] * rs * w0.w};
            *(f32x4*)(op + 4) = (f32x4){v[j][4] * rs * w1.x, v[j][5] * rs * w1.y, v[j][6] * rs * w1.z, v[j][7] * rs * w1.w}; }
    }
}
DI void zero_f32(const Ctx& C, float* p, int n) { for (int i = C.bid * NTHR + C.tid; i < n; i += C.G * NTHR) p[i] = 0.f; }

#ifndef WCONV_A
#define WCONV_A 8
#endif
#ifndef WCONV_B
#define WCONV_B 9
#endif
#ifndef G_ALIGN
#define G_ALIGN true
#endif
#ifndef G_ALIGN_RES
#define G_ALIGN_RES true
#endif
#ifndef G_SP2
#define G_SP2 true
#endif
#ifndef STAGGER_TICKS
#define STAGGER_TICKS 0
#endif
DI void stagger(const Ctx& C, int ticks) {
    if (ticks > 0 && (C.bid & 1)) { const unsigned long long t0 = __builtin_amdgcn_s_memrealtime(); while (__builtin_amdgcn_s_memrealtime() - t0 < (unsigned long long)ticks) __builtin_amdgcn_s_sleep(8); }
}
template <class Sched>
DI void build_rstd_table(const Ctx& C, const Sched& S, const float* SSQ, LAS float* tab) {
    pg8::Unit u;
    for (int i = 0; S.next(i, u); ++i)
        if (C.tid < 256) { const f32x4* p = (const f32x4*)(SSQ + (size_t)(u.pm * 256 + C.tid) * 32); f32x4 a = p[0];
#pragma unroll
            for (int j = 1; j < 8; ++j) a += p[j];
            tab[i * 256 + C.tid] = 1.0f / sqrtf(((a.x + a.y) + (a.z + a.w)) * (1.0f / DM) + EPS); }
    __syncthreads();
}
#ifndef MK_ONE_LAUNCH
#define MK_ONE_LAUNCH 1
#endif
#ifndef PHASE_MASK
#define PHASE_MASK 0xFFFF
#endif
#define EN(k) (((PHASE_MASK) >> (k)) & 1)
constexpr int PH_PER_LAYER = 8, NPHASE = 1 + DEPTH * PH_PER_LAYER;
__global__ void __launch_bounds__(NTHR, 2) fwd(Args args) {
    extern __shared__ __attribute__((aligned(16))) unsigned char lds_raw[];
    Ctx C;
    C.lds = (LAS unsigned char*)lds_raw;
    C.tid = threadIdx.x; C.lane = C.tid & 63; C.wave = __builtin_amdgcn_readfirstlane(C.tid >> 6); C.G = gridDim.x; C.bid = blockIdx.x;
    C.ws = args.ws; C.out = args.out; C.ctl = (unsigned*)(args.ws + WS_CTL);
    const Args& A = args;
    for (int u = C.tid; u < (LDS_BYTES - LDSCTL_OFF) / 4; u += NTHR) ((LAS unsigned*)(C.lds + LDSCTL_OFF))[u] = 0u;
    __syncthreads();
    const int lo = args.ph_lo, hi = args.ph_hi;
    const bool multi = (hi - lo) > 1;
    XcdBarrier bar; bar.bar = C.ctl + CW_BAR; bar.x = 0; bar.st = (volatile LAS unsigned*)(C.lds + LDSCTL_OFF);
    if (multi) bar = xcd_barrier_post(C.ctl + CW_BAR, (volatile LAS unsigned*)(C.lds + LDSCTL_OFF));
#define IN(k) (lo <= (k) && (k) < hi)
#define FRESH() do { int t_ = threadIdx.x; asm volatile("" : "+v"(t_)); C.tid = t_; C.lane = t_ & 63; int w_ = __builtin_amdgcn_readfirstlane(t_ >> 6); asm volatile("" : "+s"(w_)); C.wave = w_; } while (0)
#define SEAM(k) do { if (IN((k) + 1)) xcd_barrier(bar); } while (0)

    if (EN(0) && IN(0)) { p0_prologue(C, A);
#if defined(PROBE_P02)
        __syncthreads(); p0_prologue(C, A);
#endif
        SEAM(0); }
#pragma unroll 1
    for (int l = 0; l < DEPTH; ++l) {
        const int pb = 1 + PH_PER_LAYER * l;
        if (EN(1) && IN(pb + 0)) { FRESH();
            pg8::Gemm g{ws_bf(C, WS_X), w_in_t(C, l), NTOK, INP, DM, DM};
            pg8::ListOrder S; S.list = (const LAS int*)(C.lds + LDS_ULIST);
            { pg8::WinOrder W; W.init(C.G, C.bid); pg8::Unit u; int n = 0; while (W.next(n, u)) { if (C.tid == 0) ((LAS int*)(C.lds + LDS_ULIST))[n] = (u.pm << 8) | u.pn; ++n; } S.n = n; }
            __syncthreads();
            build_rstd_table(C, S, ws_f(C, WS_SSQ1), (LAS float*)(C.lds + LDS_RSTD));
            pg8::EpiBf16<0> E{ws_bf(C, WS_PU), INP, (const LAS float*)(C.lds + LDS_RSTD)};
            pg8::gemm_phase<pg8::EpiBf16<0>, pg8::ListOrder, G_ALIGN, G_SP2>(C.lds, g, S, E);
#if defined(PROBE_G)
            if (PROBE_G & 1) { __syncthreads(); pg8::gemm_phase<pg8::EpiBf16<0>, pg8::StaticOrder, G_ALIGN, G_SP2>(C.lds, g, S, E); }
#endif
            if (l == 0) cache_convert(C, A, 0);
            SEAM(pb + 0);
        }
        if (EN(2) && IN(pb + 1)) { FRESH(); m0_phase(C, A, l);
#if defined(PROBE_BAR)
            for (int i = 0; i < PROBE_BAR; ++i) xcd_barrier(bar);
#endif
            SEAM(pb + 1); }
        if (IN(pb + 2)) { FRESH();
            unsigned* qh = C.ctl + CW_Q + 64 * (l * 4);
            unsigned* flg = C.ctl + CW_H + 64 * (l * 14);
            if (EN(3)) { unsigned* qg = C.ctl + CW_Q + 64 * (48 + l);
                for (;;) { const int u = q_next(C, qg); if (u >= 42) break;
                    pg8::Gemm g{ws_bf(C, WS_X), w_in_t(C, l), NTOK, INP, DM, DM}; pg8::OneUnit S1{58 + u / 3, 17 + u % 3};
                    build_rstd_table(C, S1, ws_f(C, WS_SSQ1), (LAS float*)(C.lds + LDS_RSTD));
                    pg8::EpiBf16<0> E{ws_bf(C, WS_PU), INP, (const LAS float*)(C.lds + LDS_RSTD)};
                    pg8::gemm_phase<pg8::EpiBf16<0>, pg8::OneUnit, G_ALIGN, G_SP2>(C.lds, g, S1, E);
                    asm volatile("s_waitcnt vmcnt(0)" ::: "memory"); __syncthreads();
                    if (C.tid == 0) { __builtin_amdgcn_fence(__ATOMIC_RELEASE, "agent"); asm volatile("s_waitcnt vmcnt(0)" ::: "memory"); xb_add(&flg[64 * (u / 3)], 1u); } } }
            if (EN(4)) for (;;) { const int u = q_next(C, qh + 64); if (u >= 288) break; dsa_unit(C, l, u); }
            if (EN(3)) for (;;) { const int u = q_next(C, qh); if (u >= NB * 16) break;
                if ((u >> 4) == NB - 1) wait_flags(C, flg, 0, 6);
                ssd_unit(C, A, l, (u >> 4) * SEQ, SEQ / 64, u & 15, nullptr, C.out + OFF_P_SSM + ((size_t)(l * NB + (u >> 4)) * 16 + (u & 15)) * 8192); }
            if (EN(5)) { int u = q_next(C, qh + 128); while (u < 288) { const int nx = q_prefetch(C, qh + 128); band_unit(C, A, l, u); u = q_publish(C, nx); } }
            if (EN(3)) { int u = q_next(C, qh + 192); while (u < DBAT * 16) { const int nx = q_prefetch(C, qh + 192);
                wait_flags(C, flg, 6 + (u >> 6), 1);
                ssd_unit(C, A, l, NTP + (u >> 4) * DSEQ, 1, u & 15, A.in[7] + ((size_t)(l * DBAT + (u >> 4)) * 16 + (u & 15)) * 8192, C.out + OFF_S_SSM + ((size_t)(l * DBAT + (u >> 4)) * 16 + (u & 15)) * 8192);
                u = q_publish(C, nx); } }
#if defined(PROBE_MIXK)
            { unsigned* qh2 = C.ctl + CW_Q + 64 * (16 + l * 4);
            if (PROBE_MIXK & 1) for (;;) { const int u = q_next(C, qh2); if (u >= NB * 16) break;
                ssd_unit(C, A, l, (u >> 4) * SEQ, SEQ / 64, u & 15, nullptr, C.out + OFF_P_SSM + ((size_t)(l * NB + (u >> 4)) * 16 + (u & 15)) * 8192); }
            if (PROBE_MIXK & 2) for (;;) { const int u = q_next(C, qh2 + 64); if (u >= 288) break; dsa_unit(C, l, u); }
            if (PROBE_MIXK & 4) for (;;) { const int u = q_next(C, qh2 + 128); if (u >= 288) break; band_unit(C, A, l, u); }
            if (PROBE_MIXK & 8) for (;;) { const int u = q_next(C, qh2 + 192); if (u >= DBAT * 16) break;
                ssd_unit(C, A, l, NTP + (u >> 4) * DSEQ, 1, u & 15, A.in[7] + ((size_t)(l * DBAT + (u >> 4)) * 16 + (u & 15)) * 8192, C.out + OFF_S_SSM + ((size_t)(l * DBAT + (u >> 4)) * 16 + (u & 15)) * 8192); } }
#endif
            SEAM(pb + 2);
        }
        if (EN(6) && IN(pb + 3)) { FRESH(); gate_norm_phase(C, A, l);
#if defined(PROBE_GATE2)
            gate_norm_phase(C, A, l);
#endif
            SEAM(pb + 3); }
        if (EN(7) && IN(pb + 4)) { FRESH();
            pg8::Gemm g{ws_bf(C, WS_MIX), w_out_t(C, l), NTOK, DM, DM, DM}; pg8::StaticOrder S; S.init(NTOK, DM, C.G, C.bid);
            pg8::EpiResBf16 E{ws_bf(C, WS_X), DM, ws_f(C, WS_SSQ2), 1};
#if defined(PROBE_G)
            if (PROBE_G & 4) { pg8::EpiNull E2; pg8::gemm_phase<pg8::EpiNull, pg8::StaticOrder, G_ALIGN, G_SP2>(C.lds, g, S, E2); __syncthreads(); }
#endif
            pg8::gemm_phase<pg8::EpiResBf16, pg8::StaticOrder, G_ALIGN_RES, G_SP2>(C.lds, g, S, E);
            if (l + 1 < DEPTH) cache_convert(C, A, l + 1);
            SEAM(pb + 4);
        }
        if (EN(9) && IN(pb + 5)) { FRESH();
            pg8::Gemm g{ws_bf(C, WS_X), w_up_t(C, l), NTOK, DFF, DM, DM}; pg8::StaticOrder S; S.init(NTOK, DFF, C.G, C.bid);
            build_rstd_table(C, S, ws_f(C, WS_SSQ2), (LAS float*)(C.lds + LDS_RSTD));
            pg8::EpiBf16<1> E{ws_bf(C, WS_PU), DFF, (const LAS float*)(C.lds + LDS_RSTD)};
#if defined(PROBE_G)
            if (PROBE_G & 2) { pg8::gemm_phase<pg8::EpiBf16<1>, pg8::StaticOrder, G_ALIGN, G_SP2>(C.lds, g, S, E); __syncthreads(); }
            if (PROBE_G & 256) { pg8::EpiNull E2; pg8::HotOrder S2{9, C.bid}; pg8::gemm_phase<pg8::EpiNull, pg8::HotOrder, G_ALIGN, G_SP2>(C.lds, g, S2, E2); __syncthreads(); }
            if (PROBE_G & 128) { pg8::EpiNull E2; pg8::gemm_phase<pg8::EpiNull, pg8::StaticOrder, G_ALIGN, G_SP2>(C.lds, g, S, E2); __syncthreads(); }
#endif
            pg8::gemm_phase<pg8::EpiBf16<1>, pg8::StaticOrder, G_ALIGN, G_SP2>(C.lds, g, S, E);
            SEAM(pb + 5);
        }
        if (EN(10) && IN(pb + 6)) { FRESH();
#if defined(PROBE_G)
            if (PROBE_G & 8) { pg8::Gemm g{ws_bf(C, WS_PU), w_dn_t(C, l), NTP, DM, DFF, DFF}; pg8::StaticOrder S; S.init(NTP, DM, C.G, C.bid);
              pg8::EpiNull E2; pg8::gemm_phase<pg8::EpiNull, pg8::StaticOrder, G_ALIGN, G_SP2>(C.lds, g, S, E2); __syncthreads(); }
            if (PROBE_G & 16) { pg8::Gemm g{ws_bf(C, WS_PU), w_dn_t(C, l), NTOK, DM, DFF / 4, DFF}; pg8::SplitOrder S; S.init(NTP / 256, NTS / 256, DM / 256, 4, C.G, C.bid);
              pg8::EpiSplitPart E{ws_f(C, WS_G), DM, (size_t)NTS * DM, NTP};
              pg8::gemm_phase<pg8::EpiSplitPart, pg8::SplitOrder, G_ALIGN, G_SP2>(C.lds, g, S, E); __syncthreads(); }
#endif
            { pg8::Gemm g{ws_bf(C, WS_PU), w_dn_t(C, l), NTP, DM, DFF, DFF}; pg8::StaticOrder S; S.init(NTP, DM, C.G, C.bid);
              pg8::EpiResBf16 E{ws_bf(C, WS_X), DM, ws_f(C, WS_SSQ1), l + 1 < DEPTH ? 1 : 0};
              pg8::gemm_phase<pg8::EpiResBf16, pg8::StaticOrder, G_ALIGN_RES, G_SP2>(C.lds, g, S, E); }
            __syncthreads();
            { pg8::Gemm g{ws_bf(C, WS_PU), w_dn_t(C, l), NTOK, DM, DFF / 4, DFF}; pg8::SplitOrder S; S.init(NTP / 256, NTS / 256, DM / 256, 4, C.G, C.bid);
              pg8::EpiSplitPart E{ws_f(C, WS_G), DM, (size_t)NTS * DM, NTP};
              pg8::gemm_phase<pg8::EpiSplitPart, pg8::SplitOrder, G_ALIGN, G_SP2>(C.lds, g, S, E); }
            SEAM(pb + 6);
        }
        if (EN(8) && IN(pb + 7)) { FRESH();
            if (l + 1 < DEPTH) norm_phase(C, NTP, 0, nullptr);
            else final_norm_phase(C, A.in[22]);
            SEAM(pb + 7);
        }
    }
#undef IN
#undef SEAM
}

extern "C" void kernel_launch(void* const* d_in, const int* in_sizes, int n_in, void* d_out, int out_size, void* d_ws, size_t ws_size, hipStream_t stream) {
    static int grid = 0;
    if (grid == 0) {
        if (n_in != 23 || in_sizes[0] != NTP * DM || (size_t)out_size != OUT_TOTAL || ws_size < WS_END) {
            fprintf(stderr, "kernel_launch: unexpected shapes (n_in %d, in0 %d, out %d, ws %zu; need ws >= %zu); nothing launched\n", n_in, n_in > 0 ? in_sizes[0] : -1, out_size, ws_size, (size_t)WS_END); grid = -1; return; }
        int dev = 0, cus = 0, per_cu = 0;
        if (hipGetDevice(&dev) != hipSuccess || hipDeviceGetAttribute(&cus, hipDeviceAttributeMultiprocessorCount, dev) != hipSuccess) { fprintf(stderr, "kernel_launch: device query failed\n"); grid = -1; return; }
        if (hipFuncSetAttribute((const void*)fwd, hipFuncAttributeMaxDynamicSharedMemorySize, LDS_BYTES) != hipSuccess) { fprintf(stderr, "kernel_launch: hipFuncSetAttribute failed\n"); grid = -1; return; }
        if (hipOccupancyMaxActiveBlocksPerMultiprocessor(&per_cu, (const void*)fwd, NTHR, LDS_BYTES) != hipSuccess || per_cu < 1)
            fprintf(stderr, "kernel_launch: note: occupancy query reports %d workgroups per CU\n", per_cu);
        (void)hipGetLastError();
        grid = cus < 256 ? cus : 256;
    }
    if (grid < 0) return;
    if (hipMemsetAsync((char*)d_ws + WS_CTL, 0, CTL_ZERO_BYTES, stream) != hipSuccess) { fprintf(stderr, "kernel_launch: memset failed\n"); return; }
    Args a{};
    for (int i = 0; i < 23; ++i) a.in[i] = (const float*)d_in[i];
    a.out = (float*)d_out; a.ws = (unsigned char*)d_ws;
#if MK_ONE_LAUNCH
    a.ph_lo = 0; a.ph_hi = NPHASE;
    hipLaunchKernelGGL(fwd, dim3(grid), dim3(NTHR), LDS_BYTES, stream, a);
#else
    for (int p = 0; p < NPHASE; ++p) { a.ph_lo = p; a.ph_hi = p + 1; hipLaunchKernelGGL(fwd, dim3(grid), dim3(NTHR), LDS_BYTES, stream, a); }
#endif
    const hipError_t le = hipPeekAtLastError();
    if (le != hipSuccess) fprintf(stderr, "kernel_launch: launch failed: %s\n", hipGetErrorName(le));
}
```

```cpp
#include <hip/hip_runtime.h>
#include <cstdio>
#include <cstdint>
#include <cstddef>
namespace pg8 {
#define PG8_LAS __attribute__((address_space(3)))
typedef unsigned short bf16_t;
typedef short bf16x8 __attribute__((ext_vector_type(8)));
typedef float f32x4 __attribute__((ext_vector_type(4)));
typedef unsigned u32x4 __attribute__((ext_vector_type(4)));
constexpr int BM = 256, BK = 64, HALF = 128, HTB = HALF * BK * 2  , STAGE_BYTES = 8 * HTB, NXCD = 8, WGM = 8;

__host__ __device__ __forceinline__ int lds_byte(int r, int c) { const int st = (r >> 4) * 2 + (c >> 5), rr = r & 15, cc = c & 31, ob = rr * 64 + cc * 2; return st * 1024 + (ob ^ (((ob >> 9) & 1) << 5)); }
__host__ __device__ __forceinline__ void stage_rc(int b, int& R, int& C) { const int st = b / 1024, sb = b % 1024, swz = sb ^ (((sb >> 9) & 1) << 5); R = (st >> 1) * 16 + swz / 64; C = (st & 1) * 32 + (swz % 64) / 2; }
__host__ __device__ __forceinline__ int perm32(int rho) { const int n = rho >> 4, i = rho & 15; return 8 * (i >> 2) + 4 * n + (i & 3); }

struct Unit { int pm, pn, kq, ord; };
struct Gemm { const bf16_t* A; const bf16_t* Bt; int M, N, K, ld; };

struct StaticOrder {
    int nM, nN, nwg, G, c;
    __host__ __device__ void init(int M, int N, int G_, int c_) { nM = M / BM; nN = N / BM; nwg = nM * nN; G = G_; c = c_; }
    __host__ __device__ bool next(int i, Unit& u) const {
        const long L = (long)i * G + c; if (L >= nwg) return false;
        int wgid = (int)L; { const int q = nwg / NXCD, r = nwg % NXCD, xcd = wgid % NXCD, off = wgid / NXCD; wgid = (xcd < r ? xcd * (q + 1) : r * (q + 1) + (xcd - r) * q) + off; }
        const int nig = WGM * nN, gid = wgid / nig, fm = gid * WGM, gsz = (nM - fm) < WGM ? (nM - fm) : WGM;
        u.pm = fm + ((wgid % nig) % gsz); u.pn = (wgid % nig) / gsz; u.kq = 0; u.ord = i; return true;
    }
    __device__ __forceinline__ void a_ready(const Unit&) const {}
    __device__ __forceinline__ void done(const Unit&) const {}
};

struct WinOrder {
    int G, c, c2, n1;
    template <int nM, int nN> static __host__ __device__ __forceinline__ void tile(int L, int& pm, int& pn) {
        constexpr int nwg = nM * nN, q = nwg / NXCD, r = nwg % NXCD, nig = WGM * nN;
        const int xcd = L % NXCD, off = L / NXCD; const int wgid = (xcd < r ? xcd * (q + 1) : r * (q + 1) + (xcd - r) * q) + off;
        const int gid = wgid / nig, fm = gid * WGM, gsz = (nM - fm) < WGM ? (nM - fm) : WGM;
        pm = fm + ((wgid % nig) % gsz); pn = (wgid % nig) / gsz;
    }
    __host__ __device__ __forceinline__ void init(int G_, int c_) { G = G_; c = c_; c2 = (c_ + G_ - (146 % G_)) % G_; n1 = c_ < 1682 ? (1681 - c_) / G_ + 1 : 0; }
    __host__ __device__ __forceinline__ bool next(int i, Unit& u) const {
        if (i < n1) { tile<58, 29>(i * G + c, u.pm, u.pn); }
        else { const int L = (i - n1) * G + c2; if (L >= 364) return false; int pm, pn; tile<14, 26>(L, pm, pn); u.pm = pm + 58; u.pn = pn < 17 ? pn : pn + 3; }
        u.kq = 0; u.ord = i; return true;
    }
    __device__ __forceinline__ void a_ready(const Unit&) const {}
    __device__ __forceinline__ void done(const Unit&) const {}
};
struct ListOrder {
    const PG8_LAS int* list; int n;
    __device__ __forceinline__ bool next(int i, Unit& u) const { if (i >= n) return false; const int v = __builtin_amdgcn_readfirstlane(list[i]); u.pm = v >> 8; u.pn = v & 255; u.kq = 0; u.ord = i; return true; }
    __device__ __forceinline__ void a_ready(const Unit&) const {}
    __device__ __forceinline__ void done(const Unit&) const {}
};
struct OneUnit {
    int pm, pn;
    __host__ __device__ bool next(int i, Unit& u) const { if (i != 0) return false; u.pm = pm; u.pn = pn; u.kq = 0; u.ord = 0; return true; }
    __device__ __forceinline__ void a_ready(const Unit&) const {}
    __device__ __forceinline__ void done(const Unit&) const {}
};

struct SplitOrder {
    int pm0, npm, nN, nsplit, G, c;
    __host__ __device__ void init(int pm0_, int npm_, int nN_, int nsplit_, int G_, int c_) { pm0 = pm0_; npm = npm_; nN = nN_; nsplit = nsplit_; G = G_; c = c_; }
    __host__ __device__ bool next(int i, Unit& u) const {
        const long L = (long)i * G + c; if (L >= (long)npm * nN * nsplit) return false;
        const int w = (int)L; u.kq = w % nsplit; u.pn = (w / nsplit) % nN; u.pm = pm0 + w / (nsplit * nN); u.ord = i; return true;
    }
    __device__ __forceinline__ void a_ready(const Unit&) const {}
    __device__ __forceinline__ void done(const Unit&) const {}
};

struct HotOrder {
    int n, c;
    __host__ __device__ bool next(int i, Unit& u) const { if (i >= n) return false; u.pm = c & 7; u.pn = (c >> 3) & 3; u.kq = 0; u.ord = i; return true; }
    __device__ __forceinline__ void a_ready(const Unit&) const {}
    __device__ __forceinline__ void done(const Unit&) const {}
};

typedef float f32x2_t __attribute__((ext_vector_type(2)));
typedef __bf16 bf16x2_t __attribute__((ext_vector_type(2)));
__device__ __forceinline__ unsigned cvt_pk_bf16(float lo, float hi) { f32x2_t v = {lo, hi}; bf16x2_t b = __builtin_convertvector(v, bf16x2_t); return __builtin_bit_cast(unsigned, b); }

template <int ACT  , int PMODE = 0  > struct EpiBf16 {
    static constexpr bool PERM = true, AFTER_DRAIN = false;
    bf16_t* O; int ldc; const PG8_LAS float* tab;
    __device__ __forceinline__ void operator()(const f32x4 (&acc)[2][2][4][2], const Unit& u, int wr, int wc, int fr, int fq) const {
        const int row0 = u.pm * BM + wr * 64 + fr; const int col0 = u.pn * BM + wc * 32 + 8 * fq;
        float rs[2][4];
#pragma unroll
        for (int ai = 0; ai < 2; ++ai)
#pragma unroll
            for (int m = 0; m < 4; ++m) rs[ai][m] = PMODE == 1 ? 1.0f : tab[u.ord * BM + wr * 64 + fr + ai * HALF + m * 16];
#pragma unroll
        for (int ai = 0; ai < 2; ++ai)
#pragma unroll
            for (int m = 0; m < 4; ++m) { bf16_t* rowp = O + (size_t)(row0 + ai * HALF + m * 16) * ldc + col0;
#pragma unroll
                for (int bj = 0; bj < 2; ++bj) { f32x4 v0 = acc[ai][bj][m][0] * rs[ai][m], v1 = acc[ai][bj][m][1] * rs[ai][m];
                    if (ACT == 1) {
#pragma unroll
                        for (int j = 0; j < 4; ++j) { const float a = v0[j] > 0.f ? v0[j] : 0.f, b = v1[j] > 0.f ? v1[j] : 0.f; v0[j] = a * a; v1[j] = b * b; } }
                    u32x4 w; w.x = cvt_pk_bf16(v0[0], v0[1]); w.y = cvt_pk_bf16(v0[2], v0[3]); w.z = cvt_pk_bf16(v1[0], v1[1]); w.w = cvt_pk_bf16(v1[2], v1[3]);
                    if (PMODE == 2) asm volatile("" :: "v"(w)); else *(u32x4*)(rowp + bj * HALF) = w; } }
    }
};
struct EpiResF32 {
    static constexpr bool PERM = false, AFTER_DRAIN = false;
    float* X; int ldc;
    __device__ __forceinline__ void operator()(const f32x4 (&acc)[2][2][4][2], const Unit& u, int wr, int wc, int fr, int fq) const {
        const int row0 = u.pm * BM + wr * 64 + fr, col0 = u.pn * BM + wc * 32 + 4 * fq;
#pragma unroll
        for (int ai = 0; ai < 2; ++ai)
#pragma unroll
            for (int m = 0; m < 4; ++m) { float* rowp = X + (size_t)(row0 + ai * HALF + m * 16) * ldc + col0;
                f32x4 b[2][2];
#pragma unroll
                for (int bj = 0; bj < 2; ++bj)
#pragma unroll
                    for (int n = 0; n < 2; ++n) b[bj][n] = *(const f32x4*)(rowp + bj * HALF + n * 16);
#pragma unroll
                for (int bj = 0; bj < 2; ++bj)
#pragma unroll
                    for (int n = 0; n < 2; ++n) *(f32x4*)(rowp + bj * HALF + n * 16) = b[bj][n] + acc[ai][bj][m][n];
                asm volatile("" ::: "memory"); }
    }
};

struct EpiSplitRes {
    static constexpr bool PERM = false, AFTER_DRAIN = false;
    float* X; int ldc; float* P; size_t pstride; int row0;
    __device__ __forceinline__ void operator()(const f32x4 (&acc)[2][2][4][2], const Unit& u, int wr, int wc, int fr, int fq) const {
        const int rowa = u.pm * BM + wr * 64 + fr, col0 = u.pn * BM + wc * 32 + 4 * fq;
        if (u.kq == 0) {
#pragma unroll
            for (int ai = 0; ai < 2; ++ai)
#pragma unroll
                for (int m = 0; m < 4; ++m) { float* rowp = X + (size_t)(rowa + ai * HALF + m * 16) * ldc + col0;
                    f32x4 b[2][2];
#pragma unroll
                    for (int bj = 0; bj < 2; ++bj)
#pragma unroll
                        for (int n = 0; n < 2; ++n) b[bj][n] = *(const f32x4*)(rowp + bj * HALF + n * 16);
#pragma unroll
                    for (int bj = 0; bj < 2; ++bj)
#pragma unroll
                        for (int n = 0; n < 2; ++n) *(f32x4*)(rowp + bj * HALF + n * 16) = b[bj][n] + acc[ai][bj][m][n];
                    asm volatile("" ::: "memory"); }
        } else {
            float* base = P + (size_t)(u.kq - 1) * pstride;
#pragma unroll
            for (int ai = 0; ai < 2; ++ai)
#pragma unroll
                for (int m = 0; m < 4; ++m) { float* rowp = base + (size_t)(rowa - row0 + ai * HALF + m * 16) * ldc + col0;
#pragma unroll
                    for (int bj = 0; bj < 2; ++bj)
#pragma unroll
                        for (int n = 0; n < 2; ++n) *(f32x4*)(rowp + bj * HALF + n * 16) = acc[ai][bj][m][n]; }
        }
    }
};

struct EpiResBf16 {
    static constexpr bool PERM = true, AFTER_DRAIN = false;
    bf16_t* X; int ldc; float* SSQ; int emit;
    __device__ __forceinline__ void operator()(const f32x4 (&acc)[2][2][4][2], const Unit& u, int wr, int wc, int fr, int fq) const {
        const int row0 = u.pm * BM + wr * 64 + fr, col0 = u.pn * BM + wc * 32 + 8 * fq;
        u32x4 b[2][4][2];
#pragma unroll
        for (int ai = 0; ai < 2; ++ai)
#pragma unroll
            for (int m = 0; m < 4; ++m)
#pragma unroll
                for (int bj = 0; bj < 2; ++bj) b[ai][m][bj] = *(const u32x4*)(X + (size_t)(row0 + ai * HALF + m * 16) * ldc + col0 + bj * HALF);
#pragma unroll
        for (int ai = 0; ai < 2; ++ai)
#pragma unroll
            for (int m = 0; m < 4; ++m) { const int row = row0 + ai * HALF + m * 16; bf16_t* rowp = X + (size_t)row * ldc + col0; float ss = 0.f;
#pragma unroll
                for (int bj = 0; bj < 2; ++bj) { float v[8];
#pragma unroll
                    for (int j = 0; j < 4; ++j) { v[2 * j] = __uint_as_float(b[ai][m][bj][j] << 16); v[2 * j + 1] = __uint_as_float(b[ai][m][bj][j] & 0xffff0000u); }
#pragma unroll
                    for (int j = 0; j < 4; ++j) { v[j] += acc[ai][bj][m][0][j]; v[4 + j] += acc[ai][bj][m][1][j]; }
#pragma unroll
                    for (int j = 0; j < 8; ++j) ss += v[j] * v[j];
                    u32x4 w; w.x = cvt_pk_bf16(v[0], v[1]); w.y = cvt_pk_bf16(v[2], v[3]); w.z = cvt_pk_bf16(v[4], v[5]); w.w = cvt_pk_bf16(v[6], v[7]);
                    *(u32x4*)(rowp + bj * HALF) = w; }
                if (emit) { ss += __shfl_xor(ss, 16); ss += __shfl_xor(ss, 32); if (fq == 0) SSQ[(size_t)row * 32 + u.pn * 4 + wc] = ss; } }
    }
};
struct EpiSplitPart {
    static constexpr bool PERM = false, AFTER_DRAIN = false;
    float* P; int ldc; size_t pstride; int row0;
    __device__ __forceinline__ void operator()(const f32x4 (&acc)[2][2][4][2], const Unit& u, int wr, int wc, int fr, int fq) const {
        const int rowa = u.pm * BM + wr * 64 + fr, col0 = u.pn * BM + wc * 32 + 4 * fq;
        float* base = P + (size_t)u.kq * pstride;
#pragma unroll
        for (int ai = 0; ai < 2; ++ai)
#pragma unroll
            for (int m = 0; m < 4; ++m) { float* rowp = base + (size_t)(rowa - row0 + ai * HALF + m * 16) * ldc + col0;
#pragma unroll
                for (int bj = 0; bj < 2; ++bj)
#pragma unroll
                    for (int n = 0; n < 2; ++n) *(f32x4*)(rowp + bj * HALF + n * 16) = acc[ai][bj][m][n]; }
    }
};

struct EpiNull {
    static constexpr bool PERM = false, AFTER_DRAIN = false;
    __device__ __forceinline__ void operator()(const f32x4 (&acc)[2][2][4][2], const Unit&, int, int, int, int) const {
#pragma unroll
        for (int ai = 0; ai < 2; ++ai)
#pragma unroll
            for (int bj = 0; bj < 2; ++bj)
#pragma unroll
                for (int m = 0; m < 4; ++m)
#pragma unroll
                    for (int n = 0; n < 2; ++n) asm volatile("" :: "v"(acc[ai][bj][m][n]));
    }
};
template <class Epi, class Sched, bool ALIGN_EPI = false, bool SP2 = false>
__device__ __forceinline__ void gemm_phase(PG8_LAS unsigned char* lds, const Gemm g, const Sched& S, const Epi& E) {
    int tid_ = threadIdx.x; asm volatile("" : "+v"(tid_));
    const int tid = tid_, wid = __builtin_amdgcn_readfirstlane(tid >> 6), lane = tid & 63, wr = wid >> 2, wc = wid & 3, fr = lane & 15, fq = lane >> 4;
    const int K = g.K, nt = K / BK, ld = g.ld;
    unsigned voffA[2], voffB[2];
#pragma unroll
    for (int i = 0; i < 2; ++i) { int R, C; stage_rc(tid * 16 + i * 8192, R, C); const int Rb = Epi::PERM ? ((R & ~31) + perm32(R & 31)) : R;
        voffA[i] = (unsigned)(R * ld + C) * 2u; voffB[i] = (unsigned)(Rb * ld + C) * 2u; }
    const size_t kstep = (size_t)(BK * 2);
    const size_t hstep = (size_t)HALF * ld * 2;
    const size_t tstep = 2 * hstep;
    const unsigned ldsw = (unsigned)wid * 1024u;
    const int aoff = lds_byte(wr * 64 + fr, fq * 8), boff = lds_byte(wc * 32 + fr, fq * 8);
#define PG8_SA(b, h) (((b) * 2 + (h)) * HTB)
#define PG8_SB(b, h) ((4 + (b) * 2 + (h)) * HTB)
#define PG8_STAGE(bufoff, gbase, voff) do { _Pragma("unroll") for (int _i = 0; _i < 2; ++_i) \
        __builtin_amdgcn_global_load_lds((const unsigned*)((const char*)(gbase) + (voff)[_i]), (PG8_LAS unsigned*)(lds + (bufoff) + ldsw + _i * 8192), 16, 0, 0); } while (0)
#define PG8_LDA(dst, b, h) do { _Pragma("unroll") for (int m = 0; m < 4; ++m) _Pragma("unroll") for (int k = 0; k < 2; ++k) dst[m][k] = *(const PG8_LAS bf16x8*)(lds + PG8_SA(b, h) + aoff + m * 2048 + k * 1024); } while (0)
#define PG8_LDB(dst, b, h) do { _Pragma("unroll") for (int n = 0; n < 2; ++n) _Pragma("unroll") for (int k = 0; k < 2; ++k) dst[n][k] = *(const PG8_LAS bf16x8*)(lds + PG8_SB(b, h) + boff + n * 2048 + k * 1024); } while (0)
#define PG8_MMA(ai, bj, At, Bt) do { __builtin_amdgcn_s_setprio(1); _Pragma("unroll") for (int m = 0; m < 4; ++m) _Pragma("unroll") for (int n = 0; n < 2; ++n) _Pragma("unroll") for (int k = 0; k < 2; ++k) \
        acc[ai][bj][m][n] = __builtin_amdgcn_mfma_f32_16x16x32_bf16(Bt[n][k], At[m][k], acc[ai][bj][m][n], 0, 0, 0); __builtin_amdgcn_s_setprio(0); } while (0)
#define PG8_WAIT_V(n) asm volatile("s_waitcnt vmcnt(" #n ")" ::: "memory")
#define PG8_WAIT_L(n) asm volatile("s_waitcnt lgkmcnt(" #n ")" ::: "memory")
#define PG8_BAR __builtin_amdgcn_s_barrier()
#define PG8_SCHED __builtin_amdgcn_sched_barrier(0)
    Unit cur, nxt; int ui = 0;
    if (!S.next(0, cur)) return;
    f32x4 acc[2][2][4][2];
#pragma unroll
    for (int a = 0; a < 2; ++a)
#pragma unroll
        for (int b = 0; b < 2; ++b)
#pragma unroll
            for (int m = 0; m < 4; ++m)
#pragma unroll
                for (int n = 0; n < 2; ++n) acc[a][b][m][n] = (f32x4){0.f, 0.f, 0.f, 0.f};
    bf16x8 At[4][2], B0[2][2], B1[2][2];
    const char* cA = (const char*)g.A + (size_t)cur.pm * tstep + (size_t)cur.kq * K * 2; const char* cB = (const char*)g.Bt + (size_t)cur.pn * tstep + (size_t)cur.kq * K * 2;
    S.a_ready(cur);
    if constexpr (SP2) {
        PG8_STAGE(PG8_SB(0, 0), cB, voffB); PG8_STAGE(PG8_SB(0, 1), cB + hstep, voffB); PG8_STAGE(PG8_SA(0, 0), cA, voffA); PG8_STAGE(PG8_SA(0, 1), cA + hstep, voffA);
        if (wr == 1) PG8_BAR;
        PG8_WAIT_V(2); PG8_BAR;
        PG8_STAGE(PG8_SB(1, 0), cB + kstep, voffB); PG8_STAGE(PG8_SA(1, 0), cA + kstep, voffA); PG8_STAGE(PG8_SB(1, 1), cB + hstep + kstep, voffB);
        PG8_WAIT_V(6); PG8_BAR;
    } else {
        PG8_STAGE(PG8_SB(0, 0), cB, voffB); PG8_STAGE(PG8_SA(0, 0), cA, voffA); PG8_STAGE(PG8_SB(0, 1), cB + hstep, voffB); PG8_STAGE(PG8_SA(0, 1), cA + hstep, voffA);
        if (wr == 1) PG8_BAR;
        PG8_WAIT_V(4); PG8_BAR;
        PG8_STAGE(PG8_SB(1, 0), cB + kstep, voffB); PG8_STAGE(PG8_SA(1, 0), cA + kstep, voffA); PG8_STAGE(PG8_SB(1, 1), cB + hstep + kstep, voffB);
        PG8_WAIT_V(6); PG8_BAR;
    }
    for (;;) {
        const bool has_next = S.next(ui + 1, nxt);
        const char* nA = has_next ? (const char*)g.A + (size_t)nxt.pm * tstep + (size_t)nxt.kq * K * 2 : cA; const char* nB = has_next ? (const char*)g.Bt + (size_t)nxt.pn * tstep + (size_t)nxt.kq * K * 2 : cB;
        for (int t = 0; t < nt; t += 2) {
            const bool last = (t == nt - 2);
            const char* a1 = cA + (size_t)(t + 1) * kstep;
            const char* a2 = last ? nA : cA + (size_t)(t + 2) * kstep; const char* b2 = last ? nB : cB + (size_t)(t + 2) * kstep;
            const char* a3 = a2 + kstep; const char* b3 = b2 + kstep;
            if (last && has_next) S.a_ready(nxt);
            if constexpr (SP2) {
            PG8_LDB(B0, 0, 0); PG8_LDB(B1, 0, 1); PG8_SCHED; PG8_LDA(At, 0, 0); PG8_STAGE(PG8_SA(1, 1), a1 + hstep, voffA);
            PG8_WAIT_V(8); PG8_WAIT_L(0); PG8_BAR; PG8_MMA(0, 0, At, B0); PG8_MMA(0, 1, At, B1); PG8_BAR; PG8_SCHED;
            PG8_LDA(At, 0, 1); PG8_STAGE(PG8_SB(0, 0), b2, voffB); PG8_STAGE(PG8_SB(0, 1), b2 + hstep, voffB); PG8_STAGE(PG8_SA(0, 0), a2, voffA);
            PG8_WAIT_V(8); PG8_WAIT_L(0); PG8_BAR; PG8_MMA(1, 0, At, B0); PG8_MMA(1, 1, At, B1); PG8_BAR; PG8_SCHED;
            PG8_LDB(B0, 1, 0); PG8_LDB(B1, 1, 1); PG8_SCHED; PG8_LDA(At, 1, 0); PG8_STAGE(PG8_SA(0, 1), a2 + hstep, voffA);
            PG8_WAIT_V(8); PG8_WAIT_L(0); PG8_BAR; PG8_MMA(0, 0, At, B0); PG8_MMA(0, 1, At, B1); PG8_BAR; PG8_SCHED;
            PG8_LDA(At, 1, 1); PG8_STAGE(PG8_SB(1, 0), b3, voffB); PG8_STAGE(PG8_SB(1, 1), b3 + hstep, voffB); PG8_STAGE(PG8_SA(1, 0), a3, voffA);
            PG8_WAIT_V(8); PG8_WAIT_L(0); PG8_BAR; PG8_MMA(1, 0, At, B0); PG8_MMA(1, 1, At, B1); PG8_BAR; PG8_SCHED;
            } else {
            PG8_LDB(B0, 0, 0); PG8_SCHED; PG8_LDA(At, 0, 0); PG8_STAGE(PG8_SA(1, 1), a1 + hstep, voffA);
            PG8_WAIT_L(8); PG8_BAR; PG8_WAIT_L(0); PG8_MMA(0, 0, At, B0); PG8_BAR; PG8_SCHED;
            PG8_LDB(B1, 0, 1); PG8_STAGE(PG8_SB(0, 0), b2, voffB);
            PG8_BAR; PG8_WAIT_L(0); PG8_MMA(0, 1, At, B1); PG8_BAR;
            PG8_LDA(At, 0, 1); PG8_STAGE(PG8_SA(0, 0), a2, voffA);
            PG8_BAR; PG8_WAIT_L(0); PG8_MMA(1, 0, At, B0); PG8_BAR; PG8_SCHED;
            PG8_STAGE(PG8_SB(0, 1), b2 + hstep, voffB);
            PG8_WAIT_V(6); PG8_BAR; PG8_MMA(1, 1, At, B1); PG8_BAR;
            PG8_LDB(B0, 1, 0); PG8_SCHED; PG8_LDA(At, 1, 0); PG8_STAGE(PG8_SA(0, 1), a2 + hstep, voffA);
            PG8_WAIT_L(8); PG8_BAR; PG8_WAIT_L(0); PG8_MMA(0, 0, At, B0); PG8_BAR; PG8_SCHED;
            PG8_LDB(B1, 1, 1); PG8_STAGE(PG8_SB(1, 0), b3, voffB);
            PG8_BAR; PG8_WAIT_L(0); PG8_MMA(0, 1, At, B1); PG8_BAR;
            PG8_LDA(At, 1, 1); PG8_STAGE(PG8_SA(1, 0), a3, voffA);
            PG8_BAR; PG8_WAIT_L(0); PG8_MMA(1, 0, At, B0); PG8_BAR; PG8_SCHED;
            PG8_STAGE(PG8_SB(1, 1), b3 + hstep, voffB);
            PG8_WAIT_V(6); PG8_BAR; PG8_MMA(1, 1, At, B1); PG8_BAR;
            }
        }
        if constexpr (ALIGN_EPI) { if (wr == 0) PG8_BAR; }
        if constexpr (!Epi::AFTER_DRAIN) { E(acc, cur, wr, wc, fr, fq); S.done(cur); }
        if (!has_next) break;
#pragma unroll
        for (int a = 0; a < 2; ++a)
#pragma unroll
            for (int b = 0; b < 2; ++b)
#pragma unroll
                for (int m = 0; m < 4; ++m)
#pragma unroll
                    for (int n = 0; n < 2; ++n) acc[a][b][m][n] = (f32x4){0.f, 0.f, 0.f, 0.f};
        cur = nxt; cA = nA; cB = nB; ++ui;
        if constexpr (ALIGN_EPI) { if (wr == 1) PG8_BAR; }
    }
    PG8_WAIT_V(0);
    if constexpr (!ALIGN_EPI) { if (wr == 0) PG8_BAR; }
    PG8_BAR;
    if constexpr (Epi::AFTER_DRAIN) { E.fused(acc, cur, wr, wc, fr, fq, lds, wid, lane); S.done(cur); }
#undef PG8_SA
#undef PG8_SB
#undef PG8_STAGE
#undef PG8_LDA
#undef PG8_LDB
#undef PG8_MMA
#undef PG8_WAIT_V
#undef PG8_WAIT_L
#undef PG8_BAR
#undef PG8_SCHED
}
}

#define DI __device__ __forceinline__
#define LAS __attribute__((address_space(3)))
typedef unsigned short bf16;
typedef short bf16x8 __attribute__((ext_vector_type(8)));
typedef short s16x4 __attribute__((ext_vector_type(4)));
typedef short v4i16_t __attribute__((ext_vector_type(4)));
typedef float f32x4 __attribute__((ext_vector_type(4)));
typedef float f32x16 __attribute__((ext_vector_type(16)));
typedef unsigned u32x4 __attribute__((ext_vector_type(4)));
typedef unsigned u32x2 __attribute__((ext_vector_type(2)));
typedef float f32x2_t_ __attribute__((ext_vector_type(2)));

constexpr int DM = 2048, NB = 8, SEQ = 2048, DEPTH = 4, DBAT = 32, DSEQ = 64, PAST = 1024, BWIN = 512;
constexpr int NTP = NB * SEQ, NTS = DBAT * DSEQ, NTOK = NTP + NTS;
constexpr int INC = 7264, INP = 7424, DFF = 8192;
constexpr int C_AQ = 0, C_AK = 512, C_AV = 1024, C_IQ = 1536, C_IK = 2560, C_IW = 2624, C_BQ = 2640, C_BK = 3152, C_BV = 3664, C_CZ = 4176, C_XBC = 5200, C_DT = 7248;
constexpr float EPS = 1e-5f;
constexpr int NWAVES = 8, NTHR = 512;

constexpr size_t SZ_YP = (size_t)NTP * DM, SZ_YS = (size_t)NTS * DM;
constexpr size_t SZ_PAK = (size_t)DEPTH * NB * SEQ * 512, SZ_PKI = (size_t)DEPTH * NB * SEQ * 64, SZ_PBK = (size_t)DEPTH * NB * BWIN * 512;
constexpr size_t SZ_PSSM = (size_t)DEPTH * NB * 16 * 64 * 128, SZ_PCONV = (size_t)DEPTH * NB * 3 * 2048;
constexpr size_t SZ_SAK = (size_t)DEPTH * DBAT * DSEQ * 512, SZ_SKI = (size_t)DEPTH * DBAT * DSEQ * 64, SZ_SBK = SZ_SAK;
constexpr size_t SZ_SSSM = (size_t)DEPTH * DBAT * 16 * 64 * 128, SZ_SCONV = (size_t)DEPTH * DBAT * 3 * 2048;
constexpr size_t OFF_YP = 0, OFF_YS = OFF_YP + SZ_YP, OFF_P_AK = OFF_YS + SZ_YS, OFF_P_AV = OFF_P_AK + SZ_PAK, OFF_P_KI = OFF_P_AV + SZ_PAK,
                 OFF_P_BK = OFF_P_KI + SZ_PKI, OFF_P_BV = OFF_P_BK + SZ_PBK, OFF_P_SSM = OFF_P_BV + SZ_PBK, OFF_P_CONV = OFF_P_SSM + SZ_PSSM,
                 OFF_S_AK = OFF_P_CONV + SZ_PCONV, OFF_S_AV = OFF_S_AK + SZ_SAK, OFF_S_KI = OFF_S_AV + SZ_SAK, OFF_S_BK = OFF_S_KI + SZ_SKI,
                 OFF_S_BV = OFF_S_BK + SZ_SBK, OFF_S_SSM = OFF_S_BV + SZ_SBK, OFF_S_CONV = OFF_S_SSM + SZ_SSSM, OUT_TOTAL = OFF_S_CONV + SZ_SCONV;
static_assert(OUT_TOTAL == 165085184, "output size");

constexpr size_t MiB = 1u << 20;
constexpr size_t WS_CTL = 0, CTL_ZERO_BYTES = 1 * MiB;
constexpr size_t WS_ROPE = 1 * MiB;
constexpr size_t WS_W = 2 * MiB;
constexpr size_t W_IN_B = (size_t)INP * DM * 2, W_OUT_B = (size_t)DM * DM * 2, W_UP_B = (size_t)DFF * DM * 2, W_DN_B = (size_t)DM * DFF * 2, W_LAYER_B = W_IN_B + W_OUT_B + W_UP_B + W_DN_B;
static_assert(W_LAYER_B == 101 * MiB, "weights per layer");
constexpr size_t WS_X = WS_W + DEPTH * W_LAYER_B;
constexpr size_t WS_H = WS_X + (size_t)NTOK * DM * 4;
constexpr size_t WS_MIX = WS_H + (size_t)NTOK * DM * 2;
constexpr size_t WS_PU = WS_MIX + (size_t)NTOK * DM * 2;
constexpr size_t WS_XBC = WS_PU + (size_t)NTOK * DFF * 2;
constexpr size_t WS_G = WS_XBC + (size_t)NTOK * 2048 * 2;
constexpr size_t WS_DTS = WS_G + (size_t)NTOK * 1024 * 4;
constexpr size_t WS_CAK = WS_DTS + 2 * MiB;
constexpr size_t WS_CAV = WS_CAK + (size_t)DBAT * PAST * 512 * 2;
constexpr size_t WS_CBK = WS_CAV + (size_t)DBAT * PAST * 512 * 2;
constexpr size_t WS_CBV = WS_CBK + (size_t)DBAT * BWIN * 512 * 2;
constexpr size_t WS_CKI = WS_CBV + (size_t)DBAT * BWIN * 512 * 2;
constexpr size_t WS_SC = WS_CKI + (size_t)DBAT * PAST * 64 * 2;
constexpr size_t WS_SSQ1 = WS_SC + (size_t)256 * 64 * 2048 * 4, WS_SSQ2 = WS_SSQ1 + 3 * MiB;
constexpr size_t WS_END = WS_SSQ2 + 3 * MiB;
static_assert(WS_END == 1362 * MiB, "ws map");
constexpr int CW_BAR = 4096;
constexpr int LDS_ULIST = 147456;
constexpr int CW_H = 16384 + 64 * 64;
constexpr int CW_Q = 16384;

constexpr int RING_BYTES = 155648, LDSCTL_OFF = RING_BYTES, LDS_RSTD = 131072, LDS_BYTES = 157696;
constexpr int ATT_SEL = 0;
constexpr int ATT_K = 16384, KSTR = 1040, ATT_V = ATT_K + 2 * 32 * KSTR, VSTR = 1088, ATT_END = ATT_V + 2 * 32 * VSTR;
constexpr int CSTR = 272, XSTR = 144, MSTR = 144, HSTR = 272;
constexpr int SSD_CS = 0, SSD_BS = SSD_CS + 64 * CSTR, SSD_XD = SSD_BS + 64 * CSTR, SSD_XDW = SSD_XD + 64 * XSTR, SSD_MS = SSD_XDW + 64 * XSTR,
              SSD_HS = SSD_MS + 64 * MSTR, SSD_VEC = SSD_HS + 2 * 64 * HSTR, SSD_Y = SSD_VEC + 1024, YSTR = 272, SSD_Y2 = SSD_Y + 64 * YSTR, SSD_END = SSD_Y2 + 64 * YSTR;
static_assert(ATT_END <= RING_BYTES && SSD_END <= RING_BYTES, "phase scratch fits the ring region");

DI float bf2f(bf16 v) { return __uint_as_float(((unsigned)v) << 16); }
DI unsigned pk2(float lo, float hi) { return pg8::cvt_pk_bf16(lo, hi); }
DI bf16 f2bf(float f) { return (bf16)(pk2(f, 0.f) & 0xffffu); }
DI float wave_sum(float v) {
#pragma unroll
    for (int o = 1; o < 64; o <<= 1) v += __shfl_xor(v, o);
    return v;
}
DI f32x16 mfma32(bf16x8 a, bf16x8 b, f32x16 c) { return __builtin_amdgcn_mfma_f32_32x32x16_bf16(a, b, c, 0, 0, 0); }
DI int crow(int i, int hh) { return (i & 3) + 8 * (i >> 2) + 4 * hh; }
DI s16x4 tr_read(LAS unsigned char* p) { return __builtin_bit_cast(s16x4, __builtin_amdgcn_ds_read_tr16_b64_v4i16((LAS v4i16_t*)p)); }
DI bf16x8 trfrag(LAS unsigned char* tile, int stride, int k0, int c0, int lane) {
    const int i16 = lane & 15, qq = i16 >> 2, p = i16 & 3, g2 = (lane >> 4) & 1, hh = lane >> 5;
    LAS unsigned char* a = tile + (k0 + 8 * hh + qq) * stride + (c0 + 16 * g2 + 4 * p) * 2;
    const s16x4 lo = tr_read(a), hi = tr_read(a + 4 * stride);
    return __builtin_shufflevector(lo, hi, 0, 1, 2, 3, 4, 5, 6, 7);
}
DI void unpack8(u32x4 v, float (&f)[8]) {
#pragma unroll
    for (int i = 0; i < 4; ++i) { f[2 * i] = __uint_as_float(v[i] << 16); f[2 * i + 1] = __uint_as_float(v[i] & 0xffff0000u); }
}
DI u32x4 pack8(const float (&f)[8]) { u32x4 o; o.x = pk2(f[0], f[1]); o.y = pk2(f[2], f[3]); o.z = pk2(f[4], f[5]); o.w = pk2(f[6], f[7]); return o; }

#define XB_TMO      128
#define XB_XCNT(j)  (256  + 64 * (j))
#define XB_XSUB(j)  (1280 + 64 * (j))
#define XB_XGEN(j)  (2304 + 64 * (j))
#define XB_TOP      3328
#define XB_TOPGEN   3392
#define XCD_BAR_WORDS 3456
#define XB_SPIN_CAP (1u << 20)
DI unsigned xb_ld(unsigned* p)              { return __hip_atomic_load(p, __ATOMIC_RELAXED, __HIP_MEMORY_SCOPE_AGENT); }
DI unsigned xb_add(unsigned* p, unsigned v) { return __hip_atomic_fetch_add(p, v, __ATOMIC_RELAXED, __HIP_MEMORY_SCOPE_AGENT); }
DI unsigned xb_xcc_id() { return (unsigned)__builtin_amdgcn_s_getreg((3 << 11) | 20) & 0xFu; }
#define XB_SPIN(cond, bar) do { unsigned _sp = 0; while (cond) { __builtin_amdgcn_s_sleep(1); \
    if ((++_sp & 255u) == 0u) { if (xb_ld(&(bar)[XB_TMO])) break; if (_sp > XB_SPIN_CAP) { atomicAdd(&(bar)[XB_TMO], 1u); break; } } } } while (0)
struct XcdBarrier { unsigned* bar; unsigned x; volatile LAS unsigned* st; };
DI XcdBarrier xcd_barrier_post(unsigned* bar, volatile LAS unsigned* st) {
    XcdBarrier b; b.bar = bar; b.x = xb_xcc_id(); b.st = st;
    if (threadIdx.x == 0) (void)xb_add(&bar[XB_XCNT(b.x)], 1u);
    return b;
}
DI void xcd_barrier_complete(unsigned* bar, unsigned x, unsigned& nloc, unsigned& nx) {
    const unsigned G = gridDim.x * gridDim.y * gridDim.z;
    unsigned sum, cnt, mine, sp = 0u;
    for (;;) {
        sum = 0u; cnt = 0u; mine = 0u;
#pragma unroll
        for (unsigned j = 0; j < 16; ++j) { const unsigned c = xb_ld(&bar[XB_XCNT(j)]); sum += c; cnt += (c > 0u) ? 1u : 0u; mine = (j == x) ? c : mine; }
        if (sum == G) break;
        __builtin_amdgcn_s_sleep(1);
        if ((++sp & 255u) == 0u) { if (xb_ld(&bar[XB_TMO])) break; if (sp > XB_SPIN_CAP) { atomicAdd(&bar[XB_TMO], 1u); break; } }
    }
    nloc = mine > 0u ? mine : 1u; nx = cnt > 0u ? cnt : 1u;
}
DI void xcd_barrier(const XcdBarrier& b) {
    asm volatile("s_waitcnt vmcnt(0)" ::: "memory");
    __syncthreads();
    if (threadIdx.x == 0) {
        unsigned* bar = b.bar;
        __builtin_amdgcn_s_waitcnt(0);
        unsigned nloc = b.st[0], nx = b.st[1];
        if (nloc == 0u) { xcd_barrier_complete(bar, b.x, nloc, nx); b.st[0] = nloc; b.st[1] = nx; }
        const unsigned old = xb_add(&bar[XB_XSUB(b.x)], 1u);
        const unsigned gen = old / nloc;
        if (old + 1u == (gen + 1u) * nloc) {
            __builtin_amdgcn_fence(__ATOMIC_RELEASE, "agent");
            asm volatile("s_waitcnt vmcnt(0)" ::: "memory");
            const unsigned og = xb_add(&bar[XB_TOP], 1u);
            const unsigned tg = og / nx;
            if (og + 1u == (tg + 1u) * nx) xb_add(&bar[XB_TOPGEN], 1u);
            else XB_SPIN(xb_ld(&bar[XB_TOPGEN]) == tg, bar);
            __builtin_amdgcn_fence(__ATOMIC_ACQUIRE, "agent");
            xb_add(&bar[XB_XGEN(b.x)], 1u);
            asm volatile("s_waitcnt vmcnt(0)" ::: "memory");
        } else {
            XB_SPIN(xb_ld(&bar[XB_XGEN(b.x)]) == gen, bar);
            __builtin_amdgcn_fence(__ATOMIC_ACQUIRE, "agent");
            asm volatile("s_waitcnt vmcnt(0)" ::: "memory");
        }
    }
    __syncthreads();
}

struct Args { const float* in[23]; float* out; unsigned char* ws; int ph_lo, ph_hi; };
static_assert(sizeof(Args) == 23 * 8 + 8 + 8 + 8, "Args has no padding");
struct Ctx {
    LAS unsigned char* lds;
    unsigned* ctl;
    int tid, lane, wave, G, bid;
    float* out;
    unsigned char* ws;
};
DI bf16* ws_bf(const Ctx& C, size_t off) { return (bf16*)(C.ws + off); }
DI float* ws_f(const Ctx& C, size_t off) { return (float*)(C.ws + off); }
DI bf16* w_in_t(const Ctx& C, int l)  { return (bf16*)(C.ws + WS_W + (size_t)l * W_LAYER_B); }
DI bf16* w_out_t(const Ctx& C, int l) { return (bf16*)(C.ws + WS_W + (size_t)l * W_LAYER_B + W_IN_B); }
DI bf16* w_up_t(const Ctx& C, int l)  { return (bf16*)(C.ws + WS_W + (size_t)l * W_LAYER_B + W_IN_B + W_OUT_B); }
DI bf16* w_dn_t(const Ctx& C, int l)  { return (bf16*)(C.ws + WS_W + (size_t)l * W_LAYER_B + W_IN_B + W_OUT_B + W_UP_B); }

DI int q_prefetch(const Ctx& C, unsigned* head) { int v = 0; if (C.tid == 0) v = (int)__hip_atomic_fetch_add(head, 1u, __ATOMIC_RELAXED, __HIP_MEMORY_SCOPE_AGENT); return v; }
DI int q_publish(const Ctx& C, int v) {
    volatile LAS int* slot = (volatile LAS int*)(C.lds + LDSCTL_OFF + 64);
    __syncthreads();
    if (C.tid == 0) *slot = v;
    __syncthreads();
    return *slot;
}
DI int q_next(const Ctx& C, unsigned* head) {
    volatile LAS int* slot = (volatile LAS int*)(C.lds + LDSCTL_OFF + 64);
    __syncthreads();
    if (C.tid == 0) *slot = (int)__hip_atomic_fetch_add(head, 1u, __ATOMIC_RELAXED, __HIP_MEMORY_SCOPE_AGENT);
    __syncthreads();
    return *slot;
}

DI void wait_flags(const Ctx& C, unsigned* flg, int p0, int n) {
    if (C.tid == 0) { for (int p = p0; p < p0 + n; ++p) XB_SPIN(xb_ld(&flg[64 * p]) < 3u, C.ctl + CW_BAR); __builtin_amdgcn_fence(__ATOMIC_ACQUIRE, "agent"); }
    __syncthreads();
}
DI void p0_transpose_item(const float* W, int K, int N, bf16* WT, LAS float* scr, int item, int lane, const float* kscale = nullptr) {
    const int nblk = N / 32, kb = item / nblk, nb = item % nblk, k0 = 64 * kb, n0 = 32 * nb;
    float tv[32];
#pragma unroll
    for (int i = 0; i < 32; ++i) { const int kk = 2 * i + (lane >> 5); tv[i] = W[(size_t)(k0 + kk) * N + n0 + (lane & 31)]; }
#pragma unroll
    for (int i = 0; i < 32; ++i) { const int kk = 2 * i + (lane >> 5); const float sc = kscale ? kscale[k0 + kk] : 1.0f; scr[kk * 33 + (lane & 31)] = tv[i] * sc; }
    asm volatile("s_waitcnt lgkmcnt(0)" ::: "memory");
    const int c = lane & 7;
#pragma unroll
    for (int j = 0; j < 4; ++j) { const int n = (lane >> 3) + 8 * j; const LAS float* s = scr + (8 * c) * 33 + n;
        u32x4 o; o.x = pk2(s[0 * 33], s[1 * 33]); o.y = pk2(s[2 * 33], s[3 * 33]); o.z = pk2(s[4 * 33], s[5 * 33]); o.w = pk2(s[6 * 33], s[7 * 33]);
        *(u32x4*)(WT + (size_t)(n0 + n) * K + k0 + 8 * c) = o; }
    asm volatile("s_waitcnt lgkmcnt(0)" ::: "memory");
}
DI void row_ssq_slots(float ss, float* slots, int lane) { if (lane < 32) slots[lane] = lane == 0 ? ss : 0.f; }
DI void p0_row(const float* src, bf16* xrow, float* slots, int lane) {
    float ss = 0.f;
#pragma unroll
    for (int j = 0; j < 4; ++j) { const f32x4 a = ((const f32x4*)src)[2 * (lane + 64 * j)], b = ((const f32x4*)src)[2 * (lane + 64 * j) + 1];
        ss += (a.x * a.x + a.y * a.y) + (a.z * a.z + a.w * a.w) + (b.x * b.x + b.y * b.y) + (b.z * b.z + b.w * b.w);
        u32x4 o; o.x = pk2(a.x, a.y); o.y = pk2(a.z, a.w); o.z = pk2(b.x, b.y); o.w = pk2(b.z, b.w); ((u32x4*)xrow)[lane + 64 * j] = o; }
    row_ssq_slots(wave_sum(ss), slots, lane);
}
DI void res_row(bf16* xrow, const float* part, size_t pstride, int mode, float* slots, const float* w, float* outf, int lane) {
    float v[4][8]; float ss = 0.f;
#pragma unroll
    for (int j = 0; j < 4; ++j) { unpack8(((const u32x4*)xrow)[lane + 64 * j], v[j]);
        if (part) {
#pragma unroll
            for (int k = 0; k < 4; ++k) { const float* pp = part + k * pstride + 8 * (lane + 64 * j); const f32x4 a = *(const f32x4*)pp, b = *(const f32x4*)(pp + 4);
                v[j][0] += a.x; v[j][1] += a.y; v[j][2] += a.z; v[j][3] += a.w; v[j][4] += b.x; v[j][5] += b.y; v[j][6] += b.z; v[j][7] += b.w; } }
#pragma unroll
        for (int k = 0; k < 8; ++k) ss += v[j][k] * v[j][k]; }
    ss = wave_sum(ss);
    if (mode == 0) {
#pragma unroll
        for (int j = 0; j < 4; ++j) ((u32x4*)xrow)[lane + 64 * j] = pack8(v[j]);
        row_ssq_slots(ss, slots, lane);
    } else {
        const float rs = 1.0f / sqrtf(ss * (1.0f / DM) + EPS);
#pragma unroll
        for (int j = 0; j < 4; ++j) { const float* wp = w + 8 * (lane + 64 * j); const f32x4 w0 = *(const f32x4*)wp, w1 = *(const f32x4*)(wp + 4); float* op = outf + 8 * (lane + 64 * j);
            *(f32x4*)op = (f32x4){v[j][0] * rs * w0.x, v[j][1] * rs * w0.y, v[j][2] * rs * w0.z, v[j][3] * rs * w0.w};
            *(f32x4*)(op + 4) = (f32x4){v[j][4] * rs * w1.x, v[j][5] * rs * w1.y, v[j][6] * rs * w1.z, v[j][7] * rs * w1.w}; }
    }
}
DI void sincos_tab(float ang, float& c, float& s) {
    const double a = (double)ang; const double kq = rint(a * 0.63661977236758134308); const double x = a - kq * 1.57079632679489661923; const double x2 = x * x;
    const double sn = x * (1.0 + x2 * (-1.0 / 6 + x2 * (1.0 / 120 + x2 * (-1.0 / 5040 + x2 * (1.0 / 362880 + x2 * (-1.0 / 39916800 + x2 * (1.0 / 6227020800.0)))))));
    const double cn = 1.0 + x2 * (-0.5 + x2 * (1.0 / 24 + x2 * (-1.0 / 720 + x2 * (1.0 / 40320 + x2 * (-1.0 / 3628800 + x2 * (1.0 / 479001600 + x2 * (-1.0 / 87178291200.0)))))));
    const int q = ((int)kq) & 3;
    const double cc = (q == 0) ? cn : (q == 1) ? -sn : (q == 2) ? -cn : sn;
    const double sc = (q == 0) ? sn : (q == 1) ? cn : (q == 2) ? -sn : -cn;
    c = (float)cc; s = (float)sc;
}
constexpr int I_IN = (DM / 64) * (INC / 32), I_OUT = (DM / 64) * (DM / 32), I_UP = (DM / 64) * (DFF / 32), I_DN = (DFF / 64) * (DM / 32), I_L = I_IN + I_OUT + I_UP + I_DN;
static_assert(I_L % 8 == 0, "items per layer in groups of 8 waves");
DI void wconv_item(const Ctx& C, const Args& A, int l, int r, LAS float* scr) {
    if (r < I_IN) { p0_transpose_item(A.in[10] + (size_t)l * DM * INC, DM, INC, w_in_t(C, l), scr, r, C.lane, A.in[9] + (size_t)l * DM); return; } r -= I_IN;
    if (r < I_OUT) { p0_transpose_item(A.in[11] + (size_t)l * DM * DM, DM, DM, w_out_t(C, l), scr, r, C.lane); return; } r -= I_OUT;
    if (r < I_UP) { p0_transpose_item(A.in[20] + (size_t)l * DM * DFF, DM, DFF, w_up_t(C, l), scr, r, C.lane, A.in[19] + (size_t)l * DM); return; } r -= I_UP;
    p0_transpose_item(A.in[21] + (size_t)l * DFF * DM, DFF, DM, w_dn_t(C, l), scr, r, C.lane);
}
DI void wconv_some(const Ctx& C, const Args& A, int l, int max_entries) {
    unsigned* head = C.ctl + CW_Q + 64 * (40 + l);
    LAS float* scr = (LAS float*)(C.lds + C.wave * 16384);
    for (int n = 0; n < max_entries; ++n) { const int e = q_next(C, head); if (e >= I_L / 8) break; wconv_item(C, A, l, e * 8 + C.wave, scr); }
}
DI void p0_prologue(const Ctx& C, const Args& A) {
    LAS float* scr = (LAS float*)(C.lds + C.wave * 16384);
    const int gw = C.bid * NWAVES + C.wave, NGW = C.G * NWAVES;
    for (int it = gw; it < DEPTH * I_L; it += NGW) wconv_item(C, A, it / I_L, it % I_L, scr);
    { const int gt = C.bid * NTHR + C.tid, NGT = C.G * NTHR; constexpr int CH_L = (INP - INC) * DM / 8;
      for (int i = gt; i < DEPTH * CH_L; i += NGT) { const int l = i / CH_L, c = i % CH_L; ((u32x4*)(w_in_t(C, l) + (size_t)INC * DM))[c] = (u32x4){0u, 0u, 0u, 0u}; }
      float* ra = ws_f(C, WS_ROPE); float* ri = ra + 2048 * 16 * 2;
      for (int i = gt; i < 2048 * 24; i += NGT) { const int pos = i / 24, k = i % 24; const bool isa = k < 16; const int fi = isa ? k : k - 16;
          const double ex = isa ? (double)fi / 16.0 : (double)fi / 8.0; const float inv = (float)exp2(-ex * 18.931568569324174  );
          const float ang = (float)pos * inv; float c, s; sincos_tab(ang, c, s);
          float* dst = isa ? ra + (pos * 16 + fi) * 2 : ri + (pos * 8 + fi) * 2; dst[0] = c; dst[1] = s; } }
    for (int m = gw; m < NTOK; m += NGW) { const float* src = m < NTP ? A.in[0] + (size_t)m * DM : A.in[1] + (size_t)(m - NTP) * DM;
        p0_row(src, ws_bf(C, WS_X) + (size_t)m * DM, ws_f(C, WS_SSQ1) + (size_t)m * 32, C.lane); }
}

struct M0Row { unsigned ra1, ra2, ri1, ri2, rk1, rk2; u32x4 cak, cav, cik, cbk, cbv, xb[4]; f32x4 tA, tI; bf16 dt; };
DI void m0_decode(int r, bool& smp, int& b, int& t, int& pos) { smp = r >= NTP; if (!smp) { b = r >> 11; t = r & 2047; pos = t; } else { const int rr = r - NTP; b = rr >> 6; t = rr & 63; pos = PAST + t; } }
DI void m0_load(const Ctx& C, int r, int lane, M0Row& R) {
    const bf16* P = ws_bf(C, WS_PU) + (size_t)r * INP;
    bool smp; int b, t, pos; m0_decode(r, smp, b, t, pos);
    { const int h8 = lane >> 3, j = lane & 7; const bf16* p = P + (h8 < 4 ? C_AQ + h8 * 128 : C_AK + (h8 - 4) * 128) + 2 * j; R.ra1 = *(const unsigned*)p; R.ra2 = *(const unsigned*)(p + 16); }
    { const int h16 = lane >> 2, j = lane & 3; const bf16* p = P + C_IQ + h16 * 64 + 2 * j; R.ri1 = *(const unsigned*)p; R.ri2 = *(const unsigned*)(p + 8); }
    if (lane < 4) { const bf16* p = P + C_IK + 2 * lane; R.rk1 = *(const unsigned*)p; R.rk2 = *(const unsigned*)(p + 8); }
    if (lane < 48) R.cak = *(const u32x4*)(P + C_AK + (lane / 12) * 128 + 32 + (lane % 12) * 8);
    R.cav = *(const u32x4*)(P + C_AV + lane * 8);
    if (lane >= 8 && lane < 14) R.cik = *(const u32x4*)(P + C_IK + 16 + (lane - 8) * 8);
    if (smp || t >= SEQ - BWIN) { R.cbk = *(const u32x4*)(P + C_BK + lane * 8); R.cbv = *(const u32x4*)(P + C_BV + lane * 8); }
    if (lane < 16) R.dt = P[C_DT + lane];
#pragma unroll
    for (int it = 0; it < 4; ++it) R.xb[it] = *(const u32x4*)(P + C_XBC + (lane + 64 * it) * 8);
    R.tA = *(const f32x4*)(ws_f(C, WS_ROPE) + (size_t)pos * 32 + 4 * (lane & 7));
    R.tI = *(const f32x4*)(ws_f(C, WS_ROPE) + 2048 * 32 + (size_t)pos * 16 + 4 * (lane & 3));
}
DI void rope2(unsigned a, unsigned bq, f32x4 t, float (&y1)[2], float (&y2)[2]) {
    const float a0 = __uint_as_float(a << 16), a1 = __uint_as_float(a & 0xffff0000u), b0 = __uint_as_float(bq << 16), b1 = __uint_as_float(bq & 0xffff0000u);
    y1[0] = a0 * t.x - b0 * t.y; y2[0] = b0 * t.x + a0 * t.y; y1[1] = a1 * t.z - b1 * t.w; y2[1] = b1 * t.z + a1 * t.w;
}
DI void st8f(float* dst, u32x4 v) { float f[8]; unpack8(v, f); __builtin_nontemporal_store((f32x4){f[0], f[1], f[2], f[3]}, (f32x4*)dst); __builtin_nontemporal_store((f32x4){f[4], f[5], f[6], f[7]}, (f32x4*)dst + 1); }
DI void m0_window(const Ctx& C, const Args& A, int l, int r, int lane, u32x4 (&wnd)[3][4]) {
    bool smp; int b, t, pos; m0_decode(r, smp, b, t, pos);
#pragma unroll
    for (int k = 1; k <= 3; ++k) { const int tt = t - k;
#pragma unroll
        for (int it = 0; it < 4; ++it) { const int ch = (lane + 64 * it) * 8; u32x4 v = (u32x4){0u, 0u, 0u, 0u};
            if (tt >= 0) v = *(const u32x4*)(ws_bf(C, WS_PU) + (size_t)(r - k) * INP + C_XBC + ch);
            else if (smp) { const float* sp = A.in[8] + ((size_t)(l * DBAT + b) * 3 + (3 + tt)) * 2048 + ch; const f32x4 s0 = *(const f32x4*)sp, s1 = *(const f32x4*)(sp + 4);
                v.x = pk2(s0.x, s0.y); v.y = pk2(s0.z, s0.w); v.z = pk2(s1.x, s1.y); v.w = pk2(s1.z, s1.w); }
            wnd[3 - k][it] = v; } }
}
DI void m0_process(const Ctx& C, const Args& A, int l, int r, int lane, const M0Row& R, u32x4 (&wnd)[3][4], const LAS float* cwL, const LAS float* cbL) {
    bf16* P = ws_bf(C, WS_PU) + (size_t)r * INP;
    bool smp; int b, t, pos; m0_decode(r, smp, b, t, pos);
    float* out = C.out;
    float* o_ak = smp ? out + OFF_S_AK + ((size_t)(l * DBAT + b) * DSEQ + t) * 512 : out + OFF_P_AK + ((size_t)(l * NB + b) * SEQ + t) * 512;
    float* o_av = smp ? out + OFF_S_AV + ((size_t)(l * DBAT + b) * DSEQ + t) * 512 : out + OFF_P_AV + ((size_t)(l * NB + b) * SEQ + t) * 512;
    float* o_ki = smp ? out + OFF_S_KI + ((size_t)(l * DBAT + b) * DSEQ + t) * 64 : out + OFF_P_KI + ((size_t)(l * NB + b) * SEQ + t) * 64;
    float y1[2], y2[2];
    { const int h8 = lane >> 3, j = lane & 7; rope2(R.ra1, R.ra2, R.tA, y1, y2);
      bf16* p = P + (h8 < 4 ? C_AQ + h8 * 128 : C_AK + (h8 - 4) * 128) + 2 * j; *(unsigned*)p = pk2(y1[0], y1[1]); *(unsigned*)(p + 16) = pk2(y2[0], y2[1]);
      if (h8 >= 4) { float* o = o_ak + (h8 - 4) * 128 + 2 * j; *(f32x2_t_*)o = (f32x2_t_){y1[0], y1[1]}; *(f32x2_t_*)(o + 16) = (f32x2_t_){y2[0], y2[1]}; } }
    { const int h16 = lane >> 2, j = lane & 3; rope2(R.ri1, R.ri2, R.tI, y1, y2);
      bf16* p = P + C_IQ + h16 * 64 + 2 * j; *(unsigned*)p = pk2(y1[0], y1[1]); *(unsigned*)(p + 8) = pk2(y2[0], y2[1]); }
    if (lane < 4) { rope2(R.rk1, R.rk2, R.tI, y1, y2);
      bf16* p = P + C_IK + 2 * lane; *(unsigned*)p = pk2(y1[0], y1[1]); *(unsigned*)(p + 8) = pk2(y2[0], y2[1]);
      float* o = o_ki + 2 * lane; *(f32x2_t_*)o = (f32x2_t_){y1[0], y1[1]}; *(f32x2_t_*)(o + 8) = (f32x2_t_){y2[0], y2[1]}; }
    if (lane < 48) st8f(o_ak + (lane / 12) * 128 + 32 + (lane % 12) * 8, R.cak);
    st8f(o_av + lane * 8, R.cav);
    if (lane >= 8 && lane < 14) st8f(o_ki + 16 + (lane - 8) * 8, R.cik);
    if (smp || t >= SEQ - BWIN) {
        const size_t ro = smp ? ((size_t)(l * DBAT + b) * DSEQ + t) * 512 : ((size_t)(l * NB + b) * BWIN + (t - (SEQ - BWIN))) * 512;
        st8f(out + (smp ? OFF_S_BK : OFF_P_BK) + ro + lane * 8, R.cbk); st8f(out + (smp ? OFF_S_BV : OFF_P_BV) + ro + lane * 8, R.cbv);
    }
    if (lane < 16) { const float x = bf2f(R.dt) + A.in[15][l * 16 + lane]; ws_f(C, WS_DTS)[(size_t)r * 16 + lane] = x > 20.f ? x : log1pf(__expf(x)); }
    const int stt = smp ? DSEQ - 3 : SEQ - 3;
    float* o_conv = (t >= stt) ? (smp ? out + OFF_S_CONV + ((size_t)(l * DBAT + b) * 3 + (t - stt)) * 2048 : out + OFF_P_CONV + ((size_t)(l * NB + b) * 3 + (t - stt)) * 2048) : nullptr;
    bf16* xo = ws_bf(C, WS_XBC) + (size_t)r * 2048;
#pragma unroll
    for (int it = 0; it < 4; ++it) { const int ch = (lane + 64 * it) * 8;
        float acc[8], x[8];
        { const f32x4 b0 = *(const LAS f32x4*)(cbL + ch), b1 = *(const LAS f32x4*)(cbL + ch + 4); acc[0] = b0.x; acc[1] = b0.y; acc[2] = b0.z; acc[3] = b0.w; acc[4] = b1.x; acc[5] = b1.y; acc[6] = b1.z; acc[7] = b1.w; }
#pragma unroll
        for (int j = 0; j < 4; ++j) { unpack8(j < 3 ? wnd[j][it] : R.xb[it], x);
            const f32x4 w0 = *(const LAS f32x4*)(cwL + j * 2048 + ch), w1 = *(const LAS f32x4*)(cwL + j * 2048 + ch + 4);
            acc[0] += x[0] * w0.x; acc[1] += x[1] * w0.y; acc[2] += x[2] * w0.z; acc[3] += x[3] * w0.w; acc[4] += x[4] * w1.x; acc[5] += x[5] * w1.y; acc[6] += x[6] * w1.z; acc[7] += x[7] * w1.w; }
        if (o_conv) { ((f32x4*)(o_conv + ch))[0] = (f32x4){x[0], x[1], x[2], x[3]}; ((f32x4*)(o_conv + ch))[1] = (f32x4){x[4], x[5], x[6], x[7]}; }
#pragma unroll
        for (int k = 0; k < 8; ++k) acc[k] = acc[k] / (1.f + __expf(-acc[k]));
        *(u32x4*)(xo + ch) = pack8(acc);
        wnd[0][it] = wnd[1][it]; wnd[1][it] = wnd[2][it]; wnd[2][it] = R.xb[it];
        asm volatile("" ::: "memory");
    }
}
DI void cvt_f4(const float* src, bf16* dst, size_t n4, size_t gt, size_t ngt) {
    size_t i = gt;
    for (; i + 3 * ngt < n4; i += 4 * ngt) { f32x4 v[4];
#pragma unroll
        for (int k = 0; k < 4; ++k) v[k] = ((const f32x4*)src)[i + k * ngt];
#pragma unroll
        for (int k = 0; k < 4; ++k) { u32x2 o; o.x = pk2(v[k].x, v[k].y); o.y = pk2(v[k].z, v[k].w); ((u32x2*)dst)[i + k * ngt] = o; } }
    for (; i < n4; i += ngt) { const f32x4 v = ((const f32x4*)src)[i]; u32x2 o; o.x = pk2(v.x, v.y); o.y = pk2(v.z, v.w); ((u32x2*)dst)[i] = o; }
}
constexpr int CV_CH = 4096;
constexpr int CV_N0 = DBAT * PAST * 512 / 4 / CV_CH, CV_N2 = DBAT * PAST * 64 / 4 / CV_CH, CV_N3 = DBAT * BWIN * 512 / 4 / CV_CH, CV_TOTAL = 2 * CV_N0 + CV_N2 + 2 * CV_N3;
DI void cvt_chunk(const float* src, bf16* dst, int chunk, int tid) {
    const size_t base = (size_t)chunk * CV_CH; f32x4 v[8];
#pragma unroll
    for (int k = 0; k < 8; ++k) v[k] = ((const f32x4*)src)[base + tid + 512 * k];
#pragma unroll
    for (int k = 0; k < 8; ++k) { u32x2 o; o.x = pk2(v[k].x, v[k].y); o.y = pk2(v[k].z, v[k].w); ((u32x2*)dst)[base + tid + 512 * k] = o; }
}
DI void cache_convert(const Ctx& C, const Args& A, int l) {
    unsigned* head = C.ctl + CW_Q + 64 * (32 + l);
    int cq = q_next(C, head);
    while (cq < CV_TOTAL) { const int nx = q_prefetch(C, head); int c = cq;
        if (c < CV_N0) cvt_chunk(A.in[2] + (size_t)l * DBAT * PAST * 512, ws_bf(C, WS_CAK), c, C.tid);
        else { c -= CV_N0;
            if (c < CV_N0) cvt_chunk(A.in[3] + (size_t)l * DBAT * PAST * 512, ws_bf(C, WS_CAV), c, C.tid);
            else { c -= CV_N0;
                if (c < CV_N2) cvt_chunk(A.in[4] + (size_t)l * DBAT * PAST * 64, ws_bf(C, WS_CKI), c, C.tid);
                else { c -= CV_N2;
                    if (c < CV_N3) cvt_chunk(A.in[5] + (size_t)l * DBAT * BWIN * 512, ws_bf(C, WS_CBK), c, C.tid);
                    else cvt_chunk(A.in[6] + (size_t)l * DBAT * BWIN * 512, ws_bf(C, WS_CBV), c - CV_N3, C.tid); } } }
        cq = q_publish(C, nx); }
}
DI void m0_phase(const Ctx& C, const Args& A, int l) {
    LAS float* cwL = (LAS float*)C.lds; LAS float* cbL = cwL + 4 * 2048;
    { const float* cw = A.in[13] + (size_t)l * 4 * 2048; const float* cb = A.in[14] + (size_t)l * 2048;
      for (int i = C.tid; i < 2048; i += NTHR) ((LAS f32x4*)cwL)[i] = ((const f32x4*)cw)[i];
      for (int i = C.tid; i < 512; i += NTHR) ((LAS f32x4*)cbL)[i] = ((const f32x4*)cb)[i]; }
    __syncthreads();
    const int gw = C.bid * NWAVES + C.wave, NGW = C.G * NWAVES, per = (NTOK + NGW - 1) / NGW;
    const int r0 = gw * per, r1 = (r0 + per < NTOK) ? r0 + per : NTOK;
    if (r0 < r1) {
        u32x4 wnd[3][4]; M0Row cur, nxt;
        m0_load(C, r0, C.lane, cur); m0_window(C, A, l, r0, C.lane, wnd);
#pragma unroll 1
        for (int r = r0; r < r1; ++r) {
            if (r + 1 < r1) m0_load(C, r + 1, C.lane, nxt);
            if (r != r0) { bool smp; int b, t, pos; m0_decode(r, smp, b, t, pos); if (t == 0) m0_window(C, A, l, r, C.lane, wnd); }
            m0_process(C, A, l, r, C.lane, cur, wnd, cwL, cbL);
            cur = nxt;
        }
    }
}

struct KVSrc { const bf16* k0; const bf16* v0; int s0; int n0; const bf16* k1; const bf16* v1; int s1; };
template <int MODE>
DI void attn_unit(const Ctx& C, const bf16* Qp, int qstride, const KVSrc& S, int tile_lo, int tile_hi, bf16* Op, int ostride) {
    int tid = C.tid, lane = C.lane; asm volatile("" : "+v"(tid), "+v"(lane));
    const int w = C.wave, r = lane & 31, hh = lane >> 5;
    const int head = w >> 1, q = (w & 1) * 32 + r;
    LAS unsigned char* Ks = C.lds + ATT_K; LAS unsigned char* Vs = C.lds + ATT_V;
    bf16x8 qf[8];
    { const bf16* qrow = Qp + (size_t)q * qstride + head * 128 + 8 * hh;
#pragma unroll
      for (int ks = 0; ks < 8; ++ks) qf[ks] = *(const bf16x8*)(qrow + 16 * ks); }
    f32x16 o[4];
#pragma unroll
    for (int d = 0; d < 4; ++d)
#pragma unroll
        for (int i = 0; i < 16; ++i) o[d][i] = 0.f;
    float m = -1e30f, lsum = 0.f;
    constexpr float SC2 = 0.08838834764831845f * 1.4426950408889634f;
    constexpr float L2E = 1.4426950408889634f;
    u32x4 kr[4], vr[4];
#define ATT_LOAD(tile_) do { const int k0_ = (tile_) * 32; const bool first_ = k0_ < S.n0; const int st_ = first_ ? S.s0 : S.s1; \
        const bf16* kb_ = (first_ ? S.k0 + (ptrdiff_t)k0_ * S.s0 : S.k1 + (ptrdiff_t)(k0_ - S.n0) * S.s1) + (ptrdiff_t)(tid >> 6) * st_ + (tid & 63) * 8; \
        const bf16* vb_ = (first_ ? S.v0 + (ptrdiff_t)k0_ * S.s0 : S.v1 + (ptrdiff_t)(k0_ - S.n0) * S.s1) + (ptrdiff_t)(tid >> 6) * st_ + (tid & 63) * 8; \
        _Pragma("unroll") for (int i_ = 0; i_ < 4; ++i_) { kr[i_] = *(const u32x4*)(kb_ + (ptrdiff_t)(8 * i_) * st_); vr[i_] = *(const u32x4*)(vb_ + (ptrdiff_t)(8 * i_) * st_); } } while (0)
#define ATT_STORE(buf_) do { _Pragma("unroll") for (int i_ = 0; i_ < 4; ++i_) { const int ci_ = tid + 512 * i_, row_ = ci_ >> 6, ch_ = ci_ & 63; \
        *(LAS u32x4*)(Ks + (buf_) * (32 * KSTR) + row_ * KSTR + ch_ * 16) = kr[i_]; *(LAS u32x4*)(Vs + (buf_) * (32 * VSTR) + row_ * VSTR + ch_ * 16) = vr[i_]; } } while (0)
    ATT_LOAD(tile_lo);
    __syncthreads();
    ATT_STORE(0);
    if (tile_lo + 1 < tile_hi) ATT_LOAD(tile_lo + 1);
    __syncthreads();
    const int i16 = lane & 15;
    LAS unsigned char* vbase = Vs + (4 * hh + (i16 >> 2)) * VSTR + (head * 128 + 16 * ((lane >> 4) & 1) + 4 * (i16 & 3)) * 2;
    LAS unsigned char* kbase = Ks + r * KSTR + head * 256 + hh * 16;
    const LAS float* btab = (const LAS float*)(C.lds + ATT_SEL) + head * 257;
    const LAS unsigned* sel = (const LAS unsigned*)(C.lds + ATT_SEL) + q * 64;
#pragma unroll 1
    for (int tile = tile_lo; tile < tile_hi; ++tile) {
        const int cur = (tile - tile_lo) & 1;
        if (tile + 1 < tile_hi) { ATT_STORE(cur ^ 1); if (tile + 2 < tile_hi) ATT_LOAD(tile + 2); }
        f32x16 s;
        if (MODE == 0) {
            const unsigned nwd = ~(sel[tile] >> (4 * hh));
#pragma unroll
            for (int i = 0; i < 16; ++i) { int mb; asm("v_bfe_i32 %0, %1, %2, 1" : "=v"(mb) : "v"(nwd), "n"((i & 3) + 8 * (i >> 2))); s[i] = __int_as_float(mb & (int)0xFF800000); }
        } else {
            if (tile <= 11) { const float bb = btab[256] * (L2E / SC2);
#pragma unroll
                for (int i = 0; i < 16; ++i) s[i] = bb;
            } else {
#pragma unroll
                for (int i = 0; i < 16; ++i) { int rel = BWIN + q - (tile * 32 + crow(i, hh)); rel = rel > 128 ? 128 : rel; s[i] = btab[rel + 128] * (L2E / SC2); }
            }
        }
        { bf16x8 kf[8]; LAS unsigned char* kb = kbase + cur * (32 * KSTR);
#pragma unroll
          for (int ks = 0; ks < 8; ++ks) kf[ks] = *(const LAS bf16x8*)(kb + ks * 32);
#pragma unroll
          for (int ks = 0; ks < 8; ++ks) s = mfma32(kf[ks], qf[ks], s); }
        float mx = s[0];
#pragma unroll
        for (int i = 1; i < 16; ++i) mx = fmaxf(mx, s[i]);
        mx *= SC2;
        if (__any(mx > m + 8.0f)) {
            const auto rr = __builtin_amdgcn_permlane32_swap(__float_as_uint(mx), __float_as_uint(mx), false, false);
            const float mxs = fmaxf(__uint_as_float(rr[0]), __uint_as_float(rr[1]));
            const float mn = (mxs > m + 8.0f) ? mxs : m, alpha = __builtin_amdgcn_exp2f(m - mn);
            lsum *= alpha; m = mn;
#pragma unroll
            for (int d = 0; d < 4; ++d)
#pragma unroll
                for (int i = 0; i < 16; ++i) o[d][i] *= alpha;
        }
#pragma unroll
        for (int i = 0; i < 16; ++i) { s[i] = __builtin_amdgcn_exp2f(__builtin_fmaf(s[i], SC2, -m)); lsum += s[i]; }
        bf16x8 pf[2];
#pragma unroll
        for (int s2 = 0; s2 < 2; ++s2) { u32x4 pk; pk.x = pk2(s[8 * s2], s[8 * s2 + 1]); pk.y = pk2(s[8 * s2 + 2], s[8 * s2 + 3]); pk.z = pk2(s[8 * s2 + 4], s[8 * s2 + 5]); pk.w = pk2(s[8 * s2 + 6], s[8 * s2 + 7]);
            pf[s2] = __builtin_bit_cast(bf16x8, pk); }
        LAS unsigned char* vb = vbase + cur * (32 * VSTR);
#pragma unroll
        for (int dh = 0; dh < 2; ++dh) {
            s16x4 lo[2][2], hi[2][2];
#pragma unroll
            for (int d2 = 0; d2 < 2; ++d2)
#pragma unroll
                for (int s2 = 0; s2 < 2; ++s2) { lo[d2][s2] = tr_read(vb + (16 * s2) * VSTR + (2 * dh + d2) * 64); hi[d2][s2] = tr_read(vb + (16 * s2 + 8) * VSTR + (2 * dh + d2) * 64); }
#pragma unroll
            for (int d2 = 0; d2 < 2; ++d2)
#pragma unroll
                for (int s2 = 0; s2 < 2; ++s2) { const bf16x8 vt = __builtin_shufflevector(lo[d2][s2], hi[d2][s2], 0, 1, 2, 3, 4, 5, 6, 7); o[2 * dh + d2] = mfma32(vt, pf[s2], o[2 * dh + d2]); }
        }
        __syncthreads();
    }
#undef ATT_LOAD
#undef ATT_STORE
    { const auto rr = __builtin_amdgcn_permlane32_swap(__float_as_uint(lsum), __float_as_uint(lsum), false, false); lsum = __uint_as_float(rr[0]) + __uint_as_float(rr[1]); }
    const float inv = 1.0f / lsum;
    bf16* orow = Op + (size_t)q * ostride + head * 128 + 4 * hh;
#pragma unroll
    for (int d = 0; d < 4; ++d)
#pragma unroll
        for (int g = 0; g < 4; ++g) { u32x2 p; p.x = pk2(o[d][4 * g] * inv, o[d][4 * g + 1] * inv); p.y = pk2(o[d][4 * g + 2] * inv, o[d][4 * g + 3] * inv);
            *(u32x2*)(orow + 32 * d + 8 * g) = p; }
}

DI float relu_i(float x) { const int v = __float_as_int(x); return __int_as_float(v > 0 ? v : 0); }
DI unsigned fkey(float f) { const int u = __float_as_int(f); return (unsigned)(u ^ ((u >> 31) | (int)0x80000000)); }
DI void bt32(unsigned (&a)[32]) {
#pragma unroll
    for (int s = 0; s < 5; ++s) { const int j = 16 >> s;
        const unsigned m = s == 0 ? 0x0000FFFFu : s == 1 ? 0x00FF00FFu : s == 2 ? 0x0F0F0F0Fu : s == 3 ? 0x33333333u : 0x55555555u;
#pragma unroll
        for (int k = 0; k < 32; ++k) if ((k & j) == 0) {
            const unsigned x = a[k], y = a[k + j];
            a[k] = (x & m) | ((y << j) & ~m);
            a[k + j] = ((x >> j) & m) | (y & ~m); } }
}
template <int NR>
DI void topk_pair(const float* SCq  , LAS unsigned* SELa  , int NT, int r, int hh, int lane) {
    constexpr int NBLK = NR / 32;
    unsigned P[NBLK][32];
#pragma unroll
    for (int b = 0; b < NBLK; ++b)
#pragma unroll
        for (int i = 0; i < 32; ++i) { const int idx = b * 32 + i; const float f = SCq[idx * 32 + r]; P[b][i] = (idx < NT) ? fkey(f) : 0u; }
#pragma unroll
    for (int b = 0; b < NBLK; ++b) bt32(P[b]);
    unsigned L[NBLK], G[NBLK], cg = 0u; bool done = false;
#pragma unroll
    for (int b = 0; b < NBLK; ++b) { L[b] = 0xffffffffu; G[b] = 0u; }
#pragma unroll
    for (int bit = 31; bit >= 8; --bit) {
        if (__all(done)) break;
        unsigned X[NBLK], c = cg;
#pragma unroll
        for (int b = 0; b < NBLK; ++b) { X[b] = L[b] & P[b][bit]; c += __popc(X[b]); }
        int x = (int)c;
        x += __builtin_amdgcn_update_dpp(0, x, 0x111, 0xf, 0xf, true);
        x += __builtin_amdgcn_update_dpp(0, x, 0x112, 0xf, 0xf, true);
        x += __builtin_amdgcn_update_dpp(0, x, 0x114, 0xf, 0xf, true);
        x += __builtin_amdgcn_update_dpp(0, x, 0x118, 0xf, 0xf, true);
        x += __builtin_amdgcn_update_dpp(0, x, 0x142, 0xa, 0xf, true);
        const unsigned t0 = (unsigned)__builtin_amdgcn_readlane(x, 31), t1 = (unsigned)__builtin_amdgcn_readlane(x, 63);
        const unsigned tot = hh ? t1 : t0;
        const bool ge = tot >= 256u;
        if (!done) {
#pragma unroll
            for (int b = 0; b < NBLK; ++b) { const unsigned l0 = L[b], g0 = G[b]; L[b] = ge ? X[b] : (l0 ^ X[b]); G[b] = ge ? g0 : (g0 | X[b]); }
            cg = ge ? cg : c; }
        if (tot == 256u) done = true;
    }
#pragma unroll
    for (int i = 0; i < NR; ++i) { const unsigned S = G[i >> 5] | L[i >> 5]; unsigned long long mk = __ballot((S >> (i & 31)) & 1u); if (i >= NT) mk = 0ull;
        if (lane == 0) { SELa[i] = (unsigned)mk; SELa[64 + i] = (unsigned)(mk >> 32); } }
}
DI void dsa_unit(const Ctx& C, int l, int u) {
    int lane = C.lane; asm volatile("" : "+v"(lane));
    const int w = C.wave, r = lane & 31, hh = lane >> 5;
    const bf16* PROJ = ws_bf(C, WS_PU);
    int qrow0, NT, limit; KVSrc S; const bf16* ik0; const bf16* ik1; int iks0, ikn0;
    const bool smp = (u >= 120 && u < 152); const int up = u < 120 ? u : u - 32;
    if (!smp) { const int c = 31 - (up >> 3), b = up & 7; qrow0 = b * SEQ + c * 64; NT = 2 * (c + 1); limit = 64 * (c + 1);
        const bf16* base = PROJ + (size_t)(b * SEQ) * INP;
        S.k0 = base + C_AK; S.v0 = base + C_AV; S.s0 = INP; S.n0 = limit; S.k1 = S.k0; S.v1 = S.v0; S.s1 = INP;
        ik0 = base + C_IK; iks0 = INP; ikn0 = limit; ik1 = ik0;
    } else { const int b = u - 120; qrow0 = NTP + b * DSEQ; NT = (PAST + DSEQ) / 32; limit = PAST + DSEQ;
        const bf16* nb = PROJ + (size_t)qrow0 * INP;
        S.k0 = ws_bf(C, WS_CAK) + (size_t)b * PAST * 512; S.v0 = ws_bf(C, WS_CAV) + (size_t)b * PAST * 512; S.s0 = 512; S.n0 = PAST; S.k1 = nb + C_AK; S.v1 = nb + C_AV; S.s1 = INP;
        ik0 = ws_bf(C, WS_CKI) + (size_t)b * PAST * 64; iks0 = 64; ikn0 = PAST; ik1 = nb + C_IK;
    }
    float* SC = ws_f(C, WS_SC) + (size_t)C.bid * 64 * 2048;
    LAS unsigned* SEL = (LAS unsigned*)(C.lds + ATT_SEL);
    LAS unsigned char* IKS = C.lds + ATT_K; constexpr int IDX_CH = 256, IDX_STR = 144;
    int tidx = C.tid; asm volatile("" : "+v"(tidx));
    if (limit > 256) {
#ifndef REP_IDX
#define REP_IDX 1
#endif
#ifndef REP_TOPK
#define REP_TOPK 1
#endif
#ifndef REP_ATT
#define REP_ATT 1
#endif
#pragma unroll 1
    for (int pass = 0; pass < 2 * REP_IDX; ++pass) {
        bf16x8 af[2][4]; f32x2_t_ wt2[2][8];
#pragma unroll
        for (int np = 0; np < 2; ++np) { const int pp = (pass & 1) * 2 + np;
            const bf16* ap = PROJ + (size_t)(qrow0 + 8 * w + 2 * pp + (r >> 4)) * INP + C_IQ + (r & 15) * 64 + 8 * hh;
#pragma unroll
            for (int ks = 0; ks < 4; ++ks) af[np][ks] = *(const bf16x8*)(ap + 16 * ks);
#pragma unroll
            for (int i = 0; i < 16; ++i) { const int qi = 8 * w + 2 * pp + (i >> 3), hd = (i & 3) + 8 * ((i >> 2) & 1) + 4 * hh;
                wt2[np][i >> 1][i & 1] = bf2f(PROJ[(size_t)(qrow0 + qi) * INP + C_IW + hd]) * (0.25f * 0.125f); } }
        u32x4 sg[4];
#define IDX_GLOAD(ch_) do { _Pragma("unroll") for (int i_ = 0; i_ < 4; ++i_) { int key_ = (ch_) * IDX_CH + ((tidx + 512 * i_) >> 3); key_ = key_ < limit ? key_ : limit - 1; \
            const bf16* kp_ = (key_ < ikn0 ? ik0 + (size_t)key_ * iks0 : ik1 + (size_t)(key_ - ikn0) * INP) + (tidx & 7) * 8; sg[i_] = *(const u32x4*)kp_; } } while (0)
#define IDX_LSTORE(buf_) do { _Pragma("unroll") for (int i_ = 0; i_ < 4; ++i_) *(LAS u32x4*)(IKS + (buf_) * (IDX_CH * IDX_STR) + ((tidx + 512 * i_) >> 3) * IDX_STR + (tidx & 7) * 16) = sg[i_]; } while (0)
#define IDX_FRAG(dst_, kb_, tl_) do { _Pragma("unroll") for (int ks_ = 0; ks_ < 4; ++ks_) dst_[ks_] = *(const LAS bf16x8*)((kb_) + (tl_) * (32 * IDX_STR) + ks_ * 32); } while (0)
        IDX_GLOAD(0);
        IDX_LSTORE(0);
        __syncthreads();
        const int nch = (NT + 7) >> 3;
#pragma unroll 1
        for (int ch = 0; ch < nch; ++ch) {
            if (ch + 1 < nch) IDX_GLOAD(ch + 1);
            const LAS unsigned char* kb = IKS + (ch & 1) * (IDX_CH * IDX_STR) + r * IDX_STR + hh * 16;
            const int t0 = ch * 8, tn = (NT - t0) < 8 ? (NT - t0) : 8;
            bf16x8 bk[4], bk1[4], bn[4], b2[4];
            IDX_FRAG(bn, kb, 0); IDX_FRAG(b2, kb, 1);
#define IDX_TRIP(tl_) do { const int tile_ = t0 + (tl_); \
                _Pragma("unroll") for (int ks = 0; ks < 4; ++ks) { bk[ks] = bn[ks]; bk1[ks] = b2[ks]; } \
                if ((tl_) + 2 < tn) { IDX_FRAG(bn, kb, (tl_) + 2); IDX_FRAG(b2, kb, (tl_) + 3); } \
                f32x16 acc[2][2]; \
                _Pragma("unroll") for (int tt = 0; tt < 2; ++tt) _Pragma("unroll") for (int np = 0; np < 2; ++np) _Pragma("unroll") for (int i = 0; i < 16; ++i) acc[tt][np][i] = 0.f; \
                _Pragma("unroll") for (int ks = 0; ks < 4; ++ks) _Pragma("unroll") for (int np = 0; np < 2; ++np) { acc[0][np] = mfma32(af[np][ks], bk[ks], acc[0][np]); acc[1][np] = mfma32(af[np][ks], bk1[ks], acc[1][np]); } \
                _Pragma("unroll") for (int tt = 0; tt < 2; ++tt) _Pragma("unroll") for (int np = 0; np < 2; ++np) { \
                    f32x2_t_ s0, s1; \
                    _Pragma("unroll") for (int j = 0; j < 4; ++j) { \
                        const f32x2_t_ x0 = {relu_i(acc[tt][np][2 * j]), relu_i(acc[tt][np][2 * j + 1])}, x1 = {relu_i(acc[tt][np][8 + 2 * j]), relu_i(acc[tt][np][9 + 2 * j])}; \
                        if (j == 0) { asm("v_pk_mul_f32 %0, %1, %2" : "=v"(s0) : "v"(x0), "v"(wt2[np][0])); asm("v_pk_mul_f32 %0, %1, %2" : "=v"(s1) : "v"(x1), "v"(wt2[np][4])); } \
                        else { asm("v_pk_fma_f32 %0, %1, %2, %0" : "+v"(s0) : "v"(x0), "v"(wt2[np][j])); \
                               asm("v_pk_fma_f32 %0, %1, %2, %0" : "+v"(s1) : "v"(x1), "v"(wt2[np][4 + j])); } } \
                    const float p0 = s0.x + s0.y, p1 = s1.x + s1.y; \
                    const auto rr = __builtin_amdgcn_permlane32_swap(__float_as_uint(p0), __float_as_uint(p1), false, false);      \
                    const int ql = 8 * w + 2 * ((pass & 1) * 2 + np) + hh; \
                    SC[(size_t)ql * 2048 + (tile_ + tt) * 32 + r] = __uint_as_float(rr[0]) + __uint_as_float(rr[1]); } } while (0)
            IDX_TRIP(0);
            if (ch + 1 < nch) IDX_LSTORE((ch + 1) & 1);
#pragma unroll 1
            for (int tl = 2; tl < tn; tl += 2) IDX_TRIP(tl);
#undef IDX_TRIP
            __syncthreads();
        }
    }
#undef IDX_GLOAD
#undef IDX_LSTORE
#undef IDX_FRAG
    asm volatile("s_waitcnt vmcnt(0)" ::: "memory");
    __builtin_amdgcn_fence(__ATOMIC_ACQUIRE, "agent");
    asm volatile("s_waitcnt vmcnt(0)" ::: "memory");
#pragma unroll 1
    for (int pq = 0; pq < 4 * REP_TOPK; ++pq) { const int pp = pq & 3;
        const float* SCq = SC + (size_t)(8 * w + 2 * pp + hh) * 2048; LAS unsigned* SELa = SEL + (8 * w + 2 * pp) * 64;
        if (NT <= 32) topk_pair<32>(SCq, SELa, NT, r, hh, lane);
        else topk_pair<64>(SCq, SELa, NT, r, hh, lane);
    }
    } else {
        for (int i = lane; i < 8 * 64; i += 64) SEL[8 * w * 64 + i] = ((i & 63) < NT) ? 0xffffffffu : 0u;
    }
    __syncthreads();
#pragma unroll 1
    for (int rep = 0; rep < REP_ATT; ++rep)
    attn_unit<0>(C, PROJ + (size_t)qrow0 * INP + C_AQ, INP, S, 0, NT, ws_bf(C, WS_MIX) + (size_t)qrow0 * DM, DM);
}

DI void band_unit(const Ctx& C, const Args& A, int l, int u) {
    const bf16* PROJ = ws_bf(C, WS_PU);
    int qrow0, tlo; KVSrc S;
    if (u < 256) { const int c = 31 - (u >> 3), b = u & 7; qrow0 = b * SEQ + c * 64; tlo = c < 8 ? (8 - c) * 2 : 0;
        const bf16* base = PROJ + ((ptrdiff_t)b * SEQ + c * 64 - BWIN) * INP;
        S.k0 = base + C_BK; S.v0 = base + C_BV; S.s0 = INP; S.n0 = BWIN + 64; S.k1 = S.k0; S.v1 = S.v0; S.s1 = INP;
    } else { const int b = u - 256; qrow0 = NTP + b * DSEQ; tlo = 0;
        const bf16* nb = PROJ + (size_t)qrow0 * INP;
        S.k0 = ws_bf(C, WS_CBK) + (size_t)b * BWIN * 512; S.v0 = ws_bf(C, WS_CBV) + (size_t)b * BWIN * 512; S.s0 = 512; S.n0 = BWIN; S.k1 = nb + C_BK; S.v1 = nb + C_BV; S.s1 = INP;
    }
    LAS float* bt = (LAS float*)(C.lds + ATT_SEL);
    const float* brel = A.in[12] + (size_t)l * 4 * 257;
    for (int i = C.tid; i < 4 * 257; i += NTHR) bt[i] = brel[i];
    __syncthreads();
    attn_unit<1>(C, PROJ + (size_t)qrow0 * INP + C_BQ, INP, S, tlo, (BWIN + 64) / 32, ws_bf(C, WS_MIX) + (size_t)qrow0 * DM + 512, DM);
}

DI void ssd_unit(const Ctx& C, const Args& A, int l, int row0, int nchunks, int h, const float* h0, float* hout) {
    int tid = C.tid, lane = C.lane; asm volatile("" : "+v"(tid), "+v"(lane));
    const int w = C.wave, r = lane & 31, hh = lane >> 5, g = h >> 2;
    LAS unsigned char* L = C.lds;
    LAS unsigned char* Cs = L + SSD_CS; LAS unsigned char* Bs = L + SSD_BS; LAS unsigned char* XD = L + SSD_XD; LAS unsigned char* XDW = L + SSD_XDW; LAS unsigned char* Ms = L + SSD_MS; LAS unsigned char* Ys = L + SSD_Y; LAS unsigned char* Ys2 = L + SSD_Y2;
    LAS float* v_acs = (LAS float*)(L + SSD_VEC); LAS float* v_e = v_acs + 64;
    const bf16* XBC = ws_bf(C, WS_XBC); const bf16* PROJ = ws_bf(C, WS_PU); const float* DTS = ws_f(C, WS_DTS); float* G = ws_f(C, WS_G);
    const float a_h = -expf(A.in[16][l * 16 + h]); const float dsk = A.in[17][l * 16 + h];
    const int erow = tid >> 3, ech = tid & 7;
    f32x16 Hacc[2];
#pragma unroll
    for (int pb = 0; pb < 2; ++pb)
#pragma unroll
        for (int i = 0; i < 16; ++i) Hacc[pb][i] = 0.f;
    u32x4 pC[2], pB[2], pX, pZ; float pDt;
#define SSD_LOAD(c_) do { const int rb_ = row0 + (c_) * 64; \
        _Pragma("unroll") for (int i_ = 0; i_ < 2; ++i_) { const int ci_ = tid + 512 * i_; const bf16* src_ = XBC + (size_t)(rb_ + (ci_ >> 4)) * 2048 + g * 128 + (ci_ & 15) * 8; pB[i_] = *(const u32x4*)(src_ + 1024); pC[i_] = *(const u32x4*)(src_ + 1536); } \
        pX = *(const u32x4*)(XBC + (size_t)(rb_ + erow) * 2048 + h * 64 + ech * 8); pZ = *(const u32x4*)(PROJ + (size_t)(rb_ + erow) * INP + C_CZ + h * 64 + ech * 8); \
        pDt = DTS[(size_t)(rb_ + lane) * 16 + h]; } while (0)
    SSD_LOAD(0);
    if (w >= 4 && h0) { const int nb = w - 4;
#pragma unroll
        for (int pb = 0; pb < 2; ++pb)
#pragma unroll
            for (int i = 0; i < 16; ++i) Hacc[pb][i] = h0[(32 * pb + crow(i, hh)) * 128 + 32 * nb + r]; }
    __syncthreads();
    if (w >= 4) { const int nb = w - 4;
#pragma unroll
        for (int pb = 0; pb < 2; ++pb)
#pragma unroll
            for (int i = 0; i < 16; ++i) { const int p = 32 * pb + crow(i, hh), n = 32 * nb + r; *(LAS bf16*)(L + SSD_HS + p * HSTR + n * 2) = f2bf(Hacc[pb][i]); } }
#pragma unroll 1
    for (int c = 0; c < nchunks; ++c) {
        const int rbase = row0 + c * 64;
        LAS unsigned char* Hcur = L + SSD_HS + (c & 1) * 64 * HSTR; LAS unsigned char* Hnxt = L + SSD_HS + ((c + 1) & 1) * 64 * HSTR;
        const float dtl = pDt; float acs = dtl * a_h;
#pragma unroll
        for (int o = 1; o < 64; o <<= 1) { const float t = __shfl_up(acs, o); if (lane >= o) acs += t; }
        const float Atot = __shfl(acs, 63);
        const float wl = __expf(Atot - acs);
        if (w == 0) { v_acs[lane] = acs; v_e[lane] = __expf(acs); }
#pragma unroll
        for (int i = 0; i < 2; ++i) { const int ci = tid + 512 * i, row = ci >> 4, ch = ci & 15; *(LAS u32x4*)(Bs + row * CSTR + ch * 16) = pB[i]; *(LAS u32x4*)(Cs + row * CSTR + ch * 16) = pC[i]; }
        float xraw[8]; unpack8(pX, xraw); const u32x4 zc = pZ;
        { float xd[8], xw[8]; const float dt = __shfl(dtl, erow & 63), wv = __shfl(wl, erow & 63);
#pragma unroll
          for (int k = 0; k < 8; ++k) { xd[k] = xraw[k] * dt; xw[k] = xd[k] * wv; }
          *(LAS u32x4*)(XD + erow * XSTR + ech * 16) = pack8(xd); *(LAS u32x4*)(XDW + erow * XSTR + ech * 16) = pack8(xw); }
        if (c + 1 < nchunks) SSD_LOAD(c + 1);
        __syncthreads();
        if (w < 4) {
            const int lb = w >> 1, sb = w & 1; f32x16 acc;
#pragma unroll
            for (int i = 0; i < 16; ++i) acc[i] = 0.f;
            if (sb <= lb) {
#pragma unroll
                for (int ks = 0; ks < 8; ++ks) { const bf16x8 a = *(const LAS bf16x8*)(Cs + (32 * lb + r) * CSTR + (16 * ks + 8 * hh) * 2), b = *(const LAS bf16x8*)(Bs + (32 * sb + r) * CSTR + (16 * ks + 8 * hh) * 2);
                    acc = mfma32(a, b, acc); } }
            const int s = 32 * sb + r; const float acs_s = v_acs[s];
#pragma unroll
            for (int i = 0; i < 16; ++i) { const int lr = 32 * lb + crow(i, hh); const float v = (s <= lr) ? acc[i] * __expf(v_acs[lr] - acs_s) : 0.f; *(LAS bf16*)(Ms + lr * MSTR + s * 2) = f2bf(v); }
        } else {
            const int nb = w - 4; const float dec = __expf(Atot);
#pragma unroll
            for (int pb = 0; pb < 2; ++pb) {
#pragma unroll
                for (int i = 0; i < 16; ++i) Hacc[pb][i] *= dec;
#pragma unroll
                for (int ks = 0; ks < 4; ++ks) { const bf16x8 a = trfrag(XDW, XSTR, 16 * ks, 32 * pb, lane), b = trfrag(Bs, CSTR, 16 * ks, 32 * nb, lane); Hacc[pb] = mfma32(a, b, Hacc[pb]); }
#pragma unroll
                for (int i = 0; i < 16; ++i) *(LAS bf16*)(Hnxt + (32 * pb + crow(i, hh)) * HSTR + (32 * nb + r) * 2) = f2bf(Hacc[pb][i]);
            }
        }
        __syncthreads();
        {
            const int lb = (w >> 1) & 1, pb = w & 1, p = 32 * pb + r; f32x16 yv;
#pragma unroll
            for (int i = 0; i < 16; ++i) yv[i] = 0.f;
            if (w < 4) {
#pragma unroll
                for (int ks = 0; ks < 4; ++ks) { const bf16x8 a = *(const LAS bf16x8*)(Ms + (32 * lb + r) * MSTR + (16 * ks + 8 * hh) * 2), b = trfrag(XD, XSTR, 16 * ks, 32 * pb, lane); yv = mfma32(a, b, yv); }
#pragma unroll
                for (int i = 0; i < 16; ++i) *(LAS float*)(Ys + (32 * lb + crow(i, hh)) * YSTR + p * 4) = yv[i];
            } else {
#pragma unroll
                for (int ks = 0; ks < 8; ++ks) { const bf16x8 a = *(const LAS bf16x8*)(Cs + (32 * lb + r) * CSTR + (16 * ks + 8 * hh) * 2), b = *(const LAS bf16x8*)(Hcur + (32 * pb + r) * HSTR + (16 * ks + 8 * hh) * 2); yv = mfma32(a, b, yv); }
#pragma unroll
                for (int i = 0; i < 16; ++i) { const int lr = 32 * lb + crow(i, hh); *(LAS float*)(Ys2 + lr * YSTR + p * 4) = v_e[lr] * yv[i]; }
            }
        }
        __syncthreads();
        {
            float z[8]; unpack8(zc, z);
            const f32x4 y0 = *(const LAS f32x4*)(Ys + erow * YSTR + ech * 32) + *(const LAS f32x4*)(Ys2 + erow * YSTR + ech * 32), y1 = *(const LAS f32x4*)(Ys + erow * YSTR + ech * 32 + 16) + *(const LAS f32x4*)(Ys2 + erow * YSTR + ech * 32 + 16);
            float y[8] = {y0.x, y0.y, y0.z, y0.w, y1.x, y1.y, y1.z, y1.w};
#pragma unroll
            for (int k = 0; k < 8; ++k) { const float yy = y[k] + dsk * xraw[k]; y[k] = yy * z[k] / (1.f + __expf(-z[k])); }
            float* gp = G + (size_t)(rbase + erow) * 1024 + h * 64 + ech * 8;
            ((f32x4*)gp)[0] = (f32x4){y[0], y[1], y[2], y[3]}; ((f32x4*)gp)[1] = (f32x4){y[4], y[5], y[6], y[7]};
        }
    }
#undef SSD_LOAD
    if (w >= 4) { const int nb = w - 4;
#pragma unroll
        for (int pb = 0; pb < 2; ++pb)
#pragma unroll
            for (int i = 0; i < 16; ++i) hout[(32 * pb + crow(i, hh)) * 128 + 32 * nb + r] = Hacc[pb][i]; }
}

DI void gate_norm_phase(const Ctx& C, const Args& A, int l) {
    const int gw = C.bid * NWAVES + C.wave, NGW = C.G * NWAVES; const float* gn = A.in[18] + (size_t)l * 1024;
    for (int m0 = gw; m0 < NTOK; m0 += 3 * NGW) {
        f32x4 v[3][4];
#pragma unroll
        for (int k = 0; k < 3; ++k) { const int m = m0 + k * NGW; const float* grow = ws_f(C, WS_G) + (size_t)(m < NTOK ? m : m0) * 1024;
#pragma unroll
            for (int g = 0; g < 4; ++g) v[k][g] = ((const f32x4*)grow)[g * 64 + C.lane]; }
#pragma unroll
        for (int k = 0; k < 3; ++k) { const int m = m0 + k * NGW; if (m < NTOK) { bf16* orow = ws_bf(C, WS_MIX) + (size_t)m * DM + 1024;
#pragma unroll
            for (int g = 0; g < 4; ++g) { const f32x4 x = v[k][g]; const float ss = wave_sum((x.x * x.x + x.y * x.y) + (x.z * x.z + x.w * x.w));
                const float rs = 1.0f / sqrtf(ss * (1.0f / 256.f) + EPS); const f32x4 wv = ((const f32x4*)gn)[g * 64 + C.lane]; const f32x4 o = x * rs * wv;
                u32x2 p; p.x = pk2(o.x, o.y); p.y = pk2(o.z, o.w); ((u32x2*)orow)[g * 64 + C.lane] = p; } } }
    }
}
DI void norm_phase(const Ctx& C, int rlo, int mode, const float* w) {
    const int gw = C.bid * NWAVES + C.wave, NGW = C.G * NWAVES;
    for (int m = rlo + gw; m < NTOK; m += NGW)
        res_row(ws_bf(C, WS_X) + (size_t)m * DM, m >= NTP ? ws_f(C, WS_G) + (size_t)(m - NTP) * DM : nullptr, (size_t)NTS * DM, mode, ws_f(C, WS_SSQ1) + (size_t)m * 32, w, C.out + (size_t)m * DM, C.lane);
}
DI void final_norm_phase(const Ctx& C, const float* w) {
    const int gw = C.bid * NWAVES + C.wave, NGW = C.G * NWAVES, lane = C.lane; const bf16* X = ws_bf(C, WS_X);
    u32x4 nx[4]; int m = gw;
    if (m < NTOK) {
#pragma unroll
        for (int j = 0; j < 4; ++j) nx[j] = ((const u32x4*)(X + (size_t)m * DM))[lane + 64 * j]; }
    for (; m < NTOK; m += NGW) {
        float v[4][8]; float ss = 0.f;
#pragma unroll
        for (int j = 0; j < 4; ++j) unpack8(nx[j], v[j]);
        const int mn = m + NGW;
        if (mn < NTOK) {
#pragma unroll
            for (int j = 0; j < 4; ++j) nx[j] = ((const u32x4*)(X + (size_t)mn * DM))[lane + 64 * j]; }
        const float* part = m >= NTP ? ws_f(C, WS_G) + (size_t)(m - NTP) * DM : nullptr;
#pragma unroll
        for (int j = 0; j < 4; ++j) {
            if (part) {
#pragma unroll
                for (int k = 0; k < 4; ++k) { const float* pp = part + k * ((size_t)NTS * DM) + 8 * (lane + 64 * j); const f32x4 a = *(const f32x4*)pp, b = *(const f32x4*)(pp + 4);
                    v[j][0] += a.x; v[j][1] += a.y; v[j][2] += a.z; v[j][3] += a.w; v[j][4] += b.x; v[j][5] += b.y; v[j][6] += b.z; v[j][7] += b.w; } }
#pragma unroll
            for (int k = 0; k < 8; ++k) ss += v[j][k] * v[j][k]; }
        ss = wave_sum(ss);
        const float rs = 1.0f / sqrtf(ss * (1.0f / DM) + EPS); float* outf = C.out + (size_t)m * DM;
#pragma unroll
        for (int j = 0; j < 4; ++j) { const float* wp = w + 8 * (lane + 64 * j); const f32x4 w0 = *(const f32x4*)wp, w1 = *(const f32x4*)(wp + 4); float* op = outf + 8 * (lane + 64 * j);
            *(f32x4*)op = (f32x4){v[j][0] * rs * w0.x, v[j][1] * rs * w0.y, v[j][2] * rs * w0.z, v[j][3] * rs * w0.w};
            *(f32x4*)(op + 4) = (f32x4){v[j][4] * rs * w1.x, v[j][5] * rs * w1.y, v[j][6] * rs * w1.z, v[j][7] * rs * w1.w}; }
    }
}
DI void zero_f32(const Ctx& C, float* p, int n) { for (int i = C.bid * NTHR + C.tid; i < n; i += C.G * NTHR) p[i] = 0.f; }

#ifndef WCONV_A
#define WCONV_A 8
#endif
#ifndef WCONV_B
#define WCONV_B 9
#endif
#ifndef G_ALIGN
#define G_ALIGN true
#endif
#ifndef G_ALIGN_RES
#define G_ALIGN_RES true
#endif
#ifndef G_SP2
#define G_SP2 true
#endif
#ifndef STAGGER_TICKS
#define STAGGER_TICKS 0
#endif
DI void stagger(const Ctx& C, int ticks) {
    if (ticks > 0 && (C.bid & 1)) { const unsigned long long t0 = __builtin_amdgcn_s_memrealtime(); while (__builtin_amdgcn_s_memrealtime() - t0 < (unsigned long long)ticks) __builtin_amdgcn_s_sleep(8); }
}
template <class Sched>
DI void build_rstd_table(const Ctx& C, const Sched& S, const float* SSQ, LAS float* tab) {
    pg8::Unit u;
    for (int i = 0; S.next(i, u); ++i)
        if (C.tid < 256) { const f32x4* p = (const f32x4*)(SSQ + (size_t)(u.pm * 256 + C.tid) * 32); f32x4 a = p[0];
#pragma unroll
            for (int j = 1; j < 8; ++j) a += p[j];
            tab[i * 256 + C.tid] = 1.0f / sqrtf(((a.x + a.y) + (a.z + a.w)) * (1.0f / DM) + EPS); }
    __syncthreads();
}
#ifndef MK_ONE_LAUNCH
#define MK_ONE_LAUNCH 1
#endif
#ifndef PHASE_MASK
#define PHASE_MASK 0xFFFF
#endif
#define EN(k) (((PHASE_MASK) >> (k)) & 1)
constexpr int PH_PER_LAYER = 8, NPHASE = 1 + DEPTH * PH_PER_LAYER;
__global__ void __launch_bounds__(NTHR, 2) fwd(Args args) {
    extern __shared__ __attribute__((aligned(16))) unsigned char lds_raw[];
    Ctx C;
    C.lds = (LAS unsigned char*)lds_raw;
    C.tid = threadIdx.x; C.lane = C.tid & 63; C.wave = __builtin_amdgcn_readfirstlane(C.tid >> 6); C.G = gridDim.x; C.bid = blockIdx.x;
    C.ws = args.ws; C.out = args.out; C.ctl = (unsigned*)(args.ws + WS_CTL);
    const Args& A = args;
    for (int u = C.tid; u < (LDS_BYTES - LDSCTL_OFF) / 4; u += NTHR) ((LAS unsigned*)(C.lds + LDSCTL_OFF))[u] = 0u;
    __syncthreads();
    const int lo = args.ph_lo, hi = args.ph_hi;
    const bool multi = (hi - lo) > 1;
    XcdBarrier bar; bar.bar = C.ctl + CW_BAR; bar.x = 0; bar.st = (volatile LAS unsigned*)(C.lds + LDSCTL_OFF);
    if (multi) bar = xcd_barrier_post(C.ctl + CW_BAR, (volatile LAS unsigned*)(C.lds + LDSCTL_OFF));
#define IN(k) (lo <= (k) && (k) < hi)
#define FRESH() do { int t_ = threadIdx.x; asm volatile("" : "+v"(t_)); C.tid = t_; C.lane = t_ & 63; int w_ = __builtin_amdgcn_readfirstlane(t_ >> 6); asm volatile("" : "+s"(w_)); C.wave = w_; } while (0)
#define SEAM(k) do { if (IN((k) + 1)) xcd_barrier(bar); } while (0)

    if (EN(0) && IN(0)) { p0_prologue(C, A);
#if defined(PROBE_P02)
        __syncthreads(); p0_prologue(C, A);
#endif
        SEAM(0); }
#pragma unroll 1
    for (int l = 0; l < DEPTH; ++l) {
        const int pb = 1 + PH_PER_LAYER * l;
        if (EN(1) && IN(pb + 0)) { FRESH();
            pg8::Gemm g{ws_bf(C, WS_X), w_in_t(C, l), NTOK, INP, DM, DM};
            pg8::ListOrder S; S.list = (const LAS int*)(C.lds + LDS_ULIST);
            { pg8::WinOrder W; W.init(C.G, C.bid); pg8::Unit u; int n = 0; while (W.next(n, u)) { if (C.tid == 0) ((LAS int*)(C.lds + LDS_ULIST))[n] = (u.pm << 8) | u.pn; ++n; } S.n = n; }
            __syncthreads();
            build_rstd_table(C, S, ws_f(C, WS_SSQ1), (LAS float*)(C.lds + LDS_RSTD));
            pg8::EpiBf16<0> E{ws_bf(C, WS_PU), INP, (const LAS float*)(C.lds + LDS_RSTD)};
            pg8::gemm_phase<pg8::EpiBf16<0>, pg8::ListOrder, G_ALIGN, G_SP2>(C.lds, g, S, E);
#if defined(PROBE_G)
            if (PROBE_G & 1) { __syncthreads(); pg8::gemm_phase<pg8::EpiBf16<0>, pg8::StaticOrder, G_ALIGN, G_SP2>(C.lds, g, S, E); }
#endif
            if (l == 0) cache_convert(C, A, 0);
            SEAM(pb + 0);
        }
        if (EN(2) && IN(pb + 1)) { FRESH(); m0_phase(C, A, l);
#if defined(PROBE_BAR)
            for (int i = 0; i < PROBE_BAR; ++i) xcd_barrier(bar);
#endif
            SEAM(pb + 1); }
        if (IN(pb + 2)) { FRESH();
            unsigned* qh = C.ctl + CW_Q + 64 * (l * 4);
            unsigned* flg = C.ctl + CW_H + 64 * (l * 14);
            if (EN(3)) { unsigned* qg = C.ctl + CW_Q + 64 * (48 + l);
                for (;;) { const int u = q_next(C, qg); if (u >= 42) break;
                    pg8::Gemm g{ws_bf(C, WS_X), w_in_t(C, l), NTOK, INP, DM, DM}; pg8::OneUnit S1{58 + u / 3, 17 + u % 3};
                    build_rstd_table(C, S1, ws_f(C, WS_SSQ1), (LAS float*)(C.lds + LDS_RSTD));
                    pg8::EpiBf16<0> E{ws_bf(C, WS_PU), INP, (const LAS float*)(C.lds + LDS_RSTD)};
                    pg8::gemm_phase<pg8::EpiBf16<0>, pg8::OneUnit, G_ALIGN, G_SP2>(C.lds, g, S1, E);
                    asm volatile("s_waitcnt vmcnt(0)" ::: "memory"); __syncthreads();
                    if (C.tid == 0) { __builtin_amdgcn_fence(__ATOMIC_RELEASE, "agent"); asm volatile("s_waitcnt vmcnt(0)" ::: "memory"); xb_add(&flg[64 * (u / 3)], 1u); } } }
            if (EN(4)) for (;;) { const int u = q_next(C, qh + 64); if (u >= 288) break; dsa_unit(C, l, u); }
            if (EN(3)) for (;;) { const int u = q_next(C, qh); if (u >= NB * 16) break;
                if ((u >> 4) == NB - 1) wait_flags(C, flg, 0, 6);
                ssd_unit(C, A, l, (u >> 4) * SEQ, SEQ / 64, u & 15, nullptr, C.out + OFF_P_SSM + ((size_t)(l * NB + (u >> 4)) * 16 + (u & 15)) * 8192); }
            if (EN(5)) { int u = q_next(C, qh + 128); while (u < 288) { const int nx = q_prefetch(C, qh + 128); band_unit(C, A, l, u); u = q_publish(C, nx); } }
            if (EN(3)) { int u = q_next(C, qh + 192); while (u < DBAT * 16) { const int nx = q_prefetch(C, qh + 192);
                wait_flags(C, flg, 6 + (u >> 6), 1);
                ssd_unit(C, A, l, NTP + (u >> 4) * DSEQ, 1, u & 15, A.in[7] + ((size_t)(l * DBAT + (u >> 4)) * 16 + (u & 15)) * 8192, C.out + OFF_S_SSM + ((size_t)(l * DBAT + (u >> 4)) * 16 + (u & 15)) * 8192);
                u = q_publish(C, nx); } }
#if defined(PROBE_MIXK)
            { unsigned* qh2 = C.ctl + CW_Q + 64 * (16 + l * 4);
            if (PROBE_MIXK & 1) for (;;) { const int u = q_next(C, qh2); if (u >= NB * 16) break;
                ssd_unit(C, A, l, (u >> 4) * SEQ, SEQ / 64, u & 15, nullptr, C.out + OFF_P_SSM + ((size_t)(l * NB + (u >> 4)) * 16 + (u & 15)) * 8192); }
            if (PROBE_MIXK & 2) for (;;) { const int u = q_next(C, qh2 + 64); if (u >= 288) break; dsa_unit(C, l, u); }
            if (PROBE_MIXK & 4) for (;;) { const int u = q_next(C, qh2 + 128); if (u >= 288) break; band_unit(C, A, l, u); }
            if (PROBE_MIXK & 8) for (;;) { const int u = q_next(C, qh2 + 192); if (u >= DBAT * 16) break;
                ssd_unit(C, A, l, NTP + (u >> 4) * DSEQ, 1, u & 15, A.in[7] + ((size_t)(l * DBAT + (u >> 4)) * 16 + (u & 15)) * 8192, C.out + OFF_S_SSM + ((size_t)(l * DBAT + (u >> 4)) * 16 + (u & 15)) * 8192); } }
#endif
            SEAM(pb + 2);
        }
        if (EN(6) && IN(pb + 3)) { FRESH(); gate_norm_phase(C, A, l);
#if defined(PROBE_GATE2)
            gate_norm_phase(C, A, l);
#endif
            SEAM(pb + 3); }
        if (EN(7) && IN(pb + 4)) { FRESH();
            pg8::Gemm g{ws_bf(C, WS_MIX), w_out_t(C, l), NTOK, DM, DM, DM}; pg8::StaticOrder S; S.init(NTOK, DM, C.G, C.bid);
            pg8::EpiResBf16 E{ws_bf(C, WS_X), DM, ws_f(C, WS_SSQ2), 1};
#if defined(PROBE_G)
            if (PROBE_G & 4) { pg8::EpiNull E2; pg8::gemm_phase<pg8::EpiNull, pg8::StaticOrder, G_ALIGN, G_SP2>(C.lds, g, S, E2); __syncthreads(); }
#endif
            pg8::gemm_phase<pg8::EpiResBf16, pg8::StaticOrder, G_ALIGN_RES, G_SP2>(C.lds, g, S, E);
            if (l + 1 < DEPTH) cache_convert(C, A, l + 1);
            SEAM(pb + 4);
        }
        if (EN(9) && IN(pb + 5)) { FRESH();
            pg8::Gemm g{ws_bf(C, WS_X), w_up_t(C, l), NTOK, DFF, DM, DM}; pg8::StaticOrder S; S.init(NTOK, DFF, C.G, C.bid);
            build_rstd_table(C, S, ws_f(C, WS_SSQ2), (LAS float*)(C.lds + LDS_RSTD));
            pg8::EpiBf16<1> E{ws_bf(C, WS_PU), DFF, (const LAS float*)(C.lds + LDS_RSTD)};
#if defined(PROBE_G)
            if (PROBE_G & 2) { pg8::gemm_phase<pg8::EpiBf16<1>, pg8::StaticOrder, G_ALIGN, G_SP2>(C.lds, g, S, E); __syncthreads(); }
            if (PROBE_G & 256) { pg8::EpiNull E2; pg8::HotOrder S2{9, C.bid}; pg8::gemm_phase<pg8::EpiNull, pg8::HotOrder, G_ALIGN, G_SP2>(C.lds, g, S2, E2); __syncthreads(); }
            if (PROBE_G & 128) { pg8::EpiNull E2; pg8::gemm_phase<pg8::EpiNull, pg8::StaticOrder, G_ALIGN, G_SP2>(C.lds, g, S, E2); __syncthreads(); }
#endif
            pg8::gemm_phase<pg8::EpiBf16<1>, pg8::StaticOrder, G_ALIGN, G_SP2>(C.lds, g, S, E);
            SEAM(pb + 5);
        }
        if (EN(10) && IN(pb + 6)) { FRESH();
#if defined(PROBE_G)
            if (PROBE_G & 8) { pg8::Gemm g{ws_bf(C, WS_PU), w_dn_t(C, l), NTP, DM, DFF, DFF}; pg8::StaticOrder S; S.init(NTP, DM, C.G, C.bid);
              pg8::EpiNull E2; pg8::gemm_phase<pg8::EpiNull, pg8::StaticOrder, G_ALIGN, G_SP2>(C.lds, g, S, E2); __syncthreads(); }
            if (PROBE_G & 16) { pg8::Gemm g{ws_bf(C, WS_PU), w_dn_t(C, l), NTOK, DM, DFF / 4, DFF}; pg8::SplitOrder S; S.init(NTP / 256, NTS / 256, DM / 256, 4, C.G, C.bid);
              pg8::EpiSplitPart E{ws_f(C, WS_G), DM, (size_t)NTS * DM, NTP};
              pg8::gemm_phase<pg8::EpiSplitPart, pg8::SplitOrder, G_ALIGN, G_SP2>(C.lds, g, S, E); __syncthreads(); }
#endif
            { pg8::Gemm g{ws_bf(C, WS_PU), w_dn_t(C, l), NTP, DM, DFF, DFF}; pg8::StaticOrder S; S.init(NTP, DM, C.G, C.bid);
              pg8::EpiResBf16 E{ws_bf(C, WS_X), DM, ws_f(C, WS_SSQ1), l + 1 < DEPTH ? 1 : 0};
              pg8::gemm_phase<pg8::EpiResBf16, pg8::StaticOrder, G_ALIGN_RES, G_SP2>(C.lds, g, S, E); }
            __syncthreads();
            { pg8::Gemm g{ws_bf(C, WS_PU), w_dn_t(C, l), NTOK, DM, DFF / 4, DFF}; pg8::SplitOrder S; S.init(NTP / 256, NTS / 256, DM / 256, 4, C.G, C.bid);
              pg8::EpiSplitPart E{ws_f(C, WS_G), DM, (size_t)NTS * DM, NTP};
              pg8::gemm_phase<pg8::EpiSplitPart, pg8::SplitOrder, G_ALIGN, G_SP2>(C.lds, g, S, E); }
            SEAM(pb + 6);
        }
        if (EN(8) && IN(pb + 7)) { FRESH();
            if (l + 1 < DEPTH) norm_phase(C, NTP, 0, nullptr);
            else final_norm_phase(C, A.in[22]);
            SEAM(pb + 7);
        }
    }
#undef IN
#undef SEAM
}

extern "C" void kernel_launch(void* const* d_in, const int* in_sizes, int n_in, void* d_out, int out_size, void* d_ws, size_t ws_size, hipStream_t stream) {
    static int grid = 0;
    if (grid == 0) {
        if (n_in != 23 || in_sizes[0] != NTP * DM || (size_t)out_size != OUT_TOTAL || ws_size < WS_END) {
            fprintf(stderr, "kernel_launch: unexpected shapes (n_in %d, in0 %d, out %d, ws %zu; need ws >= %zu); nothing launched\n", n_in, n_in > 0 ? in_sizes[0] : -1, out_size, ws_size, (size_t)WS_END); grid = -1; return; }
        int dev = 0, cus = 0, per_cu = 0;
        if (hipGetDevice(&dev) != hipSuccess || hipDeviceGetAttribute(&cus, hipDeviceAttributeMultiprocessorCount, dev) != hipSuccess) { fprintf(stderr, "kernel_launch: device query failed\n"); grid = -1; return; }
        if (hipFuncSetAttribute((const void*)fwd, hipFuncAttributeMaxDynamicSharedMemorySize, LDS_BYTES) != hipSuccess) { fprintf(stderr, "kernel_launch: hipFuncSetAttribute failed\n"); grid = -1; return; }
        if (hipOccupancyMaxActiveBlocksPerMultiprocessor(&per_cu, (const void*)fwd, NTHR, LDS_BYTES) != hipSuccess || per_cu < 1)
            fprintf(stderr, "kernel_launch: note: occupancy query reports %d workgroups per CU\n", per_cu);
        (void)hipGetLastError();
        grid = cus < 256 ? cus : 256;
    }
    if (grid < 0) return;
    if (hipMemsetAsync((char*)d_ws + WS_CTL, 0, CTL_ZERO_BYTES, stream) != hipSuccess) { fprintf(stderr, "kernel_launch: memset failed\n"); return; }
    Args a{};
    for (int i = 0; i < 23; ++i) a.in[i] = (const float*)d_in[i];
    a.out = (float*)d_out; a.ws = (unsigned char*)d_ws;
#if MK_ONE_LAUNCH
    a.ph_lo = 0; a.ph_hi = NPHASE;
    hipLaunchKernelGGL(fwd, dim3(grid), dim3(NTHR), LDS_BYTES, stream, a);
#else
    for (int p = 0; p < NPHASE; ++p) { a.ph_lo = p; a.ph_hi = p + 1; hipLaunchKernelGGL(fwd, dim3(grid), dim3(NTHR), LDS_BYTES, stream, a); }
#endif
    const hipError_t le = hipPeekAtLastError();
    if (le != hipSuccess) fprintf(stderr, "kernel_launch: launch failed: %s\n", hipGetErrorName(le));
}
```

```cpp
#include <hip/hip_runtime.h>
#include <cstdio>
#include <cstdint>
#include <cstddef>
namespace pg8 {
#define PG8_LAS __attribute__((address_space(3)))
typedef unsigned short bf16_t;
typedef short bf16x8 __attribute__((ext_vector_type(8)));
typedef float f32x4 __attribute__((ext_vector_type(4)));
typedef unsigned u32x4 __attribute__((ext_vector_type(4)));
constexpr int BM = 256, BK = 64, HALF = 128, HTB = HALF * BK * 2  , STAGE_BYTES = 8 * HTB, NXCD = 8, WGM = 8;

__host__ __device__ __forceinline__ int lds_byte(int r, int c) { const int st = (r >> 4) * 2 + (c >> 5), rr = r & 15, cc = c & 31, ob = rr * 64 + cc * 2; return st * 1024 + (ob ^ (((ob >> 9) & 1) << 5)); }
__host__ __device__ __forceinline__ void stage_rc(int b, int& R, int& C) { const int st = b / 1024, sb = b % 1024, swz = sb ^ (((sb >> 9) & 1) << 5); R = (st >> 1) * 16 + swz / 64; C = (st & 1) * 32 + (swz % 64) / 2; }
__host__ __device__ __forceinline__ int perm32(int rho) { const int n = rho >> 4, i = rho & 15; return 8 * (i >> 2) + 4 * n + (i & 3); }

struct Unit { int pm, pn, kq, ord; };
struct Gemm { const bf16_t* A; const bf16_t* Bt; int M, N, K, ld; };

struct StaticOrder {
    int nM, nN, nwg, G, c;
    __host__ __device__ void init(int M, int N, int G_, int c_) { nM = M / BM; nN = N / BM; nwg = nM * nN; G = G_; c = c_; }
    __host__ __device__ bool next(int i, Unit& u) const {
        const long L = (long)i * G + c; if (L >= nwg) return false;
        int wgid = (int)L; { const int q = nwg / NXCD, r = nwg % NXCD, xcd = wgid % NXCD, off = wgid / NXCD; wgid = (xcd < r ? xcd * (q + 1) : r * (q + 1) + (xcd - r) * q) + off; }
        const int nig = WGM * nN, gid = wgid / nig, fm = gid * WGM, gsz = (nM - fm) < WGM ? (nM - fm) : WGM;
        u.pm = fm + ((wgid % nig) % gsz); u.pn = (wgid % nig) / gsz; u.kq = 0; u.ord = i; return true;
    }
    __device__ __forceinline__ void a_ready(const Unit&) const {}
    __device__ __forceinline__ void done(const Unit&) const {}
};

struct WinOrder {
    int G, c, c2, n1;
    template <int nM, int nN> static __host__ __device__ __forceinline__ void tile(int L, int& pm, int& pn) {
        constexpr int nwg = nM * nN, q = nwg / NXCD, r = nwg % NXCD, nig = WGM * nN;
        const int xcd = L % NXCD, off = L / NXCD; const int wgid = (xcd < r ? xcd * (q + 1) : r * (q + 1) + (xcd - r) * q) + off;
        const int gid = wgid / nig, fm = gid * WGM, gsz = (nM - fm) < WGM ? (nM - fm) : WGM;
        pm = fm + ((wgid % nig) % gsz); pn = (wgid % nig) / gsz;
    }
    __host__ __device__ __forceinline__ void init(int G_, int c_) { G = G_; c = c_; c2 = (c_ + G_ - (146 % G_)) % G_; n1 = c_ < 1682 ? (1681 - c_) / G_ + 1 : 0; }
    __host__ __device__ __forceinline__ bool next(int i, Unit& u) const {
        if (i < n1) { tile<58, 29>(i * G + c, u.pm, u.pn); }
        else { const int L = (i - n1) * G + c2; if (L >= 364) return false; int pm, pn; tile<14, 26>(L, pm, pn); u.pm = pm + 58; u.pn = pn < 17 ? pn : pn + 3; }
        u.kq = 0; u.ord = i; return true;
    }
    __device__ __forceinline__ void a_ready(const Unit&) const {}
    __device__ __forceinline__ void done(const Unit&) const {}
};
struct ListOrder {
    const PG8_LAS int* list; int n;
    __device__ __forceinline__ bool next(int i, Unit& u) const { if (i >= n) return false; const int v = __builtin_amdgcn_readfirstlane(list[i]); u.pm = v >> 8; u.pn = v & 255; u.kq = 0; u.ord = i; return true; }
    __device__ __forceinline__ void a_ready(const Unit&) const {}
    __device__ __forceinline__ void done(const Unit&) const {}
};
struct OneUnit {
    int pm, pn;
    __host__ __device__ bool next(int i, Unit& u) const { if (i != 0) return false; u.pm = pm; u.pn = pn; u.kq = 0; u.ord = 0; return true; }
    __device__ __forceinline__ void a_ready(const Unit&) const {}
    __device__ __forceinline__ void done(const Unit&) const {}
};

struct SplitOrder {
    int pm0, npm, nN, nsplit, G, c;
    __host__ __device__ void init(int pm0_, int npm_, int nN_, int nsplit_, int G_, int c_) { pm0 = pm0_; npm = npm_; nN = nN_; nsplit = nsplit_; G = G_; c = c_; }
    __host__ __device__ bool next(int i, Unit& u) const {
        const long L = (long)i * G + c; if (L >= (long)npm * nN * nsplit) return false;
        const int w = (int)L; u.kq = w % nsplit; u.pn = (w / nsplit) % nN; u.pm = pm0 + w / (nsplit * nN); u.ord = i; return true;
    }
    __device__ __forceinline__ void a_ready(const Unit&) const {}
    __device__ __forceinline__ void done(const Unit&) const {}
};

struct HotOrder {
    int n, c;
    __host__ __device__ bool next(int i, Unit& u) const { if (i >= n) return false; u.pm = c & 7; u.pn = (c >> 3) & 3; u.kq = 0; u.ord = i; return true; }
    __device__ __forceinline__ void a_ready(const Unit&) const {}
    __device__ __forceinline__ void done(const Unit&) const {}
};

typedef float f32x2_t __attribute__((ext_vector_type(2)));
typedef __bf16 bf16x2_t __attribute__((ext_vector_type(2)));
__device__ __forceinline__ unsigned cvt_pk_bf16(float lo, float hi) { f32x2_t v = {lo, hi}; bf16x2_t b = __builtin_convertvector(v, bf16x2_t); return __builtin_bit_cast(unsigned, b); }

template <int ACT  , int PMODE = 0  > struct EpiBf16 {
    static constexpr bool PERM = true, AFTER_DRAIN = false;
    bf16_t* O; int ldc; const PG8_LAS float* tab;
    __device__ __forceinline__ void operator()(const f32x4 (&acc)[2][2][4][2], const Unit& u, int wr, int wc, int fr, int fq) const {
        const int row0 = u.pm * BM + wr * 64 + fr; const int col0 = u.pn * BM + wc * 32 + 8 * fq;
        float rs[2][4];
#pragma unroll
        for (int ai = 0; ai < 2; ++ai)
#pragma unroll
            for (int m = 0; m < 4; ++m) rs[ai][m] = PMODE == 1 ? 1.0f : tab[u.ord * BM + wr * 64 + fr + ai * HALF + m * 16];
#pragma unroll
        for (int ai = 0; ai < 2; ++ai)
#pragma unroll
            for (int m = 0; m < 4; ++m) { bf16_t* rowp = O + (size_t)(row0 + ai * HALF + m * 16) * ldc + col0;
#pragma unroll
                for (int bj = 0; bj < 2; ++bj) { f32x4 v0 = acc[ai][bj][m][0] * rs[ai][m], v1 = acc[ai][bj][m][1] * rs[ai][m];
                    if (ACT == 1) {
#pragma unroll
                        for (int j = 0; j < 4; ++j) { const float a = v0[j] > 0.f ? v0[j] : 0.f, b = v1[j] > 0.f ? v1[j] : 0.f; v0[j] = a * a; v1[j] = b * b; } }
                    u32x4 w; w.x = cvt_pk_bf16(v0[0], v0[1]); w.y = cvt_pk_bf16(v0[2], v0[3]); w.z = cvt_pk_bf16(v1[0], v1[1]); w.w = cvt_pk_bf16(v1[2], v1[3]);
                    if (PMODE == 2) asm volatile("" :: "v"(w)); else *(u32x4*)(rowp + bj * HALF) = w; } }
    }
};
struct EpiResF32 {
    static constexpr bool PERM = false, AFTER_DRAIN = false;
    float* X; int ldc;
    __device__ __forceinline__ void operator()(const f32x4 (&acc)[2][2][4][2], const Unit& u, int wr, int wc, int fr, int fq) const {
        const int row0 = u.pm * BM + wr * 64 + fr, col0 = u.pn * BM + wc * 32 + 4 * fq;
#pragma unroll
        for (int ai = 0; ai < 2; ++ai)
#pragma unroll
            for (int m = 0; m < 4; ++m) { float* rowp = X + (size_t)(row0 + ai * HALF + m * 16) * ldc + col0;
                f32x4 b[2][2];
#pragma unroll
                for (int bj = 0; bj < 2; ++bj)
#pragma unroll
                    for (int n = 0; n < 2; ++n) b[bj][n] = *(const f32x4*)(rowp + bj * HALF + n * 16);
#pragma unroll
                for (int bj = 0; bj < 2; ++bj)
#pragma unroll
                    for (int n = 0; n < 2; ++n) *(f32x4*)(rowp + bj * HALF + n * 16) = b[bj][n] + acc[ai][bj][m][n];
                asm volatile("" ::: "memory"); }
    }
};

struct EpiSplitRes {
    static constexpr bool PERM = false, AFTER_DRAIN = false;
    float* X; int ldc; float* P; size_t pstride; int row0;
    __device__ __forceinline__ void operator()(const f32x4 (&acc)[2][2][4][2], const Unit& u, int wr, int wc, int fr, int fq) const {
        const int rowa = u.pm * BM + wr * 64 + fr, col0 = u.pn * BM + wc * 32 + 4 * fq;
        if (u.kq == 0) {
#pragma unroll
            for (int ai = 0; ai < 2; ++ai)
#pragma unroll
                for (int m = 0; m < 4; ++m) { float* rowp = X + (size_t)(rowa + ai * HALF + m * 16) * ldc + col0;
                    f32x4 b[2][2];
#pragma unroll
                    for (int bj = 0; bj < 2; ++bj)
#pragma unroll
                        for (int n = 0; n < 2; ++n) b[bj][n] = *(const f32x4*)(rowp + bj * HALF + n * 16);
#pragma unroll
                    for (int bj = 0; bj < 2; ++bj)
#pragma unroll
                        for (int n = 0; n < 2; ++n) *(f32x4*)(rowp + bj * HALF + n * 16) = b[bj][n] + acc[ai][bj][m][n];
                    asm volatile("" ::: "memory"); }
        } else {
            float* base = P + (size_t)(u.kq - 1) * pstride;
#pragma unroll
            for (int ai = 0; ai < 2; ++ai)
#pragma unroll
                for (int m = 0; m < 4; ++m) { float* rowp = base + (size_t)(rowa - row0 + ai * HALF + m * 16) * ldc + col0;
#pragma unroll
                    for (int bj = 0; bj < 2; ++bj)
#pragma unroll
                        for (int n = 0; n < 2; ++n) *(f32x4*)(rowp + bj * HALF + n * 16) = acc[ai][bj][m][n]; }
        }
    }
};

struct EpiResBf16 {
    static constexpr bool PERM = true, AFTER_DRAIN = false;
    bf16_t* X; int ldc; float* SSQ; int emit;
    __device__ __forceinline__ void operator()(const f32x4 (&acc)[2][2][4][2], const Unit& u, int wr, int wc, int fr, int fq) const {
        const int row0 = u.pm * BM + wr * 64 + fr, col0 = u.pn * BM + wc * 32 + 8 * fq;
        u32x4 b[2][4][2];
#pragma unroll
        for (int ai = 0; ai < 2; ++ai)
#pragma unroll
            for (int m = 0; m < 4; ++m)
#pragma unroll
                for (int bj = 0; bj < 2; ++bj) b[ai][m][bj] = *(const u32x4*)(X + (size_t)(row0 + ai * HALF + m * 16) * ldc + col0 + bj * HALF);
#pragma unroll
        for (int ai = 0; ai < 2; ++ai)
#pragma unroll
            for (int m = 0; m < 4; ++m) { const int row = row0 + ai * HALF + m * 16; bf16_t* rowp = X + (size_t)row * ldc + col0; float ss = 0.f;
#pragma unroll
                for (int bj = 0; bj < 2; ++bj) { float v[8];
#pragma unroll
                    for (int j = 0; j < 4; ++j) { v[2 * j] = __uint_as_float(b[ai][m][bj][j] << 16); v[2 * j + 1] = __uint_as_float(b[ai][m][bj][j] & 0xffff0000u); }
#pragma unroll
                    for (int j = 0; j < 4; ++j) { v[j] += acc[ai][bj][m][0][j]; v[4 + j] += acc[ai][bj][m][1][j]; }
#pragma unroll
                    for (int j = 0; j < 8; ++j) ss += v[j] * v[j];
                    u32x4 w; w.x = cvt_pk_bf16(v[0], v[1]); w.y = cvt_pk_bf16(v[2], v[3]); w.z = cvt_pk_bf16(v[4], v[5]); w.w = cvt_pk_bf16(v[6], v[7]);
                    *(u32x4*)(rowp + bj * HALF) = w; }
                if (emit) { ss += __shfl_xor(ss, 16); ss += __shfl_xor(ss, 32); if (fq == 0) SSQ[(size_t)row * 32 + u.pn * 4 + wc] = ss; } }
    }
};
struct EpiSplitPart {
    static constexpr bool PERM = false, AFTER_DRAIN = false;
    float* P; int ldc; size_t pstride; int row0;
    __device__ __forceinline__ void operator()(const f32x4 (&acc)[2][2][4][2], const Unit& u, int wr, int wc, int fr, int fq) const {
        const int rowa = u.pm * BM + wr * 64 + fr, col0 = u.pn * BM + wc * 32 + 4 * fq;
        float* base = P + (size_t)u.kq * pstride;
#pragma unroll
        for (int ai = 0; ai < 2; ++ai)
#pragma unroll
            for (int m = 0; m < 4; ++m) { float* rowp = base + (size_t)(rowa - row0 + ai * HALF + m * 16) * ldc + col0;
#pragma unroll
                for (int bj = 0; bj < 2; ++bj)
#pragma unroll
                    for (int n = 0; n < 2; ++n) *(f32x4*)(rowp + bj * HALF + n * 16) = acc[ai][bj][m][n]; }
    }
};

struct EpiNull {
    static constexpr bool PERM = false, AFTER_DRAIN = false;
    __device__ __forceinline__ void operator()(const f32x4 (&acc)[2][2][4][2], const Unit&, int, int, int, int) const {
#pragma unroll
        for (int ai = 0; ai < 2; ++ai)
#pragma unroll
            for (int bj = 0; bj < 2; ++bj)
#pragma unroll
                for (int m = 0; m < 4; ++m)
#pragma unroll
                    for (int n = 0; n < 2; ++n) asm volatile("" :: "v"(acc[ai][bj][m][n]));
    }
};
template <class Epi, class Sched, bool ALIGN_EPI = false, bool SP2 = false>
__device__ __forceinline__ void gemm_phase(PG8_LAS unsigned char* lds, const Gemm g, const Sched& S, const Epi& E) {
    int tid_ = threadIdx.x; asm volatile("" : "+v"(tid_));
    const int tid = tid_, wid = __builtin_amdgcn_readfirstlane(tid >> 6), lane = tid & 63, wr = wid >> 2, wc = wid & 3, fr = lane & 15, fq = lane >> 4;
    const int K = g.K, nt = K / BK, ld = g.ld;
    unsigned voffA[2], voffB[2];
#pragma unroll
    for (int i = 0; i < 2; ++i) { int R, C; stage_rc(tid * 16 + i * 8192, R, C); const int Rb = Epi::PERM ? ((R & ~31) + perm32(R & 31)) : R;
        voffA[i] = (unsigned)(R * ld + C) * 2u; voffB[i] = (unsigned)(Rb * ld + C) * 2u; }
    const size_t kstep = (size_t)(BK * 2);
    const size_t hstep = (size_t)HALF * ld * 2;
    const size_t tstep = 2 * hstep;
    const unsigned ldsw = (unsigned)wid * 1024u;
    const int aoff = lds_byte(wr * 64 + fr, fq * 8), boff = lds_byte(wc * 32 + fr, fq * 8);
#define PG8_SA(b, h) (((b) * 2 + (h)) * HTB)
#define PG8_SB(b, h) ((4 + (b) * 2 + (h)) * HTB)
#define PG8_STAGE(bufoff, gbase, voff) do { _Pragma("unroll") for (int _i = 0; _i < 2; ++_i) \
        __builtin_amdgcn_global_load_lds((const unsigned*)((const char*)(gbase) + (voff)[_i]), (PG8_LAS unsigned*)(lds + (bufoff) + ldsw + _i * 8192), 16, 0, 0); } while (0)
#define PG8_LDA(dst, b, h) do { _Pragma("unroll") for (int m = 0; m < 4; ++m) _Pragma("unroll") for (int k = 0; k < 2; ++k) dst[m][k] = *(const PG8_LAS bf16x8*)(lds + PG8_SA(b, h) + aoff + m * 2048 + k * 1024); } while (0)
#define PG8_LDB(dst, b, h) do { _Pragma("unroll") for (int n = 0; n < 2; ++n) _Pragma("unroll") for (int k = 0; k < 2; ++k) dst[n][k] = *(const PG8_LAS bf16x8*)(lds + PG8_SB(b, h) + boff + n * 2048 + k * 1024); } while (0)
#define PG8_MMA(ai, bj, At, Bt) do { __builtin_amdgcn_s_setprio(1); _Pragma("unroll") for (int m = 0; m < 4; ++m) _Pragma("unroll") for (int n = 0; n < 2; ++n) _Pragma("unroll") for (int k = 0; k < 2; ++k) \
        acc[ai][bj][m][n] = __builtin_amdgcn_mfma_f32_16x16x32_bf16(Bt[n][k], At[m][k], acc[ai][bj][m][n], 0, 0, 0); __builtin_amdgcn_s_setprio(0); } while (0)
#define PG8_WAIT_V(n) asm volatile("s_waitcnt vmcnt(" #n ")" ::: "memory")
#define PG8_WAIT_L(n) asm volatile("s_waitcnt lgkmcnt(" #n ")" ::: "memory")
#define PG8_BAR __builtin_amdgcn_s_barrier()
#define PG8_SCHED __builtin_amdgcn_sched_barrier(0)
    Unit cur, nxt; int ui = 0;
    if (!S.next(0, cur)) return;
    f32x4 acc[2][2][4][2];
#pragma unroll
    for (int a = 0; a < 2; ++a)
#pragma unroll
        for (int b = 0; b < 2; ++b)
#pragma unroll
            for (int m = 0; m < 4; ++m)
#pragma unroll
                for (int n = 0; n < 2; ++n) acc[a][b][m][n] = (f32x4){0.f, 0.f, 0.f, 0.f};
    bf16x8 At[4][2], B0[2][2], B1[2][2];
    const char* cA = (const char*)g.A + (size_t)cur.pm * tstep + (size_t)cur.kq * K * 2; const char* cB = (const char*)g.Bt + (size_t)cur.pn * tstep + (size_t)cur.kq * K * 2;
    S.a_ready(cur);
    if constexpr (SP2) {
        PG8_STAGE(PG8_SB(0, 0), cB, voffB); PG8_STAGE(PG8_SB(0, 1), cB + hstep, voffB); PG8_STAGE(PG8_SA(0, 0), cA, voffA); PG8_STAGE(PG8_SA(0, 1), cA + hstep, voffA);
        if (wr == 1) PG8_BAR;
        PG8_WAIT_V(2); PG8_BAR;
        PG8_STAGE(PG8_SB(1, 0), cB + kstep, voffB); PG8_STAGE(PG8_SA(1, 0), cA + kstep, voffA); PG8_STAGE(PG8_SB(1, 1), cB + hstep + kstep, voffB);
        PG8_WAIT_V(6); PG8_BAR;
    } else {
        PG8_STAGE(PG8_SB(0, 0), cB, voffB); PG8_STAGE(PG8_SA(0, 0), cA, voffA); PG8_STAGE(PG8_SB(0, 1), cB + hstep, voffB); PG8_STAGE(PG8_SA(0, 1), cA + hstep, voffA);
        if (wr == 1) PG8_BAR;
        PG8_WAIT_V(4); PG8_BAR;
        PG8_STAGE(PG8_SB(1, 0), cB + kstep, voffB); PG8_STAGE(PG8_SA(1, 0), cA + kstep, voffA); PG8_STAGE(PG8_SB(1, 1), cB + hstep + kstep, voffB);
        PG8_WAIT_V(6); PG8_BAR;
    }
    for (;;) {
        const bool has_next = S.next(ui + 1, nxt);
        const char* nA = has_next ? (const char*)g.A + (size_t)nxt.pm * tstep + (size_t)nxt.kq * K * 2 : cA; const char* nB = has_next ? (const char*)g.Bt + (size_t)nxt.pn * tstep + (size_t)nxt.kq * K * 2 : cB;
        for (int t = 0; t < nt; t += 2) {
            const bool last = (t == nt - 2);
            const char* a1 = cA + (size_t)(t + 1) * kstep;
            const char* a2 = last ? nA : cA + (size_t)(t + 2) * kstep; const char* b2 = last ? nB : cB + (size_t)(t + 2) * kstep;
            const char* a3 = a2 + kstep; const char* b3 = b2 + kstep;
            if (last && has_next) S.a_ready(nxt);
            if constexpr (SP2) {
            PG8_LDB(B0, 0, 0); PG8_LDB(B1, 0, 1); PG8_SCHED; PG8_LDA(At, 0, 0); PG8_STAGE(PG8_SA(1, 1), a1 + hstep, voffA);
            PG8_WAIT_V(8); PG8_WAIT_L(0); PG8_BAR; PG8_MMA(0, 0, At, B0); PG8_MMA(0, 1, At, B1); PG8_BAR; PG8_SCHED;
            PG8_LDA(At, 0, 1); PG8_STAGE(PG8_SB(0, 0), b2, voffB); PG8_STAGE(PG8_SB(0, 1), b2 + hstep, voffB); PG8_STAGE(PG8_SA(0, 0), a2, voffA);
            PG8_WAIT_V(8); PG8_WAIT_L(0); PG8_BAR; PG8_MMA(1, 0, At, B0); PG8_MMA(1, 1, At, B1); PG8_BAR; PG8_SCHED;
            PG8_LDB(B0, 1, 0); PG8_LDB(B1, 1, 1); PG8_SCHED; PG8_LDA(At, 1, 0); PG8_STAGE(PG8_SA(0, 1), a2 + hstep, voffA);
            PG8_WAIT_V(8); PG8_WAIT_L(0); PG8_BAR; PG8_MMA(0, 0, At, B0); PG8_MMA(0, 1, At, B1); PG8_BAR; PG8_SCHED;
            PG8_LDA(At, 1, 1); PG8_STAGE(PG8_SB(1, 0), b3, voffB); PG8_STAGE(PG8_SB(1, 1), b3 + hstep, voffB); PG8_STAGE(PG8_SA(1, 0), a3, voffA);
            PG8_WAIT_V(8); PG8_WAIT_L(0); PG8_BAR; PG8_MMA(1, 0, At, B0); PG8_MMA(1, 1, At, B1); PG8_BAR; PG8_SCHED;
            } else {
            PG8_LDB(B0, 0, 0); PG8_SCHED; PG8_LDA(At, 0, 0); PG8_STAGE(PG8_SA(1, 1), a1 + hstep, voffA);
            PG8_WAIT_L(8); PG8_BAR; PG8_WAIT_L(0); PG8_MMA(0, 0, At, B0); PG8_BAR; PG8_SCHED;
            PG8_LDB(B1, 0, 1); PG8_STAGE(PG8_SB(0, 0), b2, voffB);
            PG8_BAR; PG8_WAIT_L(0); PG8_MMA(0, 1, At, B1); PG8_BAR;
            PG8_LDA(At, 0, 1); PG8_STAGE(PG8_SA(0, 0), a2, voffA);
            PG8_BAR; PG8_WAIT_L(0); PG8_MMA(1, 0, At, B0); PG8_BAR; PG8_SCHED;
            PG8_STAGE(PG8_SB(0, 1), b2 + hstep, voffB);
            PG8_WAIT_V(6); PG8_BAR; PG8_MMA(1, 1, At, B1); PG8_BAR;
            PG8_LDB(B0, 1, 0); PG8_SCHED; PG8_LDA(At, 1, 0); PG8_STAGE(PG8_SA(0, 1), a2 + hstep, voffA);
            PG8_WAIT_L(8); PG8_BAR; PG8_WAIT_L(0); PG8_MMA(0, 0, At, B0); PG8_BAR; PG8_SCHED;
            PG8_LDB(B1, 1, 1); PG8_STAGE(PG8_SB(1, 0), b3, voffB);
            PG8_BAR; PG8_WAIT_L(0); PG8_MMA(0, 1, At, B1); PG8_BAR;
            PG8_LDA(At, 1, 1); PG8_STAGE(PG8_SA(1, 0), a3, voffA);
            PG8_BAR; PG8_WAIT_L(0); PG8_MMA(1, 0, At, B0); PG8_BAR; PG8_SCHED;
            PG8_STAGE(PG8_SB(1, 1), b3 + hstep, voffB);
            PG8_WAIT_V(6); PG8_BAR; PG8_MMA(1, 1, At, B1); PG8_BAR;
            }
        }
        if constexpr (ALIGN_EPI) { if (wr == 0) PG8_BAR; }
        if constexpr (!Epi::AFTER_DRAIN) { E(acc, cur, wr, wc, fr, fq); S.done(cur); }
        if (!has_next) break;
#pragma unroll
        for (int a = 0; a < 2; ++a)
#pragma unroll
            for (int b = 0; b < 2; ++b)
#pragma unroll
                for (int m = 0; m < 4; ++m)
#pragma unroll
                    for (int n = 0; n < 2; ++n) acc[a][b][m][n] = (f32x4){0.f, 0.f, 0.f, 0.f};
        cur = nxt; cA = nA; cB = nB; ++ui;
        if constexpr (ALIGN_EPI) { if (wr == 1) PG8_BAR; }
    }
    PG8_WAIT_V(0);
    if constexpr (!ALIGN_EPI) { if (wr == 0) PG8_BAR; }
    PG8_BAR;
    if constexpr (Epi::AFTER_DRAIN) { E.fused(acc, cur, wr, wc, fr, fq, lds, wid, lane); S.done(cur); }
#undef PG8_SA
#undef PG8_SB
#undef PG8_STAGE
#undef PG8_LDA
#undef PG8_LDB
#undef PG8_MMA
#undef PG8_WAIT_V
#undef PG8_WAIT_L
#undef PG8_BAR
#undef PG8_SCHED
}
}

#define DI __device__ __forceinline__
#define LAS __attribute__((address_space(3)))
typedef unsigned short bf16;
typedef short bf16x8 __attribute__((ext_vector_type(8)));
typedef short s16x4 __attribute__((ext_vector_type(4)));
typedef short v4i16_t __attribute__((ext_vector_type(4)));
typedef float f32x4 __attribute__((ext_vector_type(4)));
typedef float f32x16 __attribute__((ext_vector_type(16)));
typedef unsigned u32x4 __attribute__((ext_vector_type(4)));
typedef unsigned u32x2 __attribute__((ext_vector_type(2)));
typedef float f32x2_t_ __attribute__((ext_vector_type(2)));

constexpr int DM = 2048, NB = 8, SEQ = 2048, DEPTH = 4, DBAT = 32, DSEQ = 64, PAST = 1024, BWIN = 512;
constexpr int NTP = NB * SEQ, NTS = DBAT * DSEQ, NTOK = NTP + NTS;
constexpr int INC = 7264, INP = 7424, DFF = 8192;
constexpr int C_AQ = 0, C_AK = 512, C_AV = 1024, C_IQ = 1536, C_IK = 2560, C_IW = 2624, C_BQ = 2640, C_BK = 3152, C_BV = 3664, C_CZ = 4176, C_XBC = 5200, C_DT = 7248;
constexpr float EPS = 1e-5f;
constexpr int NWAVES = 8, NTHR = 512;

constexpr size_t SZ_YP = (size_t)NTP * DM, SZ_YS = (size_t)NTS * DM;
constexpr size_t SZ_PAK = (size_t)DEPTH * NB * SEQ * 512, SZ_PKI = (size_t)DEPTH * NB * SEQ * 64, SZ_PBK = (size_t)DEPTH * NB * BWIN * 512;
constexpr size_t SZ_PSSM = (size_t)DEPTH * NB * 16 * 64 * 128, SZ_PCONV = (size_t)DEPTH * NB * 3 * 2048;
constexpr size_t SZ_SAK = (size_t)DEPTH * DBAT * DSEQ * 512, SZ_SKI = (size_t)DEPTH * DBAT * DSEQ * 64, SZ_SBK = SZ_SAK;
constexpr size_t SZ_SSSM = (size_t)DEPTH * DBAT * 16 * 64 * 128, SZ_SCONV = (size_t)DEPTH * DBAT * 3 * 2048;
constexpr size_t OFF_YP = 0, OFF_YS = OFF_YP + SZ_YP, OFF_P_AK = OFF_YS + SZ_YS, OFF_P_AV = OFF_P_AK + SZ_PAK, OFF_P_KI = OFF_P_AV + SZ_PAK,
                 OFF_P_BK = OFF_P_KI + SZ_PKI, OFF_P_BV = OFF_P_BK + SZ_PBK, OFF_P_SSM = OFF_P_BV + SZ_PBK, OFF_P_CONV = OFF_P_SSM + SZ_PSSM,
                 OFF_S_AK = OFF_P_CONV + SZ_PCONV, OFF_S_AV = OFF_S_AK + SZ_SAK, OFF_S_KI = OFF_S_AV + SZ_SAK, OFF_S_BK = OFF_S_KI + SZ_SKI,
                 OFF_S_BV = OFF_S_BK + SZ_SBK, OFF_S_SSM = OFF_S_BV + SZ_SBK, OFF_S_CONV = OFF_S_SSM + SZ_SSSM, OUT_TOTAL = OFF_S_CONV + SZ_SCONV;
static_assert(OUT_TOTAL == 165085184, "output size");

constexpr size_t MiB = 1u << 20;
constexpr size_t WS_CTL = 0, CTL_ZERO_BYTES = 1 * MiB;
constexpr size_t WS_ROPE = 1 * MiB;
constexpr size_t WS_W = 2 * MiB;
constexpr size_t W_IN_B = (size_t)INP * DM * 2, W_OUT_B = (size_t)DM * DM * 2, W_UP_B = (size_t)DFF * DM * 2, W_DN_B = (size_t)DM * DFF * 2, W_LAYER_B = W_IN_B + W_OUT_B + W_UP_B + W_DN_B;
static_assert(W_LAYER_B == 101 * MiB, "weights per layer");
constexpr size_t WS_X = WS_W + DEPTH * W_LAYER_B;
constexpr size_t WS_H = WS_X + (size_t)NTOK * DM * 4;
constexpr size_t WS_MIX = WS_H + (size_t)NTOK * DM * 2;
constexpr size_t WS_PU = WS_MIX + (size_t)NTOK * DM * 2;
constexpr size_t WS_XBC = WS_PU + (size_t)NTOK * DFF * 2;
constexpr size_t WS_G = WS_XBC + (size_t)NTOK * 2048 * 2;
constexpr size_t WS_DTS = WS_G + (size_t)NTOK * 1024 * 4;
constexpr size_t WS_CAK = WS_DTS + 2 * MiB;
constexpr size_t WS_CAV = WS_CAK + (size_t)DBAT * PAST * 512 * 2;
constexpr size_t WS_CBK = WS_CAV + (size_t)DBAT * PAST * 512 * 2;
constexpr size_t WS_CBV = WS_CBK + (size_t)DBAT * BWIN * 512 * 2;
constexpr size_t WS_CKI = WS_CBV + (size_t)DBAT * BWIN * 512 * 2;
constexpr size_t WS_SC = WS_CKI + (size_t)DBAT * PAST * 64 * 2;
constexpr size_t WS_SSQ1 = WS_SC + (size_t)256 * 64 * 2048 * 4, WS_SSQ2 = WS_SSQ1 + 3 * MiB;
constexpr size_t WS_END = WS_SSQ2 + 3 * MiB;
static_assert(WS_END == 1362 * MiB, "ws map");
constexpr int CW_BAR = 4096;
constexpr int LDS_ULIST = 147456;
constexpr int CW_H = 16384 + 64 * 64;
constexpr int CW_Q = 16384;

constexpr int RING_BYTES = 155648, LDSCTL_OFF = RING_BYTES, LDS_RSTD = 131072, LDS_BYTES = 157696;
constexpr int ATT_SEL = 0;
constexpr int ATT_K = 16384, KSTR = 1040, ATT_V = ATT_K + 2 * 32 * KSTR, VSTR = 1088, ATT_END = ATT_V + 2 * 32 * VSTR;
constexpr int CSTR = 272, XSTR = 144, MSTR = 144, HSTR = 272;
constexpr int SSD_CS = 0, SSD_BS = SSD_CS + 64 * CSTR, SSD_XD = SSD_BS + 64 * CSTR, SSD_XDW = SSD_XD + 64 * XSTR, SSD_MS = SSD_XDW + 64 * XSTR,
              SSD_HS = SSD_MS + 64 * MSTR, SSD_VEC = SSD_HS + 2 * 64 * HSTR, SSD_Y = SSD_VEC + 1024, YSTR = 272, SSD_Y2 = SSD_Y + 64 * YSTR, SSD_END = SSD_Y2 + 64 * YSTR;
static_assert(ATT_END <= RING_BYTES && SSD_END <= RING_BYTES, "phase scratch fits the ring region");

DI float bf2f(bf16 v) { return __uint_as_float(((unsigned)v) << 16); }
DI unsigned pk2(float lo, float hi) { return pg8::cvt_pk_bf16(lo, hi); }
DI bf16 f2bf(float f) { return (bf16)(pk2(f, 0.f) & 0xffffu); }
DI float wave_sum(float v) {
#pragma unroll
    for (int o = 1; o < 64; o <<= 1) v += __shfl_xor(v, o);
    return v;
}
DI f32x16 mfma32(bf16x8 a, bf16x8 b, f32x16 c) { return __builtin_amdgcn_mfma_f32_32x32x16_bf16(a, b, c, 0, 0, 0); }
DI int crow(int i, int hh) { return (i & 3) + 8 * (i >> 2) + 4 * hh; }
DI s16x4 tr_read(LAS unsigned char* p) { return __builtin_bit_cast(s16x4, __builtin_amdgcn_ds_read_tr16_b64_v4i16((LAS v4i16_t*)p)); }
DI bf16x8 trfrag(LAS unsigned char* tile, int stride, int k0, int c0, int lane) {
    const int i16 = lane & 15, qq = i16 >> 2, p = i16 & 3, g2 = (lane >> 4) & 1, hh = lane >> 5;
    LAS unsigned char* a = tile + (k0 + 8 * hh + qq) * stride + (c0 + 16 * g2 + 4 * p) * 2;
    const s16x4 lo = tr_read(a), hi = tr_read(a + 4 * stride);
    return __builtin_shufflevector(lo, hi, 0, 1, 2, 3, 4, 5, 6, 7);
}
DI void unpack8(u32x4 v, float (&f)[8]) {
#pragma unroll
    for (int i = 0; i < 4; ++i) { f[2 * i] = __uint_as_float(v[i] << 16); f[2 * i + 1] = __uint_as_float(v[i] & 0xffff0000u); }
}
DI u32x4 pack8(const float (&f)[8]) { u32x4 o; o.x = pk2(f[0], f[1]); o.y = pk2(f[2], f[3]); o.z = pk2(f[4], f[5]); o.w = pk2(f[6], f[7]); return o; }

#define XB_TMO      128
#define XB_XCNT(j)  (256  + 64 * (j))
#define XB_XSUB(j)  (1280 + 64 * (j))
#define XB_XGEN(j)  (2304 + 64 * (j))
#define XB_TOP      3328
#define XB_TOPGEN   3392
#define XCD_BAR_WORDS 3456
#define XB_SPIN_CAP (1u << 20)
DI unsigned xb_ld(unsigned* p)              { return __hip_atomic_load(p, __ATOMIC_RELAXED, __HIP_MEMORY_SCOPE_AGENT); }
DI unsigned xb_add(unsigned* p, unsigned v) { return __hip_atomic_fetch_add(p, v, __ATOMIC_RELAXED, __HIP_MEMORY_SCOPE_AGENT); }
DI unsigned xb_xcc_id() { return (unsigned)__builtin_amdgcn_s_getreg((3 << 11) | 20) & 0xFu; }
#define XB_SPIN(cond, bar) do { unsigned _sp = 0; while (cond) { __builtin_amdgcn_s_sleep(1); \
    if ((++_sp & 255u) == 0u) { if (xb_ld(&(bar)[XB_TMO])) break; if (_sp > XB_SPIN_CAP) { atomicAdd(&(bar)[XB_TMO], 1u); break; } } } } while (0)
struct XcdBarrier { unsigned* bar; unsigned x; volatile LAS unsigned* st; };
DI XcdBarrier xcd_barrier_post(unsigned* bar, volatile LAS unsigned* st) {
    XcdBarrier b; b.bar = bar; b.x = xb_xcc_id(); b.st = st;
    if (threadIdx.x == 0) (void)xb_add(&bar[XB_XCNT(b.x)], 1u);
    return b;
}
DI void xcd_barrier_complete(unsigned* bar, unsigned x, unsigned& nloc, unsigned& nx) {
    const unsigned G = gridDim.x * gridDim.y * gridDim.z;
    unsigned sum, cnt, mine, sp = 0u;
    for (;;) {
        sum = 0u; cnt = 0u; mine = 0u;
#pragma unroll
        for (unsigned j = 0; j < 16; ++j) { const unsigned c = xb_ld(&bar[XB_XCNT(j)]); sum += c; cnt += (c > 0u) ? 1u : 0u; mine = (j == x) ? c : mine; }
        if (sum == G) break;
        __builtin_amdgcn_s_sleep(1);
        if ((++sp & 255u) == 0u) { if (xb_ld(&bar[XB_TMO])) break; if (sp > XB_SPIN_CAP) { atomicAdd(&bar[XB_TMO], 1u); break; } }
    }
    nloc = mine > 0u ? mine : 1u; nx = cnt > 0u ? cnt : 1u;
}
DI void xcd_barrier(const XcdBarrier& b) {
    asm volatile("s_waitcnt vmcnt(0)" ::: "memory");
    __syncthreads();
    if (threadIdx.x == 0) {
        unsigned* bar = b.bar;
        __builtin_amdgcn_s_waitcnt(0);
        unsigned nloc = b.st[0], nx = b.st[1];
        if (nloc == 0u) { xcd_barrier_complete(bar, b.x, nloc, nx); b.st[0] = nloc; b.st[1] = nx; }
        const unsigned old = xb_add(&bar[XB_XSUB(b.x)], 1u);
        const unsigned gen = old / nloc;
        if (old + 1u == (gen + 1u) * nloc) {
            __builtin_amdgcn_fence(__ATOMIC_RELEASE, "agent");
            asm volatile("s_waitcnt vmcnt(0)" ::: "memory");
            const unsigned og = xb_add(&bar[XB_TOP], 1u);
            const unsigned tg = og / nx;
            if (og + 1u == (tg + 1u) * nx) xb_add(&bar[XB_TOPGEN], 1u);
            else XB_SPIN(xb_ld(&bar[XB_TOPGEN]) == tg, bar);
            __builtin_amdgcn_fence(__ATOMIC_ACQUIRE, "agent");
            xb_add(&bar[XB_XGEN(b.x)], 1u);
            asm volatile("s_waitcnt vmcnt(0)" ::: "memory");
        } else {
            XB_SPIN(xb_ld(&bar[XB_XGEN(b.x)]) == gen, bar);
            __builtin_amdgcn_fence(__ATOMIC_ACQUIRE, "agent");
            asm volatile("s_waitcnt vmcnt(0)" ::: "memory");
        }
    }
    __syncthreads();
}

struct Args { const float* in[23]; float* out; unsigned char* ws; int ph_lo, ph_hi; };
static_assert(sizeof(Args) == 23 * 8 + 8 + 8 + 8, "Args has no padding");
struct Ctx {
    LAS unsigned char* lds;
    unsigned* ctl;
    int tid, lane, wave, G, bid;
    float* out;
    unsigned char* ws;
};
DI bf16* ws_bf(const Ctx& C, size_t off) { return (bf16*)(C.ws + off); }
DI float* ws_f(const Ctx& C, size_t off) { return (float*)(C.ws + off); }
DI bf16* w_in_t(const Ctx& C, int l)  { return (bf16*)(C.ws + WS_W + (size_t)l * W_LAYER_B); }
DI bf16* w_out_t(const Ctx& C, int l) { return (bf16*)(C.ws + WS_W + (size_t)l * W_LAYER_B + W_IN_B); }
DI bf16* w_up_t(const Ctx& C, int l)  { return (bf16*)(C.ws + WS_W + (size_t)l * W_LAYER_B + W_IN_B + W_OUT_B); }
DI bf16* w_dn_t(const Ctx& C, int l)  { return (bf16*)(C.ws + WS_W + (size_t)l * W_LAYER_B + W_IN_B + W_OUT_B + W_UP_B); }

DI int q_prefetch(const Ctx& C, unsigned* head) { int v = 0; if (C.tid == 0) v = (int)__hip_atomic_fetch_add(head, 1u, __ATOMIC_RELAXED, __HIP_MEMORY_SCOPE_AGENT); return v; }
DI int q_publish(const Ctx& C, int v) {
    volatile LAS int* slot = (volatile LAS int*)(C.lds + LDSCTL_OFF + 64);
    __syncthreads();
    if (C.tid == 0) *slot = v;
    __syncthreads();
    return *slot;
}
DI int q_next(const Ctx& C, unsigned* head) {
    volatile LAS int* slot = (volatile LAS int*)(C.lds + LDSCTL_OFF + 64);
    __syncthreads();
    if (C.tid == 0) *slot = (int)__hip_atomic_fetch_add(head, 1u, __ATOMIC_RELAXED, __HIP_MEMORY_SCOPE_AGENT);
    __syncthreads();
    return *slot;
}

DI void wait_flags(const Ctx& C, unsigned* flg, int p0, int n) {
    if (C.tid == 0) { for (int p = p0; p < p0 + n; ++p) XB_SPIN(xb_ld(&flg[64 * p]) < 3u, C.ctl + CW_BAR); __builtin_amdgcn_fence(__ATOMIC_ACQUIRE, "agent"); }
    __syncthreads();
}
DI void p0_transpose_item(const float* W, int K, int N, bf16* WT, LAS float* scr, int item, int lane, const float* kscale = nullptr) {
    const int nblk = N / 32, kb = item / nblk, nb = item % nblk, k0 = 64 * kb, n0 = 32 * nb;
    float tv[32];
#pragma unroll
    for (int i = 0; i < 32; ++i) { const int kk = 2 * i + (lane >> 5); tv[i] = W[(size_t)(k0 + kk) * N + n0 + (lane & 31)]; }
#pragma unroll
    for (int i = 0; i < 32; ++i) { const int kk = 2 * i + (lane >> 5); const float sc = kscale ? kscale[k0 + kk] : 1.0f; scr[kk * 33 + (lane & 31)] = tv[i] * sc; }
    asm volatile("s_waitcnt lgkmcnt(0)" ::: "memory");
    const int c = lane & 7;
#pragma unroll
    for (int j = 0; j < 4; ++j) { const int n = (lane >> 3) + 8 * j; const LAS float* s = scr + (8 * c) * 33 + n;
        u32x4 o; o.x = pk2(s[0 * 33], s[1 * 33]); o.y = pk2(s[2 * 33], s[3 * 33]); o.z = pk2(s[4 * 33], s[5 * 33]); o.w = pk2(s[6 * 33], s[7 * 33]);
        *(u32x4*)(WT + (size_t)(n0 + n) * K + k0 + 8 * c) = o; }
    asm volatile("s_waitcnt lgkmcnt(0)" ::: "memory");
}
DI void row_ssq_slots(float ss, float* slots, int lane) { if (lane < 32) slots[lane] = lane == 0 ? ss : 0.f; }
DI void p0_row(const float* src, bf16* xrow, float* slots, int lane) {
    float ss = 0.f;
#pragma unroll
    for (int j = 0; j < 4; ++j) { const f32x4 a = ((const f32x4*)src)[2 * (lane + 64 * j)], b = ((const f32x4*)src)[2 * (lane + 64 * j) + 1];
        ss += (a.x * a.x + a.y * a.y) + (a.z * a.z + a.w * a.w) + (b.x * b.x + b.y * b.y) + (b.z * b.z + b.w * b.w);
        u32x4 o; o.x = pk2(a.x, a.y); o.y = pk2(a.z, a.w); o.z = pk2(b.x, b.y); o.w = pk2(b.z, b.w); ((u32x4*)xrow)[lane + 64 * j] = o; }
    row_ssq_slots(wave_sum(ss), slots, lane);
}
DI void res_row(bf16* xrow, const float* part, size_t pstride, int mode, float* slots, const float* w, float* outf, int lane) {
    float v[4][8]; float ss = 0.f;
#pragma unroll
    for (int j = 0; j < 4; ++j) { unpack8(((const u32x4*)xrow)[lane + 64 * j], v[j]);
        if (part) {
#pragma unroll
            for (int k = 0; k < 4; ++k) { const float* pp = part + k * pstride + 8 * (lane + 64 * j); const f32x4 a = *(const f32x4*)pp, b = *(const f32x4*)(pp + 4);
                v[j][0] += a.x; v[j][1] += a.y; v[j][2] += a.z; v[j][3] += a.w; v[j][4] += b.x; v[j][5] += b.y; v[j][6] += b.z; v[j][7] += b.w; } }
#pragma unroll
        for (int k = 0; k < 8; ++k) ss += v[j][k] * v[j][k]; }
    ss = wave_sum(ss);
    if (mode == 0) {
#pragma unroll
        for (int j = 0; j < 4; ++j) ((u32x4*)xrow)[lane + 64 * j] = pack8(v[j]);
        row_ssq_slots(ss, slots, lane);
    } else {
        const float rs = 1.0f / sqrtf(ss * (1.0f / DM) + EPS);
#pragma unroll
        for (int j = 0; j < 4; ++j) { const float* wp = w + 8 * (lane + 64 * j); const f32x4 w0 = *(const f32x4*)wp, w1 = *(const f32x4*)(wp + 4); float* op = outf + 8 * (lane + 64 * j);
            *(f32x4*)op = (f32x4){v[j][0] * rs * w0.x, v[j][1] * rs * w0.y, v[j][2] * rs * w0.z, v[j][3] * rs * w0.w};
            *(f32x4*)(op + 4) = (f32x4){v[j][4] * rs * w1.x, v[j][5] * rs * w1.y, v[j][6] * rs * w1.z, v[j][7] * rs * w1.w}; }
    }
}
DI void sincos_tab(float ang, float& c, float& s) {
    const double a = (double)ang; const double kq = rint(a * 0.63661977236758134308); const double x = a - kq * 1.57079632679489661923; const double x2 = x * x;
    const double sn = x * (1.0 + x2 * (-1.0 / 6 + x2 * (1.0 / 120 + x2 * (-1.0 / 5040 + x2 * (1.0 / 362880 + x2 * (-1.0 / 39916800 + x2 * (1.0 / 6227020800.0)))))));
    const double cn = 1.0 + x2 * (-0.5 + x2 * (1.0 / 24 + x2 * (-1.0 / 720 + x2 * (1.0 / 40320 + x2 * (-1.0 / 3628800 + x2 * (1.0 / 479001600 + x2 * (-1.0 / 87178291200.0)))))));
    const int q = ((int)kq) & 3;
    const double cc = (q == 0) ? cn : (q == 1) ? -sn : (q == 2) ? -cn : sn;
    const double sc = (q == 0) ? sn : (q == 1) ? cn : (q == 2) ? -sn : -cn;
    c = (float)cc; s = (float)sc;
}
constexpr int I_IN = (DM / 64) * (INC / 32), I_OUT = (DM / 64) * (DM / 32), I_UP = (DM / 64) * (DFF / 32), I_DN = (DFF / 64) * (DM / 32), I_L = I_IN + I_OUT + I_UP + I_DN;
static_assert(I_L % 8 == 0, "items per layer in groups of 8 waves");
DI void wconv_item(const Ctx& C, const Args& A, int l, int r, LAS float* scr) {
    if (r < I_IN) { p0_transpose_item(A.in[10] + (size_t)l * DM * INC, DM, INC, w_in_t(C, l), scr, r, C.lane, A.in[9] + (size_t)l * DM); return; } r -= I_IN;
    if (r < I_OUT) { p0_transpose_item(A.in[11] + (size_t)l * DM * DM, DM, DM, w_out_t(C, l), scr, r, C.lane); return; } r -= I_OUT;
    if (r < I_UP) { p0_transpose_item(A.in[20] + (size_t)l * DM * DFF, DM, DFF, w_up_t(C, l), scr, r, C.lane, A.in[19] + (size_t)l * DM); return; } r -= I_UP;
    p0_transpose_item(A.in[21] + (size_t)l * DFF * DM, DFF, DM, w_dn_t(C, l), scr, r, C.lane);
}
DI void wconv_some(const Ctx& C, const Args& A, int l, int max_entries) {
    unsigned* head = C.ctl + CW_Q + 64 * (40 + l);
    LAS float* scr = (LAS float*)(C.lds + C.wave * 16384);
    for (int n = 0; n < max_entries; ++n) { const int e = q_next(C, head); if (e >= I_L / 8) break; wconv_item(C, A, l, e * 8 + C.wave, scr); }
}
DI void p0_prologue(const Ctx& C, const Args& A) {
    LAS float* scr = (LAS float*)(C.lds + C.wave * 16384);
    const int gw = C.bid * NWAVES + C.wave, NGW = C.G * NWAVES;
    for (int it = gw; it < DEPTH * I_L; it += NGW) wconv_item(C, A, it / I_L, it % I_L, scr);
    { const int gt = C.bid * NTHR + C.tid, NGT = C.G * NTHR; constexpr int CH_L = (INP - INC) * DM / 8;
      for (int i = gt; i < DEPTH * CH_L; i += NGT) { const int l = i / CH_L, c = i % CH_L; ((u32x4*)(w_in_t(C, l) + (size_t)INC * DM))[c] = (u32x4){0u, 0u, 0u, 0u}; }
      float* ra = ws_f(C, WS_ROPE); float* ri = ra + 2048 * 16 * 2;
      for (int i = gt; i < 2048 * 24; i += NGT) { const int pos = i / 24, k = i % 24; const bool isa = k < 16; const int fi = isa ? k : k - 16;
          const double ex = isa ? (double)fi / 16.0 : (double)fi / 8.0; const float inv = (float)exp2(-ex * 18.931568569324174  );
          const float ang = (float)pos * inv; float c, s; sincos_tab(ang, c, s);
          float* dst = isa ? ra + (pos * 16 + fi) * 2 : ri + (pos * 8 + fi) * 2; dst[0] = c; dst[1] = s; } }
    { const int lane = C.lane; f32x4 nx[8]; int m = gw;
#define P0_SRC(m_) ((m_) < NTP ? A.in[0] + (size_t)(m_) * DM : A.in[1] + (size_t)((m_) - NTP) * DM)
      if (m < NTOK) { const float* src = P0_SRC(m);
#pragma unroll
          for (int j = 0; j < 4; ++j) { nx[2 * j] = ((const f32x4*)src)[2 * (lane + 64 * j)]; nx[2 * j + 1] = ((const f32x4*)src)[2 * (lane + 64 * j) + 1]; } }
      for (; m < NTOK; m += NGW) {
          f32x4 cur[8];
#pragma unroll
          for (int j = 0; j < 8; ++j) cur[j] = nx[j];
          const int mn = m + NGW;
          if (mn < NTOK) { const float* src = P0_SRC(mn);
#pragma unroll
              for (int j = 0; j < 4; ++j) { nx[2 * j] = ((const f32x4*)src)[2 * (lane + 64 * j)]; nx[2 * j + 1] = ((const f32x4*)src)[2 * (lane + 64 * j) + 1]; } }
          bf16* xrow = ws_bf(C, WS_X) + (size_t)m * DM; float ss = 0.f;
#pragma unroll
          for (int j = 0; j < 4; ++j) { const f32x4 a = cur[2 * j], b = cur[2 * j + 1];
              ss += (a.x * a.x + a.y * a.y) + (a.z * a.z + a.w * a.w) + (b.x * b.x + b.y * b.y) + (b.z * b.z + b.w * b.w);
              u32x4 o; o.x = pk2(a.x, a.y); o.y = pk2(a.z, a.w); o.z = pk2(b.x, b.y); o.w = pk2(b.z, b.w); ((u32x4*)xrow)[lane + 64 * j] = o; }
          row_ssq_slots(wave_sum(ss), ws_f(C, WS_SSQ1) + (size_t)m * 32, lane); }
#undef P0_SRC
    }
}

struct M0Row { unsigned ra1, ra2, ri1, ri2, rk1, rk2; u32x4 cak, cav, cik, cbk, cbv, xb[4]; f32x4 tA, tI; bf16 dt; };
DI void m0_decode(int r, bool& smp, int& b, int& t, int& pos) { smp = r >= NTP; if (!smp) { b = r >> 11; t = r & 2047; pos = t; } else { const int rr = r - NTP; b = rr >> 6; t = rr & 63; pos = PAST + t; } }
DI void m0_load(const Ctx& C, int r, int lane, M0Row& R) {
    const bf16* P = ws_bf(C, WS_PU) + (size_t)r * INP;
    bool smp; int b, t, pos; m0_decode(r, smp, b, t, pos);
    { const int h8 = lane >> 3, j = lane & 7; const bf16* p = P + (h8 < 4 ? C_AQ + h8 * 128 : C_AK + (h8 - 4) * 128) + 2 * j; R.ra1 = *(const unsigned*)p; R.ra2 = *(const unsigned*)(p + 16); }
    { const int h16 = lane >> 2, j = lane & 3; const bf16* p = P + C_IQ + h16 * 64 + 2 * j; R.ri1 = *(const unsigned*)p; R.ri2 = *(const unsigned*)(p + 8); }
    if (lane < 4) { const bf16* p = P + C_IK + 2 * lane; R.rk1 = *(const unsigned*)p; R.rk2 = *(const unsigned*)(p + 8); }
    if (lane < 48) R.cak = *(const u32x4*)(P + C_AK + (lane / 12) * 128 + 32 + (lane % 12) * 8);
    R.cav = *(const u32x4*)(P + C_AV + lane * 8);
    if (lane >= 8 && lane < 14) R.cik = *(const u32x4*)(P + C_IK + 16 + (lane - 8) * 8);
    if (smp || t >= SEQ - BWIN) { R.cbk = *(const u32x4*)(P + C_BK + lane * 8); R.cbv = *(const u32x4*)(P + C_BV + lane * 8); }
    if (lane < 16) R.dt = P[C_DT + lane];
#pragma unroll
    for (int it = 0; it < 4; ++it) R.xb[it] = *(const u32x4*)(P + C_XBC + (lane + 64 * it) * 8);
    R.tA = *(const f32x4*)(ws_f(C, WS_ROPE) + (size_t)pos * 32 + 4 * (lane & 7));
    R.tI = *(const f32x4*)(ws_f(C, WS_ROPE) + 2048 * 32 + (size_t)pos * 16 + 4 * (lane & 3));
}
DI void rope2(unsigned a, unsigned bq, f32x4 t, float (&y1)[2], float (&y2)[2]) {
    const float a0 = __uint_as_float(a << 16), a1 = __uint_as_float(a & 0xffff0000u), b0 = __uint_as_float(bq << 16), b1 = __uint_as_float(bq & 0xffff0000u);
    y1[0] = a0 * t.x - b0 * t.y; y2[0] = b0 * t.x + a0 * t.y; y1[1] = a1 * t.z - b1 * t.w; y2[1] = b1 * t.z + a1 * t.w;
}
DI void st8f(float* dst, u32x4 v) { float f[8]; unpack8(v, f); __builtin_nontemporal_store((f32x4){f[0], f[1], f[2], f[3]}, (f32x4*)dst); __builtin_nontemporal_store((f32x4){f[4], f[5], f[6], f[7]}, (f32x4*)dst + 1); }
DI void m0_window(const Ctx& C, const Args& A, int l, int r, int lane, u32x4 (&wnd)[3][4]) {
    bool smp; int b, t, pos; m0_decode(r, smp, b, t, pos);
#pragma unroll
    for (int k = 1; k <= 3; ++k) { const int tt = t - k;
#pragma unroll
        for (int it = 0; it < 4; ++it) { const int ch = (lane + 64 * it) * 8; u32x4 v = (u32x4){0u, 0u, 0u, 0u};
            if (tt >= 0) v = *(const u32x4*)(ws_bf(C, WS_PU) + (size_t)(r - k) * INP + C_XBC + ch);
            else if (smp) { const float* sp = A.in[8] + ((size_t)(l * DBAT + b) * 3 + (3 + tt)) * 2048 + ch; const f32x4 s0 = *(const f32x4*)sp, s1 = *(const f32x4*)(sp + 4);
                v.x = pk2(s0.x, s0.y); v.y = pk2(s0.z, s0.w); v.z = pk2(s1.x, s1.y); v.w = pk2(s1.z, s1.w); }
            wnd[3 - k][it] = v; } }
}
DI void m0_process(const Ctx& C, const Args& A, int l, int r, int lane, const M0Row& R, u32x4 (&wnd)[3][4], const LAS float* cwL, const LAS float* cbL) {
    bf16* P = ws_bf(C, WS_PU) + (size_t)r * INP;
    bool smp; int b, t, pos; m0_decode(r, smp, b, t, pos);
    float* out = C.out;
    float* o_ak = smp ? out + OFF_S_AK + ((size_t)(l * DBAT + b) * DSEQ + t) * 512 : out + OFF_P_AK + ((size_t)(l * NB + b) * SEQ + t) * 512;
    float* o_av = smp ? out + OFF_S_AV + ((size_t)(l * DBAT + b) * DSEQ + t) * 512 : out + OFF_P_AV + ((size_t)(l * NB + b) * SEQ + t) * 512;
    float* o_ki = smp ? out + OFF_S_KI + ((size_t)(l * DBAT + b) * DSEQ + t) * 64 : out + OFF_P_KI + ((size_t)(l * NB + b) * SEQ + t) * 64;
    float y1[2], y2[2];
    { const int h8 = lane >> 3, j = lane & 7; rope2(R.ra1, R.ra2, R.tA, y1, y2);
      bf16* p = P + (h8 < 4 ? C_AQ + h8 * 128 : C_AK + (h8 - 4) * 128) + 2 * j; *(unsigned*)p = pk2(y1[0], y1[1]); *(unsigned*)(p + 16) = pk2(y2[0], y2[1]);
      if (h8 >= 4) { float* o = o_ak + (h8 - 4) * 128 + 2 * j; *(f32x2_t_*)o = (f32x2_t_){y1[0], y1[1]}; *(f32x2_t_*)(o + 16) = (f32x2_t_){y2[0], y2[1]}; } }
    { const int h16 = lane >> 2, j = lane & 3; rope2(R.ri1, R.ri2, R.tI, y1, y2);
      bf16* p = P + C_IQ + h16 * 64 + 2 * j; *(unsigned*)p = pk2(y1[0], y1[1]); *(unsigned*)(p + 8) = pk2(y2[0], y2[1]); }
    if (lane < 4) { rope2(R.rk1, R.rk2, R.tI, y1, y2);
      bf16* p = P + C_IK + 2 * lane; *(unsigned*)p = pk2(y1[0], y1[1]); *(unsigned*)(p + 8) = pk2(y2[0], y2[1]);
      float* o = o_ki + 2 * lane; *(f32x2_t_*)o = (f32x2_t_){y1[0], y1[1]}; *(f32x2_t_*)(o + 8) = (f32x2_t_){y2[0], y2[1]}; }
    if (lane < 48) st8f(o_ak + (lane / 12) * 128 + 32 + (lane % 12) * 8, R.cak);
    st8f(o_av + lane * 8, R.cav);
    if (lane >= 8 && lane < 14) st8f(o_ki + 16 + (lane - 8) * 8, R.cik);
    if (smp || t >= SEQ - BWIN) {
        const size_t ro = smp ? ((size_t)(l * DBAT + b) * DSEQ + t) * 512 : ((size_t)(l * NB + b) * BWIN + (t - (SEQ - BWIN))) * 512;
        st8f(out + (smp ? OFF_S_BK : OFF_P_BK) + ro + lane * 8, R.cbk); st8f(out + (smp ? OFF_S_BV : OFF_P_BV) + ro + lane * 8, R.cbv);
    }
    if (lane < 16) { const float x = bf2f(R.dt) + A.in[15][l * 16 + lane]; ws_f(C, WS_DTS)[(size_t)r * 16 + lane] = x > 20.f ? x : log1pf(__expf(x)); }
    const int stt = smp ? DSEQ - 3 : SEQ - 3;
    float* o_conv = (t >= stt) ? (smp ? out + OFF_S_CONV + ((size_t)(l * DBAT + b) * 3 + (t - stt)) * 2048 : out + OFF_P_CONV + ((size_t)(l * NB + b) * 3 + (t - stt)) * 2048) : nullptr;
    bf16* xo = ws_bf(C, WS_XBC) + (size_t)r * 2048;
#pragma unroll
    for (int it = 0; it < 4; ++it) { const int ch = (lane + 64 * it) * 8;
        float acc[8], x[8];
        { const f32x4 b0 = *(const LAS f32x4*)(cbL + ch), b1 = *(const LAS f32x4*)(cbL + ch + 4); acc[0] = b0.x; acc[1] = b0.y; acc[2] = b0.z; acc[3] = b0.w; acc[4] = b1.x; acc[5] = b1.y; acc[6] = b1.z; acc[7] = b1.w; }
#pragma unroll
        for (int j = 0; j < 4; ++j) { unpack8(j < 3 ? wnd[j][it] : R.xb[it], x);
            const f32x4 w0 = *(const LAS f32x4*)(cwL + j * 2048 + ch), w1 = *(const LAS f32x4*)(cwL + j * 2048 + ch + 4);
            acc[0] += x[0] * w0.x; acc[1] += x[1] * w0.y; acc[2] += x[2] * w0.z; acc[3] += x[3] * w0.w; acc[4] += x[4] * w1.x; acc[5] += x[5] * w1.y; acc[6] += x[6] * w1.z; acc[7] += x[7] * w1.w; }
        if (o_conv) { ((f32x4*)(o_conv + ch))[0] = (f32x4){x[0], x[1], x[2], x[3]}; ((f32x4*)(o_conv + ch))[1] = (f32x4){x[4], x[5], x[6], x[7]}; }
#pragma unroll
        for (int k = 0; k < 8; ++k) acc[k] = acc[k] / (1.f + __expf(-acc[k]));
        *(u32x4*)(xo + ch) = pack8(acc);
        wnd[0][it] = wnd[1][it]; wnd[1][it] = wnd[2][it]; wnd[2][it] = R.xb[it];
        asm volatile("" ::: "memory");
    }
}
DI void cvt_f4(const float* src, bf16* dst, size_t n4, size_t gt, size_t ngt) {
    size_t i = gt;
    for (; i + 3 * ngt < n4; i += 4 * ngt) { f32x4 v[4];
#pragma unroll
        for (int k = 0; k < 4; ++k) v[k] = ((const f32x4*)src)[i + k * ngt];
#pragma unroll
        for (int k = 0; k < 4; ++k) { u32x2 o; o.x = pk2(v[k].x, v[k].y); o.y = pk2(v[k].z, v[k].w); ((u32x2*)dst)[i + k * ngt] = o; } }
    for (; i < n4; i += ngt) { const f32x4 v = ((const f32x4*)src)[i]; u32x2 o; o.x = pk2(v.x, v.y); o.y = pk2(v.z, v.w); ((u32x2*)dst)[i] = o; }
}
constexpr int CV_CH = 4096;
constexpr int CV_N0 = DBAT * PAST * 512 / 4 / CV_CH, CV_N2 = DBAT * PAST * 64 / 4 / CV_CH, CV_N3 = DBAT * BWIN * 512 / 4 / CV_CH, CV_TOTAL = 2 * CV_N0 + CV_N2 + 2 * CV_N3;
DI void cvt_chunk(const float* src, bf16* dst, int chunk, int tid) {
    const size_t base = (size_t)chunk * CV_CH; f32x4 v[8];
#pragma unroll
    for (int k = 0; k < 8; ++k) v[k] = ((const f32x4*)src)[base + tid + 512 * k];
#pragma unroll
    for (int k = 0; k < 8; ++k) { u32x2 o; o.x = pk2(v[k].x, v[k].y); o.y = pk2(v[k].z, v[k].w); ((u32x2*)dst)[base + tid + 512 * k] = o; }
}
DI void cache_convert(const Ctx& C, const Args& A, int l) {
    unsigned* head = C.ctl + CW_Q + 64 * (32 + l);
    for (;;) { int c = q_next(C, head); if (c >= CV_TOTAL) break;
        if (c < CV_N0) { cvt_chunk(A.in[2] + (size_t)l * DBAT * PAST * 512, ws_bf(C, WS_CAK), c, C.tid); continue; } c -= CV_N0;
        if (c < CV_N0) { cvt_chunk(A.in[3] + (size_t)l * DBAT * PAST * 512, ws_bf(C, WS_CAV), c, C.tid); continue; } c -= CV_N0;
        if (c < CV_N2) { cvt_chunk(A.in[4] + (size_t)l * DBAT * PAST * 64, ws_bf(C, WS_CKI), c, C.tid); continue; } c -= CV_N2;
        if (c < CV_N3) { cvt_chunk(A.in[5] + (size_t)l * DBAT * BWIN * 512, ws_bf(C, WS_CBK), c, C.tid); continue; } c -= CV_N3;
        cvt_chunk(A.in[6] + (size_t)l * DBAT * BWIN * 512, ws_bf(C, WS_CBV), c, C.tid); }
}
DI void m0_phase(const Ctx& C, const Args& A, int l) {
    LAS float* cwL = (LAS float*)C.lds; LAS float* cbL = cwL + 4 * 2048;
    { const float* cw = A.in[13] + (size_t)l * 4 * 2048; const float* cb = A.in[14] + (size_t)l * 2048;
      for (int i = C.tid; i < 2048; i += NTHR) ((LAS f32x4*)cwL)[i] = ((const f32x4*)cw)[i];
      for (int i = C.tid; i < 512; i += NTHR) ((LAS f32x4*)cbL)[i] = ((const f32x4*)cb)[i]; }
    __syncthreads();
    const int gw = C.bid * NWAVES + C.wave, NGW = C.G * NWAVES, per = (NTOK + NGW - 1) / NGW;
    const int r0 = gw * per, r1 = (r0 + per < NTOK) ? r0 + per : NTOK;
    if (r0 < r1) {
        u32x4 wnd[3][4]; M0Row cur, nxt;
        m0_load(C, r0, C.lane, cur); m0_window(C, A, l, r0, C.lane, wnd);
#pragma unroll 1
        for (int r = r0; r < r1; ++r) {
            if (r + 1 < r1) m0_load(C, r + 1, C.lane, nxt);
            if (r != r0) { bool smp; int b, t, pos; m0_decode(r, smp, b, t, pos); if (t == 0) m0_window(C, A, l, r, C.lane, wnd); }
            m0_process(C, A, l, r, C.lane, cur, wnd, cwL, cbL);
            cur = nxt;
        }
    }
}

struct KVSrc { const bf16* k0; const bf16* v0; int s0; int n0; const bf16* k1; const bf16* v1; int s1; };
template <int MODE>
DI void attn_unit(const Ctx& C, const bf16* Qp, int qstride, const KVSrc& S, int tile_lo, int tile_hi, bf16* Op, int ostride) {
    int tid = C.tid, lane = C.lane; asm volatile("" : "+v"(tid), "+v"(lane));
    const int w = C.wave, r = lane & 31, hh = lane >> 5;
    const int head = w >> 1, q = (w & 1) * 32 + r;
    LAS unsigned char* Ks = C.lds + ATT_K; LAS unsigned char* Vs = C.lds + ATT_V;
    bf16x8 qf[8];
    { const bf16* qrow = Qp + (size_t)q * qstride + head * 128 + 8 * hh;
#pragma unroll
      for (int ks = 0; ks < 8; ++ks) qf[ks] = *(const bf16x8*)(qrow + 16 * ks); }
    f32x16 o[4];
#pragma unroll
    for (int d = 0; d < 4; ++d)
#pragma unroll
        for (int i = 0; i < 16; ++i) o[d][i] = 0.f;
    float m = -1e30f, lsum = 0.f;
    constexpr float SC2 = 0.08838834764831845f * 1.4426950408889634f;
    constexpr float L2E = 1.4426950408889634f;
    u32x4 kr[4], vr[4];
#define ATT_LOAD(tile_) do { const int k0_ = (tile_) * 32; const bool first_ = k0_ < S.n0; const int st_ = first_ ? S.s0 : S.s1; \
        const bf16* kb_ = (first_ ? S.k0 + (ptrdiff_t)k0_ * S.s0 : S.k1 + (ptrdiff_t)(k0_ - S.n0) * S.s1) + (ptrdiff_t)(tid >> 6) * st_ + (tid & 63) * 8; \
        const bf16* vb_ = (first_ ? S.v0 + (ptrdiff_t)k0_ * S.s0 : S.v1 + (ptrdiff_t)(k0_ - S.n0) * S.s1) + (ptrdiff_t)(tid >> 6) * st_ + (tid & 63) * 8; \
        _Pragma("unroll") for (int i_ = 0; i_ < 4; ++i_) { kr[i_] = *(const u32x4*)(kb_ + (ptrdiff_t)(8 * i_) * st_); vr[i_] = *(const u32x4*)(vb_ + (ptrdiff_t)(8 * i_) * st_); } } while (0)
#define ATT_STORE(buf_) do { _Pragma("unroll") for (int i_ = 0; i_ < 4; ++i_) { const int ci_ = tid + 512 * i_, row_ = ci_ >> 6, ch_ = ci_ & 63; \
        *(LAS u32x4*)(Ks + (buf_) * (32 * KSTR) + row_ * KSTR + ch_ * 16) = kr[i_]; *(LAS u32x4*)(Vs + (buf_) * (32 * VSTR) + row_ * VSTR + ch_ * 16) = vr[i_]; } } while (0)
    ATT_LOAD(tile_lo);
    __syncthreads();
    ATT_STORE(0);
    if (tile_lo + 1 < tile_hi) ATT_LOAD(tile_lo + 1);
    __syncthreads();
    const int i16 = lane & 15;
    LAS unsigned char* vbase = Vs + (4 * hh + (i16 >> 2)) * VSTR + (head * 128 + 16 * ((lane >> 4) & 1) + 4 * (i16 & 3)) * 2;
    LAS unsigned char* kbase = Ks + r * KSTR + head * 256 + hh * 16;
    const LAS float* btab = (const LAS float*)(C.lds + ATT_SEL) + head * 257;
    const LAS unsigned* sel = (const LAS unsigned*)(C.lds + ATT_SEL) + q * 64;
#pragma unroll 1
    for (int tile = tile_lo; tile < tile_hi; ++tile) {
        const int cur = (tile - tile_lo) & 1;
        if (tile + 1 < tile_hi) { ATT_STORE(cur ^ 1); if (tile + 2 < tile_hi) ATT_LOAD(tile + 2); }
        f32x16 s;
        if (MODE == 0) {
            const unsigned nwd = ~(sel[tile] >> (4 * hh));
#pragma unroll
            for (int i = 0; i < 16; ++i) { int mb; asm("v_bfe_i32 %0, %1, %2, 1" : "=v"(mb) : "v"(nwd), "n"((i & 3) + 8 * (i >> 2))); s[i] = __int_as_float(mb & (int)0xFF800000); }
        } else {
            if (tile <= 11) { const float bb = btab[256] * (L2E / SC2);
#pragma unroll
                for (int i = 0; i < 16; ++i) s[i] = bb;
            } else {
#pragma unroll
                for (int i = 0; i < 16; ++i) { int rel = BWIN + q - (tile * 32 + crow(i, hh)); rel = rel > 128 ? 128 : rel; s[i] = btab[rel + 128] * (L2E / SC2); }
            }
        }
        { bf16x8 kf[8]; LAS unsigned char* kb = kbase + cur * (32 * KSTR);
#pragma unroll
          for (int ks = 0; ks < 8; ++ks) kf[ks] = *(const LAS bf16x8*)(kb + ks * 32);
#pragma unroll
          for (int ks = 0; ks < 8; ++ks) s = mfma32(kf[ks], qf[ks], s); }
        float mx = s[0];
#pragma unroll
        for (int i = 1; i < 16; ++i) mx = fmaxf(mx, s[i]);
        mx *= SC2;
        if (__any(mx > m + 8.0f)) {
            const auto rr = __builtin_amdgcn_permlane32_swap(__float_as_uint(mx), __float_as_uint(mx), false, false);
            const float mxs = fmaxf(__uint_as_float(rr[0]), __uint_as_float(rr[1]));
            const float mn = (mxs > m + 8.0f) ? mxs : m, alpha = __builtin_amdgcn_exp2f(m - mn);
            lsum *= alpha; m = mn;
#pragma unroll
            for (int d = 0; d < 4; ++d)
#pragma unroll
                for (int i = 0; i < 16; ++i) o[d][i] *= alpha;
        }
#pragma unroll
        for (int i = 0; i < 16; ++i) { s[i] = __builtin_amdgcn_exp2f(__builtin_fmaf(s[i], SC2, -m)); lsum += s[i]; }
        bf16x8 pf[2];
#pragma unroll
        for (int s2 = 0; s2 < 2; ++s2) { u32x4 pk; pk.x = pk2(s[8 * s2], s[8 * s2 + 1]); pk.y = pk2(s[8 * s2 + 2], s[8 * s2 + 3]); pk.z = pk2(s[8 * s2 + 4], s[8 * s2 + 5]); pk.w = pk2(s[8 * s2 + 6], s[8 * s2 + 7]);
            pf[s2] = __builtin_bit_cast(bf16x8, pk); }
        LAS unsigned char* vb = vbase + cur * (32 * VSTR);
#pragma unroll
        for (int dh = 0; dh < 2; ++dh) {
            s16x4 lo[2][2], hi[2][2];
#pragma unroll
            for (int d2 = 0; d2 < 2; ++d2)
#pragma unroll
                for (int s2 = 0; s2 < 2; ++s2) { lo[d2][s2] = tr_read(vb + (16 * s2) * VSTR + (2 * dh + d2) * 64); hi[d2][s2] = tr_read(vb + (16 * s2 + 8) * VSTR + (2 * dh + d2) * 64); }
#pragma unroll
            for (int d2 = 0; d2 < 2; ++d2)
#pragma unroll
                for (int s2 = 0; s2 < 2; ++s2) { const bf16x8 vt = __builtin_shufflevector(lo[d2][s2], hi[d2][s2], 0, 1, 2, 3, 4, 5, 6, 7); o[2 * dh + d2] = mfma32(vt, pf[s2], o[2 * dh + d2]); }
        }
        __syncthreads();
    }
#undef ATT_LOAD
#undef ATT_STORE
    { const auto rr = __builtin_amdgcn_permlane32_swap(__float_as_uint(lsum), __float_as_uint(lsum), false, false); lsum = __uint_as_float(rr[0]) + __uint_as_float(rr[1]); }
    const float inv = 1.0f / lsum;
    bf16* orow = Op + (size_t)q * ostride + head * 128 + 4 * hh;
#pragma unroll
    for (int d = 0; d < 4; ++d)
#pragma unroll
        for (int g = 0; g < 4; ++g) { u32x2 p; p.x = pk2(o[d][4 * g] * inv, o[d][4 * g + 1] * inv); p.y = pk2(o[d][4 * g + 2] * inv, o[d][4 * g + 3] * inv);
            *(u32x2*)(orow + 32 * d + 8 * g) = p; }
}

DI float relu_i(float x) { const int v = __float_as_int(x); return __int_as_float(v > 0 ? v : 0); }
DI unsigned fkey(float f) { const int u = __float_as_int(f); return (unsigned)(u ^ ((u >> 31) | (int)0x80000000)); }
DI void bt32(unsigned (&a)[32]) {
#pragma unroll
    for (int s = 0; s < 5; ++s) { const int j = 16 >> s;
        const unsigned m = s == 0 ? 0x0000FFFFu : s == 1 ? 0x00FF00FFu : s == 2 ? 0x0F0F0F0Fu : s == 3 ? 0x33333333u : 0x55555555u;
#pragma unroll
        for (int k = 0; k < 32; ++k) if ((k & j) == 0) {
            const unsigned x = a[k], y = a[k + j];
            a[k] = (x & m) | ((y << j) & ~m);
            a[k + j] = ((x >> j) & m) | (y & ~m); } }
}
template <int NR>
DI void topk_pair(const float* SCq  , LAS unsigned* SELa  , int NT, int r, int hh, int lane) {
    constexpr int NBLK = NR / 32;
    unsigned P[NBLK][32];
#pragma unroll
    for (int b = 0; b < NBLK; ++b)
#pragma unroll
        for (int i = 0; i < 32; ++i) { const int idx = b * 32 + i; const float f = SCq[idx * 32 + r]; P[b][i] = (idx < NT) ? fkey(f) : 0u; }
#pragma unroll
    for (int b = 0; b < NBLK; ++b) bt32(P[b]);
    unsigned L[NBLK], G[NBLK], cg = 0u; bool done = false;
#pragma unroll
    for (int b = 0; b < NBLK; ++b) { L[b] = 0xffffffffu; G[b] = 0u; }
#pragma unroll
    for (int bit = 31; bit >= 8; --bit) {
        if (__all(done)) break;
        unsigned X[NBLK], c = cg;
#pragma unroll
        for (int b = 0; b < NBLK; ++b) { X[b] = L[b] & P[b][bit]; c += __popc(X[b]); }
        int x = (int)c;
        x += __builtin_amdgcn_update_dpp(0, x, 0x111, 0xf, 0xf, true);
        x += __builtin_amdgcn_update_dpp(0, x, 0x112, 0xf, 0xf, true);
        x += __builtin_amdgcn_update_dpp(0, x, 0x114, 0xf, 0xf, true);
        x += __builtin_amdgcn_update_dpp(0, x, 0x118, 0xf, 0xf, true);
        x += __builtin_amdgcn_update_dpp(0, x, 0x142, 0xa, 0xf, true);
        const unsigned t0 = (unsigned)__builtin_amdgcn_readlane(x, 31), t1 = (unsigned)__builtin_amdgcn_readlane(x, 63);
        const unsigned tot = hh ? t1 : t0;
        const bool ge = tot >= 256u;
        if (!done) {
#pragma unroll
            for (int b = 0; b < NBLK; ++b) { const unsigned l0 = L[b], g0 = G[b]; L[b] = ge ? X[b] : (l0 ^ X[b]); G[b] = ge ? g0 : (g0 | X[b]); }
            cg = ge ? cg : c; }
        if (tot == 256u) done = true;
    }
#pragma unroll
    for (int i = 0; i < NR; ++i) { const unsigned S = G[i >> 5] | L[i >> 5]; unsigned long long mk = __ballot((S >> (i & 31)) & 1u); if (i >= NT) mk = 0ull;
        if (lane == 0) { SELa[i] = (unsigned)mk; SELa[64 + i] = (unsigned)(mk >> 32); } }
}
DI void dsa_unit(const Ctx& C, int l, int u) {
    int lane = C.lane; asm volatile("" : "+v"(lane));
    const int w = C.wave, r = lane & 31, hh = lane >> 5;
    const bf16* PROJ = ws_bf(C, WS_PU);
    int qrow0, NT, limit; KVSrc S; const bf16* ik0; const bf16* ik1; int iks0, ikn0;
    const bool smp = (u >= 120 && u < 152); const int up = u < 120 ? u : u - 32;
    if (!smp) { const int c = 31 - (up >> 3), b = up & 7; qrow0 = b * SEQ + c * 64; NT = 2 * (c + 1); limit = 64 * (c + 1);
        const bf16* base = PROJ + (size_t)(b * SEQ) * INP;
        S.k0 = base + C_AK; S.v0 = base + C_AV; S.s0 = INP; S.n0 = limit; S.k1 = S.k0; S.v1 = S.v0; S.s1 = INP;
        ik0 = base + C_IK; iks0 = INP; ikn0 = limit; ik1 = ik0;
    } else { const int b = u - 120; qrow0 = NTP + b * DSEQ; NT = (PAST + DSEQ) / 32; limit = PAST + DSEQ;
        const bf16* nb = PROJ + (size_t)qrow0 * INP;
        S.k0 = ws_bf(C, WS_CAK) + (size_t)b * PAST * 512; S.v0 = ws_bf(C, WS_CAV) + (size_t)b * PAST * 512; S.s0 = 512; S.n0 = PAST; S.k1 = nb + C_AK; S.v1 = nb + C_AV; S.s1 = INP;
        ik0 = ws_bf(C, WS_CKI) + (size_t)b * PAST * 64; iks0 = 64; ikn0 = PAST; ik1 = nb + C_IK;
    }
    float* SC = ws_f(C, WS_SC) + (size_t)C.bid * 64 * 2048;
    LAS unsigned* SEL = (LAS unsigned*)(C.lds + ATT_SEL);
    LAS unsigned char* IKS = C.lds + ATT_K; constexpr int IDX_CH = 256, IDX_STR = 144;
    int tidx = C.tid; asm volatile("" : "+v"(tidx));
    if (limit > 256) {
#ifndef REP_IDX
#define REP_IDX 1
#endif
#ifndef REP_TOPK
#define REP_TOPK 1
#endif
#ifndef REP_ATT
#define REP_ATT 1
#endif
#pragma unroll 1
    for (int pass = 0; pass < 2 * REP_IDX; ++pass) {
        bf16x8 af[2][4]; f32x2_t_ wt2[2][8];
#pragma unroll
        for (int np = 0; np < 2; ++np) { const int pp = (pass & 1) * 2 + np;
            const bf16* ap = PROJ + (size_t)(qrow0 + 8 * w + 2 * pp + (r >> 4)) * INP + C_IQ + (r & 15) * 64 + 8 * hh;
#pragma unroll
            for (int ks = 0; ks < 4; ++ks) af[np][ks] = *(const bf16x8*)(ap + 16 * ks);
#pragma unroll
            for (int i = 0; i < 16; ++i) { const int qi = 8 * w + 2 * pp + (i >> 3), hd = (i & 3) + 8 * ((i >> 2) & 1) + 4 * hh;
                wt2[np][i >> 1][i & 1] = bf2f(PROJ[(size_t)(qrow0 + qi) * INP + C_IW + hd]) * (0.25f * 0.125f); } }
        u32x4 sg[4];
#define IDX_GLOAD(ch_) do { _Pragma("unroll") for (int i_ = 0; i_ < 4; ++i_) { int key_ = (ch_) * IDX_CH + ((tidx + 512 * i_) >> 3); key_ = key_ < limit ? key_ : limit - 1; \
            const bf16* kp_ = (key_ < ikn0 ? ik0 + (size_t)key_ * iks0 : ik1 + (size_t)(key_ - ikn0) * INP) + (tidx & 7) * 8; sg[i_] = *(const u32x4*)kp_; } } while (0)
#define IDX_LSTORE(buf_) do { _Pragma("unroll") for (int i_ = 0; i_ < 4; ++i_) *(LAS u32x4*)(IKS + (buf_) * (IDX_CH * IDX_STR) + ((tidx + 512 * i_) >> 3) * IDX_STR + (tidx & 7) * 16) = sg[i_]; } while (0)
#define IDX_FRAG(dst_, kb_, tl_) do { _Pragma("unroll") for (int ks_ = 0; ks_ < 4; ++ks_) dst_[ks_] = *(const LAS bf16x8*)((kb_) + (tl_) * (32 * IDX_STR) + ks_ * 32); } while (0)
        IDX_GLOAD(0);
        IDX_LSTORE(0);
        __syncthreads();
        const int nch = (NT + 7) >> 3;
#pragma unroll 1
        for (int ch = 0; ch < nch; ++ch) {
            if (ch + 1 < nch) IDX_GLOAD(ch + 1);
            const LAS unsigned char* kb = IKS + (ch & 1) * (IDX_CH * IDX_STR) + r * IDX_STR + hh * 16;
            const int t0 = ch * 8, tn = (NT - t0) < 8 ? (NT - t0) : 8;
            bf16x8 bk[4], bk1[4], bn[4], b2[4];
            IDX_FRAG(bn, kb, 0); IDX_FRAG(b2, kb, 1);
#define IDX_TRIP(tl_) do { const int tile_ = t0 + (tl_); \
                _Pragma("unroll") for (int ks = 0; ks < 4; ++ks) { bk[ks] = bn[ks]; bk1[ks] = b2[ks]; } \
                if ((tl_) + 2 < tn) { IDX_FRAG(bn, kb, (tl_) + 2); IDX_FRAG(b2, kb, (tl_) + 3); } \
                f32x16 acc[2][2]; \
                _Pragma("unroll") for (int tt = 0; tt < 2; ++tt) _Pragma("unroll") for (int np = 0; np < 2; ++np) _Pragma("unroll") for (int i = 0; i < 16; ++i) acc[tt][np][i] = 0.f; \
                _Pragma("unroll") for (int ks = 0; ks < 4; ++ks) _Pragma("unroll") for (int np = 0; np < 2; ++np) { acc[0][np] = mfma32(af[np][ks], bk[ks], acc[0][np]); acc[1][np] = mfma32(af[np][ks], bk1[ks], acc[1][np]); } \
                _Pragma("unroll") for (int tt = 0; tt < 2; ++tt) _Pragma("unroll") for (int np = 0; np < 2; ++np) { \
                    f32x2_t_ s0, s1; \
                    _Pragma("unroll") for (int j = 0; j < 4; ++j) { \
                        const f32x2_t_ x0 = {relu_i(acc[tt][np][2 * j]), relu_i(acc[tt][np][2 * j + 1])}, x1 = {relu_i(acc[tt][np][8 + 2 * j]), relu_i(acc[tt][np][9 + 2 * j])}; \
                        if (j == 0) { asm("v_pk_mul_f32 %0, %1, %2" : "=v"(s0) : "v"(x0), "v"(wt2[np][0])); asm("v_pk_mul_f32 %0, %1, %2" : "=v"(s1) : "v"(x1), "v"(wt2[np][4])); } \
                        else { asm("v_pk_fma_f32 %0, %1, %2, %0" : "+v"(s0) : "v"(x0), "v"(wt2[np][j])); \
                               asm("v_pk_fma_f32 %0, %1, %2, %0" : "+v"(s1) : "v"(x1), "v"(wt2[np][4 + j])); } } \
                    const float p0 = s0.x + s0.y, p1 = s1.x + s1.y; \
                    const auto rr = __builtin_amdgcn_permlane32_swap(__float_as_uint(p0), __float_as_uint(p1), false, false);      \
                    const int ql = 8 * w + 2 * ((pass & 1) * 2 + np) + hh; \
                    SC[(size_t)ql * 2048 + (tile_ + tt) * 32 + r] = __uint_as_float(rr[0]) + __uint_as_float(rr[1]); } } while (0)
            IDX_TRIP(0);
            if (ch + 1 < nch) IDX_LSTORE((ch + 1) & 1);
#pragma unroll 1
            for (int tl = 2; tl < tn; tl += 2) IDX_TRIP(tl);
#undef IDX_TRIP
            __syncthreads();
        }
    }
#undef IDX_GLOAD
#undef IDX_LSTORE
#undef IDX_FRAG
    asm volatile("s_waitcnt vmcnt(0)" ::: "memory");
    __builtin_amdgcn_fence(__ATOMIC_ACQUIRE, "agent");
    asm volatile("s_waitcnt vmcnt(0)" ::: "memory");
#pragma unroll 1
    for (int pq = 0; pq < 4 * REP_TOPK; ++pq) { const int pp = pq & 3;
        const float* SCq = SC + (size_t)(8 * w + 2 * pp + hh) * 2048; LAS unsigned* SELa = SEL + (8 * w + 2 * pp) * 64;
        if (NT <= 32) topk_pair<32>(SCq, SELa, NT, r, hh, lane);
        else topk_pair<64>(SCq, SELa, NT, r, hh, lane);
    }
    } else {
        for (int i = lane; i < 8 * 64; i += 64) SEL[8 * w * 64 + i] = ((i & 63) < NT) ? 0xffffffffu : 0u;
    }
    __syncthreads();
#pragma unroll 1
    for (int rep = 0; rep < REP_ATT; ++rep)
    attn_unit<0>(C, PROJ + (size_t)qrow0 * INP + C_AQ, INP, S, 0, NT, ws_bf(C, WS_MIX) + (size_t)qrow0 * DM, DM);
}

DI void band_unit(const Ctx& C, const Args& A, int l, int u) {
    const bf16* PROJ = ws_bf(C, WS_PU);
    int qrow0, tlo; KVSrc S;
    if (u < 256) { const int c = 31 - (u >> 3), b = u & 7; qrow0 = b * SEQ + c * 64; tlo = c < 8 ? (8 - c) * 2 : 0;
        const bf16* base = PROJ + ((ptrdiff_t)b * SEQ + c * 64 - BWIN) * INP;
        S.k0 = base + C_BK; S.v0 = base + C_BV; S.s0 = INP; S.n0 = BWIN + 64; S.k1 = S.k0; S.v1 = S.v0; S.s1 = INP;
    } else { const int b = u - 256; qrow0 = NTP + b * DSEQ; tlo = 0;
        const bf16* nb = PROJ + (size_t)qrow0 * INP;
        S.k0 = ws_bf(C, WS_CBK) + (size_t)b * BWIN * 512; S.v0 = ws_bf(C, WS_CBV) + (size_t)b * BWIN * 512; S.s0 = 512; S.n0 = BWIN; S.k1 = nb + C_BK; S.v1 = nb + C_BV; S.s1 = INP;
    }
    LAS float* bt = (LAS float*)(C.lds + ATT_SEL);
    const float* brel = A.in[12] + (size_t)l * 4 * 257;
    for (int i = C.tid; i < 4 * 257; i += NTHR) bt[i] = brel[i];
    __syncthreads();
    attn_unit<1>(C, PROJ + (size_t)qrow0 * INP + C_BQ, INP, S, tlo, (BWIN + 64) / 32, ws_bf(C, WS_MIX) + (size_t)qrow0 * DM + 512, DM);
}

DI void ssd_unit(const Ctx& C, const Args& A, int l, int row0, int nchunks, int h, const float* h0, float* hout) {
    int tid = C.tid, lane = C.lane; asm volatile("" : "+v"(tid), "+v"(lane));
    const int w = C.wave, r = lane & 31, hh = lane >> 5, g = h >> 2;
    LAS unsigned char* L = C.lds;
    LAS unsigned char* Cs = L + SSD_CS; LAS unsigned char* Bs = L + SSD_BS; LAS unsigned char* XD = L + SSD_XD; LAS unsigned char* XDW = L + SSD_XDW; LAS unsigned char* Ms = L + SSD_MS; LAS unsigned char* Ys = L + SSD_Y; LAS unsigned char* Ys2 = L + SSD_Y2;
    LAS float* v_acs = (LAS float*)(L + SSD_VEC); LAS float* v_e = v_acs + 64;
    const bf16* XBC = ws_bf(C, WS_XBC); const bf16* PROJ = ws_bf(C, WS_PU); const float* DTS = ws_f(C, WS_DTS); float* G = ws_f(C, WS_G);
    const float a_h = -expf(A.in[16][l * 16 + h]); const float dsk = A.in[17][l * 16 + h];
    const int erow = tid >> 3, ech = tid & 7;
    f32x16 Hacc[2];
#pragma unroll
    for (int pb = 0; pb < 2; ++pb)
#pragma unroll
        for (int i = 0; i < 16; ++i) Hacc[pb][i] = 0.f;
    u32x4 pC[2], pB[2], pX, pZ; float pDt;
#define SSD_LOAD(c_) do { const int rb_ = row0 + (c_) * 64; \
        _Pragma("unroll") for (int i_ = 0; i_ < 2; ++i_) { const int ci_ = tid + 512 * i_; const bf16* src_ = XBC + (size_t)(rb_ + (ci_ >> 4)) * 2048 + g * 128 + (ci_ & 15) * 8; pB[i_] = *(const u32x4*)(src_ + 1024); pC[i_] = *(const u32x4*)(src_ + 1536); } \
        pX = *(const u32x4*)(XBC + (size_t)(rb_ + erow) * 2048 + h * 64 + ech * 8); pZ = *(const u32x4*)(PROJ + (size_t)(rb_ + erow) * INP + C_CZ + h * 64 + ech * 8); \
        pDt = DTS[(size_t)(rb_ + lane) * 16 + h]; } while (0)
    SSD_LOAD(0);
    if (w >= 4 && h0) { const int nb = w - 4;
#pragma unroll
        for (int pb = 0; pb < 2; ++pb)
#pragma unroll
            for (int i = 0; i < 16; ++i) Hacc[pb][i] = h0[(32 * pb + crow(i, hh)) * 128 + 32 * nb + r]; }
    __syncthreads();
    if (w >= 4) { const int nb = w - 4;
#pragma unroll
        for (int pb = 0; pb < 2; ++pb)
#pragma unroll
            for (int i = 0; i < 16; ++i) { const int p = 32 * pb + crow(i, hh), n = 32 * nb + r; *(LAS bf16*)(L + SSD_HS + p * HSTR + n * 2) = f2bf(Hacc[pb][i]); } }
#pragma unroll 1
    for (int c = 0; c < nchunks; ++c) {
        const int rbase = row0 + c * 64;
        LAS unsigned char* Hcur = L + SSD_HS + (c & 1) * 64 * HSTR; LAS unsigned char* Hnxt = L + SSD_HS + ((c + 1) & 1) * 64 * HSTR;
        const float dtl = pDt; float acs = dtl * a_h;
#pragma unroll
        for (int o = 1; o < 64; o <<= 1) { const float t = __shfl_up(acs, o); if (lane >= o) acs += t; }
        const float Atot = __shfl(acs, 63);
        const float wl = __expf(Atot - acs);
        if (w == 0) { v_acs[lane] = acs; v_e[lane] = __expf(acs); }
#pragma unroll
        for (int i = 0; i < 2; ++i) { const int ci = tid + 512 * i, row = ci >> 4, ch = ci & 15; *(LAS u32x4*)(Bs + row * CSTR + ch * 16) = pB[i]; *(LAS u32x4*)(Cs + row * CSTR + ch * 16) = pC[i]; }
        float xraw[8]; unpack8(pX, xraw); const u32x4 zc = pZ;
        { float xd[8], xw[8]; const float dt = __shfl(dtl, erow & 63), wv = __shfl(wl, erow & 63);
#pragma unroll
          for (int k = 0; k < 8; ++k) { xd[k] = xraw[k] * dt; xw[k] = xd[k] * wv; }
          *(LAS u32x4*)(XD + erow * XSTR + ech * 16) = pack8(xd); *(LAS u32x4*)(XDW + erow * XSTR + ech * 16) = pack8(xw); }
        if (c + 1 < nchunks) SSD_LOAD(c + 1);
        __syncthreads();
        if (w < 4) {
            const int lb = w >> 1, sb = w & 1; f32x16 acc;
#pragma unroll
            for (int i = 0; i < 16; ++i) acc[i] = 0.f;
            if (sb <= lb) {
#pragma unroll
                for (int ks = 0; ks < 8; ++ks) { const bf16x8 a = *(const LAS bf16x8*)(Cs + (32 * lb + r) * CSTR + (16 * ks + 8 * hh) * 2), b = *(const LAS bf16x8*)(Bs + (32 * sb + r) * CSTR + (16 * ks + 8 * hh) * 2);
                    acc = mfma32(a, b, acc); } }
            const int s = 32 * sb + r; const float acs_s = v_acs[s];
#pragma unroll
            for (int i = 0; i < 16; ++i) { const int lr = 32 * lb + crow(i, hh); const float v = (s <= lr) ? acc[i] * __expf(v_acs[lr] - acs_s) : 0.f; *(LAS bf16*)(Ms + lr * MSTR + s * 2) = f2bf(v); }
        } else {
            const int nb = w - 4; const float dec = __expf(Atot);
#pragma unroll
            for (int pb = 0; pb < 2; ++pb) {
#pragma unroll
                for (int i = 0; i < 16; ++i) Hacc[pb][i] *= dec;
#pragma unroll
                for (int ks = 0; ks < 4; ++ks) { const bf16x8 a = trfrag(XDW, XSTR, 16 * ks, 32 * pb, lane), b = trfrag(Bs, CSTR, 16 * ks, 32 * nb, lane); Hacc[pb] = mfma32(a, b, Hacc[pb]); }
#pragma unroll
                for (int i = 0; i < 16; ++i) *(LAS bf16*)(Hnxt + (32 * pb + crow(i, hh)) * HSTR + (32 * nb + r) * 2) = f2bf(Hacc[pb][i]);
            }
        }
        __syncthreads();
        {
            const int lb = (w >> 1) & 1, pb = w & 1, p = 32 * pb + r; f32x16 yv;
#pragma unroll
            for (int i = 0; i < 16; ++i) yv[i] = 0.f;
            if (w < 4) {
#pragma unroll
                for (int ks = 0; ks < 4; ++ks) { const bf16x8 a = *(const LAS bf16x8*)(Ms + (32 * lb + r) * MSTR + (16 * ks + 8 * hh) * 2), b = trfrag(XD, XSTR, 16 * ks, 32 * pb, lane); yv = mfma32(a, b, yv); }
#pragma unroll
                for (int i = 0; i < 16; ++i) *(LAS float*)(Ys + (32 * lb + crow(i, hh)) * YSTR + p * 4) = yv[i];
            } else {
#pragma unroll
                for (int ks = 0; ks < 8; ++ks) { const bf16x8 a = *(const LAS bf16x8*)(Cs + (32 * lb + r) * CSTR + (16 * ks + 8 * hh) * 2), b = *(const LAS bf16x8*)(Hcur + (32 * pb + r) * HSTR + (16 * ks + 8 * hh) * 2); yv = mfma32(a, b, yv); }
#pragma unroll
                for (int i = 0; i < 16; ++i) { const int lr = 32 * lb + crow(i, hh); *(LAS float*)(Ys2 + lr * YSTR + p * 4) = v_e[lr] * yv[i]; }
            }
        }
        __syncthreads();
        {
            float z[8]; unpack8(zc, z);
            const f32x4 y0 = *(const LAS f32x4*)(Ys + erow * YSTR + ech * 32) + *(const LAS f32x4*)(Ys2 + erow * YSTR + ech * 32), y1 = *(const LAS f32x4*)(Ys + erow * YSTR + ech * 32 + 16) + *(const LAS f32x4*)(Ys2 + erow * YSTR + ech * 32 + 16);
            float y[8] = {y0.x, y0.y, y0.z, y0.w, y1.x, y1.y, y1.z, y1.w};
#pragma unroll
            for (int k = 0; k < 8; ++k) { const float yy = y[k] + dsk * xraw[k]; y[k] = yy * z[k] / (1.f + __expf(-z[k])); }
            float* gp = G + (size_t)(rbase + erow) * 1024 + h * 64 + ech * 8;
            ((f32x4*)gp)[0] = (f32x4){y[0], y[1], y[2], y[3]}; ((f32x4*)gp)[1] = (f32x4){y[4], y[5], y[6], y[7]};
        }
    }
#undef SSD_LOAD
    if (w >= 4) { const int nb = w - 4;
#pragma unroll
        for (int pb = 0; pb < 2; ++pb)
#pragma unroll
            for (int i = 0; i < 16; ++i) hout[(32 * pb + crow(i, hh)) * 128 + 32 * nb + r] = Hacc[pb][i]; }
}

DI void gate_norm_phase(const Ctx& C, const Args& A, int l) {
    const int gw = C.bid * NWAVES + C.wave, NGW = C.G * NWAVES; const float* gn = A.in[18] + (size_t)l * 1024;
    for (int m0 = gw; m0 < NTOK; m0 += 3 * NGW) {
        f32x4 v[3][4];
#pragma unroll
        for (int k = 0; k < 3; ++k) { const int m = m0 + k * NGW; const float* grow = ws_f(C, WS_G) + (size_t)(m < NTOK ? m : m0) * 1024;
#pragma unroll
            for (int g = 0; g < 4; ++g) v[k][g] = ((const f32x4*)grow)[g * 64 + C.lane]; }
#pragma unroll
        for (int k = 0; k < 3; ++k) { const int m = m0 + k * NGW; if (m < NTOK) { bf16* orow = ws_bf(C, WS_MIX) + (size_t)m * DM + 1024;
#pragma unroll
            for (int g = 0; g < 4; ++g) { const f32x4 x = v[k][g]; const float ss = wave_sum((x.x * x.x + x.y * x.y) + (x.z * x.z + x.w * x.w));
                const float rs = 1.0f / sqrtf(ss * (1.0f / 256.f) + EPS); const f32x4 wv = ((const f32x4*)gn)[g * 64 + C.lane]; const f32x4 o = x * rs * wv;
                u32x2 p; p.x = pk2(o.x, o.y); p.y = pk2(o.z, o.w); ((u32x2*)orow)[g * 64 + C.lane] = p; } } }
    }
}
DI void norm_phase(const Ctx& C, int rlo, int mode, const float* w) {
    const int gw = C.bid * NWAVES + C.wave, NGW = C.G * NWAVES;
    for (int m = rlo + gw; m < NTOK; m += NGW)
        res_row(ws_bf(C, WS_X) + (size_t)m * DM, m >= NTP ? ws_f(C, WS_G) + (size_t)(m - NTP) * DM : nullptr, (size_t)NTS * DM, mode, ws_f(C, WS_SSQ1) + (size_t)m * 32, w, C.out + (size_t)m * DM, C.lane);
}
DI void final_norm_phase(const Ctx& C, const float* w) {
    const int gw = C.bid * NWAVES + C.wave, NGW = C.G * NWAVES, lane = C.lane; const bf16* X = ws_bf(C, WS_X);
    u32x4 nx[4]; int m = gw;
    if (m < NTOK) {
#pragma unroll
        for (int j = 0; j < 4; ++j) nx[j] = ((const u32x4*)(X + (size_t)m * DM))[lane + 64 * j]; }
    for (; m < NTOK; m += NGW) {
        float v[4][8]; float ss = 0.f;
#pragma unroll
        for (int j = 0; j < 4; ++j) unpack8(nx[j], v[j]);
        const int mn = m + NGW;
        if (mn < NTOK) {
#pragma unroll
            for (int j = 0; j < 4; ++j) nx[j] = ((const u32x4*)(X + (size_t)mn * DM))[lane + 64 * j]; }
        const float* part = m >= NTP ? ws_f(C, WS_G) + (size_t)(m - NTP) * DM : nullptr;
#pragma unroll
        for (int j = 0; j < 4; ++j) {
            if (part) {
#pragma unroll
                for (int k = 0; k < 4; ++k) { const float* pp = part + k * ((size_t)NTS * DM) + 8 * (lane + 64 * j); const f32x4 a = *(const f32x4*)pp, b = *(const f32x4*)(pp + 4);
                    v[j][0] += a.x; v[j][1] += a.y; v[j][2] += a.z; v[j][3] += a.w; v[j][4] += b.x; v[j][5] += b.y; v[j][6] += b.z; v[j][7] += b.w; } }
#pragma unroll
            for (int k = 0; k < 8; ++k) ss += v[j][k] * v[j][k]; }
        ss = wave_sum(ss);
        const float rs = 1.0f / sqrtf(ss * (1.0f / DM) + EPS); float* outf = C.out + (size_t)m * DM;
#pragma unroll
        for (int j = 0; j < 4; ++j) { const float* wp = w + 8 * (lane + 64 * j); const f32x4 w0 = *(const f32x4*)wp, w1 = *(const f32x4*)(wp + 4); float* op = outf + 8 * (lane + 64 * j);
            *(f32x4*)op = (f32x4){v[j][0] * rs * w0.x, v[j][1] * rs * w0.y, v[j][2] * rs * w0.z, v[j][3] * rs * w0.w};
            *(f32x4*)(op + 4) = (f32x4){v[j][4] * rs * w1.x, v[j][5] * rs * w1.y, v[j][6] * rs * w1.z, v[j][7] * rs * w1.w}; }
    }
}
DI void zero_f32(const Ctx& C, float* p, int n) { for (int i = C.bid * NTHR + C.tid; i < n; i += C.G * NTHR) p[i] = 0.f; }

#ifndef WCONV_A
#define WCONV_A 8
#endif
#ifndef WCONV_B
#define WCONV_B 9
#endif
#ifndef G_ALIGN
#define G_ALIGN true
#endif
#ifndef G_ALIGN_RES
#define G_ALIGN_RES true
#endif
#ifndef G_SP2
#define G_SP2 true
#endif
#ifndef STAGGER_TICKS
#define STAGGER_TICKS 0
#endif
DI void stagger(const Ctx& C, int ticks) {
    if (ticks > 0 && (C.bid & 1)) { const unsigned long long t0 = __builtin_amdgcn_s_memrealtime(); while (__builtin_amdgcn_s_memrealtime() - t0 < (unsigned long long)ticks) __builtin_amdgcn_s_sleep(8); }
}
template <class Sched>
DI void build_rstd_table(const Ctx& C, const Sched& S, const float* SSQ, LAS float* tab) {
    pg8::Unit u;
    for (int i = 0; S.next(i, u); ++i)
        if (C.tid < 256) { const f32x4* p = (const f32x4*)(SSQ + (size_t)(u.pm * 256 + C.tid) * 32); f32x4 a = p[0];
#pragma unroll
            for (int j = 1; j < 8; ++j) a += p[j];
            tab[i * 256 + C.tid] = 1.0f / sqrtf(((a.x + a.y) + (a.z + a.w)) * (1.0f / DM) + EPS); }
    __syncthreads();
}
#ifndef MK_ONE_LAUNCH
#define MK_ONE_LAUNCH 1
#endif
#ifndef PHASE_MASK
#define PHASE_MASK 0xFFFF
#endif
#define EN(k) (((PHASE_MASK) >> (k)) & 1)
constexpr int PH_PER_LAYER = 8, NPHASE = 1 + DEPTH * PH_PER_LAYER;
__global__ void __launch_bounds__(NTHR, 2) fwd(Args args) {
    extern __shared__ __attribute__((aligned(16))) unsigned char lds_raw[];
    Ctx C;
    C.lds = (LAS unsigned char*)lds_raw;
    C.tid = threadIdx.x; C.lane = C.tid & 63; C.wave = __builtin_amdgcn_readfirstlane(C.tid >> 6); C.G = gridDim.x; C.bid = blockIdx.x;
    C.ws = args.ws; C.out = args.out; C.ctl = (unsigned*)(args.ws + WS_CTL);
    const Args& A = args;
    for (int u = C.tid; u < (LDS_BYTES - LDSCTL_OFF) / 4; u += NTHR) ((LAS unsigned*)(C.lds + LDSCTL_OFF))[u] = 0u;
    __syncthreads();
    const int lo = args.ph_lo, hi = args.ph_hi;
    const bool multi = (hi - lo) > 1;
    XcdBarrier bar; bar.bar = C.ctl + CW_BAR; bar.x = 0; bar.st = (volatile LAS unsigned*)(C.lds + LDSCTL_OFF);
    if (multi) bar = xcd_barrier_post(C.ctl + CW_BAR, (volatile LAS unsigned*)(C.lds + LDSCTL_OFF));
#define IN(k) (lo <= (k) && (k) < hi)
#define FRESH() do { int t_ = threadIdx.x; asm volatile("" : "+v"(t_)); C.tid = t_; C.lane = t_ & 63; int w_ = __builtin_amdgcn_readfirstlane(t_ >> 6); asm volatile("" : "+s"(w_)); C.wave = w_; } while (0)
#define SEAM(k) do { if (IN((k) + 1)) xcd_barrier(bar); } while (0)

    if (EN(0) && IN(0)) { p0_prologue(C, A);
#if defined(PROBE_P02)
        __syncthreads(); p0_prologue(C, A);
#endif
        SEAM(0); }
#pragma unroll 1
    for (int l = 0; l < DEPTH; ++l) {
        const int pb = 1 + PH_PER_LAYER * l;
        if (EN(1) && IN(pb + 0)) { FRESH();
            pg8::Gemm g{ws_bf(C, WS_X), w_in_t(C, l), NTOK, INP, DM, DM};
            pg8::ListOrder S; S.list = (const LAS int*)(C.lds + LDS_ULIST);
            { pg8::WinOrder W; W.init(C.G, C.bid); pg8::Unit u; int n = 0; while (W.next(n, u)) { if (C.tid == 0) ((LAS int*)(C.lds + LDS_ULIST))[n] = (u.pm << 8) | u.pn; ++n; } S.n = n; }
            __syncthreads();
            build_rstd_table(C, S, ws_f(C, WS_SSQ1), (LAS float*)(C.lds + LDS_RSTD));
            pg8::EpiBf16<0> E{ws_bf(C, WS_PU), INP, (const LAS float*)(C.lds + LDS_RSTD)};
            pg8::gemm_phase<pg8::EpiBf16<0>, pg8::ListOrder, G_ALIGN, G_SP2>(C.lds, g, S, E);
#if defined(PROBE_G)
            if (PROBE_G & 1) { __syncthreads(); pg8::gemm_phase<pg8::EpiBf16<0>, pg8::StaticOrder, G_ALIGN, G_SP2>(C.lds, g, S, E); }
#endif
            if (l == 0) cache_convert(C, A, 0);
            SEAM(pb + 0);
        }
        if (EN(2) && IN(pb + 1)) { FRESH(); m0_phase(C, A, l);
#if defined(PROBE_BAR)
            for (int i = 0; i < PROBE_BAR; ++i) xcd_barrier(bar);
#endif
            SEAM(pb + 1); }
        if (IN(pb + 2)) { FRESH();
            unsigned* qh = C.ctl + CW_Q + 64 * (l * 4);
            unsigned* flg = C.ctl + CW_H + 64 * (l * 14);
            if (EN(3)) { unsigned* qg = C.ctl + CW_Q + 64 * (48 + l);
                for (;;) { const int u = q_next(C, qg); if (u >= 42) break;
                    pg8::Gemm g{ws_bf(C, WS_X), w_in_t(C, l), NTOK, INP, DM, DM}; pg8::OneUnit S1{58 + u / 3, 17 + u % 3};
                    build_rstd_table(C, S1, ws_f(C, WS_SSQ1), (LAS float*)(C.lds + LDS_RSTD));
                    pg8::EpiBf16<0> E{ws_bf(C, WS_PU), INP, (const LAS float*)(C.lds + LDS_RSTD)};
                    pg8::gemm_phase<pg8::EpiBf16<0>, pg8::OneUnit, G_ALIGN, G_SP2>(C.lds, g, S1, E);
                    asm volatile("s_waitcnt vmcnt(0)" ::: "memory"); __syncthreads();
                    if (C.tid == 0) { __builtin_amdgcn_fence(__ATOMIC_RELEASE, "agent"); asm volatile("s_waitcnt vmcnt(0)" ::: "memory"); xb_add(&flg[64 * (u / 3)], 1u); } } }
            if (EN(4)) for (;;) { const int u = q_next(C, qh + 64); if (u >= 288) break; dsa_unit(C, l, u); }
            if (EN(3)) for (;;) { const int u = q_next(C, qh); if (u >= NB * 16) break;
                if ((u >> 4) == NB - 1) wait_flags(C, flg, 0, 6);
                ssd_unit(C, A, l, (u >> 4) * SEQ, SEQ / 64, u & 15, nullptr, C.out + OFF_P_SSM + ((size_t)(l * NB + (u >> 4)) * 16 + (u & 15)) * 8192); }
            if (EN(5)) { int u = q_next(C, qh + 128); while (u < 288) { const int nx = q_prefetch(C, qh + 128); band_unit(C, A, l, u); u = q_publish(C, nx); } }
            if (EN(3)) { int u = q_next(C, qh + 192); while (u < DBAT * 16) { const int nx = q_prefetch(C, qh + 192);
                wait_flags(C, flg, 6 + (u >> 6), 1);
                ssd_unit(C, A, l, NTP + (u >> 4) * DSEQ, 1, u & 15, A.in[7] + ((size_t)(l * DBAT + (u >> 4)) * 16 + (u & 15)) * 8192, C.out + OFF_S_SSM + ((size_t)(l * DBAT + (u >> 4)) * 16 + (u & 15)) * 8192);
                u = q_publish(C, nx); } }
#if defined(PROBE_MIXK)
            { unsigned* qh2 = C.ctl + CW_Q + 64 * (16 + l * 4);
            if (PROBE_MIXK & 1) for (;;) { const int u = q_next(C, qh2); if (u >= NB * 16) break;
                ssd_unit(C, A, l, (u >> 4) * SEQ, SEQ / 64, u & 15, nullptr, C.out + OFF_P_SSM + ((size_t)(l * NB + (u >> 4)) * 16 + (u & 15)) * 8192); }
            if (PROBE_MIXK & 2) for (;;) { const int u = q_next(C, qh2 + 64); if (u >= 288) break; dsa_unit(C, l, u); }
            if (PROBE_MIXK & 4) for (;;) { const int u = q_next(C, qh2 + 128); if (u >= 288) break; band_unit(C, A, l, u); }
            if (PROBE_MIXK & 8) for (;;) { const int u = q_next(C, qh2 + 192); if (u >= DBAT * 16) break;
                ssd_unit(C, A, l, NTP + (u >> 4) * DSEQ, 1, u & 15, A.in[7] + ((size_t)(l * DBAT + (u >> 4)) * 16 + (u & 15)) * 8192, C.out + OFF_S_SSM + ((size_t)(l * DBAT + (u >> 4)) * 16 + (u & 15)) * 8192); } }
#endif
            SEAM(pb + 2);
        }
        if (EN(6) && IN(pb + 3)) { FRESH(); gate_norm_phase(C, A, l);
#if defined(PROBE_GATE2)
            gate_norm_phase(C, A, l);
#endif
            SEAM(pb + 3); }
        if (EN(7) && IN(pb + 4)) { FRESH();
            pg8::Gemm g{ws_bf(C, WS_MIX), w_out_t(C, l), NTOK, DM, DM, DM}; pg8::StaticOrder S; S.init(NTOK, DM, C.G, C.bid);
            pg8::EpiResBf16 E{ws_bf(C, WS_X), DM, ws_f(C, WS_SSQ2), 1};
#if defined(PROBE_G)
            if (PROBE_G & 4) { pg8::EpiNull E2; pg8::gemm_phase<pg8::EpiNull, pg8::StaticOrder, G_ALIGN, G_SP2>(C.lds, g, S, E2); __syncthreads(); }
#endif
            pg8::gemm_phase<pg8::EpiResBf16, pg8::StaticOrder, G_ALIGN_RES, G_SP2>(C.lds, g, S, E);
            if (l + 1 < DEPTH) cache_convert(C, A, l + 1);
            SEAM(pb + 4);
        }
        if (EN(9) && IN(pb + 5)) { FRESH();
            pg8::Gemm g{ws_bf(C, WS_X), w_up_t(C, l), NTOK, DFF, DM, DM}; pg8::StaticOrder S; S.init(NTOK, DFF, C.G, C.bid);
            build_rstd_table(C, S, ws_f(C, WS_SSQ2), (LAS float*)(C.lds + LDS_RSTD));
            pg8::EpiBf16<1> E{ws_bf(C, WS_PU), DFF, (const LAS float*)(C.lds + LDS_RSTD)};
#if defined(PROBE_G)
            if (PROBE_G & 2) { pg8::gemm_phase<pg8::EpiBf16<1>, pg8::StaticOrder, G_ALIGN, G_SP2>(C.lds, g, S, E); __syncthreads(); }
            if (PROBE_G & 256) { pg8::EpiNull E2; pg8::HotOrder S2{9, C.bid}; pg8::gemm_phase<pg8::EpiNull, pg8::HotOrder, G_ALIGN, G_SP2>(C.lds, g, S2, E2); __syncthreads(); }
            if (PROBE_G & 128) { pg8::EpiNull E2; pg8::gemm_phase<pg8::EpiNull, pg8::StaticOrder, G_ALIGN, G_SP2>(C.lds, g, S, E2); __syncthreads(); }
#endif
            pg8::gemm_phase<pg8::EpiBf16<1>, pg8::StaticOrder, G_ALIGN, G_SP2>(C.lds, g, S, E);
            SEAM(pb + 5);
        }
        if (EN(10) && IN(pb + 6)) { FRESH();
#if defined(PROBE_G)
            if (PROBE_G & 8) { pg8::Gemm g{ws_bf(C, WS_PU), w_dn_t(C, l), NTP, DM, DFF, DFF}; pg8::StaticOrder S; S.init(NTP, DM, C.G, C.bid);
              pg8::EpiNull E2; pg8::gemm_phase<pg8::EpiNull, pg8::StaticOrder, G_ALIGN, G_SP2>(C.lds, g, S, E2); __syncthreads(); }
            if (PROBE_G & 16) { pg8::Gemm g{ws_bf(C, WS_PU), w_dn_t(C, l), NTOK, DM, DFF / 4, DFF}; pg8::SplitOrder S; S.init(NTP / 256, NTS / 256, DM / 256, 4, C.G, C.bid);
              pg8::EpiSplitPart E{ws_f(C, WS_G), DM, (size_t)NTS * DM, NTP};
              pg8::gemm_phase<pg8::EpiSplitPart, pg8::SplitOrder, G_ALIGN, G_SP2>(C.lds, g, S, E); __syncthreads(); }
#endif
            { pg8::Gemm g{ws_bf(C, WS_PU), w_dn_t(C, l), NTP, DM, DFF, DFF}; pg8::StaticOrder S; S.init(NTP, DM, C.G, C.bid);
              pg8::EpiResBf16 E{ws_bf(C, WS_X), DM, ws_f(C, WS_SSQ1), l + 1 < DEPTH ? 1 : 0};
              pg8::gemm_phase<pg8::EpiResBf16, pg8::StaticOrder, G_ALIGN_RES, G_SP2>(C.lds, g, S, E); }
            __syncthreads();
            { pg8::Gemm g{ws_bf(C, WS_PU), w_dn_t(C, l), NTOK, DM, DFF / 4, DFF}; pg8::SplitOrder S; S.init(NTP / 256, NTS / 256, DM / 256, 4, C.G, C.bid);
              pg8::EpiSplitPart E{ws_f(C, WS_G), DM, (size_t)NTS * DM, NTP};
              pg8::gemm_phase<pg8::EpiSplitPart, pg8::SplitOrder, G_ALIGN, G_SP2>(C.lds, g, S, E); }
            SEAM(pb + 6);
        }
        if (EN(8) && IN(pb + 7)) { FRESH();
            if (l + 1 < DEPTH) norm_phase(C, NTP, 0, nullptr);
            else final_norm_phase(C, A.in[22]);
            SEAM(pb + 7);
        }
    }
#undef IN
#undef SEAM
}

extern "C" void kernel_launch(void* const* d_in, const int* in_sizes, int n_in, void* d_out, int out_size, void* d_ws, size_t ws_size, hipStream_t stream) {
    static int grid = 0;
    if (grid == 0) {
        if (n_in != 23 || in_sizes[0] != NTP * DM || (size_t)out_size != OUT_TOTAL || ws_size < WS_END) {
            fprintf(stderr, "kernel_launch: unexpected shapes (n_in %d, in0 %d, out %d, ws %zu; need ws >= %zu); nothing launched\n", n_in, n_in > 0 ? in_sizes[0] : -1, out_size, ws_size, (size_t)WS_END); grid = -1; return; }
        int dev = 0, cus = 0, per_cu = 0;
        if (hipGetDevice(&dev) != hipSuccess || hipDeviceGetAttribute(&cus, hipDeviceAttributeMultiprocessorCount, dev) != hipSuccess) { fprintf(stderr, "kernel_launch: device query failed\n"); grid = -1; return; }
        if (hipFuncSetAttribute((const void*)fwd, hipFuncAttributeMaxDynamicSharedMemorySize, LDS_BYTES) != hipSuccess) { fprintf(stderr, "kernel_launch: hipFuncSetAttribute failed\n"); grid = -1; return; }
        if (hipOccupancyMaxActiveBlocksPerMultiprocessor(&per_cu, (const void*)fwd, NTHR, LDS_BYTES) != hipSuccess || per_cu < 1)
            fprintf(stderr, "kernel_launch: note: occupancy query reports %d workgroups per CU\n", per_cu);
        (void)hipGetLastError();
        grid = cus < 256 ? cus : 256;
    }
    if (grid < 0) return;
    if (hipMemsetAsync((char*)d_ws + WS_CTL, 0, CTL_ZERO_BYTES, stream) != hipSuccess) { fprintf(stderr, "kernel_launch: memset failed\n"); return; }
    Args a{};
    for (int i = 0; i < 23; ++i) a.in[i] = (const float*)d_in[i];
    a.out = (float*)d_out; a.ws = (unsigned char*)d_ws;
#if MK_ONE_LAUNCH
    a.ph_lo = 0; a.ph_hi = NPHASE;
    hipLaunchKernelGGL(fwd, dim3(grid), dim3(NTHR), LDS_BYTES, stream, a);
#else
    for (int p = 0; p < NPHASE; ++p) { a.ph_lo = p; a.ph_hi = p + 1; hipLaunchKernelGGL(fwd, dim3(grid), dim3(NTHR), LDS_BYTES, stream, a); }
#endif
    const hipError_t le = hipPeekAtLastError();
    if (le != hipSuccess) fprintf(stderr, "kernel_launch: launch failed: %s\n", hipGetErrorName(le));
}
```
